# Optimizing an MI355X kernel written in HIP

```python
import math
import jax, jax.numpy as jnp
from jax import lax
import numpy as np

D_MODEL = 2048
BATCH = 1
SEQ = 8192
DEPTH = 4

GRID_W = 64
CTX_LEN = 256
N_EVEN = (DEPTH + 1) // 2
N_ODD = DEPTH // 2
EPS = 1e-6
MIX = D_MODEL

A_HEADS = 8
A_DV = MIX // 2 // A_HEADS
A_DK = A_DV // 2
A_CHUNK = 64
FORGET_BIAS = 3.0

B_HEADS = 8
B_KV_HEADS = 2
B_DH = MIX // 2 // B_HEADS
B_WINDOW = 128
ROPE_THETA = 10000.0

C_HEADS = 16
C_DH = MIX // C_HEADS
NA_KH = 8
NA_KW = 16

P_HEADS = 8
P_NKEYS = 128
P_EXPERTS = P_NKEYS * P_NKEYS
P_TOPK = 16
P_DKEY = 256
P_BLOCK = 128

AB_SIZES = (A_HEADS * A_DK, A_HEADS * A_DK, A_HEADS * A_DV, A_HEADS * A_DV, 4 * A_HEADS,
            B_HEADS * B_DH, B_KV_HEADS * B_DH, B_KV_HEADS * B_DH)
AB_IN = sum(AB_SIZES)
AB_SPLITS = tuple(sum(AB_SIZES[:i + 1]) for i in range(len(AB_SIZES) - 1))

F32 = jnp.float32

kernel_name = "hybrid_mlstm_swa_natten_peer_dit"


def rmsnorm(x, g):
    x32 = x.astype(F32)
    y = x32 * lax.rsqrt(jnp.mean(x32 * x32, axis=-1, keepdims=True) + EPS)
    return (y * g.astype(F32)).astype(x.dtype)


def modulate(h, shift, scale):
    return h * (1 + scale) + shift


def rope_1d(x, pos):
    half = x.shape[-1] // 2
    freqs = ROPE_THETA ** (-jnp.arange(half, dtype=F32) / half)
    ang = pos.astype(F32)[:, None] * freqs[None, :]
    cos, sin = jnp.cos(ang)[:, None, :], jnp.sin(ang)[:, None, :]
    x1, x2 = x[..., :half].astype(F32), x[..., half:].astype(F32)
    return jnp.concatenate([x1 * cos - x2 * sin, x2 * cos + x1 * sin], -1).astype(x.dtype)


def rope_axial_2d(x):
    t = jnp.arange(x.shape[1])
    d2 = x.shape[-1] // 2
    return jnp.concatenate([rope_1d(x[..., :d2], t // GRID_W), rope_1d(x[..., d2:], t % GRID_W)], -1)


def mlstm_scan(q, k, v, ig, lf, state):
    b_, h_, t_, _ = q.shape
    nc = t_ // A_CHUNK

    def chunks(a):
        a = a.reshape(a.shape[:2] + (nc, A_CHUNK) + a.shape[3:])
        return jnp.moveaxis(a, 2, 0)

    tril = jnp.tril(jnp.ones((A_CHUNK, A_CHUNK), bool))

    def step(carry, xs):
        C, n, m = carry
        qc, kc, vc, ic, fc = xs
        F = jnp.cumsum(fc, axis=-1)
        Dm = jnp.where(tril, F[..., :, None] - F[..., None, :] + ic[..., None, :], -jnp.inf)
        inter = F + m[..., None]
        mt = jnp.maximum(inter, Dm.max(-1))
        Sw = jnp.einsum('bhtd,bhsd->bhts', qc, kc) * jnp.exp(Dm - mt[..., None])
        a = jnp.exp(inter - mt)
        num = a[..., None] * jnp.einsum('bhed,bhtd->bhte', C, qc) + jnp.einsum('bhts,bhse->bhte', Sw, vc)
        den = a * jnp.einsum('bhd,bhtd->bht', n, qc) + Sw.sum(-1)
        hc = num / jnp.maximum(jnp.abs(den), jnp.exp(-mt))[..., None]
        FL = F[..., -1]
        wend = FL[..., None] - F + ic
        m_new = jnp.maximum(FL + m, wend.max(-1))
        decay = jnp.exp(FL + m - m_new)
        wv = jnp.exp(wend - m_new[..., None])
        C_new = decay[..., None, None] * C + jnp.einsum('bhs,bhse,bhsd->bhed', wv, vc, kc)
        n_new = decay[..., None] * n + jnp.einsum('bhs,bhsd->bhd', wv, kc)
        return (C_new, n_new, m_new), hc

    state, h = lax.scan(step, state, tuple(chunks(a) for a in (q, k, v, ig, lf)))
    h = jnp.moveaxis(h, 0, 2).reshape(b_, h_, t_, A_DV)
    return h, state


def mlstm_bidir(qc, kc, vc, gc, ql, kl, vl, gl):
    b_ = ql.shape[0]
    zero = (jnp.zeros((b_, A_HEADS, A_DV, A_DK), F32), jnp.zeros((b_, A_HEADS, A_DK), F32),
            jnp.zeros((b_, A_HEADS), F32))
    hc_sum, hl_sum = None, None
    for d in range(2):
        flip = (lambda a: jnp.flip(a, axis=2)) if d == 1 else (lambda a: a)
        ig_c, lf_c = gc[..., 2 * d], jax.nn.log_sigmoid(gc[..., 2 * d + 1])
        ig_l, lf_l = gl[..., 2 * d], jax.nn.log_sigmoid(gl[..., 2 * d + 1])
        h_c, st = mlstm_scan(flip(qc), flip(kc), flip(vc), flip(ig_c), flip(lf_c), zero)
        h_l, _ = mlstm_scan(flip(ql), flip(kl), flip(vl), flip(ig_l), flip(lf_l), st)
        h_c, h_l = flip(h_c), flip(h_l)
        hc_sum = h_c if hc_sum is None else hc_sum + h_c
        hl_sum = h_l if hl_sum is None else hl_sum + h_l
    return hc_sum, hl_sum


def window_gqa(qc, kc, vc, ql, kl, vl, sink, with_ctx):
    b_, t_ = ql.shape[:2]
    lc = kc.shape[1]
    g_ = B_HEADS // B_KV_HEADS
    w_ = B_WINDOW
    nb = t_ // w_
    scale = B_DH ** -0.5
    qb = ql.reshape(b_, nb, w_, B_KV_HEADS, g_, B_DH)

    def band(a):
        ap = jnp.pad(a, ((0, 0), (w_, w_), (0, 0), (0, 0))).reshape(b_, nb + 2, w_, B_KV_HEADS, B_DH)
        return jnp.concatenate([ap[:, :-2], ap[:, 1:-1], ap[:, 2:]], axis=2)

    kw, vw = band(kl), band(vl)
    blk = jnp.arange(nb)[:, None, None] * w_
    qpos = blk + jnp.arange(w_)[None, :, None]
    kpos = blk - w_ + jnp.arange(3 * w_)[None, None, :]
    valid = (jnp.abs(kpos - qpos) <= w_) & (kpos >= 0) & (kpos < t_)
    s_loc = jnp.einsum('bnqhgd,bnkhd->bnhgqk', qb, kw).astype(F32) * scale
    s_loc = jnp.where(valid[None, :, None, None], s_loc, -jnp.inf)
    s_ctx = jnp.einsum('bnqhgd,bchd->bnhgqc', qb, kc).astype(F32) * scale
    sk = sink.astype(F32).reshape(B_KV_HEADS, g_)[:, :, None, None]
    s_snk = jnp.broadcast_to(sk, s_loc.shape[:-1] + (1,))
    p = jax.nn.softmax(jnp.concatenate([s_loc, s_ctx, s_snk], -1), axis=-1).astype(vl.dtype)
    out = (jnp.einsum('bnhgqk,bnkhd->bnqhgd', p[..., :3 * w_], vw)
           + jnp.einsum('bnhgqc,bchd->bnqhgd', p[..., 3 * w_:3 * w_ + lc], vc))
    yl = out.reshape(b_, t_, B_HEADS * B_DH)
    if not with_ctx:
        return None, yl
    qcg = qc.reshape(b_, lc, B_KV_HEADS, g_, B_DH)
    s = jnp.einsum('bqhgd,bkhd->bhgqk', qcg, kc).astype(F32) * scale
    s_snk = jnp.broadcast_to(sk, s.shape[:-1] + (1,))
    p = jax.nn.softmax(jnp.concatenate([s, s_snk], -1), axis=-1).astype(vc.dtype)
    yc = jnp.einsum('bhgqk,bkhd->bqhgd', p[..., :lc], vc).reshape(b_, lc, B_HEADS * B_DH)
    return yc, yl


def mixer_ab(hc, hl, w_in, gate_b, mh_g, sink, w_out, with_ctx):
    def project(h):
        b_, t_ = h.shape[:2]
        aq, ak, av, ao, ag, bq, bk, bv = jnp.split(h @ w_in, AB_SPLITS, axis=-1)
        hd = lambda a, n: jnp.moveaxis(a.reshape(b_, t_, n, -1).astype(F32), 2, 1)
        gates = jnp.transpose((ag + gate_b).astype(F32).reshape(b_, t_, 4, A_HEADS), (0, 3, 1, 2))
        return (hd(aq, A_HEADS) * A_DK ** -0.5, hd(ak, A_HEADS), hd(av, A_HEADS), gates, ao,
                bq.reshape(b_, t_, B_HEADS, B_DH), bk.reshape(b_, t_, B_KV_HEADS, B_DH),
                bv.reshape(b_, t_, B_KV_HEADS, B_DH))

    cq, ck, cv, cg, co, cbq, cbk, cbv = project(hc)
    lq, lk, lv, lg, lo, lbq, lbk, lbv = project(hl)
    hA_c, hA_l = mlstm_bidir(cq, ck, cv, cg, lq, lk, lv, lg)

    def a_out(h, o):
        h = jnp.moveaxis(h, 1, 2)
        h = h * lax.rsqrt(jnp.mean(h * h, axis=-1, keepdims=True) + EPS)
        b_, t_ = h.shape[:2]
        return (h.reshape(b_, t_, -1) * mh_g.astype(F32)).astype(o.dtype) * jax.nn.sigmoid(o)

    yB_c, yB_l = window_gqa(cbq, cbk, cbv, rope_axial_2d(lbq), rope_axial_2d(lbk), lbv, sink, with_ctx)
    yl = jnp.concatenate([a_out(hA_l, lo), yB_l], -1) @ w_out
    yc = (jnp.concatenate([a_out(hA_c, co), yB_c], -1) @ w_out) if with_ctx else None
    return yc, yl


def neighborhood_attn(qc, kc, vc, ql, kl, vl, rpb, with_ctx):
    b_, t_ = ql.shape[:2]
    lc = kc.shape[1]
    rows = t_ // GRID_W
    kh = min(NA_KH, rows)
    scale = C_DH ** -0.5
    r = jnp.arange(rows)
    row_idx = jnp.clip(r - kh // 2, 0, rows - kh)[:, None] + jnp.arange(kh)[None, :]
    col = jnp.arange(GRID_W)
    c0 = jnp.clip(col - NA_KW // 2, 0, GRID_W - NA_KW)
    col_ok = (col[None, :] >= c0[:, None]) & (col[None, :] < c0[:, None] + NA_KW)
    qg = ql.reshape(b_, rows, GRID_W, C_HEADS, C_DH)
    kband = kl.reshape(b_, rows, GRID_W, C_HEADS, C_DH)[:, row_idx]
    vband = vl.reshape(b_, rows, GRID_W, C_HEADS, C_DH)[:, row_idx]
    s_loc = jnp.einsum('brqhd,brakhd->brhqak', qg, kband).astype(F32) * scale
    dr = row_idx - r[:, None] + (NA_KH - 1)
    dc = jnp.clip(col[None, :] - col[:, None] + (NA_KW - 1), 0, 2 * NA_KW - 2)
    bias = rpb.astype(F32)[:, dr[:, None, :, None], dc[None, :, None, :]]
    s_loc = jnp.where(col_ok[:, None, :], s_loc + jnp.moveaxis(bias, 0, 1)[None], -jnp.inf)
    s_loc = s_loc.reshape(b_, rows, C_HEADS, GRID_W, kh * GRID_W)
    s_ctx = jnp.einsum('brqhd,bchd->brhqc', qg, kc).astype(F32) * scale
    p = jax.nn.softmax(jnp.concatenate([s_loc, s_ctx], -1), axis=-1).astype(vl.dtype)
    out = (jnp.einsum('brhqk,brkhd->brqhd', p[..., :kh * GRID_W],
                      vband.reshape(b_, rows, kh * GRID_W, C_HEADS, C_DH))
           + jnp.einsum('brhqc,bchd->brqhd', p[..., kh * GRID_W:], vc))
    yl = out.reshape(b_, t_, C_HEADS * C_DH)
    if not with_ctx:
        return None, yl
    s = jnp.einsum('bqhd,bkhd->bhqk', qc, kc).astype(F32) * scale
    p = jax.nn.softmax(s, axis=-1).astype(vc.dtype)
    yc = jnp.einsum('bhqk,bkhd->bqhd', p, vc).reshape(b_, lc, C_HEADS * C_DH)
    return yc, yl


def mixer_c(hc, hl, w_in, rpb, w_out, with_ctx):
    def project(h):
        b_, t_ = h.shape[:2]
        q, k, v = jnp.split(h @ w_in, 3, axis=-1)
        return tuple(a.reshape(b_, t_, C_HEADS, C_DH) for a in (q, k, v))

    cq, ck, cv = project(hc)
    lq, lk, lv = project(hl)
    yc, yl = neighborhood_attn(cq, ck, cv, lq, lk, lv, rpb, with_ctx)
    return ((yc @ w_out) if with_ctx else None), yl @ w_out


def peer(h, wq, keys, u, v):
    b_, n_, d_ = h.shape
    q = (h @ wq).reshape(b_, n_, P_HEADS, 2, P_DKEY // 2)
    s = jnp.einsum('bnhpd,hpkd->bnhpk', q, keys).astype(F32)
    s1, i1 = lax.top_k(s[..., 0, :], P_TOPK)
    s2, i2 = lax.top_k(s[..., 1, :], P_TOPK)
    cand = (s1[..., :, None] + s2[..., None, :]).reshape(b_, n_, P_HEADS, P_TOPK * P_TOPK)
    cidx = (i1[..., :, None] * P_NKEYS + i2[..., None, :]).reshape(b_, n_, P_HEADS, P_TOPK * P_TOPK)
    sc, pos = lax.top_k(cand, P_TOPK)
    idx = jnp.take_along_axis(cidx, pos, axis=-1)
    g = jax.nn.softmax(sc, axis=-1).astype(h.dtype)
    nblk = (b_ * n_) // P_BLOCK
    xb = h.reshape(nblk, P_BLOCK, d_)
    ib = idx.reshape(nblk, P_BLOCK, P_HEADS * P_TOPK)
    gb = g.reshape(nblk, P_BLOCK, P_HEADS * P_TOPK)

    def expert_block(args):
        xk, ik, gk = args
        act = jax.nn.gelu(jnp.einsum('td,tkd->tk', xk, u[ik]), approximate=False)
        return jnp.einsum('tk,tkd->td', gk * act, v[ik])

    return lax.map(expert_block, (xb, ib, gb)).reshape(b_, n_, d_)


def _nrm(k, shape, scale):
    return jax.random.normal(k, shape, F32) * scale


def setup_inputs(seed: int = 0) -> dict:
    key = jax.random.key(seed)
    ks = jax.random.split(key, 21)
    D = D_MODEL
    gate_base = jnp.repeat(jnp.array([0.0, FORGET_BIAS, 0.0, FORGET_BIAS], F32), A_HEADS)
    return {
        "x": _nrm(ks[0], (BATCH, SEQ, D), 1.0),
        "c": _nrm(ks[1], (BATCH, D), 1.0),
        "ctx": _nrm(ks[2], (BATCH, CTX_LEN, D), 1.0),
        "c_ctx": _nrm(ks[3], (D,), 1.0),
        "ada_w": _nrm(ks[4], (DEPTH, D, 6 * D), 0.5 * D ** -0.5),
        "ada_b": _nrm(ks[5], (DEPTH, 6 * D), 0.02),
        "norm1_g": 1.0 + _nrm(ks[6], (DEPTH, D), 0.02),
        "norm2_g": 1.0 + _nrm(ks[7], (DEPTH, D), 0.02),
        "ab_w_in": _nrm(ks[8], (N_EVEN, D, AB_IN), D ** -0.5),
        "ab_gate_b": gate_base + _nrm(ks[9], (N_EVEN, 4 * A_HEADS), 0.1),
        "ab_mh_g": 1.0 + _nrm(ks[10], (N_EVEN, A_HEADS * A_DV), 0.02),
        "ab_sink": _nrm(ks[11], (N_EVEN, B_HEADS), 0.5),
        "ab_w_out": _nrm(ks[12], (N_EVEN, MIX, D), MIX ** -0.5),
        "na_w_in": _nrm(ks[13], (N_ODD, D, 3 * MIX), D ** -0.5),
        "na_rpb": _nrm(ks[14], (N_ODD, C_HEADS, 2 * NA_KH - 1, 2 * NA_KW - 1), 0.1),
        "na_w_out": _nrm(ks[15], (N_ODD, MIX, D), MIX ** -0.5),
        "peer_wq": _nrm(ks[16], (DEPTH, D, P_HEADS * P_DKEY), D ** -0.5),
        "peer_keys": _nrm(ks[17], (DEPTH, P_HEADS, 2, P_NKEYS, P_DKEY // 2), (P_DKEY // 2) ** -0.5),
        "peer_u": _nrm(ks[18], (DEPTH, P_EXPERTS, D), D ** -0.5),
        "peer_v": _nrm(ks[19], (DEPTH, P_EXPERTS, D), P_HEADS ** -0.5),
        "final_g": 1.0 + _nrm(ks[20], (D,), 0.02),
    }


def reference(x, c, ctx, c_ctx, ada_w, ada_b, norm1_g, norm2_g, ab_w_in, ab_gate_b, ab_mh_g, ab_sink,
              ab_w_out, na_w_in, na_rpb, na_w_out, peer_wq, peer_keys, peer_u, peer_v, final_g):
    xl, xc = x, ctx
    lc = ctx.shape[1]
    s_lat = jax.nn.silu(c)
    s_ctx = jax.nn.silu(c_ctx)
    for l in range(DEPTH):
        with_ctx = l < DEPTH - 1
        ml = [m[:, None, :] for m in jnp.split(s_lat @ ada_w[l] + ada_b[l], 6, axis=-1)]
        mc = jnp.split(s_ctx @ ada_w[l] + ada_b[l], 6, axis=-1)
        hl = modulate(rmsnorm(xl, norm1_g[l]), ml[0], ml[1])
        hc = modulate(rmsnorm(xc, norm1_g[l]), mc[0], mc[1])
        if l % 2 == 0:
            e = l // 2
            yc, yl = mixer_ab(hc, hl, ab_w_in[e], ab_gate_b[e], ab_mh_g[e], ab_sink[e], ab_w_out[e], with_ctx)
        else:
            o = l // 2
            yc, yl = mixer_c(hc, hl, na_w_in[o], na_rpb[o], na_w_out[o], with_ctx)
        xl = xl + ml[2] * yl
        hl = modulate(rmsnorm(xl, norm2_g[l]), ml[3], ml[4])
        if with_ctx:
            xc = xc + mc[2] * yc
            hc = modulate(rmsnorm(xc, norm2_g[l]), mc[3], mc[4])
            y = peer(jnp.concatenate([hc, hl], axis=1), peer_wq[l], peer_keys[l], peer_u[l], peer_v[l])
            xc = xc + mc[5] * y[:, :lc]
            xl = xl + ml[5] * y[:, lc:]
        else:
            xl = xl + ml[5] * peer(hl, peer_wq[l], peer_keys[l], peer_u[l], peer_v[l])
    return rmsnorm(xl, final_g)
```

```cpp
#include <hip/hip_runtime.h>
#include <cstdio>
#include <cstdint>
namespace pg8 {
#define PG8_LAS __attribute__((address_space(3)))
typedef unsigned short bf16_t;
typedef short bf16x8 __attribute__((ext_vector_type(8)));
typedef float f32x4 __attribute__((ext_vector_type(4)));
typedef unsigned u32x4 __attribute__((ext_vector_type(4)));
constexpr int BM = 256, BK = 64, HALF = 128, HTB = HALF * BK * 2  , STAGE_BYTES = 8 * HTB, NXCD = 8, WGM = 8;

__host__ __device__ __forceinline__ int lds_byte(int r, int c) { const int st = (r >> 4) * 2 + (c >> 5), rr = r & 15, cc = c & 31, ob = rr * 64 + cc * 2; return st * 1024 + (ob ^ (((ob >> 9) & 1) << 5)); }
__host__ __device__ __forceinline__ void stage_rc(int b, int& R, int& C) { const int st = b / 1024, sb = b % 1024, swz = sb ^ (((sb >> 9) & 1) << 5); R = (st >> 1) * 16 + swz / 64; C = (st & 1) * 32 + (swz % 64) / 2; }
__host__ __device__ __forceinline__ int perm32(int rho) { const int n = rho >> 4, i = rho & 15; return 8 * (i >> 2) + 4 * n + (i & 3); }

struct Unit { int pm, pn; };
struct Gemm { const bf16_t* A; const bf16_t* Bt; int M, N, K; };

struct StaticOrder {
    int nM, nN, nwg, G, c;
    __host__ __device__ void init(int M, int N, int G_, int c_) { nM = M / BM; nN = N / BM; nwg = nM * nN; G = G_; c = c_; }
    __host__ __device__ bool next(int i, Unit& u) const {
        const long L = (long)i * G + c; if (L >= nwg) return false;
        int wgid = (int)L; { const int q = nwg / NXCD, r = nwg % NXCD, xcd = wgid % NXCD, off = wgid / NXCD; wgid = (xcd < r ? xcd * (q + 1) : r * (q + 1) + (xcd - r) * q) + off; }
        const int nig = WGM * nN, gid = wgid / nig, fm = gid * WGM, gsz = (nM - fm) < WGM ? (nM - fm) : WGM;
        u.pm = fm + ((wgid % nig) % gsz); u.pn = (wgid % nig) / gsz; return true;
    }
    __device__ __forceinline__ void a_ready(const Unit&) const {}
    __device__ __forceinline__ void done(const Unit&) const {}
};
__device__ __forceinline__ unsigned cvt_pk_bf16(float lo, float hi) { unsigned r; asm volatile("v_cvt_pk_bf16_f32 %0, %1, %2" : "=v"(r) : "v"(lo), "v"(hi)); return r; }
template <class Epi, class Sched, bool STAMP = false>
__device__ __forceinline__ void gemm_phase(PG8_LAS unsigned char* lds, const Gemm g, const Sched& S, const Epi& E, unsigned long long* stamps, int tid_in) {
    int tid_l = tid_in; asm volatile("" : "+v"(tid_l));
    const int tid = tid_l, wid = __builtin_amdgcn_readfirstlane(tid >> 6), lane = tid & 63, wr = wid >> 2, wc = wid & 3, fr = lane & 15, fq = lane >> 4;
    const int K = g.K, nt = K / BK;
    int ts_lo = 0, ts_hi = 0, nts = 0; const unsigned long long rt_entry = STAMP ? (unsigned long long)wall_clock64() : 0ull;
#define PG8_STAMP() do { if (STAMP && wid == 0 && nts < 64) { const unsigned long long _c = (unsigned long long)clock64(); \
        ts_lo = (lane == nts) ? (int)(unsigned)_c : ts_lo; ts_hi = (lane == nts) ? (int)(unsigned)(_c >> 32) : ts_hi; ++nts; } } while (0)
    PG8_STAMP();
    unsigned voffA[2], voffB[2];
#pragma unroll
    for (int i = 0; i < 2; ++i) { int R, C; stage_rc(tid * 16 + i * 8192, R, C); const int Rb = Epi::PERM ? ((R & ~31) + perm32(R & 31)) : R;
        voffA[i] = (unsigned)(R * K + C) * 2u; voffB[i] = (unsigned)(Rb * K + C) * 2u; }
    const size_t kstep = (size_t)(BK * 2);
    const size_t hstep = (size_t)HALF * K * 2;
    const size_t tstep = 2 * hstep;
    const unsigned ldsw = (unsigned)wid * 1024u;
    const int aoff = lds_byte(wr * 64 + fr, fq * 8), boff = lds_byte(wc * 32 + fr, fq * 8);
#define PG8_SA(b, h) (((b) * 2 + (h)) * HTB)
#define PG8_SB(b, h) ((4 + (b) * 2 + (h)) * HTB)
#define PG8_STAGE(bufoff, gbase, voff) do { _Pragma("unroll") for (int _i = 0; _i < 2; ++_i) \
        __builtin_amdgcn_global_load_lds((const unsigned*)((const char*)(gbase) + (voff)[_i]), (PG8_LAS unsigned*)(lds + (bufoff) + ldsw + _i * 8192), 16, 0, 0); } while (0)
#define PG8_LDA(dst, b, h) do { _Pragma("unroll") for (int m = 0; m < 4; ++m) _Pragma("unroll") for (int k = 0; k < 2; ++k) dst[m][k] = *(const PG8_LAS bf16x8*)(lds + PG8_SA(b, h) + aoff + m * 2048 + k * 1024); } while (0)
#define PG8_LDB(dst, b, h) do { _Pragma("unroll") for (int n = 0; n < 2; ++n) _Pragma("unroll") for (int k = 0; k < 2; ++k) dst[n][k] = *(const PG8_LAS bf16x8*)(lds + PG8_SB(b, h) + boff + n * 2048 + k * 1024); } while (0)
#define PG8_MMA(ai, bj, At, Bt) do { __builtin_amdgcn_s_setprio(1); _Pragma("unroll") for (int m = 0; m < 4; ++m) _Pragma("unroll") for (int n = 0; n < 2; ++n) _Pragma("unroll") for (int k = 0; k < 2; ++k) \
        acc[ai][bj][m][n] = __builtin_amdgcn_mfma_f32_16x16x32_bf16(Bt[n][k], At[m][k], acc[ai][bj][m][n], 0, 0, 0); __builtin_amdgcn_s_setprio(0); } while (0)
#define PG8_WAIT_V(n) asm volatile("s_waitcnt vmcnt(" #n ")" ::: "memory")
#define PG8_WAIT_L(n) asm volatile("s_waitcnt lgkmcnt(" #n ")" ::: "memory")
#define PG8_BAR __builtin_amdgcn_s_barrier()
#define PG8_SCHED __builtin_amdgcn_sched_barrier(0)
    Unit cur, nxt; int ui = 0;
    if (!S.next(0, cur)) return;
    f32x4 acc[2][2][4][2];
#pragma unroll
    for (int a = 0; a < 2; ++a)
#pragma unroll
        for (int b = 0; b < 2; ++b)
#pragma unroll
            for (int m = 0; m < 4; ++m)
#pragma unroll
                for (int n = 0; n < 2; ++n) acc[a][b][m][n] = (f32x4){0.f, 0.f, 0.f, 0.f};
    bf16x8 At[4][2], B0[2][2], B1[2][2];
    const char* cA = (const char*)g.A + (size_t)cur.pm * tstep; const char* cB = (const char*)g.Bt + (size_t)cur.pn * tstep;
    S.a_ready(cur);
    PG8_STAGE(PG8_SB(0, 0), cB, voffB); PG8_STAGE(PG8_SA(0, 0), cA, voffA); PG8_STAGE(PG8_SB(0, 1), cB + hstep, voffB); PG8_STAGE(PG8_SA(0, 1), cA + hstep, voffA);
    if (wr == 1) PG8_BAR;
    PG8_WAIT_V(4); PG8_BAR;
    PG8_STAGE(PG8_SB(1, 0), cB + kstep, voffB); PG8_STAGE(PG8_SA(1, 0), cA + kstep, voffA); PG8_STAGE(PG8_SB(1, 1), cB + hstep + kstep, voffB);
    PG8_WAIT_V(6); PG8_BAR;
    PG8_STAMP();
    for (;;) {
        const bool has_next = S.next(ui + 1, nxt);
        const char* nA = has_next ? (const char*)g.A + (size_t)nxt.pm * tstep : cA; const char* nB = has_next ? (const char*)g.Bt + (size_t)nxt.pn * tstep : cB;
        for (int t = 0; t < nt; t += 2) {
            const bool last = (t == nt - 2);
            const char* a1 = cA + (size_t)(t + 1) * kstep;
            const char* a2 = last ? nA : cA + (size_t)(t + 2) * kstep; const char* b2 = last ? nB : cB + (size_t)(t + 2) * kstep;
            const char* a3 = a2 + kstep; const char* b3 = b2 + kstep;
            if (last && has_next) S.a_ready(nxt);
            PG8_LDB(B0, 0, 0); PG8_SCHED; PG8_LDA(At, 0, 0); PG8_STAGE(PG8_SA(1, 1), a1 + hstep, voffA);
            PG8_WAIT_L(8); PG8_BAR; PG8_WAIT_L(0); PG8_MMA(0, 0, At, B0); PG8_BAR; PG8_SCHED;
            PG8_LDB(B1, 0, 1); PG8_STAGE(PG8_SB(0, 0), b2, voffB);
            PG8_BAR; PG8_WAIT_L(0); PG8_MMA(0, 1, At, B1); PG8_BAR;
            PG8_LDA(At, 0, 1); PG8_STAGE(PG8_SA(0, 0), a2, voffA);
            PG8_BAR; PG8_WAIT_L(0); PG8_MMA(1, 0, At, B0); PG8_BAR; PG8_SCHED;
            PG8_STAGE(PG8_SB(0, 1), b2 + hstep, voffB);
            PG8_WAIT_V(6); PG8_BAR; PG8_MMA(1, 1, At, B1); PG8_BAR;
            PG8_LDB(B0, 1, 0); PG8_SCHED; PG8_LDA(At, 1, 0); PG8_STAGE(PG8_SA(0, 1), a2 + hstep, voffA);
            PG8_WAIT_L(8); PG8_BAR; PG8_WAIT_L(0); PG8_MMA(0, 0, At, B0); PG8_BAR; PG8_SCHED;
            PG8_LDB(B1, 1, 1); PG8_STAGE(PG8_SB(1, 0), b3, voffB);
            PG8_BAR; PG8_WAIT_L(0); PG8_MMA(0, 1, At, B1); PG8_BAR;
            PG8_LDA(At, 1, 1); PG8_STAGE(PG8_SA(1, 0), a3, voffA);
            PG8_BAR; PG8_WAIT_L(0); PG8_MMA(1, 0, At, B0); PG8_BAR; PG8_SCHED;
            PG8_STAGE(PG8_SB(1, 1), b3 + hstep, voffB);
            PG8_WAIT_V(6); PG8_BAR; PG8_MMA(1, 1, At, B1); PG8_BAR;
        }
        PG8_STAMP();
        if constexpr (!Epi::AFTER_DRAIN) { E(acc, cur, wr, wc, fr, fq); S.done(cur); }
        PG8_STAMP();
        if (!has_next) break;
#pragma unroll
        for (int a = 0; a < 2; ++a)
#pragma unroll
            for (int b = 0; b < 2; ++b)
#pragma unroll
                for (int m = 0; m < 4; ++m)
#pragma unroll
                    for (int n = 0; n < 2; ++n) acc[a][b][m][n] = (f32x4){0.f, 0.f, 0.f, 0.f};
        cur = nxt; cA = nA; cB = nB; ++ui;
    }
    PG8_WAIT_V(0);
    if (wr == 0) PG8_BAR;
    PG8_BAR;
    if constexpr (Epi::AFTER_DRAIN) { E.fused(acc, cur, wr, wc, fr, fq, lds, wid, lane); S.done(cur); }
    PG8_STAMP();
    if (STAMP && wid == 0) { stamps[lane] = lane < nts ? (((unsigned long long)(unsigned)ts_hi << 32) | (unsigned)ts_lo) : 0ull;
        if (lane == 62) stamps[62] = rt_entry; if (lane == 63) stamps[63] = (unsigned long long)wall_clock64(); }
#undef PG8_STAMP
#undef PG8_SA
#undef PG8_SB
#undef PG8_STAGE
#undef PG8_LDA
#undef PG8_LDB
#undef PG8_MMA
#undef PG8_WAIT_V
#undef PG8_WAIT_L
#undef PG8_BAR
#undef PG8_SCHED
}
}

constexpr int D = 2048, T = 8192, LC = 256, M = T + LC, DEPTH = 4, D6 = 6 * D;
constexpr int NAB = 4864, NNA = 6144;
constexpr int NCH = M / 64;
constexpr float EPS = 1e-6f, LOG2E = 1.4426950408889634f;
constexpr int NWAVES = 8;

constexpr size_t MiB = 1u << 20;
constexpr size_t WS_CTL = 0, CTL_ZERO_BYTES = 1 * MiB;
constexpr size_t WS_MOD = 1 * MiB;
constexpr size_t WS_ROPE = 2 * MiB;
constexpr size_t WS_KEYS = 3 * MiB;
constexpr size_t WS_WAB_IN = 8 * MiB;
constexpr size_t WS_WAB_OUT = 46 * MiB;
constexpr size_t WS_WNA_IN = 62 * MiB;
constexpr size_t WS_WNA_OUT = 110 * MiB;
constexpr size_t WS_WQ = 126 * MiB;
constexpr size_t WS_X = 160 * MiB;
constexpr size_t WS_H = 226 * MiB;
constexpr size_t WS_PROJ = 260 * MiB;
constexpr size_t WS_MIX = 360 * MiB;
constexpr size_t WS_QP = 394 * MiB;
constexpr size_t WS_IDX = 428 * MiB;
constexpr size_t WS_GATE = 433 * MiB;
constexpr size_t WS_U = 440 * MiB;
constexpr size_t WS_SNAP = 516 * MiB;
constexpr size_t WS_CHS = 554 * MiB;
constexpr size_t WS_END = 560 * MiB;
constexpr size_t PJ_Q = 0, PJ_K = 33 * MiB, PJ_VT = 66 * MiB;
constexpr size_t PJ_AQ = 0, PJ_AK = 9 * MiB, PJ_AKT = 18 * MiB, PJ_AVT = 27 * MiB, PJ_AO = 44 * MiB,
                 PJ_BQ = 61 * MiB, PJ_BK = 78 * MiB, PJ_BVT = 83 * MiB, PJ_G = 88 * MiB;
constexpr int LDS_BYTES = 147456;
constexpr int LDS_MISC = 131072;

#define LAS __attribute__((address_space(3)))
#define CAS __attribute__((address_space(4)))
typedef unsigned short bf16_t;
typedef short bf16x8 __attribute__((ext_vector_type(8)));
typedef float f32x4 __attribute__((ext_vector_type(4)));
typedef unsigned u32x4 __attribute__((ext_vector_type(4)));
typedef unsigned u32x2 __attribute__((ext_vector_type(2)));

struct Params {
    const float *x, *c, *ctx, *c_ctx, *ada_w, *ada_b, *norm1_g, *norm2_g, *ab_w_in, *ab_gate_b, *ab_mh_g, *ab_sink, *ab_w_out,
                *na_w_in, *na_rpb, *na_w_out, *peer_wq, *peer_keys, *peer_u, *peer_v, *final_g;
    float* out; unsigned char* ws; int ph_lo, ph_hi;
};

__device__ __forceinline__ float bf_lo(unsigned w) { return __uint_as_float(w << 16); }
__device__ __forceinline__ float bf_hi(unsigned w) { return __uint_as_float(w & 0xffff0000u); }
__device__ __forceinline__ unsigned pk2(float lo, float hi) { return pg8::cvt_pk_bf16(lo, hi); }
__device__ __forceinline__ float wave_sum(float v) {
#pragma unroll
    for (int o = 1; o < 64; o <<= 1) v += __shfl_xor(v, o);
    return v;
}
__device__ __forceinline__ float wave_max(float v) {
#pragma unroll
    for (int o = 1; o < 64; o <<= 1) v = fmaxf(v, __shfl_xor(v, o));
    return v;
}
__device__ __forceinline__ float scan_add(float x, int lane, int suffix) {
#pragma unroll
    for (int off = 1; off < 64; off <<= 1) {
        const float up = __shfl_up(x, off), dn = __shfl_down(x, off);
        const bool ok = suffix ? (lane + off < 64) : (lane >= off);
        x = ok ? x + (suffix ? dn : up) : x;
    }
    return x;
}
__device__ __forceinline__ float scan_max(float x, int lane, int suffix) {
#pragma unroll
    for (int off = 1; off < 64; off <<= 1) {
        const float up = __shfl_up(x, off), dn = __shfl_down(x, off);
        const bool ok = suffix ? (lane + off < 64) : (lane >= off);
        x = ok ? fmaxf(x, suffix ? dn : up) : x;
    }
    return x;
}
__device__ __forceinline__ float log_sigmoid(float x) { return fminf(x, 0.f) - log1pf(expf(-fabsf(x))); }
__device__ __forceinline__ bf16x8 mk_frag(u32x4 w) { return __builtin_bit_cast(bf16x8, w); }
#define MFMA16(a, b, c) __builtin_amdgcn_mfma_f32_16x16x32_bf16((a), (b), (c), 0, 0, 0)

#define XB_TMO      128
#define XB_XCNT(j)  (256  + 64 * (j))
#define XB_XSUB(j)  (1280 + 64 * (j))
#define XB_XGEN(j)  (2304 + 64 * (j))
#define XB_TOP      3328
#define XB_TOPGEN   3392
#define XCD_BAR_WORDS 3456
#define XB_SPIN_CAP (1u << 22)
__device__ __forceinline__ unsigned xb_ld(unsigned* p)              { return __hip_atomic_load(p, __ATOMIC_RELAXED, __HIP_MEMORY_SCOPE_AGENT); }
__device__ __forceinline__ unsigned xb_add(unsigned* p, unsigned v) { return __hip_atomic_fetch_add(p, v, __ATOMIC_RELAXED, __HIP_MEMORY_SCOPE_AGENT); }
__device__ __forceinline__ unsigned xb_xcc_id() { return (unsigned)__builtin_amdgcn_s_getreg((3 << 11) | 20) & 0xFu; }
#define XB_SPIN(cond, bar) do { unsigned _sp = 0; while (cond) { __builtin_amdgcn_s_sleep(1); \
    if ((++_sp & 255u) == 0u) { if (xb_ld(&(bar)[XB_TMO])) break; if (_sp > XB_SPIN_CAP) { atomicAdd(&(bar)[XB_TMO], 1u); break; } } } } while (0)
struct XcdBarrier { unsigned* bar; unsigned x; volatile LAS unsigned* st; };
__device__ __forceinline__ XcdBarrier xcd_barrier_post(unsigned* bar, volatile LAS unsigned* st, int tid) {
    XcdBarrier b; b.bar = bar; b.x = xb_xcc_id(); b.st = st;
    if (tid == 0) (void)xb_add(&bar[XB_XCNT(b.x)], 1u);
    return b;
}
__device__ __forceinline__ void xcd_barrier_complete(unsigned* bar, unsigned x, unsigned& nloc, unsigned& nx) {
    const unsigned G = gridDim.x * gridDim.y * gridDim.z;
    unsigned sum, cnt, mine, sp = 0u;
    for (;;) {
        sum = 0u; cnt = 0u; mine = 0u;
#pragma unroll
        for (unsigned j = 0; j < 16; ++j) { const unsigned c = xb_ld(&bar[XB_XCNT(j)]); sum += c; cnt += (c > 0u) ? 1u : 0u; mine = (j == x) ? c : mine; }
        if (sum == G) break;
        __builtin_amdgcn_s_sleep(1);
        if ((++sp & 255u) == 0u) { if (xb_ld(&bar[XB_TMO])) break; if (sp > XB_SPIN_CAP) { atomicAdd(&bar[XB_TMO], 1u); break; } }
    }
    nloc = mine > 0u ? mine : 1u; nx = cnt > 0u ? cnt : 1u;
}
__device__ __forceinline__ void xcd_barrier(const XcdBarrier& b, int tid) {
    asm volatile("s_waitcnt vmcnt(0)" ::: "memory");
    __syncthreads();
    if (tid == 0) {
        unsigned* bar = b.bar;
        __builtin_amdgcn_s_waitcnt(0);
        unsigned nloc = b.st[0], nx = b.st[1];
        if (nloc == 0u) { xcd_barrier_complete(bar, b.x, nloc, nx); b.st[0] = nloc; b.st[1] = nx; }
        const unsigned old = xb_add(&bar[XB_XSUB(b.x)], 1u);
        const unsigned gen = old / nloc;
        if (old + 1u == (gen + 1u) * nloc) {
            __builtin_amdgcn_fence(__ATOMIC_RELEASE, "agent");
            asm volatile("s_waitcnt vmcnt(0)" ::: "memory");
            const unsigned og = xb_add(&bar[XB_TOP], 1u);
            const unsigned tg = og / nx;
            if (og + 1u == (tg + 1u) * nx) xb_add(&bar[XB_TOPGEN], 1u);
            else XB_SPIN(xb_ld(&bar[XB_TOPGEN]) == tg, bar);
            __builtin_amdgcn_fence(__ATOMIC_ACQUIRE, "agent");
            xb_add(&bar[XB_XGEN(b.x)], 1u);
            asm volatile("s_waitcnt vmcnt(0)" ::: "memory");
        } else {
            XB_SPIN(xb_ld(&bar[XB_XGEN(b.x)]) == gen, bar);
            __builtin_amdgcn_fence(__ATOMIC_ACQUIRE, "agent");
            asm volatile("s_waitcnt vmcnt(0)" ::: "memory");
        }
    }
    __syncthreads();
}

template <class MapF>
__device__ __forceinline__ void transpose_item(const float* W, int Nsrc, int K, bf16_t* WT, int nblk, LAS float* scr, int item, int lane, MapF map) {
    const int kb = item / nblk, nb = item % nblk, k0 = 64 * kb, n0 = 32 * nb;
    const int sc = map(n0 + (lane & 31));
#pragma unroll 8
    for (int i = 0; i < 32; ++i) { const int kk = 2 * i + (lane >> 5); scr[kk * 33 + (lane & 31)] = sc >= 0 ? W[(size_t)(k0 + kk) * Nsrc + sc] : 0.f; }
    asm volatile("s_waitcnt lgkmcnt(0)" ::: "memory");
    const int c = lane & 7;
#pragma unroll
    for (int j = 0; j < 4; ++j) { const int n = (lane >> 3) + 8 * j; const LAS float* s = scr + (8 * c) * 33 + n;
        u32x4 o; o.x = pk2(s[0 * 33], s[1 * 33]); o.y = pk2(s[2 * 33], s[3 * 33]); o.z = pk2(s[4 * 33], s[5 * 33]); o.w = pk2(s[6 * 33], s[7 * 33]);
        *(u32x4*)(WT + (size_t)(n0 + n) * K + k0 + 8 * c) = o; }
    asm volatile("s_waitcnt lgkmcnt(0)" ::: "memory");
}
struct MapId { __device__ __forceinline__ int operator()(int n) const { return n; } };
struct MapAB {
    __device__ __forceinline__ int operator()(int n) const {
        if (n < 3072) return n;
        if (n < 4352) { const int base_d = n < 4096 ? 3072 : 4096, base_s = n < 4096 ? 3104 : 4128; const int r = n - base_d, hh = r >> 7, pp = r & 127;
            const int i = 64 * (pp >> 6) + ((pp & 63) >> 1) + 32 * (pp & 1); return base_s + hh * 128 + i; }
        if (n < 4608) return 4384 + (n - 4352);
        if (n < 4640) return 3072 + (n - 4608);
        return -1;
    }
};
__device__ __forceinline__ float silu(float v) { return v / (1.f + expf(-v)); }

__device__ __forceinline__ void ph_prologue(const Params& p, LAS unsigned char* lds, int tid, int lane, int wave, int vcu, int G) {
    const int gw = vcu * NWAVES + wave, NGW = G * NWAVES;
    const size_t gtid = (size_t)vcu * 512 + tid, gn = (size_t)G * 512;
    {
        const f32x4* xs = (const f32x4*)p.x; const f32x4* cs = (const f32x4*)p.ctx; f32x4* X = (f32x4*)(p.ws + WS_X);
        const size_t nlat = (size_t)T * D / 4, ntot = (size_t)M * D / 4;
        for (size_t i = gtid; i < ntot; i += gn) X[i] = i < nlat ? xs[i] : cs[i - nlat];
    }
    {
        const float2* ks = (const float2*)p.peer_keys; unsigned* kd = (unsigned*)(p.ws + WS_KEYS);
        for (size_t i = gtid; i < (size_t)4 * 8 * 2 * 128 * 128 / 2; i += gn) { const float2 v = ks[i]; kd[i] = pk2(v.x, v.y); }
    }
    {
        float2* rt = (float2*)(p.ws + WS_ROPE);
        for (size_t i = gtid; i < 128 * 32; i += gn) { const int pos = (int)(i >> 5), j = (int)(i & 31);
            const float freq = powf(10000.f, -(float)j / 32.f), ang = (float)pos * freq; rt[i] = make_float2(cosf(ang), sinf(ang)); }
    }
    {
        LAS float* sv = (LAS float*)lds;
        LAS float* red = (LAS float*)(lds + 16384);
        for (int i = tid; i < 2048; i += 512) { sv[i] = silu(p.c[i]); sv[2048 + i] = silu(p.c_ctx[i]); }
        __syncthreads();
        float* MOD = (float*)(p.ws + WS_MOD);
        for (int u = vcu; u < 4 * 192; u += G) {
            const int l = u / 192, n0 = (u % 192) * 64;
            const float* wp = p.ada_w + ((size_t)l * 2048 + wave * 256) * D6 + n0 + lane;
            float a0 = 0.f, a1 = 0.f;
            for (int k = 0; k < 256; k += 8) {
                float wv[8];
#pragma unroll
                for (int j = 0; j < 8; ++j) wv[j] = wp[(size_t)(k + j) * D6];
#pragma unroll
                for (int j = 0; j < 8; ++j) { a0 += sv[wave * 256 + k + j] * wv[j]; a1 += sv[2048 + wave * 256 + k + j] * wv[j]; }
            }
            red[(wave * 2 + 0) * 64 + lane] = a0; red[(wave * 2 + 1) * 64 + lane] = a1;
            __syncthreads();
            if (wave < 2) { float s = 0.f;
#pragma unroll
                for (int w = 0; w < 8; ++w) s += red[(w * 2 + wave) * 64 + lane];
                MOD[((size_t)l * 2 + wave) * D6 + n0 + lane] = s + p.ada_b[(size_t)l * D6 + n0 + lane]; }
            __syncthreads();
        }
    }
    {
        LAS float* scr = (LAS float*)(lds + wave * 16384);
        constexpr int I_ABI = 32 * (NAB / 32), I_SQ = 32 * (D / 32), I_NAI = 32 * (NNA / 32);
        constexpr int NITEMS = 2 * I_ABI + 2 * I_SQ + 2 * I_NAI + 2 * I_SQ + 4 * I_SQ;
        for (int it = gw; it < NITEMS; it += NGW) {
            int r = it;
            if (r < 2 * I_ABI) { const int e = r / I_ABI; r -= e * I_ABI;
                transpose_item(p.ab_w_in + (size_t)e * D * 4640, 4640, D, (bf16_t*)(p.ws + WS_WAB_IN) + (size_t)e * NAB * D, NAB / 32, scr, r, lane, MapAB()); continue; }
            r -= 2 * I_ABI;
            if (r < 2 * I_SQ) { const int e = r / I_SQ; r -= e * I_SQ;
                transpose_item(p.ab_w_out + (size_t)e * D * D, D, D, (bf16_t*)(p.ws + WS_WAB_OUT) + (size_t)e * D * D, D / 32, scr, r, lane, MapId()); continue; }
            r -= 2 * I_SQ;
            if (r < 2 * I_NAI) { const int e = r / I_NAI; r -= e * I_NAI;
                transpose_item(p.na_w_in + (size_t)e * D * NNA, NNA, D, (bf16_t*)(p.ws + WS_WNA_IN) + (size_t)e * NNA * D, NNA / 32, scr, r, lane, MapId()); continue; }
            r -= 2 * I_NAI;
            if (r < 2 * I_SQ) { const int e = r / I_SQ; r -= e * I_SQ;
                transpose_item(p.na_w_out + (size_t)e * D * D, D, D, (bf16_t*)(p.ws + WS_WNA_OUT) + (size_t)e * D * D, D / 32, scr, r, lane, MapId()); continue; }
            r -= 2 * I_SQ;
            { const int e = r / I_SQ; r -= e * I_SQ;
                transpose_item(p.peer_wq + (size_t)e * D * D, D, D, (bf16_t*)(p.ws + WS_WQ) + (size_t)e * D * D, D / 32, scr, r, lane, MapId()); }
        }
    }
}

__device__ __forceinline__ void ph_norm(const Params& p, int l, int which, int lane, int gw, int NGW) {
    const float* gvec = (which ? p.norm2_g : p.norm1_g) + (size_t)l * D;
    const float* MOD = (const float*)(p.ws + WS_MOD) + (size_t)l * 2 * D6;
    const float* X = (const float*)(p.ws + WS_X); bf16_t* H = (bf16_t*)(p.ws + WS_H);
    for (int m = gw; m < M; m += NGW) {
        const float* mod = MOD + (m >= T ? D6 : 0) + (which ? 3 * D : 0);
        const f32x4* xr = (const f32x4*)(X + (size_t)m * D) + lane;
        f32x4 v[8]; float ss = 0.f;
#pragma unroll
        for (int j = 0; j < 8; ++j) { v[j] = xr[64 * j]; ss += (v[j].x * v[j].x + v[j].y * v[j].y) + (v[j].z * v[j].z + v[j].w * v[j].w); }
        ss = wave_sum(ss);
        const float rstd = rsqrtf(ss * (1.f / D) + EPS);
#pragma unroll
        for (int j = 0; j < 8; ++j) { const int col = 256 * j + 4 * lane;
            const f32x4 g4 = *(const f32x4*)(gvec + col), sh = *(const f32x4*)(mod + col), sc = *(const f32x4*)(mod + D + col);
            const f32x4 h = v[j] * rstd * g4 * (sc + 1.f) + sh;
            u32x2 o; o.x = pk2(h.x, h.y); o.y = pk2(h.z, h.w);
            *(u32x2*)(H + (size_t)m * D + col) = o; }
    }
}
__device__ __forceinline__ void ph_final(const Params& p, int lane, int gw, int NGW) {
    const float* X = (const float*)(p.ws + WS_X);
    for (int m = gw; m < T; m += NGW) {
        const f32x4* xr = (const f32x4*)(X + (size_t)m * D) + lane;
        f32x4 v[8]; float ss = 0.f;
#pragma unroll
        for (int j = 0; j < 8; ++j) { v[j] = xr[64 * j]; ss += (v[j].x * v[j].x + v[j].y * v[j].y) + (v[j].z * v[j].z + v[j].w * v[j].w); }
        ss = wave_sum(ss);
        const float rstd = rsqrtf(ss * (1.f / D) + EPS);
#pragma unroll
        for (int j = 0; j < 8; ++j) { const int col = 256 * j + 4 * lane; const f32x4 g4 = *(const f32x4*)(p.final_g + col);
            *(f32x4*)(p.out + (size_t)m * D + col) = v[j] * rstd * g4; }
    }
}

__device__ __forceinline__ void store8_bf16(bf16_t* dst, f32x4 v0, f32x4 v1) {
    u32x4 w; w.x = pk2(v0[0], v0[1]); w.y = pk2(v0[2], v0[3]); w.z = pk2(v1[0], v1[1]); w.w = pk2(v1[2], v1[3]);
    *(u32x4*)dst = w;
}
__device__ __forceinline__ void store8_T(bf16_t* BT, int dim0, int row, f32x4 v0, f32x4 v1) {
    const unsigned a = pk2(v0[0], v0[1]), b = pk2(v0[2], v0[3]), c = pk2(v1[0], v1[1]), d = pk2(v1[2], v1[3]);
    bf16_t* q = BT + (size_t)dim0 * M + row;
    q[0 * (size_t)M] = (bf16_t)(a & 0xffff); q[1 * (size_t)M] = (bf16_t)(a >> 16); q[2 * (size_t)M] = (bf16_t)(b & 0xffff); q[3 * (size_t)M] = (bf16_t)(b >> 16);
    q[4 * (size_t)M] = (bf16_t)(c & 0xffff); q[5 * (size_t)M] = (bf16_t)(c >> 16); q[6 * (size_t)M] = (bf16_t)(d & 0xffff); q[7 * (size_t)M] = (bf16_t)(d >> 16);
}
__device__ __forceinline__ void rope8(f32x4& v0, f32x4& v1, const float2* rope, int row, int pp  ) {
    const int pos = (pp < 64) ? (row >> 6) : (row & 63), j0 = (pp & 63) >> 1;
    const f32x4* t = (const f32x4*)(rope + pos * 32 + j0);
    const f32x4 c01 = t[0], c23 = t[1];
    const float a0 = v0[0], b0 = v0[1], a1 = v0[2], b1 = v0[3], a2 = v1[0], b2 = v1[1], a3 = v1[2], b3 = v1[3];
    v0[0] = a0 * c01[0] - b0 * c01[1]; v0[1] = b0 * c01[0] + a0 * c01[1];
    v0[2] = a1 * c01[2] - b1 * c01[3]; v0[3] = b1 * c01[2] + a1 * c01[3];
    v1[0] = a2 * c23[0] - b2 * c23[1]; v1[1] = b2 * c23[0] + a2 * c23[1];
    v1[2] = a3 * c23[2] - b3 * c23[3]; v1[3] = b3 * c23[2] + a3 * c23[3];
}
struct EpiEven {
    static constexpr bool PERM = true, AFTER_DRAIN = false;
    unsigned char* proj; const float* gate_b; const float2* rope;
    __device__ __forceinline__ void operator()(const f32x4 (&acc)[2][2][4][2], const pg8::Unit& u, int wr, int wc, int fr, int fq) const {
        const int pn = u.pn;
#pragma unroll
        for (int ai = 0; ai < 2; ++ai)
#pragma unroll
            for (int m = 0; m < 4; ++m) { const int row = u.pm * 256 + ai * 128 + wr * 64 + m * 16 + fr;
#pragma unroll
                for (int bj = 0; bj < 2; ++bj) { const int col0 = pn * 256 + bj * 128 + wc * 32 + 8 * fq;
                    f32x4 v0 = acc[ai][bj][m][0], v1 = acc[ai][bj][m][1];
                    if (pn < 2) { store8_bf16((bf16_t*)(proj + PJ_AQ) + (size_t)row * 512 + col0, v0 * 0.125f, v1 * 0.125f); }
                    else if (pn < 4) { const int c = col0 - 512; store8_bf16((bf16_t*)(proj + PJ_AK) + (size_t)row * 512 + c, v0, v1); store8_T((bf16_t*)(proj + PJ_AKT), c, row, v0, v1); }
                    else if (pn < 8) { store8_T((bf16_t*)(proj + PJ_AVT), col0 - 1024, row, v0, v1); }
                    else if (pn < 12) { store8_bf16((bf16_t*)(proj + PJ_AO) + (size_t)row * 1024 + (col0 - 2048), v0, v1); }
                    else if (pn < 16) { const int c = col0 - 3072; if (row < T) rope8(v0, v1, rope, row, c & 127); store8_bf16((bf16_t*)(proj + PJ_BQ) + (size_t)row * 1024 + c, v0, v1); }
                    else if (pn == 16) { const int c = col0 - 4096; if (row < T) rope8(v0, v1, rope, row, c & 127); store8_bf16((bf16_t*)(proj + PJ_BK) + (size_t)row * 256 + c, v0, v1); }
                    else if (pn == 17) { store8_T((bf16_t*)(proj + PJ_BVT), col0 - 4352, row, v0, v1); }
                    else { const int c = col0 - 4608; if (c < 32) { float* gp = (float*)(proj + PJ_G) + (size_t)row * 32 + c;
                            *(f32x4*)gp = v0 + *(const f32x4*)(gate_b + c); *(f32x4*)(gp + 4) = v1 + *(const f32x4*)(gate_b + c + 4); } }
                } }
    }
};
struct EpiOdd {
    static constexpr bool PERM = true, AFTER_DRAIN = false;
    unsigned char* proj;
    __device__ __forceinline__ void operator()(const f32x4 (&acc)[2][2][4][2], const pg8::Unit& u, int wr, int wc, int fr, int fq) const {
        const int pn = u.pn;
#pragma unroll
        for (int ai = 0; ai < 2; ++ai)
#pragma unroll
            for (int m = 0; m < 4; ++m) { const int row = u.pm * 256 + ai * 128 + wr * 64 + m * 16 + fr;
#pragma unroll
                for (int bj = 0; bj < 2; ++bj) { const int col0 = pn * 256 + bj * 128 + wc * 32 + 8 * fq;
                    const f32x4 v0 = acc[ai][bj][m][0], v1 = acc[ai][bj][m][1];
                    if (pn < 8) store8_bf16((bf16_t*)(proj + PJ_Q) + (size_t)row * 2048 + col0, v0, v1);
                    else if (pn < 16) store8_bf16((bf16_t*)(proj + PJ_K) + (size_t)row * 2048 + (col0 - 2048), v0, v1);
                    else store8_T((bf16_t*)(proj + PJ_VT), col0 - 4096, row, v0, v1);
                } }
    }
};
struct EpiResid {
    static constexpr bool PERM = true, AFTER_DRAIN = false;
    float* X; const float* gl; const float* gc;
    __device__ __forceinline__ void operator()(const f32x4 (&acc)[2][2][4][2], const pg8::Unit& u, int wr, int wc, int fr, int fq) const {
#pragma unroll
        for (int ai = 0; ai < 2; ++ai)
#pragma unroll
            for (int m = 0; m < 4; ++m) { const int row = u.pm * 256 + ai * 128 + wr * 64 + m * 16 + fr; const float* g = row < T ? gl : gc;
#pragma unroll
                for (int bj = 0; bj < 2; ++bj) { const int col0 = u.pn * 256 + bj * 128 + wc * 32 + 8 * fq;
                    f32x4* xp = (f32x4*)(X + (size_t)row * D + col0);
                    const f32x4 g0 = *(const f32x4*)(g + col0), g1 = *(const f32x4*)(g + col0 + 4);
                    xp[0] = xp[0] + g0 * acc[ai][bj][m][0]; xp[1] = xp[1] + g1 * acc[ai][bj][m][1];
                } }
    }
};
struct EpiPlain {
    static constexpr bool PERM = true, AFTER_DRAIN = false;
    bf16_t* O;
    __device__ __forceinline__ void operator()(const f32x4 (&acc)[2][2][4][2], const pg8::Unit& u, int wr, int wc, int fr, int fq) const {
#pragma unroll
        for (int ai = 0; ai < 2; ++ai)
#pragma unroll
            for (int m = 0; m < 4; ++m) { const int row = u.pm * 256 + ai * 128 + wr * 64 + m * 16 + fr;
#pragma unroll
                for (int bj = 0; bj < 2; ++bj) { const int col0 = u.pn * 256 + bj * 128 + wc * 32 + 8 * fq;
                    store8_bf16(O + (size_t)row * D + col0, acc[ai][bj][m][0], acc[ai][bj][m][1]); } }
    }
};

template <class TF>
__device__ __forceinline__ void attn_wave16(const bf16_t* __restrict__ Qh, int qstride, int qrow0,
                                            const bf16_t* __restrict__ Kh, int kstride, const bf16_t* __restrict__ VTh  ,
                                            int ntiles, const TF& tf, bool has_sink, float sink, float scale,
                                            bf16_t* __restrict__ Oh, int ostride, int lane) {
    asm volatile("" : "+v"(lane));
    const int fr = lane & 15, fq = lane >> 4;
    bf16x8 qf[4];
#pragma unroll
    for (int kd = 0; kd < 4; ++kd) qf[kd] = *(const bf16x8*)(Qh + (size_t)(qrow0 + fr) * qstride + 32 * kd + 8 * fq);
    f32x4 o[8];
#pragma unroll
    for (int nd = 0; nd < 8; ++nd) o[nd] = (f32x4){0.f, 0.f, 0.f, 0.f};
    float mrun = has_sink ? sink * LOG2E : -1e30f;
    float lrun = (has_sink && fq == 0) ? 1.f : 0.f;
    const float sc2 = scale * LOG2E;
    for (int ti = 0; ti < ntiles; ++ti) {
        const int tok0 = tf.tok0(ti);
        f32x4 s[2];
#pragma unroll
        for (int sub = 0; sub < 2; ++sub) {
            s[sub] = (f32x4){0.f, 0.f, 0.f, 0.f};
            int tk = tok0 + 16 * sub + fr; tk = tk < 0 ? 0 : (tk > M - 1 ? M - 1 : tk);
#pragma unroll
            for (int kd = 0; kd < 4; ++kd) { const bf16x8 kf = *(const bf16x8*)(Kh + (size_t)tk * kstride + 32 * kd + 8 * fq); s[sub] = MFMA16(kf, qf[kd], s[sub]); }
        }
        float pv[8]; float tmax = -INFINITY;
#pragma unroll
        for (int sub = 0; sub < 2; ++sub)
#pragma unroll
            for (int r = 0; r < 4; ++r) { const int ks = 16 * sub + 4 * fq + r; const float b = tf.bias(ti, ks);
                const float v = s[sub][r] * sc2 + b * LOG2E; pv[4 * sub + r] = v; tmax = fmaxf(tmax, v); }
        tmax = fmaxf(tmax, __shfl_xor(tmax, 16)); tmax = fmaxf(tmax, __shfl_xor(tmax, 32));
        const float mnew = fmaxf(mrun, tmax), alpha = exp2f(mrun - mnew);
        float ps = 0.f;
#pragma unroll
        for (int i = 0; i < 8; ++i) { pv[i] = exp2f(pv[i] - mnew); ps += pv[i]; }
        lrun = lrun * alpha + ps; mrun = mnew;
#pragma unroll
        for (int nd = 0; nd < 8; ++nd) o[nd] = o[nd] * alpha;
        u32x4 pw; pw.x = pk2(pv[0], pv[1]); pw.y = pk2(pv[2], pv[3]); pw.z = pk2(pv[4], pv[5]); pw.w = pk2(pv[6], pv[7]);
        const bf16x8 pf = mk_frag(pw);
        int t0 = tok0 + 4 * fq, t1 = tok0 + 16 + 4 * fq;
        t0 = t0 < 0 ? 0 : (t0 > M - 4 ? M - 4 : t0); t1 = t1 < 0 ? 0 : (t1 > M - 4 ? M - 4 : t1);
#pragma unroll
        for (int nd = 0; nd < 8; ++nd) { const bf16_t* vr = VTh + (size_t)(16 * nd + fr) * M;
            const u32x2 a = *(const u32x2*)(vr + t0), b = *(const u32x2*)(vr + t1);
            u32x4 w; w.x = a.x; w.y = a.y; w.z = b.x; w.w = b.y;
            o[nd] = MFMA16(mk_frag(w), pf, o[nd]); }
    }
    lrun += __shfl_xor(lrun, 16); lrun += __shfl_xor(lrun, 32);
    const float rl = 1.f / lrun;
#pragma unroll
    for (int nd = 0; nd < 8; ++nd) { const f32x4 v = o[nd] * rl; u32x2 w; w.x = pk2(v[0], v[1]); w.y = pk2(v[2], v[3]);
        *(u32x2*)(Oh + (size_t)(qrow0 + fr) * ostride + 16 * nd + 4 * fq) = w; }
}
struct TFCtxOnly {
    __device__ __forceinline__ int tok0(int ti) const { return T + 32 * ti; }
    __device__ __forceinline__ float bias(int, int) const { return 0.f; }
};
struct TFGqa {
    int jb, tq;
    __device__ __forceinline__ int tok0(int ti) const { return ti < 9 ? 16 * jb - 128 + 32 * ti : T + 32 * (ti - 9); }
    __device__ __forceinline__ float bias(int ti, int ks) const {
        if (ti >= 9) return 0.f;
        const int kp = 16 * jb - 128 + 32 * ti + ks, d = kp - tq;
        return (kp >= 0 && kp < T && d <= 128 && d >= -128) ? 0.f : -INFINITY;
    }
};
struct TFNa {
    int r0, kc0, r, c, c0; const float* rpb;
    __device__ __forceinline__ int tok0(int ti) const { return ti < 8 ? 64 * (r0 + ti) + kc0 : T + 32 * (ti - 8); }
    __device__ __forceinline__ float bias(int ti, int ks) const {
        if (ti >= 8) return 0.f;
        const int kc = kc0 + ks;
        if (kc < c0 || kc >= c0 + 16) return -INFINITY;
        return rpb[(r0 + ti - r + 7) * 31 + (kc - c + 15)];
    }
};

__device__ __forceinline__ void ph_attn_even(const Params& p, int e, bool with_ctx, int lane, int wave, int vcu, int G) {
    unsigned char* proj = p.ws + WS_PROJ;
    const bf16_t* BQ = (const bf16_t*)(proj + PJ_BQ); const bf16_t* BK = (const bf16_t*)(proj + PJ_BK); const bf16_t* BVT = (const bf16_t*)(proj + PJ_BVT);
    bf16_t* MIX = (bf16_t*)(p.ws + WS_MIX);
    const float scale = 0.08838834764831845f;
    for (int U = vcu; U < 512; U += G) {
        const int jbp = U >> 1, kvh = U & 1, h = kvh * 4 + (wave & 3), jb = 2 * jbp + (wave >> 2);
        TFGqa tf; tf.jb = jb; tf.tq = 16 * jb + (lane & 15);
        attn_wave16(BQ + h * 128, 1024, 16 * jb, BK + kvh * 128, 256, BVT + (size_t)kvh * 128 * M, 17, tf, true, p.ab_sink[e * 8 + h], scale, MIX + 1024 + h * 128, 2048, lane);
    }
    if (with_ctx) for (int U = vcu; U < 16; U += G) {
        const int h = wave, kvh = h >> 2;
        attn_wave16(BQ + h * 128, 1024, T + 16 * U, BK + kvh * 128, 256, BVT + (size_t)kvh * 128 * M, 8, TFCtxOnly(), true, p.ab_sink[e * 8 + h], scale, MIX + 1024 + h * 128, 2048, lane);
    }
}
__device__ __forceinline__ void ph_attn_odd(const Params& p, int o, bool with_ctx, int lane, int wave, int vcu, int G) {
    unsigned char* proj = p.ws + WS_PROJ;
    const bf16_t* Q = (const bf16_t*)(proj + PJ_Q); const bf16_t* K = (const bf16_t*)(proj + PJ_K); const bf16_t* VT = (const bf16_t*)(proj + PJ_VT);
    bf16_t* MIX = (bf16_t*)(p.ws + WS_MIX);
    const float scale = 0.08838834764831845f;
    for (int U = vcu; U < 1024; U += G) {
        const int r = U >> 3, hp = U & 7, cq = wave & 3, h = 2 * hp + (wave >> 2);
        TFNa tf; tf.r = r; tf.r0 = r - 4 < 0 ? 0 : (r - 4 > 120 ? 120 : r - 4); tf.kc0 = cq == 0 ? 0 : (cq == 1 ? 8 : (cq == 2 ? 24 : 32));
        tf.c = 16 * cq + (lane & 15); tf.c0 = tf.c - 8 < 0 ? 0 : (tf.c - 8 > 48 ? 48 : tf.c - 8); tf.rpb = p.na_rpb + ((size_t)o * 16 + h) * 15 * 31;
        attn_wave16(Q + h * 128, 2048, 64 * r + 16 * cq, K + h * 128, 2048, VT + (size_t)h * 128 * M, 16, tf, false, 0.f, scale, MIX + h * 128, 2048, lane);
    }
    if (with_ctx) for (int U = vcu; U < 32; U += G) {
        const int jb = U >> 1, h = (U & 1) * 8 + wave;
        attn_wave16(Q + h * 128, 2048, T + 16 * jb, K + h * 128, 2048, VT + (size_t)h * 128 * M, 8, TFCtxOnly(), false, 0.f, scale, MIX + h * 128, 2048, lane);
    }
}

__device__ __forceinline__ void mlstm_A_unit(const Params& p, int cc, int hd, int lane) {
    asm volatile("" : "+v"(lane));
    const int fr = lane & 15, fq = lane >> 4, dir = hd >> 3, head = hd & 7, tok0 = cc * 64;
    unsigned char* proj = p.ws + WS_PROJ;
    const bf16_t* AKT = (const bf16_t*)(proj + PJ_AKT); const bf16_t* AVT = (const bf16_t*)(proj + PJ_AVT); const float* Gt = (const float*)(proj + PJ_G);
    float* U = (float*)(p.ws + WS_U); float* CHS = (float*)(p.ws + WS_CHS);
    const float* grow = Gt + (size_t)(tok0 + lane) * 32;
    const float ig = grow[(2 * dir) * 8 + head], lf = log_sigmoid(grow[(2 * dir + 1) * 8 + head]);
    const float F = scan_add(lf, lane, dir);
    const float FL = __shfl(F, dir ? 0 : 63);
    const float wend = FL - F + ig, wmax = wave_max(wend), wv = expf(wend - wmax);
    if (lane == 0) { CHS[((size_t)hd * NCH + cc) * 2] = FL; CHS[((size_t)hd * NCH + cc) * 2 + 1] = wmax; }
    bf16x8 af[4][2];
#pragma unroll
    for (int ks = 0; ks < 2; ++ks) {
        float w8[8];
#pragma unroll
        for (int j = 0; j < 8; ++j) w8[j] = __shfl(wv, 32 * ks + 8 * fq + j);
#pragma unroll
        for (int nd = 0; nd < 4; ++nd) {
            const u32x4 raw = *(const u32x4*)(AKT + (size_t)(head * 64 + 16 * nd + fr) * M + tok0 + 32 * ks + 8 * fq);
            u32x4 w; w.x = pk2(bf_lo(raw.x) * w8[0], bf_hi(raw.x) * w8[1]); w.y = pk2(bf_lo(raw.y) * w8[2], bf_hi(raw.y) * w8[3]);
            w.z = pk2(bf_lo(raw.z) * w8[4], bf_hi(raw.z) * w8[5]); w.w = pk2(bf_lo(raw.w) * w8[6], bf_hi(raw.w) * w8[7]);
            af[nd][ks] = mk_frag(w);
        }
    }
    const unsigned onew = (fr == 0) ? 0x3F803F80u : 0u;
#pragma unroll
    for (int ne = 0; ne < 9; ++ne) {
        bf16x8 bfr[2];
#pragma unroll
        for (int ks = 0; ks < 2; ++ks) {
            if (ne < 8) bfr[ks] = *(const bf16x8*)(AVT + (size_t)(head * 128 + 16 * ne + fr) * M + tok0 + 32 * ks + 8 * fq);
            else { u32x4 w; w.x = onew; w.y = onew; w.z = onew; w.w = onew; bfr[ks] = mk_frag(w); }
        }
#pragma unroll
        for (int nd = 0; nd < 4; ++nd) {
            f32x4 acc = (f32x4){0.f, 0.f, 0.f, 0.f};
#pragma unroll
            for (int ks = 0; ks < 2; ++ks) acc = MFMA16(af[nd][ks], bfr[ks], acc);
            *(f32x4*)(U + (((size_t)hd * NCH + cc) * 144 + 16 * ne + fr) * 64 + 16 * nd + 4 * fq) = acc;
        }
    }
}
__device__ __forceinline__ void ph_mlstm_B(const Params& p, LAS unsigned char* lds, int tid, int G) {
    const float* U = (const float*)(p.ws + WS_U); const float* CHS = (const float*)(p.ws + WS_CHS);
    bf16_t* SNAP = (bf16_t*)(p.ws + WS_SNAP); float* MPREV = (float*)(p.ws + WS_CHS + 65536);
    LAS float* sFL = (LAS float*)lds; LAS float* sWM = sFL + 132;
    for (int b = blockIdx.x; b < 256; b += G) {
        const int hd = b >> 4, part = b & 15, dir = hd >> 3;
        __syncthreads();
        if (tid < NCH) { sFL[tid] = CHS[((size_t)hd * NCH + tid) * 2]; sWM[tid] = CHS[((size_t)hd * NCH + tid) * 2 + 1]; }
        __syncthreads();
        const int i0 = part * 512 + tid; const bool has2 = (part == 0 && tid < 64); const int i1 = 8192 + tid;
        float C0 = 0.f, C1 = 0.f, m = 0.f;
#pragma unroll 4
        for (int step = 0; step < NCH; ++step) {
            const int cc = dir ? (NCH - 1 - step) : (step < 4 ? 128 + step : step - 4);
            const size_t base = ((size_t)hd * NCH + cc) * 9216;
            const float u0 = U[base + i0], u1 = has2 ? U[base + i1] : 0.f;
            SNAP[base + i0] = (bf16_t)(pk2(C0, 0.f) & 0xffff);
            if (has2) SNAP[base + i1] = (bf16_t)(pk2(C1, 0.f) & 0xffff);
            if (part == 0 && tid == 0) MPREV[hd * NCH + cc] = m;
            const float FL = sFL[cc], wm = sWM[cc], mn = fmaxf(FL + m, wm), decay = expf(FL + m - mn), inj = expf(wm - mn);
            C0 = decay * C0 + inj * u0; C1 = decay * C1 + inj * u1; m = mn;
        }
    }
}
__device__ __forceinline__ void mlstm_C_unit(const Params& p, int e_idx, int cc, int head, int tq, int lane) {
    asm volatile("" : "+v"(lane));
    const int fr = lane & 15, fq = lane >> 4, tok0 = cc * 64, tl = 16 * tq + fr;
    unsigned char* proj = p.ws + WS_PROJ;
    const bf16_t* AQ = (const bf16_t*)(proj + PJ_AQ); const bf16_t* AK = (const bf16_t*)(proj + PJ_AK); const bf16_t* AVT = (const bf16_t*)(proj + PJ_AVT);
    const bf16_t* AO = (const bf16_t*)(proj + PJ_AO); const float* Gt = (const float*)(proj + PJ_G);
    const bf16_t* SNAP = (const bf16_t*)(p.ws + WS_SNAP); const float* MPREV = (const float*)(p.ws + WS_CHS + 65536);
    bf16_t* MIX = (bf16_t*)(p.ws + WS_MIX);
    bf16x8 qf[2];
#pragma unroll
    for (int kd = 0; kd < 2; ++kd) qf[kd] = *(const bf16x8*)(AQ + (size_t)(tok0 + tl) * 512 + head * 64 + 32 * kd + 8 * fq);
    f32x4 s[4];
#pragma unroll
    for (int ns = 0; ns < 4; ++ns) { s[ns] = (f32x4){0.f, 0.f, 0.f, 0.f};
#pragma unroll
        for (int kd = 0; kd < 2; ++kd) { const bf16x8 kf = *(const bf16x8*)(AK + (size_t)(tok0 + 16 * ns + fr) * 512 + head * 64 + 32 * kd + 8 * fq); s[ns] = MFMA16(kf, qf[kd], s[ns]); } }
    f32x4 hs[8];
#pragma unroll
    for (int ne = 0; ne < 8; ++ne) hs[ne] = (f32x4){0.f, 0.f, 0.f, 0.f};
    const float* grow = Gt + (size_t)(tok0 + lane) * 32;
    for (int dir = 0; dir < 2; ++dir) {
        const int hd = dir * 8 + head;
        const float ig = grow[(2 * dir) * 8 + head], lf = log_sigmoid(grow[(2 * dir + 1) * 8 + head]);
        const float F = scan_add(lf, lane, dir), Bs = ig - F, pm = scan_max(Bs, lane, dir);
        const float inter = F + MPREV[hd * NCH + cc], mt = fmaxf(inter, F + pm);
        const float A_t = __shfl(F - mt, tl), a_t = __shfl(expf(inter - mt), tl), fl_t = __shfl(expf(-mt), tl);
        bf16x8 pf[2];
#pragma unroll
        for (int ks = 0; ks < 2; ++ks) { unsigned w[4];
#pragma unroll
            for (int hf = 0; hf < 2; ++hf) { const int ns = 2 * ks + hf; float ev[4];
#pragma unroll
                for (int r = 0; r < 4; ++r) { const int sl = 16 * ns + 4 * fq + r; const float B_s = __shfl(Bs, sl);
                    const bool valid = dir ? (sl >= tl) : (sl <= tl);
                    ev[r] = s[ns][r] * expf(valid ? (A_t + B_s) : -INFINITY); }
                w[2 * hf] = pk2(ev[0], ev[1]); w[2 * hf + 1] = pk2(ev[2], ev[3]); }
            u32x4 ww; ww.x = w[0]; ww.y = w[1]; ww.z = w[2]; ww.w = w[3]; pf[ks] = mk_frag(ww); }
        const bf16_t* snap = SNAP + ((size_t)hd * NCH + cc) * 9216;
        float rden = 0.f;
#pragma unroll
        for (int it = 0; it < 9; ++it) {
            const int ne = (it == 0) ? 8 : it - 1;
            f32x4 acc = (f32x4){0.f, 0.f, 0.f, 0.f};
#pragma unroll
            for (int kd = 0; kd < 2; ++kd) {
                u32x4 cw = *(const u32x4*)(snap + (size_t)(16 * ne + fr) * 64 + 32 * kd + 8 * fq);
                if (ne == 8 && fr != 0) { cw.x = 0u; cw.y = 0u; cw.z = 0u; cw.w = 0u; }
                acc = MFMA16(mk_frag(cw), qf[kd], acc);
            }
            acc = acc * a_t;
#pragma unroll
            for (int ks = 0; ks < 2; ++ks) {
                u32x4 vw;
                if (ne < 8) { const bf16_t* vr = AVT + (size_t)(head * 128 + 16 * ne + fr) * M + tok0 + 32 * ks + 4 * fq;
                    const u32x2 a = *(const u32x2*)vr, b = *(const u32x2*)(vr + 16); vw.x = a.x; vw.y = a.y; vw.z = b.x; vw.w = b.y; }
                else { const unsigned onew = (fr == 0) ? 0x3F803F80u : 0u; vw.x = onew; vw.y = onew; vw.z = onew; vw.w = onew; }
                acc = MFMA16(mk_frag(vw), pf[ks], acc);
            }
            if (ne == 8) { const float den = __shfl(acc[0], fr); rden = 1.f / fmaxf(fabsf(den), fl_t); }
            else hs[ne] = hs[ne] + acc * rden;
        }
    }
    float ss = 0.f;
#pragma unroll
    for (int ne = 0; ne < 8; ++ne) ss += (hs[ne][0] * hs[ne][0] + hs[ne][1] * hs[ne][1]) + (hs[ne][2] * hs[ne][2] + hs[ne][3] * hs[ne][3]);
    ss += __shfl_xor(ss, 16); ss += __shfl_xor(ss, 32);
    const float rs = rsqrtf(ss * (1.f / 128.f) + EPS);
    const int tok = tok0 + tl;
#pragma unroll
    for (int ne = 0; ne < 8; ++ne) { const int col = head * 128 + 16 * ne + 4 * fq;
        const f32x4 g4 = *(const f32x4*)(p.ab_mh_g + (size_t)e_idx * 1024 + col);
        const u32x2 ow = *(const u32x2*)(AO + (size_t)tok * 1024 + col);
        const float o0 = bf_lo(ow.x), o1 = bf_hi(ow.x), o2 = bf_lo(ow.y), o3 = bf_hi(ow.y);
        const f32x4 v = hs[ne] * rs * g4;
        u32x2 w; w.x = pk2(v[0] / (1.f + expf(-o0)), v[1] / (1.f + expf(-o1))); w.y = pk2(v[2] / (1.f + expf(-o2)), v[3] / (1.f + expf(-o3)));
        *(u32x2*)(MIX + (size_t)tok * 2048 + col) = w; }
}

#define CE_DESC(a, b) do { const float _x = fmaxf(a, b), _y = fminf(a, b); a = _x; b = _y; } while (0)
__device__ __forceinline__ void sort16_desc(float (&v)[16]) {
#pragma unroll
    for (int k = 2; k <= 16; k <<= 1)
#pragma unroll
        for (int j = k >> 1; j > 0; j >>= 1)
#pragma unroll
            for (int i = 0; i < 16; ++i) { const int l = i ^ j; if (l > i) { if ((i & k) == 0) CE_DESC(v[i], v[l]); else CE_DESC(v[l], v[i]); } }
}
__device__ __forceinline__ void merge16_desc(float (&a)[16], const float (&b)[16]) {
#pragma unroll
    for (int i = 0; i < 16; ++i) a[i] = fmaxf(a[i], b[15 - i]);
#pragma unroll
    for (int j = 8; j > 0; j >>= 1)
#pragma unroll
        for (int i = 0; i < 16; ++i) { const int l = i ^ j; if (l > i) CE_DESC(a[i], a[l]); }
}
__device__ __forceinline__ void ce_desc_p(float& va, int& pa, float& vb, int& pb) {
    float nva, nvb; int npa, npb;
    asm volatile("v_cmp_gt_f32 vcc, %5, %4\n\tv_cndmask_b32 %0, %4, %5, vcc\n\tv_cndmask_b32 %1, %5, %4, vcc\n\tv_cndmask_b32 %2, %6, %7, vcc\n\tv_cndmask_b32 %3, %7, %6, vcc"
                 : "=&v"(nva), "=&v"(nvb), "=&v"(npa), "=&v"(npb) : "v"(va), "v"(vb), "v"(pa), "v"(pb) : "vcc");
    va = nva; vb = nvb; pa = npa; pb = npb;
}
#define CE_DESC_P(va, pa, vb, pb) ce_desc_p(va, pa, vb, pb)
__device__ __forceinline__ void sort16p_desc(float (&v)[16], int (&q)[16]) {
#pragma unroll
    for (int k = 2; k <= 16; k <<= 1)
#pragma unroll
        for (int j = k >> 1; j > 0; j >>= 1)
#pragma unroll
            for (int i = 0; i < 16; ++i) { const int l = i ^ j; if (l > i) { if ((i & k) == 0) CE_DESC_P(v[i], q[i], v[l], q[l]); else CE_DESC_P(v[l], q[l], v[i], q[i]); } }
}
__device__ __forceinline__ void merge16p_desc(float (&a)[16], int (&qa)[16], const float (&b)[16], const int (&qb)[16]) {
#pragma unroll
    for (int i = 0; i < 16; ++i) { float tb = b[15 - i]; int tq = qb[15 - i]; ce_desc_p(a[i], qa[i], tb, tq); }
#pragma unroll
    for (int j = 8; j > 0; j >>= 1)
#pragma unroll
        for (int i = 0; i < 16; ++i) { const int l = i ^ j; if (l > i) CE_DESC_P(a[i], qa[i], a[l], qa[l]); }
}
#define CAND_G0(X) X(0,0) X(0,1) X(0,2) X(0,3) X(0,4) X(0,5) X(0,6) X(0,7) X(0,8) X(0,9) X(0,10) X(0,11) X(0,12) X(0,13) X(0,14) X(0,15)
#define CAND_G1(X) X(1,0) X(1,1) X(1,2) X(1,3) X(1,4) X(1,5) X(1,6) X(1,7) X(2,0) X(2,1) X(2,2) X(2,3) X(2,4) X(3,0) X(3,1) X(3,2)
#define CAND_G2(X) X(3,3) X(4,0) X(4,1) X(4,2) X(5,0) X(5,1) X(6,0) X(6,1) X(7,0) X(7,1) X(8,0) X(9,0) X(10,0) X(11,0) X(12,0) X(13,0)
#define CAND_G3(X) X(14,0) X(15,0)

__device__ __forceinline__ void peer_topk_unit(const Params& p, int l, int mt, int hh, int lane) {
    asm volatile("" : "+v"(lane));
    const int fr = lane & 15, fq = lane >> 4, row = mt * 16 + fr;
    const bf16_t* QP = (const bf16_t*)(p.ws + WS_QP); const bf16_t* KEYS = (const bf16_t*)(p.ws + WS_KEYS);
    float s1[16], s2[16]; int i1[16], i2[16];
#pragma unroll
    for (int p2 = 0; p2 < 2; ++p2) {
        bf16x8 qf[4];
#pragma unroll
        for (int kd = 0; kd < 4; ++kd) qf[kd] = *(const bf16x8*)(QP + (size_t)row * 2048 + hh * 256 + p2 * 128 + 32 * kd + 8 * fq);
        float a[16], b[16];
#pragma unroll
        for (int nk = 0; nk < 8; ++nk) {
            f32x4 acc = (f32x4){0.f, 0.f, 0.f, 0.f};
#pragma unroll
            for (int kd = 0; kd < 4; ++kd) { const bf16x8 kf = *(const bf16x8*)(KEYS + ((((size_t)l * 8 + hh) * 2 + p2) * 128 + 16 * nk + fr) * 128 + 32 * kd + 8 * fq); acc = MFMA16(kf, qf[kd], acc); }
#pragma unroll
            for (int r = 0; r < 4; ++r) { const unsigned idx = 16 * nk + 4 * fq + r; const float v = __uint_as_float((__float_as_uint(acc[r]) & ~0x7Fu) | idx);
                if (nk < 4) a[4 * nk + r] = v; else b[4 * (nk - 4) + r] = v; }
            __builtin_amdgcn_sched_barrier(0);
        }
        sort16_desc(a); sort16_desc(b); merge16_desc(a, b);
#pragma unroll
        for (int i = 0; i < 16; ++i) b[i] = __shfl_xor(a[i], 16);
        merge16_desc(a, b);
#pragma unroll
        for (int i = 0; i < 16; ++i) b[i] = __shfl_xor(a[i], 32);
        merge16_desc(a, b);
#pragma unroll
        for (int i = 0; i < 16; ++i) { const unsigned bits = __float_as_uint(a[i]); const float v = __uint_as_float(bits & ~0x7Fu); const int id = (int)(bits & 0x7Fu);
            if (p2 == 0) { s1[i] = v; i1[i] = id; } else { s2[i] = v; i2[i] = id; } }
    }
    float tv[16], gv[16]; int tp[16], gp[16];
    { int ci = 0;
#define CX(A, B) tv[ci] = s1[A] + s2[B]; tp[ci] = i1[A] * 128 + i2[B]; ++ci;
      CAND_G0(CX)
      sort16p_desc(tv, tp); }
    { int ci = 0;
#define CY(A, B) gv[ci] = s1[A] + s2[B]; gp[ci] = i1[A] * 128 + i2[B]; ++ci;
      CAND_G1(CY)
      sort16p_desc(gv, gp); merge16p_desc(tv, tp, gv, gp); }
    { int ci = 0;
      CAND_G2(CY)
      sort16p_desc(gv, gp); merge16p_desc(tv, tp, gv, gp); }
    { int ci = 0;
      CAND_G3(CY)
#pragma unroll
      for (int i = 2; i < 16; ++i) { gv[i] = -1e30f; gp[i] = 0; }
      sort16p_desc(gv, gp); merge16p_desc(tv, tp, gv, gp); }
#undef CX
#undef CY
    float sum = 0.f; const float tmx = tv[0];
#pragma unroll
    for (int i = 0; i < 16; ++i) { tv[i] = expf(tv[i] - tmx); sum += tv[i]; }
    const float rsum = 1.f / sum;
    if (fq == 0) {
        int* IDX = (int*)(p.ws + WS_IDX) + (size_t)row * 128 + hh * 16; float* GT = (float*)(p.ws + WS_GATE) + (size_t)row * 128 + hh * 16;
#pragma unroll
        for (int i = 0; i < 16; i += 4) {
            *(int4*)(IDX + i) = make_int4(tp[i], tp[i + 1], tp[i + 2], tp[i + 3]);
            *(f32x4*)(GT + i) = (f32x4){tv[i] * rsum, tv[i + 1] * rsum, tv[i + 2] * rsum, tv[i + 3] * rsum};
        }
    }
}

__device__ __forceinline__ void peer_gather_token(const Params& p, int l, int m, int lane) {
    asm volatile("" : "+v"(lane));
    const float* U = p.peer_u + (size_t)l * 16384 * D; const float* V = p.peer_v + (size_t)l * 16384 * D;
    const bf16_t* H = (const bf16_t*)(p.ws + WS_H) + (size_t)m * D; float* X = (float*)(p.ws + WS_X) + (size_t)m * D;
    const int* IDX = (const int*)(p.ws + WS_IDX) + (size_t)m * 128; const float* GT = (const float*)(p.ws + WS_GATE) + (size_t)m * 128;
    f32x4 h[8];
#pragma unroll
    for (int j = 0; j < 8; ++j) { const u32x2 w = *(const u32x2*)(H + 256 * j + 4 * lane); h[j] = (f32x4){bf_lo(w.x), bf_hi(w.x), bf_lo(w.y), bf_hi(w.y)}; }
    const int id0 = IDX[lane], id1 = IDX[64 + lane];
    float act0 = 0.f, act1 = 0.f;
    for (int k = 0; k < 128; ++k) {
        const int e = __shfl(k < 64 ? id0 : id1, k & 63);
        const f32x4* ur = (const f32x4*)(U + (size_t)e * D) + lane;
        float d = 0.f;
#pragma unroll
        for (int j = 0; j < 8; ++j) { const f32x4 u = ur[64 * j]; d += (u.x * h[j].x + u.y * h[j].y) + (u.z * h[j].z + u.w * h[j].w); }
        d = wave_sum(d);
        if (k < 64) act0 = (lane == k) ? d : act0; else act1 = (lane == k - 64) ? d : act1;
    }
    const float c0 = GT[lane] * (0.5f * act0 * (1.f + erff(act0 * 0.70710678118654752f)));
    const float c1 = GT[64 + lane] * (0.5f * act1 * (1.f + erff(act1 * 0.70710678118654752f)));
    f32x4 y[8];
#pragma unroll
    for (int j = 0; j < 8; ++j) y[j] = (f32x4){0.f, 0.f, 0.f, 0.f};
    for (int k = 0; k < 128; ++k) {
        const int e = __shfl(k < 64 ? id0 : id1, k & 63);
        const float cf = __shfl(k < 64 ? c0 : c1, k & 63);
        const f32x4* vr = (const f32x4*)(V + (size_t)e * D) + lane;
#pragma unroll
        for (int j = 0; j < 8; ++j) y[j] = y[j] + vr[64 * j] * cf;
    }
    const float* g = (const float*)(p.ws + WS_MOD) + ((size_t)l * 2 + (m >= T ? 1 : 0)) * D6 + 5 * D;
#pragma unroll
    for (int j = 0; j < 8; ++j) { const int col = 256 * j + 4 * lane; f32x4* xp = (f32x4*)(X + col); *xp = *xp + *(const f32x4*)(g + col) * y[j]; }
}

__device__ __forceinline__ Params load_params(const CAS Params* k) {
    Params r;
#define LP(f) r.f = k->f;
    LP(x) LP(c) LP(ctx) LP(c_ctx) LP(ada_w) LP(ada_b) LP(norm1_g) LP(norm2_g) LP(ab_w_in) LP(ab_gate_b) LP(ab_mh_g) LP(ab_sink) LP(ab_w_out)
    LP(na_w_in) LP(na_rpb) LP(na_w_out) LP(peer_wq) LP(peer_keys) LP(peer_u) LP(peer_v) LP(final_g) LP(out) LP(ws) LP(ph_lo) LP(ph_hi)
#undef LP
    return r;
}
constexpr int PH_PER_LAYER = 10, PH_FINAL = 1 + DEPTH * PH_PER_LAYER, N_PHASES = PH_FINAL + 1;
template <unsigned PH_MASK> __global__ void __launch_bounds__(NWAVES * 64, 2) fwd_kernel(Params p) {
    extern __shared__ __attribute__((aligned(16))) unsigned char lds_raw[];
    LAS unsigned char* lds = (LAS unsigned char*)lds_raw;
    const int wave = __builtin_amdgcn_readfirstlane((int)threadIdx.x >> 6);
#define LANE_ID() ((int)__builtin_amdgcn_mbcnt_hi(~0u, __builtin_amdgcn_mbcnt_lo(~0u, 0u)))
    const int G = gridDim.x; const int bx = blockIdx.x; const int vcu = (G % 8 == 0) ? (bx % 8) * (G / 8) + bx / 8 : bx;
    const int gw = vcu * NWAVES + wave, NGW = G * NWAVES;
    volatile LAS unsigned* MISC = (volatile LAS unsigned*)(lds + LDS_MISC);
    if (wave == 0) MISC[LANE_ID()] = 0u;
    __syncthreads();
    XcdBarrier bar = xcd_barrier_post((unsigned*)(((const CAS Params*)__builtin_amdgcn_kernarg_segment_ptr())->ws + WS_CTL) + 4096, MISC + 8, wave * 64 + LANE_ID());
    const CAS Params* kp = (const CAS Params*)__builtin_amdgcn_kernarg_segment_ptr();
    const int lo = kp->ph_lo, hi = kp->ph_hi;
#define PM(k) (((PH_MASK) >> (k)) & 1u)
#define IN(k) (lo <= (k) && (k) < hi)
#define SEAM(k) do { if (IN(k) && IN((k) + 1)) xcd_barrier(bar, wave * 64 + LANE_ID()); } while (0)
#define LAUNDER() const CAS Params* kq_ = kp; asm volatile("" : "+s"(kq_)); const Params pl = load_params(kq_); unsigned char* ws = pl.ws; int ll = LANE_ID(); asm volatile("" : "+v"(ll)); const int tid = wave * 64 + ll; (void)ws; (void)ll; (void)tid
    if (PM(0) && IN(0)) { LAUNDER(); ph_prologue(pl, lds, tid, ll, wave, vcu, G); __syncthreads(); }
    SEAM(0);
    for (int l = 0; l < DEPTH; ++l) {
        const int pb = 1 + l * PH_PER_LAYER; const bool even = (l & 1) == 0; const int ei = l >> 1; const bool with_ctx = l < DEPTH - 1;
        if (PM(1) && IN(pb + 0)) { LAUNDER(); ph_norm(pl, l, 0, ll, gw, NGW); }
        SEAM(pb + 0);
        if (PM(2) && IN(pb + 1)) {
            LAUNDER();
            if (even) { pg8::Gemm g{(const bf16_t*)(ws + WS_H), (const bf16_t*)(ws + WS_WAB_IN) + (size_t)ei * NAB * D, M, NAB, D}; pg8::StaticOrder S; S.init(M, NAB, G, bx);
                EpiEven E{ws + WS_PROJ, pl.ab_gate_b + ei * 32, (const float2*)(ws + WS_ROPE)};
                pg8::gemm_phase<EpiEven, pg8::StaticOrder, false>(lds, g, S, E, nullptr, tid); }
            else { pg8::Gemm g{(const bf16_t*)(ws + WS_H), (const bf16_t*)(ws + WS_WNA_IN) + (size_t)ei * NNA * D, M, NNA, D}; pg8::StaticOrder S; S.init(M, NNA, G, bx);
                EpiOdd E{ws + WS_PROJ};
                pg8::gemm_phase<EpiOdd, pg8::StaticOrder, false>(lds, g, S, E, nullptr, tid); }
        }
        SEAM(pb + 1);
        if (PM(3) && IN(pb + 2)) {
            LAUNDER();
            if (even) { ph_attn_even(pl, ei, with_ctx, ll, wave, vcu, G);
                for (int q = gw; q < NCH * 16; q += NGW) mlstm_A_unit(pl, q >> 4, q & 15, ll); }
            else ph_attn_odd(pl, ei, with_ctx, ll, wave, vcu, G);
        }
        SEAM(pb + 2);
        if (PM(4) && IN(pb + 3)) { LAUNDER(); if (even) ph_mlstm_B(pl, lds, tid, G); }
        SEAM(pb + 3);
        if (PM(5) && IN(pb + 4)) { LAUNDER(); if (even) for (int q = gw; q < NCH * 32; q += NGW) mlstm_C_unit(pl, ei, q >> 5, (q >> 2) & 7, q & 3, ll); }
        SEAM(pb + 4);
        if (PM(6) && IN(pb + 5)) {
            LAUNDER();
            const float* MODl = (const float*)(ws + WS_MOD) + (size_t)l * 2 * D6;
            pg8::Gemm g{(const bf16_t*)(ws + WS_MIX), even ? (const bf16_t*)(ws + WS_WAB_OUT) + (size_t)ei * D * D : (const bf16_t*)(ws + WS_WNA_OUT) + (size_t)ei * D * D, M, D, D};
            pg8::StaticOrder S; S.init(M, D, G, bx);
            EpiResid E{(float*)(ws + WS_X), MODl + 2 * D, MODl + D6 + 2 * D};
            pg8::gemm_phase<EpiResid, pg8::StaticOrder, false>(lds, g, S, E, nullptr, tid);
        }
        SEAM(pb + 5);
        if (PM(7) && IN(pb + 6)) { LAUNDER(); ph_norm(pl, l, 1, ll, gw, NGW); }
        SEAM(pb + 6);
        if (PM(8) && IN(pb + 7)) {
            LAUNDER();
            pg8::Gemm g{(const bf16_t*)(ws + WS_H), (const bf16_t*)(ws + WS_WQ) + (size_t)l * D * D, M, D, D};
            pg8::StaticOrder S; S.init(M, D, G, bx);
            EpiPlain E{(bf16_t*)(ws + WS_QP)};
            pg8::gemm_phase<EpiPlain, pg8::StaticOrder, false>(lds, g, S, E, nullptr, tid);
        }
        SEAM(pb + 7);
        if (PM(9) && IN(pb + 8)) { LAUNDER(); for (int q = gw; q < (M / 16) * 8; q += NGW) peer_topk_unit(pl, l, q >> 3, q & 7, ll); }
        SEAM(pb + 8);
        if (PM(10) && IN(pb + 9)) { LAUNDER(); for (int m = gw; m < M; m += NGW) peer_gather_token(pl, l, m, ll); }
        SEAM(pb + 9);
    }
    if (PM(11) && IN(PH_FINAL)) { LAUNDER(); ph_final(pl, ll, gw, NGW); }
#undef IN
#undef SEAM
#undef LAUNDER
#undef LANE_ID
}

#ifndef MK_ONE_LAUNCH
#define MK_ONE_LAUNCH 0
#endif
typedef void (*kern_t)(Params);
static kern_t kern_for_bit(int b) {
    switch (b) {
        case 0: return fwd_kernel<1u << 0>; case 1: return fwd_kernel<1u << 1>; case 2: return fwd_kernel<1u << 2>; case 3: return fwd_kernel<1u << 3>;
        case 4: return fwd_kernel<1u << 4>; case 5: return fwd_kernel<1u << 5>; case 6: return fwd_kernel<1u << 6>; case 7: return fwd_kernel<1u << 7>;
        case 8: return fwd_kernel<1u << 8>; case 9: return fwd_kernel<1u << 9>; case 10: return fwd_kernel<1u << 10>; default: return fwd_kernel<1u << 11>;
    }
}
extern "C" void kernel_launch(void* const* d_in, const int* in_sizes, int n_in, void* d_out, int out_size, void* d_ws, size_t ws_size, hipStream_t stream) {
    static int grid = 0;
    if (grid == 0) {
        int dev = 0, cus = 0;
        if (n_in != 21 || ws_size < WS_END) { fprintf(stderr, "kernel_launch: unexpected inputs (n_in %d, ws %zu)\n", n_in, ws_size); grid = -1; return; }
        if (hipGetDevice(&dev) != hipSuccess || hipDeviceGetAttribute(&cus, hipDeviceAttributeMultiprocessorCount, dev) != hipSuccess) { grid = -1; return; }
#if MK_ONE_LAUNCH
        if (hipFuncSetAttribute((const void*)fwd_kernel<0xFFFu>, hipFuncAttributeMaxDynamicSharedMemorySize, LDS_BYTES) != hipSuccess) { fprintf(stderr, "kernel_launch: hipFuncSetAttribute failed\n"); grid = -1; return; }
#else
        for (int b = 0; b < 12; ++b) if (hipFuncSetAttribute((const void*)kern_for_bit(b), hipFuncAttributeMaxDynamicSharedMemorySize, LDS_BYTES) != hipSuccess) { fprintf(stderr, "kernel_launch: hipFuncSetAttribute failed\n"); grid = -1; return; }
#endif
        (void)hipGetLastError();
        grid = cus;
    }
    if (grid < 0) return;
    (void)hipMemsetAsync((char*)d_ws + WS_CTL, 0, CTL_ZERO_BYTES, stream);
    Params p{};
    const float** pin = (const float**)&p;
    for (int i = 0; i < 21; ++i) pin[i] = (const float*)d_in[i];
    p.out = (float*)d_out; p.ws = (unsigned char*)d_ws;
#if MK_ONE_LAUNCH
    p.ph_lo = 0; p.ph_hi = N_PHASES;
    hipLaunchKernelGGL(fwd_kernel<0xFFFu>, dim3(grid), dim3(NWAVES * 64), LDS_BYTES, stream, p);
#else
    for (int ph = 0; ph < N_PHASES; ++ph) {
        int bit = 0;
        if (ph == PH_FINAL) bit = 11;
        else if (ph >= 1) { const int l = (ph - 1) / PH_PER_LAYER, k = (ph - 1) % PH_PER_LAYER; if ((l & 1) && (k == 3 || k == 4)) continue; bit = 1 + k; }
        p.ph_lo = ph; p.ph_hi = ph + 1;
        hipLaunchKernelGGL(kern_for_bit(bit), dim3(grid), dim3(NWAVES * 64), LDS_BYTES, stream, p);
    }
#endif
}
```

```cpp
#include <hip/hip_runtime.h>
#include <cstdio>
#include <cstdint>
namespace pg8 {
#define PG8_LAS __attribute__((address_space(3)))
typedef unsigned short bf16_t;
typedef short bf16x8 __attribute__((ext_vector_type(8)));
typedef float f32x4 __attribute__((ext_vector_type(4)));
typedef unsigned u32x4 __attribute__((ext_vector_type(4)));
constexpr int BM = 256, BK = 64, HALF = 128, HTB = HALF * BK * 2  , STAGE_BYTES = 8 * HTB, NXCD = 8, WGM = 8;

__host__ __device__ __forceinline__ int lds_byte(int r, int c) { const int st = (r >> 4) * 2 + (c >> 5), rr = r & 15, cc = c & 31, ob = rr * 64 + cc * 2; return st * 1024 + (ob ^ (((ob >> 9) & 1) << 5)); }
__host__ __device__ __forceinline__ void stage_rc(int b, int& R, int& C) { const int st = b / 1024, sb = b % 1024, swz = sb ^ (((sb >> 9) & 1) << 5); R = (st >> 1) * 16 + swz / 64; C = (st & 1) * 32 + (swz % 64) / 2; }
__host__ __device__ __forceinline__ int perm32(int rho) { const int n = rho >> 4, i = rho & 15; return 8 * (i >> 2) + 4 * n + (i & 3); }

struct Unit { int pm, pn; };
struct Gemm { const bf16_t* A; const bf16_t* Bt; int M, N, K; };

struct StaticOrder {
    int nM, nN, nwg, G, c;
    __host__ __device__ void init(int M, int N, int G_, int c_) { nM = M / BM; nN = N / BM; nwg = nM * nN; G = G_; c = c_; }
    __host__ __device__ __forceinline__ bool next(int i, Unit& u) const {
        const long L = (long)i * G + c; if (L >= nwg) return false;
        int wgid = (int)L; { const int q = nwg / NXCD, r = nwg % NXCD, xcd = wgid % NXCD, off = wgid / NXCD; wgid = (xcd < r ? xcd * (q + 1) : r * (q + 1) + (xcd - r) * q) + off; }
        const int nig = WGM * nN, gid = wgid / nig, fm = gid * WGM, gsz = (nM - fm) < WGM ? (nM - fm) : WGM;
        u.pm = fm + ((wgid % nig) % gsz); u.pn = (wgid % nig) / gsz; return true;
    }
    __device__ __forceinline__ void a_ready(const Unit&) const {}
    __device__ __forceinline__ void done(const Unit&) const {}
};
__device__ __forceinline__ unsigned cvt_pk_bf16(float lo, float hi) { unsigned r; asm volatile("s_nop 1\n\tv_cvt_pk_bf16_f32 %0, %1, %2\n\ts_nop 1" : "=v"(r) : "v"(lo), "v"(hi)); return r; }
template <class Epi, class Sched, bool STAMP = false>
__device__ __forceinline__ void gemm_phase(PG8_LAS unsigned char* lds, const Gemm g, const Sched& S, const Epi& E, unsigned long long* stamps, int tid_in) {
    int tid_l = tid_in; asm volatile("" : "+v"(tid_l));
    const int tid = tid_l, wid = __builtin_amdgcn_readfirstlane(tid >> 6), lane = tid & 63, wr = wid >> 2, wc = wid & 3, fr = lane & 15, fq = lane >> 4;
    const int K = g.K, nt = K / BK;
    int ts_lo = 0, ts_hi = 0, nts = 0; const unsigned long long rt_entry = STAMP ? (unsigned long long)wall_clock64() : 0ull;
#define PG8_STAMP() do { if (STAMP && wid == 0 && nts < 64) { const unsigned long long _c = (unsigned long long)clock64(); \
        ts_lo = (lane == nts) ? (int)(unsigned)_c : ts_lo; ts_hi = (lane == nts) ? (int)(unsigned)(_c >> 32) : ts_hi; ++nts; } } while (0)
    PG8_STAMP();
    unsigned voffA[2], voffB[2];
#pragma unroll
    for (int i = 0; i < 2; ++i) { int R, C; stage_rc(tid * 16 + i * 8192, R, C); const int Rb = Epi::PERM ? ((R & ~31) + perm32(R & 31)) : R;
        voffA[i] = (unsigned)(R * K + C) * 2u; voffB[i] = (unsigned)(Rb * K + C) * 2u; }
    const size_t kstep = (size_t)(BK * 2);
    const size_t hstep = (size_t)HALF * K * 2;
    const size_t tstep = 2 * hstep;
    const unsigned ldsw = (unsigned)wid * 1024u;
    const int aoff = lds_byte(wr * 64 + fr, fq * 8), boff = lds_byte(wc * 32 + fr, fq * 8);
#define PG8_SA(b, h) (((b) * 2 + (h)) * HTB)
#define PG8_SB(b, h) ((4 + (b) * 2 + (h)) * HTB)
#define PG8_STAGE(bufoff, gbase, voff) do { _Pragma("unroll") for (int _i = 0; _i < 2; ++_i) \
        __builtin_amdgcn_global_load_lds((const unsigned*)((const char*)(gbase) + (voff)[_i]), (PG8_LAS unsigned*)(lds + (bufoff) + ldsw + _i * 8192), 16, 0, 0); } while (0)
#define PG8_LDA(dst, b, h) do { _Pragma("unroll") for (int m = 0; m < 4; ++m) _Pragma("unroll") for (int k = 0; k < 2; ++k) dst[m][k] = *(const PG8_LAS bf16x8*)(lds + PG8_SA(b, h) + aoff + m * 2048 + k * 1024); } while (0)
#define PG8_LDB(dst, b, h) do { _Pragma("unroll") for (int n = 0; n < 2; ++n) _Pragma("unroll") for (int k = 0; k < 2; ++k) dst[n][k] = *(const PG8_LAS bf16x8*)(lds + PG8_SB(b, h) + boff + n * 2048 + k * 1024); } while (0)
#define PG8_MMA(ai, bj, At, Bt) do { __builtin_amdgcn_s_setprio(1); _Pragma("unroll") for (int m = 0; m < 4; ++m) _Pragma("unroll") for (int n = 0; n < 2; ++n) _Pragma("unroll") for (int k = 0; k < 2; ++k) \
        acc[ai][bj][m][n] = __builtin_amdgcn_mfma_f32_16x16x32_bf16(Bt[n][k], At[m][k], acc[ai][bj][m][n], 0, 0, 0); __builtin_amdgcn_s_setprio(0); } while (0)
#define PG8_WAIT_V(n) asm volatile("s_waitcnt vmcnt(" #n ")" ::: "memory")
#define PG8_WAIT_L(n) asm volatile("s_waitcnt lgkmcnt(" #n ")" ::: "memory")
#define PG8_BAR __builtin_amdgcn_s_barrier()
#define PG8_SCHED __builtin_amdgcn_sched_barrier(0)
    Unit cur, nxt; int ui = 0;
    if (!S.next(0, cur)) return;
    f32x4 acc[2][2][4][2];
#pragma unroll
    for (int a = 0; a < 2; ++a)
#pragma unroll
        for (int b = 0; b < 2; ++b)
#pragma unroll
            for (int m = 0; m < 4; ++m)
#pragma unroll
                for (int n = 0; n < 2; ++n) acc[a][b][m][n] = (f32x4){0.f, 0.f, 0.f, 0.f};
    bf16x8 At[4][2], B0[2][2], B1[2][2];
    const char* cA = (const char*)g.A + (size_t)cur.pm * tstep; const char* cB = (const char*)g.Bt + (size_t)cur.pn * tstep;
    S.a_ready(cur);
    PG8_STAGE(PG8_SB(0, 0), cB, voffB); PG8_STAGE(PG8_SA(0, 0), cA, voffA); PG8_STAGE(PG8_SB(0, 1), cB + hstep, voffB); PG8_STAGE(PG8_SA(0, 1), cA + hstep, voffA);
    if (wr == 1) PG8_BAR;
    PG8_WAIT_V(4); PG8_BAR;
    PG8_STAGE(PG8_SB(1, 0), cB + kstep, voffB); PG8_STAGE(PG8_SA(1, 0), cA + kstep, voffA); PG8_STAGE(PG8_SB(1, 1), cB + hstep + kstep, voffB);
    PG8_WAIT_V(6); PG8_BAR;
    PG8_STAMP();
    for (;;) {
        const bool has_next = S.next(ui + 1, nxt);
        const char* nA = has_next ? (const char*)g.A + (size_t)nxt.pm * tstep : cA; const char* nB = has_next ? (const char*)g.Bt + (size_t)nxt.pn * tstep : cB;
        for (int t = 0; t < nt; t += 2) {
            const bool last = (t == nt - 2);
            const char* a1 = cA + (size_t)(t + 1) * kstep;
            const char* a2 = last ? nA : cA + (size_t)(t + 2) * kstep; const char* b2 = last ? nB : cB + (size_t)(t + 2) * kstep;
            const char* a3 = a2 + kstep; const char* b3 = b2 + kstep;
            if (last && has_next) S.a_ready(nxt);
            PG8_LDB(B0, 0, 0); PG8_SCHED; PG8_LDA(At, 0, 0); PG8_STAGE(PG8_SA(1, 1), a1 + hstep, voffA);
            PG8_WAIT_L(8); PG8_BAR; PG8_WAIT_L(0); PG8_MMA(0, 0, At, B0); PG8_BAR; PG8_SCHED;
            PG8_LDB(B1, 0, 1); PG8_STAGE(PG8_SB(0, 0), b2, voffB);
            PG8_BAR; PG8_WAIT_L(0); PG8_MMA(0, 1, At, B1); PG8_BAR;
            PG8_LDA(At, 0, 1); PG8_STAGE(PG8_SA(0, 0), a2, voffA);
            PG8_BAR; PG8_WAIT_L(0); PG8_MMA(1, 0, At, B0); PG8_BAR; PG8_SCHED;
            PG8_STAGE(PG8_SB(0, 1), b2 + hstep, voffB);
            PG8_WAIT_V(6); PG8_BAR; PG8_MMA(1, 1, At, B1); PG8_BAR;
            PG8_LDB(B0, 1, 0); PG8_SCHED; PG8_LDA(At, 1, 0); PG8_STAGE(PG8_SA(0, 1), a2 + hstep, voffA);
            PG8_WAIT_L(8); PG8_BAR; PG8_WAIT_L(0); PG8_MMA(0, 0, At, B0); PG8_BAR; PG8_SCHED;
            PG8_LDB(B1, 1, 1); PG8_STAGE(PG8_SB(1, 0), b3, voffB);
            PG8_BAR; PG8_WAIT_L(0); PG8_MMA(0, 1, At, B1); PG8_BAR;
            PG8_LDA(At, 1, 1); PG8_STAGE(PG8_SA(1, 0), a3, voffA);
            PG8_BAR; PG8_WAIT_L(0); PG8_MMA(1, 0, At, B0); PG8_BAR; PG8_SCHED;
            PG8_STAGE(PG8_SB(1, 1), b3 + hstep, voffB);
            PG8_WAIT_V(6); PG8_BAR; PG8_MMA(1, 1, At, B1); PG8_BAR;
        }
        PG8_STAMP();
        if constexpr (!Epi::AFTER_DRAIN) { E(acc, cur, wr, wc, fr, fq); S.done(cur); }
        PG8_STAMP();
        if (!has_next) break;
#pragma unroll
        for (int a = 0; a < 2; ++a)
#pragma unroll
            for (int b = 0; b < 2; ++b)
#pragma unroll
                for (int m = 0; m < 4; ++m)
#pragma unroll
                    for (int n = 0; n < 2; ++n) acc[a][b][m][n] = (f32x4){0.f, 0.f, 0.f, 0.f};
        cur = nxt; cA = nA; cB = nB; ++ui;
    }
    PG8_WAIT_V(0);
    if (wr == 0) PG8_BAR;
    PG8_BAR;
    if constexpr (Epi::AFTER_DRAIN) { E.fused(acc, cur, wr, wc, fr, fq, lds, wid, lane); S.done(cur); }
    PG8_STAMP();
    if (STAMP && wid == 0) { stamps[lane] = lane < nts ? (((unsigned long long)(unsigned)ts_hi << 32) | (unsigned)ts_lo) : 0ull;
        if (lane == 62) stamps[62] = rt_entry; if (lane == 63) stamps[63] = (unsigned long long)wall_clock64(); }
#undef PG8_STAMP
#undef PG8_SA
#undef PG8_SB
#undef PG8_STAGE
#undef PG8_LDA
#undef PG8_LDB
#undef PG8_MMA
#undef PG8_WAIT_V
#undef PG8_WAIT_L
#undef PG8_BAR
#undef PG8_SCHED
}
}

constexpr int D = 2048, T = 8192, LC = 256, M = T + LC, DEPTH = 4, D6 = 6 * D;
constexpr int NAB = 4864, NNA = 6144;
constexpr int NCH = M / 64;
constexpr float EPS = 1e-6f, LOG2E = 1.4426950408889634f;
constexpr int NWAVES = 8;

constexpr size_t MiB = 1u << 20;
constexpr size_t WS_CTL = 0, CTL_ZERO_BYTES = 32768;
constexpr size_t WS_MOD = 1 * MiB;
constexpr size_t WS_ROPE = 2 * MiB;
constexpr size_t WS_KEYS = 3 * MiB;
constexpr size_t WS_WAB_IN = 8 * MiB;
constexpr size_t WS_WAB_OUT = 46 * MiB;
constexpr size_t WS_WNA_IN = 62 * MiB;
constexpr size_t WS_WNA_OUT = 110 * MiB;
constexpr size_t WS_WQ = 126 * MiB;
constexpr size_t WS_X = 160 * MiB;
constexpr size_t WS_H = 226 * MiB;
constexpr size_t WS_PROJ = 260 * MiB;
constexpr size_t WS_MIX = 360 * MiB;
constexpr size_t WS_QP = 394 * MiB;
constexpr size_t WS_IDX = 428 * MiB;
constexpr size_t WS_GATE = 433 * MiB;
constexpr size_t WS_U = 440 * MiB;
constexpr size_t WS_SNAP = 516 * MiB;
constexpr size_t WS_CHS = 554 * MiB;
constexpr size_t WS_GF = 555 * MiB;
constexpr size_t WS_H8 = 564 * MiB;
constexpr size_t WS_SH = 581 * MiB;
constexpr size_t WS_SU = 582 * MiB;
constexpr size_t WS_SV = 583 * MiB;
constexpr size_t WS_U8 = 584 * MiB;
constexpr size_t WS_V8 = 712 * MiB;
constexpr size_t WS_WQC = 842 * MiB;
constexpr size_t WS_BQ = 866 * MiB;
constexpr size_t WS_XB = 868 * MiB;
constexpr size_t WS_PART = 902 * MiB;
constexpr size_t WS_PARTC = 903 * MiB;
constexpr size_t WS_PARTB = 904 * MiB;
constexpr size_t WS_DELTA = 906 * MiB;
constexpr size_t WS_END = 972 * MiB;
constexpr size_t PJ_Q = 0, PJ_K = 33 * MiB, PJ_VT = 66 * MiB;
constexpr size_t PJ_AQ = 0, PJ_AK = 9 * MiB, PJ_AKT = 18 * MiB, PJ_AVT = 27 * MiB, PJ_AO = 44 * MiB,
                 PJ_BQ = 61 * MiB, PJ_BK = 78 * MiB, PJ_BVT = 83 * MiB, PJ_G = 88 * MiB;
constexpr int LDS_BYTES = 147456;
constexpr int LDS_MISC = 131072;

#define LAS __attribute__((address_space(3)))
#define CAS __attribute__((address_space(4)))
typedef unsigned short bf16_t;
typedef short bf16x8 __attribute__((ext_vector_type(8)));
typedef float f32x4 __attribute__((ext_vector_type(4)));
typedef unsigned u32x4 __attribute__((ext_vector_type(4)));
typedef unsigned u32x2 __attribute__((ext_vector_type(2)));

struct Params {
    const float *x, *c, *ctx, *c_ctx, *ada_w, *ada_b, *norm1_g, *norm2_g, *ab_w_in, *ab_gate_b, *ab_mh_g, *ab_sink, *ab_w_out,
                *na_w_in, *na_rpb, *na_w_out, *peer_wq, *peer_keys, *peer_u, *peer_v, *final_g;
    float* out; unsigned char* ws; int ph_lo, ph_hi, grid, pad;
};

__device__ __forceinline__ float bf_lo(unsigned w) { return __uint_as_float(w << 16); }
__device__ __forceinline__ float bf_hi(unsigned w) { return __uint_as_float(w & 0xffff0000u); }
__device__ __forceinline__ unsigned pk2(float lo, float hi) { return pg8::cvt_pk_bf16(lo, hi); }
__device__ __forceinline__ float wave_sum(float v) {
#pragma unroll
    for (int o = 1; o < 64; o <<= 1) v += __shfl_xor(v, o);
    return v;
}
__device__ __forceinline__ float wave_max(float v) {
#pragma unroll
    for (int o = 1; o < 64; o <<= 1) v = fmaxf(v, __shfl_xor(v, o));
    return v;
}
__device__ __forceinline__ float scan_add(float x, int lane, int suffix) {
#pragma unroll
    for (int off = 1; off < 64; off <<= 1) {
        const float up = __shfl_up(x, off), dn = __shfl_down(x, off);
        const bool ok = suffix ? (lane + off < 64) : (lane >= off);
        x = ok ? x + (suffix ? dn : up) : x;
    }
    return x;
}
__device__ __forceinline__ float scan_max(float x, int lane, int suffix) {
#pragma unroll
    for (int off = 1; off < 64; off <<= 1) {
        const float up = __shfl_up(x, off), dn = __shfl_down(x, off);
        const bool ok = suffix ? (lane + off < 64) : (lane >= off);
        x = ok ? fmaxf(x, suffix ? dn : up) : x;
    }
    return x;
}
__device__ __forceinline__ float fq_max(float v) { v = fmaxf(v, __shfl_xor(v, 16)); return fmaxf(v, __shfl_xor(v, 32)); }
__device__ __forceinline__ float fq_sum(float v) { v += __shfl_xor(v, 16); return v + __shfl_xor(v, 32); }
__device__ __forceinline__ float log_sigmoid(float x) { return fminf(x, 0.f) - log1pf(expf(-fabsf(x))); }
__device__ __forceinline__ bf16x8 mk_frag(u32x4 w) { return __builtin_bit_cast(bf16x8, w); }
#define MFMA16(a, b, c) __builtin_amdgcn_mfma_f32_16x16x32_bf16((a), (b), (c), 0, 0, 0)

#define XB_TMO      128
#define XB_XCNT(j)  (256  + 64 * (j))
#define XB_XSUB(j)  (1280 + 64 * (j))
#define XB_XGEN(j)  (2304 + 64 * (j))
#define XB_TOP      3328
#define XB_TOPGEN   3392
#define XCD_BAR_WORDS 3456
#define XB_SPIN_CAP (1u << 22)
__device__ __forceinline__ unsigned xb_ld(unsigned* p)              { return __hip_atomic_load(p, __ATOMIC_RELAXED, __HIP_MEMORY_SCOPE_AGENT); }
__device__ __forceinline__ unsigned xb_add(unsigned* p, unsigned v) { return __hip_atomic_fetch_add(p, v, __ATOMIC_RELAXED, __HIP_MEMORY_SCOPE_AGENT); }
__device__ __forceinline__ unsigned xb_xcc_id() { return (unsigned)__builtin_amdgcn_s_getreg((3 << 11) | 20) & 0xFu; }
#define XB_SPIN(cond, bar) do { unsigned _sp = 0; while (cond) { __builtin_amdgcn_s_sleep(1); \
    if ((++_sp & 255u) == 0u) { if (xb_ld(&(bar)[XB_TMO])) break; if (_sp > XB_SPIN_CAP) { atomicAdd(&(bar)[XB_TMO], 1u); break; } } } } while (0)
struct XcdBarrier { unsigned* bar; unsigned x; volatile LAS unsigned* st; };
__device__ __forceinline__ XcdBarrier xcd_barrier_post(unsigned* bar, volatile LAS unsigned* st, int tid) {
    XcdBarrier b; b.bar = bar; b.x = xb_xcc_id(); b.st = st;
    if (tid == 0) (void)xb_add(&bar[XB_XCNT(b.x)], 1u);
    return b;
}
__device__ __forceinline__ void xcd_barrier_complete(unsigned* bar, unsigned x, unsigned& nloc, unsigned& nx) {
    const unsigned G = gridDim.x * gridDim.y * gridDim.z;
    unsigned sum, cnt, mine, sp = 0u;
    for (;;) {
        sum = 0u; cnt = 0u; mine = 0u;
#pragma unroll
        for (unsigned j = 0; j < 16; ++j) { const unsigned c = xb_ld(&bar[XB_XCNT(j)]); sum += c; cnt += (c > 0u) ? 1u : 0u; mine = (j == x) ? c : mine; }
        if (sum == G) break;
        __builtin_amdgcn_s_sleep(1);
        if ((++sp & 255u) == 0u) { if (xb_ld(&bar[XB_TMO])) break; if (sp > XB_SPIN_CAP) { atomicAdd(&bar[XB_TMO], 1u); break; } }
    }
    nloc = mine > 0u ? mine : 1u; nx = cnt > 0u ? cnt : 1u;
}
__device__ __forceinline__ void xcd_barrier(const XcdBarrier& b, int tid) {
    asm volatile("s_waitcnt vmcnt(0)" ::: "memory");
    __syncthreads();
    if (tid == 0) {
        unsigned* bar = b.bar;
        __builtin_amdgcn_s_waitcnt(0);
        unsigned nloc = b.st[0], nx = b.st[1];
        if (nloc == 0u) { xcd_barrier_complete(bar, b.x, nloc, nx); b.st[0] = nloc; b.st[1] = nx; }
        const unsigned old = xb_add(&bar[XB_XSUB(b.x)], 1u);
        const unsigned gen = old / nloc;
        if (old + 1u == (gen + 1u) * nloc) {
            __builtin_amdgcn_fence(__ATOMIC_RELEASE, "agent");
            asm volatile("s_waitcnt vmcnt(0)" ::: "memory");
            const unsigned og = xb_add(&bar[XB_TOP], 1u);
            const unsigned tg = og / nx;
            if (og + 1u == (tg + 1u) * nx) xb_add(&bar[XB_TOPGEN], 1u);
            else XB_SPIN(xb_ld(&bar[XB_TOPGEN]) == tg, bar);
            __builtin_amdgcn_fence(__ATOMIC_ACQUIRE, "agent");
            xb_add(&bar[XB_XGEN(b.x)], 1u);
            asm volatile("s_waitcnt vmcnt(0)" ::: "memory");
        } else {
            XB_SPIN(xb_ld(&bar[XB_XGEN(b.x)]) == gen, bar);
            __builtin_amdgcn_fence(__ATOMIC_ACQUIRE, "agent");
            asm volatile("s_waitcnt vmcnt(0)" ::: "memory");
        }
    }
    __syncthreads();
}

__device__ __forceinline__ void peer_convert_row(const Params& p, int l, int q, int lane) {
    const int tb = q >> 14, e = q & 16383;
    const f32x4* src = (const f32x4*)((tb ? p.peer_v : p.peer_u) + ((size_t)l * 16384 + e) * D) + lane;
    f32x4 v[8]; float am = 0.f;
#pragma unroll
    for (int j = 0; j < 8; ++j) { v[j] = src[64 * j]; am = fmaxf(am, fmaxf(fmaxf(fabsf(v[j].x), fabsf(v[j].y)), fmaxf(fabsf(v[j].z), fabsf(v[j].w)))); }
    am = wave_max(am);
    const float sc = am > 0.f ? am * (1.f / 127.f) : 1.f, inv = am > 0.f ? 127.f / am : 0.f;
    if (lane == 0) ((float*)(p.ws + (tb ? WS_SV : WS_SU)))[l * 16384 + e] = sc;
    unsigned char* dst = p.ws + (tb ? WS_V8 : WS_U8) + (size_t)l * (32 * MiB) + (size_t)e * 128 + 4 * (lane & 31);
    const unsigned flip = tb ? 0x80808080u : 0u;
#pragma unroll
    for (int j = 0; j < 8; ++j) {
        const int q0 = (int)rintf(v[j].x * inv), q1 = (int)rintf(v[j].y * inv), q2 = (int)rintf(v[j].z * inv), q3 = (int)rintf(v[j].w * inv);
        const unsigned w = ((unsigned)q0 & 0xffu) | (((unsigned)q1 & 0xffu) << 8) | (((unsigned)q2 & 0xffu) << 16) | (((unsigned)q3 & 0xffu) << 24);
        *(unsigned*)(dst + (size_t)(2 * j + (lane >> 5)) * (2 * MiB)) = w ^ flip;
    }
}
__device__ __forceinline__ const f32x4* peer_row_src(const Params& p, int l, int q, int lane) { return (const f32x4*)(((q >> 14) ? p.peer_v : p.peer_u) + ((size_t)l * 16384 + (q & 16383)) * D) + lane; }
__device__ __forceinline__ void peer_convert_rows(const Params& p, int l, int q0, int q1, int qs, int lane) {
    if (q0 >= q1) return;
    f32x4 nx[8];
    { const f32x4* src = peer_row_src(p, l, q0, lane);
#pragma unroll
      for (int j = 0; j < 8; ++j) nx[j] = src[64 * j]; }
#pragma unroll 1
    for (int q = q0; q < q1; q += qs) {
        const int tb = q >> 14, e = q & 16383;
        f32x4 v[8]; float am = 0.f;
#pragma unroll
        for (int j = 0; j < 8; ++j) { v[j] = nx[j]; am = fmaxf(am, fmaxf(fmaxf(fabsf(v[j].x), fabsf(v[j].y)), fmaxf(fabsf(v[j].z), fabsf(v[j].w)))); }
        if (q + qs < q1) { const f32x4* src = peer_row_src(p, l, q + qs, lane);
#pragma unroll
            for (int j = 0; j < 8; ++j) nx[j] = src[64 * j]; }
        am = wave_max(am);
        const float qm = tb ? 127.f : 7.f;
        const float sc = am > 0.f ? am / qm : 1.f, inv = am > 0.f ? qm / am : 0.f;
        if (lane == 0) ((float*)(p.ws + (tb ? WS_SV : WS_SU)))[l * 16384 + e] = sc;
        if (tb) {
            unsigned char* dst = p.ws + WS_V8 + (size_t)l * (32 * MiB) + (size_t)e * 128 + 4 * (lane & 31);
#pragma unroll
            for (int j = 0; j < 8; ++j) {
                const int q0_ = (int)rintf(v[j].x * inv), q1_ = (int)rintf(v[j].y * inv), q2_ = (int)rintf(v[j].z * inv), q3_ = (int)rintf(v[j].w * inv);
                const unsigned w = ((unsigned)q0_ & 0xffu) | (((unsigned)q1_ & 0xffu) << 8) | (((unsigned)q2_ & 0xffu) << 16) | (((unsigned)q3_ & 0xffu) << 24);
                *(unsigned*)(dst + (size_t)(2 * j + (lane >> 5)) * (2 * MiB)) = w;
            }
        } else {
            unsigned char* dst = p.ws + WS_U8 + (size_t)l * (32 * MiB) + (size_t)e * 128 + 4 * (lane >> 1);
#pragma unroll
            for (int j = 0; j < 8; ++j) {
                const int q0_ = (int)rintf(v[j].x * inv) + 8, q1_ = (int)rintf(v[j].y * inv) + 8, q2_ = (int)rintf(v[j].z * inv) + 8, q3_ = (int)rintf(v[j].w * inv) + 8;
                const unsigned w = (unsigned)q0_ | ((unsigned)q1_ << 8) | ((unsigned)q2_ << 16) | ((unsigned)q3_ << 24);
                const unsigned hi = (unsigned)__shfl_xor((int)w, 1);
                if (!(lane & 1)) *(unsigned*)(dst + (size_t)j * (2 * MiB)) = w | (hi << 4);
            }
        }
    }
}
constexpr int DEFQ_EVEN = 128, DEFQ_ODD = 96, IDLE_EVEN = 256 - (33 * 19) % 256, IDLE_ODD = 256 - (33 * 24) % 256;
__device__ __forceinline__ int peer_deferred_rows(int l, int G) { return (l == 0 || G != 256) ? 0 : (((l - 1) & 1) ? IDLE_ODD * DEFQ_ODD : IDLE_EVEN * DEFQ_EVEN); }
__device__ __forceinline__ void peer_convert_deferred(const Params& p, int l  , int bx, int G, int wave, int lane) {
    if (l + 1 >= DEPTH || G != 256) return;
    const int idle = (l & 1) ? IDLE_ODD : IDLE_EVEN, dq = (l & 1) ? DEFQ_ODD : DEFQ_EVEN, j = bx - (256 - idle);
    if (j < 0) return;
    peer_convert_rows(p, l + 1, j * dq + wave, (j + 1) * dq, NWAVES, lane);
}
struct ScaleOne { __device__ __forceinline__ float operator()(int) const { return 1.f; } };
template <class MapF, class ScaleF = ScaleOne>
__device__ __forceinline__ void transpose_item(const float* W, int Nsrc, int K, bf16_t* WT, int nblk, LAS float* scr, int item, int lane, MapF map, ScaleF ksc = ScaleF()) {
    const int kb = item / nblk, nb = item % nblk, k0 = 64 * kb, n0 = 32 * nb;
    const int sc = map(n0 + (lane & 31));
    float w[32];
#pragma unroll
    for (int i = 0; i < 32; ++i) w[i] = sc >= 0 ? W[(size_t)(k0 + 2 * i + (lane >> 5)) * Nsrc + sc] : 0.f;
#pragma unroll
    for (int i = 0; i < 32; ++i) { const int kk = 2 * i + (lane >> 5); scr[kk * 33 + (lane & 31)] = w[i] * ksc(k0 + kk); }
    asm volatile("s_waitcnt lgkmcnt(0)" ::: "memory");
    const int c = lane & 7;
    float tt[4][8];
#pragma unroll
    for (int j = 0; j < 4; ++j) { const LAS float* s = scr + (8 * c) * 33 + (lane >> 3) + 8 * j;
#pragma unroll
        for (int r = 0; r < 8; ++r) tt[j][r] = s[r * 33]; }
    __builtin_amdgcn_sched_barrier(0);
#pragma unroll
    for (int j = 0; j < 4; ++j) { const int n = (lane >> 3) + 8 * j;
        u32x4 o; o.x = pk2(tt[j][0], tt[j][1]); o.y = pk2(tt[j][2], tt[j][3]); o.z = pk2(tt[j][4], tt[j][5]); o.w = pk2(tt[j][6], tt[j][7]);
        *(u32x4*)(WT + (size_t)(n0 + n) * K + k0 + 8 * c) = o; }
    asm volatile("s_waitcnt lgkmcnt(0)" ::: "memory");
}
struct MapId { __device__ __forceinline__ int operator()(int n) const { return n; } };
struct MapAB {
    __device__ __forceinline__ int operator()(int n) const {
        if (n < 3072) return n;
        if (n < 4352) { const int base_d = n < 4096 ? 3072 : 4096, base_s = n < 4096 ? 3104 : 4128; const int r = n - base_d, hh = r >> 7, pp = r & 127;
            const int i = 64 * (pp >> 6) + ((pp & 63) >> 1) + 32 * (pp & 1); return base_s + hh * 128 + i; }
        if (n < 4608) return 4384 + (n - 4352);
        if (n < 4640) return 3072 + (n - 4608);
        return -1;
    }
};
__device__ __forceinline__ float silu(float v) { return v / (1.f + expf(-v)); }
struct __attribute__((packed, aligned(4))) F3 { float a, b, c; };

__device__ __forceinline__ void ph_prologue(const Params& p, LAS unsigned char* lds, int tid, int lane, int wave, int vcu, int G) {
    const int gw = vcu * NWAVES + wave, NGW = G * NWAVES;
    const size_t gtid = (size_t)vcu * 512 + tid, gn = (size_t)G * 512;
    {
        const float2* ks = (const float2*)p.peer_keys; unsigned* kd = (unsigned*)(p.ws + WS_KEYS);
        for (size_t i = gtid; i < (size_t)4 * 8 * 2 * 128 * 128 / 2; i += gn) { const float2 v = ks[i]; kd[i] = pk2(v.x, v.y); }
    }
    {
        float2* rt = (float2*)(p.ws + WS_ROPE);
        for (size_t i = gtid; i < 128 * 32; i += gn) { const int pos = (int)(i >> 5), j = (int)(i & 31);
            const float freq = powf(10000.f, -(float)j / 32.f), ang = (float)pos * freq; rt[i] = make_float2(cosf(ang), sinf(ang)); }
    }
    {
        LAS float* sv = (LAS float*)lds;
        LAS float* red = (LAS float*)(lds + 16384);
        for (int i = tid; i < 2048; i += 512) { sv[i] = silu(p.c[i]); sv[2048 + i] = silu(p.c_ctx[i]); }
        __syncthreads();
        float* MOD = (float*)(p.ws + WS_MOD);
        for (int u = vcu; u < 4 * 64; u += G) {
            const int l = u >> 6, n0 = (u & 63) * 192;
            const float* wp = p.ada_w + ((size_t)l * 2048 + wave * 256) * D6 + n0 + 3 * lane;
            float a0x = 0.f, a0y = 0.f, a0z = 0.f, a1x = 0.f, a1y = 0.f, a1z = 0.f;
#pragma unroll 1
            for (int k = 0; k < 256; k += 16) {
                F3 wv[16];
#pragma unroll
                for (int j = 0; j < 16; ++j) wv[j] = *(const F3*)(wp + (size_t)(k + j) * D6);
#pragma unroll
                for (int j = 0; j < 16; ++j) { const float s0 = sv[wave * 256 + k + j], s1 = sv[2048 + wave * 256 + k + j];
                    a0x += s0 * wv[j].a; a0y += s0 * wv[j].b; a0z += s0 * wv[j].c; a1x += s1 * wv[j].a; a1y += s1 * wv[j].b; a1z += s1 * wv[j].c; }
            }
            { LAS float* r0 = red + (wave * 2 + 0) * 192 + 3 * lane; LAS float* r1 = red + (wave * 2 + 1) * 192 + 3 * lane;
              r0[0] = a0x; r0[1] = a0y; r0[2] = a0z; r1[0] = a1x; r1[1] = a1y; r1[2] = a1z; }
            __syncthreads();
            if (tid < 384) { const int which = tid >= 192 ? 1 : 0, col = tid - 192 * which; float s = 0.f;
#pragma unroll
                for (int w = 0; w < 8; ++w) s += red[(w * 2 + which) * 192 + col];
                MOD[((size_t)l * 2 + which) * D6 + n0 + col] = s + p.ada_b[(size_t)l * D6 + n0 + col]; }
            __syncthreads();
        }
    }
    {
        LAS float* scr = (LAS float*)(lds + wave * 16384);
        constexpr int I_ABI = 32 * (NAB / 32), I_SQ = 32 * (D / 32), I_NAI = 32 * (NNA / 32);
        constexpr int NITEMS = 2 * I_ABI + 2 * I_SQ + 2 * I_NAI + 2 * I_SQ;
        for (int it = gw; it < NITEMS; it += NGW) {
            int r = it;
            if (r < 2 * I_ABI) { const int e = r / I_ABI; r -= e * I_ABI;
                transpose_item(p.ab_w_in + (size_t)e * D * 4640, 4640, D, (bf16_t*)(p.ws + WS_WAB_IN) + (size_t)e * NAB * D, NAB / 32, scr, r, lane, MapAB()); continue; }
            r -= 2 * I_ABI;
            if (r < 2 * I_SQ) { const int e = r / I_SQ; r -= e * I_SQ;
                transpose_item(p.ab_w_out + (size_t)e * D * D, D, D, (bf16_t*)(p.ws + WS_WAB_OUT) + (size_t)e * D * D, D / 32, scr, r, lane, MapId()); continue; }
            r -= 2 * I_SQ;
            if (r < 2 * I_NAI) { const int e = r / I_NAI; r -= e * I_NAI;
                transpose_item(p.na_w_in + (size_t)e * D * NNA, NNA, D, (bf16_t*)(p.ws + WS_WNA_IN) + (size_t)e * NNA * D, NNA / 32, scr, r, lane, MapId()); continue; }
            r -= 2 * I_NAI;
            { const int e = r / I_SQ; r -= e * I_SQ;
                transpose_item(p.na_w_out + (size_t)e * D * D, D, D, (bf16_t*)(p.ws + WS_WNA_OUT) + (size_t)e * D * D, D / 32, scr, r, lane, MapId()); }
        }
    }
#pragma unroll 1
    for (int l = 0; l < DEPTH; ++l) peer_convert_rows(p, l, peer_deferred_rows(l, G) + gw, 32768, NGW, lane);
}
__device__ __forceinline__ void fold_item(const Params& p, int l, int item, LAS float* scr, int lane) {
    const int kb = item >> 6, nb = item & 63, k0 = 64 * kb, n0 = 32 * nb;
    const float* MOD = (const float*)(p.ws + WS_MOD) + (size_t)l * 2 * D6;
    const float* W = p.peer_wq + (size_t)l * D * D;
    LAS float* kv = scr + 2112;
    float w[32];
#pragma unroll
    for (int i = 0; i < 32; ++i) w[i] = W[(size_t)(k0 + 2 * i + (lane >> 5)) * D + n0 + (lane & 31)];
    { const int k = k0 + lane; const float g2 = p.norm2_g[(size_t)l * D + k], m4 = MOD[4 * D + k], m4c = MOD[D6 + 4 * D + k], m3 = MOD[3 * D + k], m3c = MOD[D6 + 3 * D + k];
      __builtin_amdgcn_sched_barrier(0);
      kv[lane] = g2 * (1.f + m4); kv[64 + lane] = g2 * (1.f + m4c); kv[128 + lane] = m3; kv[192 + lane] = m3c; }
    asm volatile("s_waitcnt lgkmcnt(0)" ::: "memory");
    float bl = 0.f, bc = 0.f;
#pragma unroll
    for (int i = 0; i < 32; ++i) { const int kk = 2 * i + (lane >> 5); bl += w[i] * kv[128 + kk]; bc += w[i] * kv[192 + kk]; }
    bl += __shfl_xor(bl, 32); bc += __shfl_xor(bc, 32);
    if (lane < 32) { float* PB = (float*)(p.ws + WS_PARTB) + ((size_t)(l * 2) * 32 + kb) * D + n0 + lane; PB[0] = bl; PB[(size_t)32 * D] = bc; }
    const int c = lane & 7;
#pragma unroll 1
    for (int v = 0; v < (l < DEPTH - 1 ? 2 : 1); ++v) {
        bf16_t* WT = (bf16_t*)(p.ws + (v ? WS_WQC : WS_WQ)) + (size_t)l * D * D;
        float kf[32];
#pragma unroll
        for (int i = 0; i < 32; ++i) kf[i] = kv[64 * v + 2 * i + (lane >> 5)];
        __builtin_amdgcn_sched_barrier(0);
#pragma unroll
        for (int i = 0; i < 32; ++i) { const int kk = 2 * i + (lane >> 5); scr[kk * 33 + (lane & 31)] = w[i] * kf[i]; }
        asm volatile("s_waitcnt lgkmcnt(0)" ::: "memory");
        float tt[4][8];
#pragma unroll
        for (int j = 0; j < 4; ++j) { const LAS float* s = scr + (8 * c) * 33 + (lane >> 3) + 8 * j;
#pragma unroll
            for (int r = 0; r < 8; ++r) tt[j][r] = s[r * 33]; }
        __builtin_amdgcn_sched_barrier(0);
#pragma unroll
        for (int j = 0; j < 4; ++j) { const int n = (lane >> 3) + 8 * j;
            u32x4 o; o.x = pk2(tt[j][0], tt[j][1]); o.y = pk2(tt[j][2], tt[j][3]); o.z = pk2(tt[j][4], tt[j][5]); o.w = pk2(tt[j][6], tt[j][7]);
            *(u32x4*)(WT + (size_t)(n0 + n) * D + k0 + 8 * c) = o; }
        asm volatile("s_waitcnt lgkmcnt(0)" ::: "memory");
    }
}
__device__ __forceinline__ void ph_fold_wq(const Params& p, LAS unsigned char* lds, int lane, int wave, int gw, int NGW) {
    LAS float* scr = (LAS float*)(lds + wave * 16384);
    for (int it = gw; it < DEPTH * 2048; it += NGW) fold_item(p, it >> 11, it & 2047, scr, lane);
}
__device__ __forceinline__ void ph_fold_bias(const Params& p, int lane, int gw, int NGW) {
    for (int i = gw * 64 + lane; i < DEPTH * 2 * D; i += NGW * 64) { const float* PB = (const float*)(p.ws + WS_PARTB) + (size_t)(i >> 11) * 32 * D + (i & 2047); float s = 0.f;
        float pv[32];
#pragma unroll
        for (int kb = 0; kb < 32; ++kb) pv[kb] = PB[(size_t)kb * D];
#pragma unroll
        for (int kb = 0; kb < 32; ++kb) s += pv[kb];
        ((float*)(p.ws + WS_BQ))[i] = s; }
}
__device__ __forceinline__ void norm_row(const Params& p, int l, int which, int m, int lane) {
    const float* gvec = (which ? p.norm2_g : p.norm1_g) + (size_t)l * D;
    const float* MOD = (const float*)(p.ws + WS_MOD) + (size_t)l * 2 * D6;
    const float* X = (const float*)(p.ws + WS_X); bf16_t* H = (bf16_t*)(p.ws + WS_H);
    {
        const float* mod = MOD + (m >= T ? D6 : 0) + (which ? 3 * D : 0);
        const float* xrow = (l == 0 && which == 0) ? (m < T ? p.x + (size_t)m * D : p.ctx + (size_t)(m - T) * D) : X + (size_t)m * D;
        const f32x4* xr = (const f32x4*)xrow + lane;
        f32x4 v[8]; float ss = 0.f;
#pragma unroll
        for (int j = 0; j < 8; ++j) { v[j] = xr[64 * j]; ss += (v[j].x * v[j].x + v[j].y * v[j].y) + (v[j].z * v[j].z + v[j].w * v[j].w); }
        ss = wave_sum(ss);
        const float rstd = rsqrtf(ss * (1.f / D) + EPS);
        f32x4 g4a[8], sha[8], sca[8];
#pragma unroll
        for (int j = 0; j < 8; ++j) { const int col = 256 * j + 4 * lane; g4a[j] = *(const f32x4*)(gvec + col); sha[j] = *(const f32x4*)(mod + col); sca[j] = *(const f32x4*)(mod + D + col); }
        __builtin_amdgcn_sched_barrier(0);
#pragma unroll
        for (int j = 0; j < 8; ++j) { const int col = 256 * j + 4 * lane;
            const f32x4 h = v[j] * rstd * g4a[j] * (sca[j] + 1.f) + sha[j]; v[j] = h;
            if (!which) { u32x2 o; o.x = pk2(h.x, h.y); o.y = pk2(h.z, h.w); *(u32x2*)(H + (size_t)m * D + col) = o; } }
        if (which) {
            float am = 0.f;
#pragma unroll
            for (int j = 0; j < 8; ++j) am = fmaxf(am, fmaxf(fmaxf(fabsf(v[j].x), fabsf(v[j].y)), fmaxf(fabsf(v[j].z), fabsf(v[j].w))));
            am = wave_max(am);
            const float inv = am > 0.f ? 127.f / am : 0.f;
            if (lane == 0) ((float*)(p.ws + WS_SH))[m] = am > 0.f ? am * (1.f / 127.f) : 1.f;
            unsigned char* h8 = p.ws + WS_H8 + (size_t)m * D + 4 * lane;
#pragma unroll
            for (int j = 0; j < 8; ++j) {
                const int q0 = (int)rintf(v[j].x * inv), q1 = (int)rintf(v[j].y * inv), q2 = (int)rintf(v[j].z * inv), q3 = (int)rintf(v[j].w * inv);
                *(unsigned*)(h8 + 256 * j) = ((unsigned)q0 & 0xffu) | (((unsigned)q1 & 0xffu) << 8) | (((unsigned)q2 & 0xffu) << 16) | (((unsigned)q3 & 0xffu) << 24);
            }
        }
    }
}
template <int NR> __device__ __forceinline__ void h8_rows(const Params& p, int l, int m0, int lane, int wave) {
    const float* gvec = p.norm2_g + (size_t)l * D;
    const float* MOD = (const float*)(p.ws + WS_MOD) + (size_t)l * 2 * D6 + 3 * D;
    const float* X = (const float*)(p.ws + WS_X);
    f32x4 nx[8];
    { const f32x4* xr = (const f32x4*)(X + (size_t)(m0 + wave) * D) + lane;
#pragma unroll
      for (int j = 0; j < 8; ++j) nx[j] = xr[64 * j]; }
#pragma unroll 1
    for (int mi = wave; mi < NR; mi += NWAVES) {
        const int m = m0 + mi; const float* mod = MOD + (m >= T ? D6 : 0);
        f32x4 v[8]; float ss = 0.f;
#pragma unroll
        for (int j = 0; j < 8; ++j) { v[j] = nx[j]; ss += (v[j].x * v[j].x + v[j].y * v[j].y) + (v[j].z * v[j].z + v[j].w * v[j].w); }
        if (mi + NWAVES < NR) { const f32x4* xr = (const f32x4*)(X + (size_t)(m + NWAVES) * D) + lane;
#pragma unroll
            for (int j = 0; j < 8; ++j) nx[j] = xr[64 * j]; }
        ss = wave_sum(ss);
        const float rstd = rsqrtf(ss * (1.f / D) + EPS);
        float am = 0.f;
        f32x4 g4a[8], sha[8], sca[8];
#pragma unroll
        for (int j = 0; j < 8; ++j) { const int col = 256 * j + 4 * lane; g4a[j] = *(const f32x4*)(gvec + col); sha[j] = *(const f32x4*)(mod + col); sca[j] = *(const f32x4*)(mod + D + col); }
        __builtin_amdgcn_sched_barrier(0);
#pragma unroll
        for (int j = 0; j < 8; ++j) {
            const f32x4 h = v[j] * rstd * g4a[j] * (sca[j] + 1.f) + sha[j]; v[j] = h;
            am = fmaxf(am, fmaxf(fmaxf(fabsf(h.x), fabsf(h.y)), fmaxf(fabsf(h.z), fabsf(h.w)))); }
        am = wave_max(am);
        const float inv = am > 0.f ? 127.f / am : 0.f;
        if (lane == 0) ((float*)(p.ws + WS_SH))[m] = am > 0.f ? am * (1.f / 127.f) : 1.f;
        unsigned char* h8 = p.ws + WS_H8 + (size_t)m * D + 4 * lane;
        int qs = 0;
#pragma unroll
        for (int j = 0; j < 8; ++j) {
            const int q0 = (int)rintf(v[j].x * inv), q1 = (int)rintf(v[j].y * inv), q2 = (int)rintf(v[j].z * inv), q3 = (int)rintf(v[j].w * inv);
            qs += (q0 + q1) + (q2 + q3);
            *(unsigned*)(h8 + 256 * j) = ((unsigned)q0 & 0xffu) | (((unsigned)q1 & 0xffu) << 8) | (((unsigned)q2 & 0xffu) << 16) | (((unsigned)q3 & 0xffu) << 24);
        }
        const float qsum = wave_sum((float)qs);
        if (lane == 0) ((float*)(p.ws + WS_SH + 512 * 1024))[m] = qsum;
    }
}
__device__ __forceinline__ void ph_norm(const Params& p, int l, int which, int lane, int gw, int NGW) {
    for (int m = gw; m < M; m += NGW) norm_row(p, l, which, m, lane);
}
__device__ __forceinline__ void final_row(const Params& p, int m, int lane) {
    const float* X = (const float*)(p.ws + WS_X);
    {
        const f32x4* xr = (const f32x4*)(X + (size_t)m * D) + lane;
        f32x4 v[8]; float ss = 0.f;
#pragma unroll
        for (int j = 0; j < 8; ++j) { v[j] = xr[64 * j]; ss += (v[j].x * v[j].x + v[j].y * v[j].y) + (v[j].z * v[j].z + v[j].w * v[j].w); }
        ss = wave_sum(ss);
        const float rstd = rsqrtf(ss * (1.f / D) + EPS);
#pragma unroll
        for (int j = 0; j < 8; ++j) { const int col = 256 * j + 4 * lane; const f32x4 g4 = *(const f32x4*)(p.final_g + col);
            *(f32x4*)(p.out + (size_t)m * D + col) = v[j] * rstd * g4; }
    }
}

#define AT(T, base, off) ((T*)((unsigned char*)(base) + (size_t)(unsigned)(off)))
__device__ __forceinline__ void peer_tail_row(const Params& p, int l, int m, int lane) {
    const float* MODl = (const float*)(p.ws + WS_MOD) + ((size_t)l * 2 + (m >= T ? 1 : 0)) * D6;
    f32x4* X4 = (f32x4*)((float*)(p.ws + WS_X) + (size_t)m * D) + lane;
    f32x4 v[8];
    {
        const f32x4* D4 = (const f32x4*)((const float*)(p.ws + WS_DELTA) + (size_t)m * D) + lane; const f32x4* G4 = (const f32x4*)(MODl + 5 * D) + lane;
        f32x4 dv[8], gv[8];
#pragma unroll
        for (int j = 0; j < 8; ++j) { v[j] = X4[64 * j]; dv[j] = D4[64 * j]; gv[j] = G4[64 * j]; }
        __builtin_amdgcn_sched_barrier(0);
#pragma unroll
        for (int j = 0; j < 8; ++j) v[j] = v[j] + gv[j] * dv[j];
    }
    const bool last = l + 1 >= DEPTH;
    if (last && m >= T) return;
    const float* MODn = (const float*)(p.ws + WS_MOD) + ((size_t)(last ? l : l + 1) * 2 + (m >= T ? 1 : 0)) * D6;
    const f32x4* NG = (const f32x4*)(last ? p.final_g : p.norm1_g + (size_t)(l + 1) * D) + lane;
    f32x4 g4[8], sh[8], sc[8];
#pragma unroll
    for (int j = 0; j < 8; ++j) { g4[j] = NG[64 * j]; if (!last) { sh[j] = ((const f32x4*)MODn + lane)[64 * j]; sc[j] = ((const f32x4*)(MODn + D) + lane)[64 * j]; } }
    __builtin_amdgcn_sched_barrier(0);
    float ss = 0.f;
#pragma unroll
    for (int j = 0; j < 8; ++j) { if (!last) X4[64 * j] = v[j]; ss += (v[j].x * v[j].x + v[j].y * v[j].y) + (v[j].z * v[j].z + v[j].w * v[j].w); }
    ss = wave_sum(ss);
    const float rstd = rsqrtf(ss * (1.f / D) + EPS);
    if (last) {
        f32x4* O4 = (f32x4*)(p.out + (size_t)m * D) + lane;
#pragma unroll
        for (int j = 0; j < 8; ++j) O4[64 * j] = v[j] * rstd * g4[j];
    } else {
        bf16_t* H = (bf16_t*)(p.ws + WS_H) + (size_t)m * D + 4 * lane;
#pragma unroll
        for (int j = 0; j < 8; ++j) { const f32x4 h = v[j] * rstd * g4[j] * (sc[j] + 1.f) + sh[j]; u32x2 o; o.x = pk2(h.x, h.y); o.y = pk2(h.z, h.w); *(u32x2*)(H + 256 * j) = o; }
    }
}
__device__ __forceinline__ void store4_bf16(unsigned char* base, unsigned off, f32x4 v) { u32x2 w; w.x = pk2(v[0], v[1]); w.y = pk2(v[2], v[3]); *AT(u32x2, base, off) = w; }
__device__ __forceinline__ void store4_T(unsigned char* base, unsigned off0  , f32x4 v) {
    const unsigned a = pk2(v[0], v[1]), b = pk2(v[2], v[3]);
    constexpr unsigned RS = (unsigned)M * 2u;
    *AT(bf16_t, base, off0 + 0 * RS) = (bf16_t)(a & 0xffff); *AT(bf16_t, base, off0 + 1 * RS) = (bf16_t)(a >> 16);
    *AT(bf16_t, base, off0 + 2 * RS) = (bf16_t)(b & 0xffff); *AT(bf16_t, base, off0 + 3 * RS) = (bf16_t)(b >> 16);
}
__device__ __forceinline__ void rope4(f32x4& v, const float2* rope, int row, int pp  ) {
    const int pos = (pp < 64) ? (row >> 6) : (row & 63), j0 = (pp & 63) >> 1;
    const f32x4 cs = *AT(const f32x4, rope, (unsigned)(pos * 32 + j0) * 8u);
    const float a0 = v[0], b0 = v[1], a1 = v[2], b1 = v[3];
    v[0] = a0 * cs[0] - b0 * cs[1]; v[1] = b0 * cs[0] + a0 * cs[1];
    v[2] = a1 * cs[2] - b1 * cs[3]; v[3] = b1 * cs[2] + a1 * cs[3];
}
__device__ __forceinline__ void store8_bf16(unsigned char* base, unsigned off, f32x4 v0, f32x4 v1) {
    u32x4 w; w.x = pk2(v0[0], v0[1]); w.y = pk2(v0[2], v0[3]); w.z = pk2(v1[0], v1[1]); w.w = pk2(v1[2], v1[3]);
    *AT(u32x4, base, off) = w;
}
__device__ __forceinline__ void store8_T(unsigned char* base, unsigned off0  , f32x4 v0, f32x4 v1) {
    const unsigned a = pk2(v0[0], v0[1]), b = pk2(v0[2], v0[3]), c = pk2(v1[0], v1[1]), d = pk2(v1[2], v1[3]);
    constexpr unsigned RS = (unsigned)M * 2u;
    *AT(bf16_t, base, off0 + 0 * RS) = (bf16_t)(a & 0xffff); *AT(bf16_t, base, off0 + 1 * RS) = (bf16_t)(a >> 16);
    *AT(bf16_t, base, off0 + 2 * RS) = (bf16_t)(b & 0xffff); *AT(bf16_t, base, off0 + 3 * RS) = (bf16_t)(b >> 16);
    *AT(bf16_t, base, off0 + 4 * RS) = (bf16_t)(c & 0xffff); *AT(bf16_t, base, off0 + 5 * RS) = (bf16_t)(c >> 16);
    *AT(bf16_t, base, off0 + 6 * RS) = (bf16_t)(d & 0xffff); *AT(bf16_t, base, off0 + 7 * RS) = (bf16_t)(d >> 16);
}
__device__ __forceinline__ void rope8(f32x4& v0, f32x4& v1, const float2* rope, int row, int pp  ) {
    const int pos = (pp < 64) ? (row >> 6) : (row & 63), j0 = (pp & 63) >> 1;
    const f32x4* t = AT(const f32x4, rope, (unsigned)(pos * 32 + j0) * 8u);
    const f32x4 c01 = t[0], c23 = t[1];
    const float a0 = v0[0], b0 = v0[1], a1 = v0[2], b1 = v0[3], a2 = v1[0], b2 = v1[1], a3 = v1[2], b3 = v1[3];
    v0[0] = a0 * c01[0] - b0 * c01[1]; v0[1] = b0 * c01[0] + a0 * c01[1];
    v0[2] = a1 * c01[2] - b1 * c01[3]; v0[3] = b1 * c01[2] + a1 * c01[3];
    v1[0] = a2 * c23[0] - b2 * c23[1]; v1[1] = b2 * c23[0] + a2 * c23[1];
    v1[2] = a3 * c23[2] - b3 * c23[3]; v1[3] = b3 * c23[2] + a3 * c23[3];
}
struct EpiEven {
    static constexpr bool PERM = true, AFTER_DRAIN = false;
    unsigned char* proj; const float* gate_b; const float2* rope;
    __device__ __forceinline__ void elem4(unsigned row, unsigned col0, f32x4 v) const {
        const unsigned pn = col0 >> 8;
        if (pn < 2) { store4_bf16(proj, (unsigned)PJ_AQ + (row * 512u + col0) * 2u, v * 0.125f); }
        else if (pn < 4) { const unsigned c = col0 - 512; store4_bf16(proj, (unsigned)PJ_AK + (row * 512u + c) * 2u, v); store4_T(proj, (unsigned)PJ_AKT + (c * (unsigned)M + row) * 2u, v); }
        else if (pn < 8) { store4_T(proj, (unsigned)PJ_AVT + ((col0 - 1024) * (unsigned)M + row) * 2u, v); }
        else if (pn < 12) { store4_bf16(proj, (unsigned)PJ_AO + (row * 1024u + (col0 - 2048)) * 2u, v); }
        else if (pn < 16) { const unsigned c = col0 - 3072; if (row < (unsigned)T) rope4(v, rope, row, c & 127); store4_bf16(proj, (unsigned)PJ_BQ + (row * 1024u + c) * 2u, v); }
        else if (pn == 16) { const unsigned c = col0 - 4096; if (row < (unsigned)T) rope4(v, rope, row, c & 127); store4_bf16(proj, (unsigned)PJ_BK + (row * 256u + c) * 2u, v); }
        else if (pn == 17) { store4_T(proj, (unsigned)PJ_BVT + ((col0 - 4352) * (unsigned)M + row) * 2u, v); }
        else { const unsigned c = col0 - 4608; if (c < 32) *AT(f32x4, proj, (unsigned)PJ_G + (row * 32u + c) * 4u) = v + *AT(const f32x4, gate_b, c * 4u); }
    }
    __device__ __forceinline__ void operator()(const f32x4 (&acc)[2][2][4][2], const pg8::Unit& u, int wr, int wc, int fr, int fq) const {
        const int pn = u.pn;
#pragma unroll
        for (int ai = 0; ai < 2; ++ai)
#pragma unroll
            for (int m = 0; m < 4; ++m) { const unsigned row = u.pm * 256 + ai * 128 + wr * 64 + m * 16 + fr;
#pragma unroll
                for (int bj = 0; bj < 2; ++bj) { const unsigned col0 = pn * 256 + bj * 128 + wc * 32 + 8 * fq;
                    f32x4 v0 = acc[ai][bj][m][0], v1 = acc[ai][bj][m][1];
                    if (pn < 2) { store8_bf16(proj, (unsigned)PJ_AQ + (row * 512u + col0) * 2u, v0 * 0.125f, v1 * 0.125f); }
                    else if (pn < 4) { const unsigned c = col0 - 512; store8_bf16(proj, (unsigned)PJ_AK + (row * 512u + c) * 2u, v0, v1); store8_T(proj, (unsigned)PJ_AKT + (c * (unsigned)M + row) * 2u, v0, v1); }
                    else if (pn < 8) { store8_T(proj, (unsigned)PJ_AVT + ((col0 - 1024) * (unsigned)M + row) * 2u, v0, v1); }
                    else if (pn < 12) { store8_bf16(proj, (unsigned)PJ_AO + (row * 1024u + (col0 - 2048)) * 2u, v0, v1); }
                    else if (pn < 16) { const unsigned c = col0 - 3072; if (row < (unsigned)T) rope8(v0, v1, rope, row, c & 127); store8_bf16(proj, (unsigned)PJ_BQ + (row * 1024u + c) * 2u, v0, v1); }
                    else if (pn == 16) { const unsigned c = col0 - 4096; if (row < (unsigned)T) rope8(v0, v1, rope, row, c & 127); store8_bf16(proj, (unsigned)PJ_BK + (row * 256u + c) * 2u, v0, v1); }
                    else if (pn == 17) { store8_T(proj, (unsigned)PJ_BVT + ((col0 - 4352) * (unsigned)M + row) * 2u, v0, v1); }
                    else { const unsigned c = col0 - 4608; if (c < 32) { const unsigned go = (unsigned)PJ_G + (row * 32u + c) * 4u;
                            *AT(f32x4, proj, go) = v0 + *AT(const f32x4, gate_b, c * 4u); *AT(f32x4, proj, go + 16u) = v1 + *AT(const f32x4, gate_b, c * 4u + 16u); } }
                } }
    }
};
struct EpiOdd {
    static constexpr bool PERM = true, AFTER_DRAIN = false;
    unsigned char* proj;
    __device__ __forceinline__ void elem4(unsigned row, unsigned col0, f32x4 v) const {
        const unsigned pn = col0 >> 8;
        if (pn < 8) store4_bf16(proj, (unsigned)PJ_Q + (row * 2048u + col0) * 2u, v);
        else if (pn < 16) store4_bf16(proj, (unsigned)PJ_K + (row * 2048u + (col0 - 2048)) * 2u, v);
        else store4_T(proj, (unsigned)PJ_VT + ((col0 - 4096) * (unsigned)M + row) * 2u, v);
    }
    __device__ __forceinline__ void operator()(const f32x4 (&acc)[2][2][4][2], const pg8::Unit& u, int wr, int wc, int fr, int fq) const {
        const int pn = u.pn;
#pragma unroll
        for (int ai = 0; ai < 2; ++ai)
#pragma unroll
            for (int m = 0; m < 4; ++m) { const unsigned row = u.pm * 256 + ai * 128 + wr * 64 + m * 16 + fr;
#pragma unroll
                for (int bj = 0; bj < 2; ++bj) { const unsigned col0 = pn * 256 + bj * 128 + wc * 32 + 8 * fq;
                    const f32x4 v0 = acc[ai][bj][m][0], v1 = acc[ai][bj][m][1];
                    if (pn < 8) store8_bf16(proj, (unsigned)PJ_Q + (row * 2048u + col0) * 2u, v0, v1);
                    else if (pn < 16) store8_bf16(proj, (unsigned)PJ_K + (row * 2048u + (col0 - 2048)) * 2u, v0, v1);
                    else store8_T(proj, (unsigned)PJ_VT + ((col0 - 4096) * (unsigned)M + row) * 2u, v0, v1);
                } }
    }
};
struct EpiResid {
    static constexpr bool PERM = true, AFTER_DRAIN = false;
    float* X; const float* gl; const float* gc; const float* srcl; const float* srcc;
    unsigned char* XB; float* part; float* partc;
    __device__ __forceinline__ void elem4(unsigned row, unsigned col0, f32x4 v) const {
        f32x4* xp = AT(f32x4, X, (row * (unsigned)D + col0) * 4u);
        const f32x4* sp = AT(const f32x4, srcc, ((row - (unsigned)T) * (unsigned)D + col0) * 4u);
        const f32x4 x = *sp + *AT(const f32x4, gc, col0 * 4u) * v;
        *xp = x; store4_bf16(XB, (row * (unsigned)D + col0) * 2u, x);
        const float s = fq_sum((x.x * x.x + x.y * x.y) + (x.z * x.z + x.w * x.w));
        if (((col0 >> 2) & 3u) == 0u) *AT(float, partc, ((row - (unsigned)T) * 128u + (col0 >> 4)) * 4u) = s;
    }
    __device__ __forceinline__ void operator()(const f32x4 (&acc)[2][2][4][2], const pg8::Unit& u, int wr, int wc, int fr, int fq) const {
        const float* g = (u.pm * 256 < T) ? gl : gc;
        f32x4 gg[2][2];
#pragma unroll
        for (int bj = 0; bj < 2; ++bj) { const unsigned col0 = u.pn * 256 + bj * 128 + wc * 32 + 8 * fq; gg[bj][0] = *AT(const f32x4, g, col0 * 4u); gg[bj][1] = *AT(const f32x4, g, col0 * 4u + 16u); }
#pragma unroll
        for (int ai = 0; ai < 2; ++ai) {
            f32x4 sv[4][2][2];
#pragma unroll
            for (int m = 0; m < 4; ++m) { const unsigned row = u.pm * 256 + ai * 128 + wr * 64 + m * 16 + fr;
#pragma unroll
                for (int bj = 0; bj < 2; ++bj) { const unsigned col0 = u.pn * 256 + bj * 128 + wc * 32 + 8 * fq;
                    const f32x4* sp = (u.pm * 256 < T) ? AT(const f32x4, srcl, (row * (unsigned)D + col0) * 4u) : AT(const f32x4, srcc, ((row - (unsigned)T) * (unsigned)D + col0) * 4u);
                    sv[m][bj][0] = sp[0]; sv[m][bj][1] = sp[1]; } }
            __builtin_amdgcn_sched_barrier(0);
#pragma unroll
            for (int m = 0; m < 4; ++m) { const unsigned row = u.pm * 256 + ai * 128 + wr * 64 + m * 16 + fr; float ssq = 0.f;
#pragma unroll
                for (int bj = 0; bj < 2; ++bj) { const unsigned col0 = u.pn * 256 + bj * 128 + wc * 32 + 8 * fq;
                    f32x4* xp = AT(f32x4, X, (row * (unsigned)D + col0) * 4u);
                    const f32x4 x0 = sv[m][bj][0] + gg[bj][0] * acc[ai][bj][m][0], x1 = sv[m][bj][1] + gg[bj][1] * acc[ai][bj][m][1];
                    xp[0] = x0; xp[1] = x1; store8_bf16(XB, (row * (unsigned)D + col0) * 2u, x0, x1);
                    ssq += ((x0.x * x0.x + x0.y * x0.y) + (x0.z * x0.z + x0.w * x0.w)) + ((x1.x * x1.x + x1.y * x1.y) + (x1.z * x1.z + x1.w * x1.w));
                }
                ssq = fq_sum(ssq);
                if (fq == 0) *AT(float, part, (row * 32u + u.pn * 4u + wc) * 4u) = ssq; }
            __builtin_amdgcn_sched_barrier(0);
        }
    }
};
struct EpiPlain {
    static constexpr bool PERM = true, AFTER_DRAIN = false;
    bf16_t* O;
    __device__ __forceinline__ void elem4(unsigned row, unsigned col0, f32x4 v) const { store4_bf16((unsigned char*)O, (row * (unsigned)D + col0) * 2u, v); }
    __device__ __forceinline__ void operator()(const f32x4 (&acc)[2][2][4][2], const pg8::Unit& u, int wr, int wc, int fr, int fq) const {
#pragma unroll
        for (int ai = 0; ai < 2; ++ai)
#pragma unroll
            for (int m = 0; m < 4; ++m) { const unsigned row = u.pm * 256 + ai * 128 + wr * 64 + m * 16 + fr;
#pragma unroll
                for (int bj = 0; bj < 2; ++bj) { const unsigned col0 = u.pn * 256 + bj * 128 + wc * 32 + 8 * fq;
                    store8_bf16((unsigned char*)O, (row * (unsigned)D + col0) * 2u, acc[ai][bj][m][0], acc[ai][bj][m][1]); } }
    }
};
struct EpiQ {
    static constexpr bool PERM = true, AFTER_DRAIN = false;
    bf16_t* O; const float* part; const float* bias;
    __device__ __forceinline__ void operator()(const f32x4 (&acc)[2][2][4][2], const pg8::Unit& u, int wr, int wc, int fr, int fq) const {
        f32x4 bb[2][2], pp[2][4][2];
#pragma unroll
        for (int bj = 0; bj < 2; ++bj) { const unsigned col0 = u.pn * 256 + bj * 128 + wc * 32 + 8 * fq; bb[bj][0] = *AT(const f32x4, bias, col0 * 4u); bb[bj][1] = *AT(const f32x4, bias, col0 * 4u + 16u); }
#pragma unroll
        for (int ai = 0; ai < 2; ++ai)
#pragma unroll
            for (int m = 0; m < 4; ++m) { const unsigned row = u.pm * 256 + ai * 128 + wr * 64 + m * 16 + fr;
                pp[ai][m][0] = *AT(const f32x4, part, (row * 32u + 8u * fq) * 4u); pp[ai][m][1] = *AT(const f32x4, part, (row * 32u + 8u * fq) * 4u + 16u); }
        __builtin_amdgcn_sched_barrier(0);
#pragma unroll
        for (int ai = 0; ai < 2; ++ai)
#pragma unroll
            for (int m = 0; m < 4; ++m) { const unsigned row = u.pm * 256 + ai * 128 + wr * 64 + m * 16 + fr;
                const f32x4 p0 = pp[ai][m][0], p1 = pp[ai][m][1];
                const float r = rsqrtf(fq_sum(((p0.x + p0.y) + (p0.z + p0.w)) + ((p1.x + p1.y) + (p1.z + p1.w))) * (1.f / D) + EPS);
#pragma unroll
                for (int bj = 0; bj < 2; ++bj) { const unsigned col0 = u.pn * 256 + bj * 128 + wc * 32 + 8 * fq;
                    store8_bf16((unsigned char*)O, (row * (unsigned)D + col0) * 2u, acc[ai][bj][m][0] * r + bb[bj][0], acc[ai][bj][m][1] * r + bb[bj][1]); } }
    }
};
struct EpiQC {
    bf16_t* O; const float* partc; const float* bias;
    __device__ __forceinline__ void elem4(unsigned row, unsigned col0, f32x4 v) const {
        const unsigned po = ((row - (unsigned)T) * 128u + 32u * ((col0 >> 2) & 3u)) * 4u; float sq = 0.f;
#pragma unroll
        for (int i = 0; i < 8; ++i) { const f32x4 t = *AT(const f32x4, partc, po + 16u * i); sq += (t.x + t.y) + (t.z + t.w); }
        const float r = rsqrtf(fq_sum(sq) * (1.f / D) + EPS);
        store4_bf16((unsigned char*)O, (row * (unsigned)D + col0) * 2u, v * r + *AT(const f32x4, bias, col0 * 4u)); }
};
struct EpiInProj {
    static constexpr bool PERM = true, AFTER_DRAIN = false;
    EpiEven ev; EpiOdd od; bool even;
    __device__ __forceinline__ void elem4(unsigned row, unsigned col0, f32x4 v) const { if (even) ev.elem4(row, col0, v); else od.elem4(row, col0, v); }
    __device__ __forceinline__ void operator()(const f32x4 (&acc)[2][2][4][2], const pg8::Unit& u, int wr, int wc, int fr, int fq) const {
        if (even) ev(acc, u, wr, wc, fr, fq); else od(acc, u, wr, wc, fr, fq);
    }
};
struct EpiOutQ {
    static constexpr bool PERM = true, AFTER_DRAIN = false;
    EpiResid rs; EpiPlain pl; bool resid;
    __device__ __forceinline__ void operator()(const f32x4 (&acc)[2][2][4][2], const pg8::Unit& u, int wr, int wc, int fr, int fq) const {
        if (resid) rs(acc, u, wr, wc, fr, fq); else pl(acc, u, wr, wc, fr, fq);
    }
};

template <class Epi, int NT  >
__device__ __forceinline__ void ctx_gemm_piece(const bf16_t* __restrict__ A, const bf16_t* __restrict__ Bt, const Epi& E, int rb, int cb, int wave, int lane) {
    const int fr = lane & 15, fq = lane >> 4;
    const bf16_t* ap = A + (size_t)(T + 16 * rb + fr) * D + 8 * fq;
    const bf16_t* bp = Bt + (size_t)(cb * 128 * NT + 16 * NT * wave + fr) * D + 8 * fq;
    f32x4 acc[NT];
#pragma unroll
    for (int n = 0; n < NT; ++n) acc[n] = (f32x4){0.f, 0.f, 0.f, 0.f};
    constexpr int KC = NT == 1 ? 16 : 8;
#pragma unroll 1
    for (int k0 = 0; k0 < D; k0 += 32 * KC) {
        bf16x8 af[KC], bfg[NT][KC];
#pragma unroll
        for (int kk = 0; kk < KC; ++kk) { af[kk] = *(const bf16x8*)(ap + k0 + 32 * kk);
#pragma unroll
            for (int n = 0; n < NT; ++n) bfg[n][kk] = *(const bf16x8*)(bp + (size_t)16 * n * D + k0 + 32 * kk); }
        __builtin_amdgcn_sched_barrier(0);
#pragma unroll
        for (int kk = 0; kk < KC; ++kk)
#pragma unroll
            for (int n = 0; n < NT; ++n) acc[n] = MFMA16(bfg[n][kk], af[kk], acc[n]);
    }
#pragma unroll
    for (int n = 0; n < NT; ++n) E.elem4((unsigned)(T + 16 * rb + fr), (unsigned)(cb * 128 * NT + 16 * NT * wave + 16 * n + 4 * fq), acc[n]);
}
template <class Epi>
__device__ __forceinline__ void ctx_gemm(const bf16_t* __restrict__ A, const bf16_t* __restrict__ Bt, int N, const Epi& E, int wave, int lane, int vcu, int G) {
    asm volatile("" : "+v"(lane));
    const int npc = 16 * (N >> 7);
    for (int pc = vcu; pc < npc; pc += G) ctx_gemm_piece<Epi, 1>(A, Bt, E, pc & 15, pc >> 4, wave, lane);
}

template <class TF>
__device__ __forceinline__ void attn_wave16(const bf16_t* __restrict__ Qh, int qstride, int qrow0,
                                            const bf16_t* __restrict__ Kh, int kstride, const bf16_t* __restrict__ VTh  ,
                                            int ntiles, const TF& tf, bool has_sink, float sink, float scale,
                                            bf16_t* __restrict__ Oh, int ostride, int lane) {
    asm volatile("" : "+v"(lane));
    const int fr = lane & 15, fq = lane >> 4;
    bf16x8 qf[4];
#pragma unroll
    for (int kd = 0; kd < 4; ++kd) qf[kd] = *(const bf16x8*)(Qh + (size_t)(qrow0 + fr) * qstride + 32 * kd + 8 * fq);
    f32x4 o[8];
#pragma unroll
    for (int nd = 0; nd < 8; ++nd) o[nd] = (f32x4){0.f, 0.f, 0.f, 0.f};
    float mrun = has_sink ? sink * LOG2E : -1e30f;
    float lrun = (has_sink && fq == 0) ? 1.f : 0.f;
    const float sc2 = scale * LOG2E;
    for (int ti = 0; ti < ntiles; ++ti) {
        const int tok0 = tf.tok0(ti);
        f32x4 s[2];
#pragma unroll
        for (int sub = 0; sub < 2; ++sub) {
            s[sub] = (f32x4){0.f, 0.f, 0.f, 0.f};
            int tk = tok0 + 16 * sub + fr; tk = tk < 0 ? 0 : (tk > M - 1 ? M - 1 : tk);
#pragma unroll
            for (int kd = 0; kd < 4; ++kd) { const bf16x8 kf = *(const bf16x8*)(Kh + (size_t)tk * kstride + 32 * kd + 8 * fq); s[sub] = MFMA16(kf, qf[kd], s[sub]); }
        }
        float pv[8]; float tmax = -INFINITY;
#pragma unroll
        for (int sub = 0; sub < 2; ++sub)
#pragma unroll
            for (int r = 0; r < 4; ++r) { const int ks = 16 * sub + 4 * fq + r; const float b = tf.bias(ti, ks);
                const float v = s[sub][r] * sc2 + b * LOG2E; pv[4 * sub + r] = v; tmax = fmaxf(tmax, v); }
        tmax = fmaxf(tmax, __shfl_xor(tmax, 16)); tmax = fmaxf(tmax, __shfl_xor(tmax, 32));
        const float mnew = fmaxf(mrun, tmax), alpha = exp2f(mrun - mnew);
        float ps = 0.f;
#pragma unroll
        for (int i = 0; i < 8; ++i) { pv[i] = exp2f(pv[i] - mnew); ps += pv[i]; }
        lrun = lrun * alpha + ps; mrun = mnew;
#pragma unroll
        for (int nd = 0; nd < 8; ++nd) o[nd] = o[nd] * alpha;
        u32x4 pw; pw.x = pk2(pv[0], pv[1]); pw.y = pk2(pv[2], pv[3]); pw.z = pk2(pv[4], pv[5]); pw.w = pk2(pv[6], pv[7]);
        const bf16x8 pf = mk_frag(pw);
        int t0 = tok0 + 4 * fq, t1 = tok0 + 16 + 4 * fq;
        t0 = t0 < 0 ? 0 : (t0 > M - 4 ? M - 4 : t0); t1 = t1 < 0 ? 0 : (t1 > M - 4 ? M - 4 : t1);
#pragma unroll
        for (int nd = 0; nd < 8; ++nd) { const bf16_t* vr = VTh + (size_t)(16 * nd + fr) * M;
            const u32x2 a = *(const u32x2*)(vr + t0), b = *(const u32x2*)(vr + t1);
            u32x4 w; w.x = a.x; w.y = a.y; w.z = b.x; w.w = b.y;
            o[nd] = MFMA16(mk_frag(w), pf, o[nd]); }
    }
    lrun += __shfl_xor(lrun, 16); lrun += __shfl_xor(lrun, 32);
    const float rl = 1.f / lrun;
#pragma unroll
    for (int nd = 0; nd < 8; ++nd) { const f32x4 v = o[nd] * rl; u32x2 w; w.x = pk2(v[0], v[1]); w.y = pk2(v[2], v[3]);
        *(u32x2*)(Oh + (size_t)(qrow0 + fr) * ostride + 16 * nd + 4 * fq) = w; }
}
struct TFCtxOnly {
    __device__ __forceinline__ int tok0(int ti) const { return T + 32 * ti; }
    __device__ __forceinline__ float bias(int, int) const { return 0.f; }
};
struct TFGqa {
    int jb, tq;
    __device__ __forceinline__ int tok0(int ti) const { return ti < 9 ? 16 * jb - 128 + 32 * ti : T + 32 * (ti - 9); }
    __device__ __forceinline__ float bias(int ti, int ks) const {
        if (ti >= 9) return 0.f;
        const int kp = 16 * jb - 128 + 32 * ti + ks, d = kp - tq;
        return (kp >= 0 && kp < T && d <= 128 && d >= -128) ? 0.f : -INFINITY;
    }
};
struct TFNa {
    int r0, kc0, r, c, c0; const float* rpb;
    __device__ __forceinline__ int tok0(int ti) const { return ti < 8 ? 64 * (r0 + ti) + kc0 : T + 32 * (ti - 8); }
    __device__ __forceinline__ float bias(int ti, int ks) const {
        if (ti >= 8) return 0.f;
        const int kc = kc0 + ks;
        if (kc < c0 || kc >= c0 + 16) return -INFINITY;
        return rpb[(r0 + ti - r + 7) * 31 + (kc - c + 15)];
    }
};

#ifndef ATT_NB
#define ATT_NB 4
#endif
constexpr int ATT_KB = 16384, ATT_VROW = 136, ATT_BUF = ATT_KB + 128 * ATT_VROW;
template <class TF, int MODE = 0>
__device__ __forceinline__ void attn_wg(const TF& tf, const bf16_t* __restrict__ Qh, int qstride, int qrow0, int qrow1,
                                        const bf16_t* __restrict__ Kh, int kstride, const bf16_t* __restrict__ VTh,
                                        bool has_sink, float sink, float scale, bf16_t* __restrict__ Oh, int ostride, LAS unsigned char* lds, int tid, int lane, bool rt_false = false) {
    asm volatile("" : "+v"(lane));
    const int fr = lane & 15, fq = lane >> 4;
    bf16x8 qf[2][4];
#pragma unroll
    for (int qt = 0; qt < 2; ++qt)
#pragma unroll
        for (int kd = 0; kd < 4; ++kd) qf[qt][kd] = *(const bf16x8*)(Qh + (size_t)((qt ? qrow1 : qrow0) + fr) * qstride + 32 * kd + 8 * fq);
    f32x4 o[2][8]; float mrun[2], lrun[2];
#pragma unroll
    for (int qt = 0; qt < 2; ++qt) { mrun[qt] = has_sink ? sink * LOG2E : -1e30f; lrun[qt] = (has_sink && fq == 0) ? 1.f : 0.f;
#pragma unroll
        for (int nd = 0; nd < 8; ++nd) o[qt][nd] = (f32x4){0.f, 0.f, 0.f, 0.f}; }
    const float sc2 = scale * LOG2E;
    const int kr0 = tid >> 4, kch = tid & 15, vd0 = tid >> 3, vc8 = tid & 7;
    u32x4 kreg[2], vreg[2];
    const int nt = tf.ntiles();
#define ATT_LOAD(ti) do { const int t0_ = tf.tile_t0(ti); _Pragma("unroll") for (int i_ = 0; i_ < 2; ++i_) { \
        int tk_ = t0_ + kr0 + 32 * i_; tk_ = tk_ < 0 ? 0 : (tk_ > M - 1 ? M - 1 : tk_); kreg[i_] = *(const u32x4*)(Kh + (size_t)tk_ * kstride + 8 * kch); \
        int tv_ = t0_ + 8 * vc8; tv_ = tv_ < 0 ? 0 : (tv_ > M - 8 ? M - 8 : tv_); vreg[i_] = *(const u32x4*)(VTh + (size_t)(vd0 + 64 * i_) * M + tv_); } } while (0)
#define ATT_STORE(b) do { LAS unsigned char* bb_ = lds + (b) * ATT_BUF; _Pragma("unroll") for (int i_ = 0; i_ < 2; ++i_) { const int r_ = kr0 + 32 * i_; \
        *(LAS u32x4*)(bb_ + r_ * 256 + ((kch ^ (r_ & 15)) << 4)) = kreg[i_]; \
        LAS u32x2* vp_ = (LAS u32x2*)(bb_ + ATT_KB + (vd0 + 64 * i_) * ATT_VROW + 16 * vc8); u32x2 a_, b_; a_.x = vreg[i_].x; a_.y = vreg[i_].y; b_.x = vreg[i_].z; b_.y = vreg[i_].w; vp_[0] = a_; vp_[1] = b_; } } while (0)
    __syncthreads();
    ATT_LOAD(0); ATT_STORE(0);
    __syncthreads();
    for (int ti = 0; ti < nt; ++ti) {
        if (ti + 1 < nt && MODE != 2) ATT_LOAD(ti + 1);
        if (tf.active(ti) && MODE != 3) {
            const LAS unsigned char* kb = lds + (ti & 1) * ATT_BUF; const LAS unsigned char* vbase = kb + ATT_KB;
            const int ns = tf.nsteps(ti);
            for (int st = 0; st < ns; ++st) {
                int ws[2]; f32x4 s[2][2]; float pv[2][8], bs8[2][8], alpha[2];
#pragma unroll
                for (int qt = 0; qt < 2; ++qt) { ws[qt] = tf.win(ti, qt, st);
#pragma unroll
                    for (int sub = 0; sub < 2; ++sub) { s[qt][sub] = (f32x4){0.f, 0.f, 0.f, 0.f}; const int tl = ws[qt] + 16 * sub + fr;
#pragma unroll
                        for (int kd = 0; kd < 4; ++kd) { const bf16x8 kf = *(const LAS bf16x8*)(kb + tl * 256 + (((4 * kd + fq) ^ (tl & 15)) << 4)); s[qt][sub] = MFMA16(kf, qf[qt][kd], s[qt][sub]); } } }
#pragma unroll
                for (int qt = 0; qt < 2; ++qt) tf.bias8(ti, qt, ws[qt] + 4 * fq, bs8[qt]);
                float tmax[2];
#pragma unroll
                for (int qt = 0; qt < 2; ++qt) { tmax[qt] = -INFINITY;
#pragma unroll
                    for (int sub = 0; sub < 2; ++sub)
#pragma unroll
                        for (int r = 0; r < 4; ++r) { const float v = s[qt][sub][r] * sc2 + bs8[qt][4 * sub + r] * LOG2E; pv[qt][4 * sub + r] = v; tmax[qt] = fmaxf(tmax[qt], v); } }
                { const float t0 = __shfl_xor(tmax[0], 16), t1 = __shfl_xor(tmax[1], 16);
                  __builtin_amdgcn_sched_barrier(0);
                  tmax[0] = fmaxf(tmax[0], t0); tmax[1] = fmaxf(tmax[1], t1); }
                { const float t0 = __shfl_xor(tmax[0], 32), t1 = __shfl_xor(tmax[1], 32);
                  __builtin_amdgcn_sched_barrier(0);
                  tmax[0] = fmaxf(tmax[0], t0); tmax[1] = fmaxf(tmax[1], t1); }
                if (__builtin_amdgcn_ballot_w64(tmax[0] > mrun[0] + 8.f || tmax[1] > mrun[1] + 8.f) != 0ull) {
#pragma unroll
                    for (int qt = 0; qt < 2; ++qt) { const float mnew = fmaxf(mrun[qt], tmax[qt]); alpha[qt] = __builtin_amdgcn_exp2f(mrun[qt] - mnew); lrun[qt] *= alpha[qt]; mrun[qt] = mnew;
#pragma unroll
                        for (int nd = 0; nd < 8; ++nd) o[qt][nd] = o[qt][nd] * alpha[qt]; }
                }
#pragma unroll
                for (int qt = 0; qt < 2; ++qt) {
                    float ps = 0.f;
#pragma unroll
                    for (int i = 0; i < 8; ++i) { pv[qt][i] = __builtin_amdgcn_exp2f(pv[qt][i] - mrun[qt]); ps += pv[qt][i]; }
                    lrun[qt] += ps; }
                bf16x8 pf[2];
#pragma unroll
                for (int qt = 0; qt < 2; ++qt) { u32x4 pw; pw.x = pk2(pv[qt][0], pv[qt][1]); pw.y = pk2(pv[qt][2], pv[qt][3]); pw.z = pk2(pv[qt][4], pv[qt][5]); pw.w = pk2(pv[qt][6], pv[qt][7]); pf[qt] = mk_frag(pw); }
                constexpr int NB_ = ATT_NB;
#pragma unroll
                for (int nh = 0; nh < 8; nh += NB_) {
                    u32x4 vw[NB_][2];
#pragma unroll
                    for (int n4 = 0; n4 < NB_; ++n4)
#pragma unroll
                        for (int qt = 0; qt < 2; ++qt) { const LAS unsigned char* vr = vbase + (16 * (nh + n4) + fr) * ATT_VROW + 2 * (ws[qt] + 4 * fq);
                            const u32x2 a = *(const LAS u32x2*)vr, b2 = *(const LAS u32x2*)(vr + 32);
                            vw[n4][qt].x = a.x; vw[n4][qt].y = a.y; vw[n4][qt].z = b2.x; vw[n4][qt].w = b2.y; }
                    __builtin_amdgcn_sched_barrier(0);
#pragma unroll
                    for (int n4 = 0; n4 < NB_; ++n4)
#pragma unroll
                        for (int qt = 0; qt < 2; ++qt) o[qt][nh + n4] = MFMA16(mk_frag(vw[n4][qt]), pf[qt], o[qt][nh + n4]);
                    __builtin_amdgcn_sched_barrier(0);
                }
            }
        }
        if (ti + 1 < nt) ATT_STORE((ti + 1) & 1);
        __syncthreads();
    }
#undef ATT_LOAD
#undef ATT_STORE
    if (MODE == 0 || rt_false)
#pragma unroll
    for (int qt = 0; qt < 2; ++qt) {
        const float lt = fq_sum(lrun[qt]);
        const float rl = 1.f / lt;
#pragma unroll
        for (int nd = 0; nd < 8; ++nd) { const f32x4 v = o[qt][nd] * rl; u32x2 w; w.x = pk2(v[0], v[1]); w.y = pk2(v[2], v[3]);
            *(u32x2*)(Oh + (size_t)((qt ? qrow1 : qrow0) + fr) * ostride + 16 * nd + 4 * fq) = w; }
    }
}
struct TFCtxW {
    __device__ __forceinline__ int ntiles() const { return 4; }
    __device__ __forceinline__ int tile_t0(int ti) const { return T + 64 * ti; }
    __device__ __forceinline__ bool active(int) const { return true; }
    __device__ __forceinline__ int nsteps(int) const { return 2; }
    __device__ __forceinline__ int win(int, int, int st) const { return 32 * st; }
    __device__ __forceinline__ void bias8(int, int, int, float (&b)[8]) const {
#pragma unroll
        for (int i = 0; i < 8; ++i) b[i] = 0.f; }
};
struct TFGqaW {
    int jb64, q0;
    __device__ __forceinline__ int ntiles() const { return 9; }
    __device__ __forceinline__ int tile_t0(int ti) const { return ti < 5 ? 64 * jb64 - 128 + 64 * ti : T + 64 * (ti - 5); }
    __device__ __forceinline__ bool active(int) const { return true; }
    __device__ __forceinline__ int nsteps(int) const { return 2; }
    __device__ __forceinline__ int win(int, int, int st) const { return 32 * st; }
    __device__ __forceinline__ void bias8(int ti, int qt, int key0, float (&b)[8]) const {
        const bool plain = ti >= 5 || (ti >= 1 && ti <= 3 && 64 * jb64 - 128 + 64 * ti >= 0 && 64 * jb64 - 128 + 64 * ti + 63 < T);
        if (plain) {
#pragma unroll
            for (int i = 0; i < 8; ++i) b[i] = 0.f;
        } else {
#pragma unroll
            for (int i = 0; i < 8; ++i) { const int key = key0 + 16 * (i >> 2) + (i & 3); const int kp = 64 * jb64 - 128 + 64 * ti + key, d = kp - (q0 + 16 * qt);
                b[i] = (kp >= 0 && kp < T && d <= 128 && d >= -128) ? 0.f : -INFINITY; }
        }
    }
};
struct TFNaW {
    int rlo, nl, r, r0, hf, fr; const LAS float* rpb;
    __device__ __forceinline__ int ntiles() const { return nl + 4; }
    __device__ __forceinline__ int tile_t0(int ti) const { return ti < nl ? 64 * (rlo + ti) : T + 64 * (ti - nl); }
    __device__ __forceinline__ bool active(int ti) const { return ti >= nl || (rlo + ti >= r0 && rlo + ti < r0 + 8); }
    __device__ __forceinline__ int nsteps(int ti) const { return ti < nl ? 1 : 2; }
    __device__ __forceinline__ int win(int ti, int qt, int st) const { if (ti >= nl) return 32 * st; const int cq = 2 * hf + qt; return cq == 0 ? 0 : (cq == 1 ? 8 : (cq == 2 ? 24 : 32)); }
    __device__ __forceinline__ void bias8(int ti, int qt, int key0, float (&b)[8]) const {
        if (ti >= nl) {
#pragma unroll
            for (int i = 0; i < 8; ++i) b[i] = 0.f;
        } else {
            const int c = 32 * hf + 16 * qt + fr, c0 = c - 8 < 0 ? 0 : (c - 8 > 48 ? 48 : c - 8);
            const LAS float* row = rpb + (rlo + ti - r + 7) * 31;
#pragma unroll
            for (int i = 0; i < 8; ++i) { const int key = key0 + 16 * (i >> 2) + (i & 3); int off = key - c + 15; off = off < 0 ? 0 : (off > 30 ? 30 : off);
                const float v = row[off]; b[i] = ((unsigned)(key - c0) < 16u) ? v : -INFINITY; }
        }
    }
};

__device__ __forceinline__ void ph_attn_even(const Params& p, int e, bool with_ctx, LAS unsigned char* lds, int tid, int lane, int wave, int vcu, int G) {
    unsigned char* proj = p.ws + WS_PROJ;
    const bf16_t* BQ = (const bf16_t*)(proj + PJ_BQ); const bf16_t* BK = (const bf16_t*)(proj + PJ_BK); const bf16_t* BVT = (const bf16_t*)(proj + PJ_BVT);
    bf16_t* MIX = (bf16_t*)(p.ws + WS_MIX);
    const float scale = 0.08838834764831845f;
#ifdef ATT_PROBE
    for (int U = vcu; U < 256; U += G) {
        const int jb64 = U >> 1, kvh = U & 1, h = kvh * 4 + (wave & 3), hf = wave >> 2;
        TFGqaW tf; tf.jb64 = jb64; tf.q0 = 64 * jb64 + 32 * hf + (lane & 15);
        attn_wg<TFGqaW, ATT_PROBE>(tf, BQ + h * 128, 1024, 64 * jb64 + 32 * hf, 64 * jb64 + 32 * hf + 16, BK + kvh * 128, 256, BVT + (size_t)kvh * 128 * M, true, p.ab_sink[e * 8 + h], scale, MIX + 1024 + h * 128, 2048, lds, tid, lane, p.grid == 12345);
    }
#endif
    for (int U = vcu; U < 256; U += G) {
        const int jb64 = U >> 1, kvh = U & 1, h = kvh * 4 + (wave & 3), hf = wave >> 2;
        TFGqaW tf; tf.jb64 = jb64; tf.q0 = 64 * jb64 + 32 * hf + (lane & 15);
        attn_wg(tf, BQ + h * 128, 1024, 64 * jb64 + 32 * hf, 64 * jb64 + 32 * hf + 16, BK + kvh * 128, 256, BVT + (size_t)kvh * 128 * M, true, p.ab_sink[e * 8 + h], scale, MIX + 1024 + h * 128, 2048, lds, tid, lane);
    }
    if (with_ctx) for (int U = G - 1 - vcu; U < 8; U += G) {
        const int h = U, kvh = h >> 2;
        attn_wg(TFCtxW(), BQ + h * 128, 1024, T + 32 * wave, T + 32 * wave + 16, BK + kvh * 128, 256, BVT + (size_t)kvh * 128 * M, true, p.ab_sink[e * 8 + h], scale, MIX + 1024 + h * 128, 2048, lds, tid, lane);
    }
}
__device__ __forceinline__ void ph_attn_odd(const Params& p, int o, bool with_ctx, LAS unsigned char* lds, int tid, int lane, int wave, int vcu, int G) {
    unsigned char* proj = p.ws + WS_PROJ;
    const bf16_t* Q = (const bf16_t*)(proj + PJ_Q); const bf16_t* K = (const bf16_t*)(proj + PJ_K); const bf16_t* VT = (const bf16_t*)(proj + PJ_VT);
    bf16_t* MIX = (bf16_t*)(p.ws + WS_MIX);
    const float scale = 0.08838834764831845f;
#ifdef NA_PROBE
    for (int U = vcu; U < 512; U += G) {
        const int rg = U >> 4, h = U & 15, r = 4 * rg + (wave >> 1), hf = wave & 1;
        TFNaW tf; tf.r = r; tf.r0 = r - 4 < 0 ? 0 : (r - 4 > 120 ? 120 : r - 4); tf.hf = hf; tf.fr = lane & 15; tf.rpb = (const LAS float*)(lds + 2 * ATT_BUF);
        { const float* rsrc = p.na_rpb + ((size_t)o * 16 + h) * 15 * 31; __syncthreads(); if (tid < 465) ((LAS float*)(lds + 2 * ATT_BUF))[tid] = rsrc[tid]; }
        const int rl_ = 4 * rg - 4 < 0 ? 0 : (4 * rg - 4 > 120 ? 120 : 4 * rg - 4), rh_ = (4 * rg - 1 < 0 ? 0 : (4 * rg - 1 > 120 ? 120 : 4 * rg - 1)) + 7;
        tf.rlo = rl_; tf.nl = rh_ - rl_ + 1;
        attn_wg<TFNaW, 1>(tf, Q + h * 128, 2048, 64 * r + 32 * hf, 64 * r + 32 * hf + 16, K + h * 128, 2048, VT + (size_t)h * 128 * M, false, 0.f, scale, MIX + h * 128, 2048, lds, tid, lane, p.grid == 12345);
    }
#endif
    for (int U = vcu; U < 512; U += G) {
        const int rg = U >> 4, h = U & 15, r = 4 * rg + (wave >> 1), hf = wave & 1;
        TFNaW tf; tf.r = r; tf.r0 = r - 4 < 0 ? 0 : (r - 4 > 120 ? 120 : r - 4); tf.hf = hf; tf.fr = lane & 15; tf.rpb = (const LAS float*)(lds + 2 * ATT_BUF);
        { const float* rsrc = p.na_rpb + ((size_t)o * 16 + h) * 15 * 31; __syncthreads(); if (tid < 465) ((LAS float*)(lds + 2 * ATT_BUF))[tid] = rsrc[tid]; }
        const int rl_ = 4 * rg - 4 < 0 ? 0 : (4 * rg - 4 > 120 ? 120 : 4 * rg - 4), rh_ = (4 * rg - 1 < 0 ? 0 : (4 * rg - 1 > 120 ? 120 : 4 * rg - 1)) + 7;
        tf.rlo = rl_; tf.nl = rh_ - rl_ + 1;
        attn_wg(tf, Q + h * 128, 2048, 64 * r + 32 * hf, 64 * r + 32 * hf + 16, K + h * 128, 2048, VT + (size_t)h * 128 * M, false, 0.f, scale, MIX + h * 128, 2048, lds, tid, lane);
    }
    if (with_ctx) for (int U = G - 1 - vcu; U < 16; U += G) {
        const int h = U;
        attn_wg(TFCtxW(), Q + h * 128, 2048, T + 32 * wave, T + 32 * wave + 16, K + h * 128, 2048, VT + (size_t)h * 128 * M, false, 0.f, scale, MIX + h * 128, 2048, lds, tid, lane);
    }
}

__device__ __forceinline__ void mlstm_A_unit(const Params& p, int cc, int hd, int lane) {
    asm volatile("" : "+v"(lane));
    const int fr = lane & 15, fq = lane >> 4, dir = hd >> 3, head = hd & 7, tok0 = cc * 64;
    unsigned char* proj = p.ws + WS_PROJ;
    const bf16_t* AKT = (const bf16_t*)(proj + PJ_AKT); const bf16_t* AVT = (const bf16_t*)(proj + PJ_AVT); const float* Gt = (const float*)(proj + PJ_G);
    float* U = (float*)(p.ws + WS_U); float* CHS = (float*)(p.ws + WS_CHS);
    const float* grow = Gt + (size_t)(tok0 + lane) * 32;
    u32x4 rawk[2][4]; bf16x8 bv[8][2];
#pragma unroll
    for (int ks = 0; ks < 2; ++ks)
#pragma unroll
        for (int nd = 0; nd < 4; ++nd) rawk[ks][nd] = *(const u32x4*)(AKT + (size_t)(head * 64 + 16 * nd + fr) * M + tok0 + 32 * ks + 8 * fq);
#pragma unroll
    for (int ne = 0; ne < 8; ++ne)
#pragma unroll
        for (int ks = 0; ks < 2; ++ks) bv[ne][ks] = *(const bf16x8*)(AVT + (size_t)(head * 128 + 16 * ne + fr) * M + tok0 + 32 * ks + 8 * fq);
    const float ig = grow[(2 * dir) * 8 + head], lf_raw = grow[(2 * dir + 1) * 8 + head];
    __builtin_amdgcn_sched_barrier(0);
    const float lf = log_sigmoid(lf_raw);
    const float F = scan_add(lf, lane, dir);
    const float FL = __shfl(F, dir ? 0 : 63);
    const float wend = FL - F + ig, wmax = wave_max(wend), wv = expf(wend - wmax);
    if (lane == 0) { CHS[((size_t)hd * NCH + cc) * 2] = FL; CHS[((size_t)hd * NCH + cc) * 2 + 1] = wmax; }
    { float* GF = (float*)(p.ws + WS_GF); const float Bs_ = ig - F, pm_ = scan_max(Bs_, lane, dir); const size_t gi = (size_t)hd * M + tok0 + lane;
      GF[gi] = F; GF[(size_t)16 * M + gi] = Bs_; GF[(size_t)32 * M + gi] = pm_; }
    bf16x8 af[4][2];
#pragma unroll
    for (int ks = 0; ks < 2; ++ks) {
        float w8[8];
#pragma unroll
        for (int j = 0; j < 8; ++j) w8[j] = __shfl(wv, 32 * ks + 8 * fq + j);
#pragma unroll
        for (int nd = 0; nd < 4; ++nd) {
            const u32x4 raw = rawk[ks][nd];
            u32x4 w; w.x = pk2(bf_lo(raw.x) * w8[0], bf_hi(raw.x) * w8[1]); w.y = pk2(bf_lo(raw.y) * w8[2], bf_hi(raw.y) * w8[3]);
            w.z = pk2(bf_lo(raw.z) * w8[4], bf_hi(raw.z) * w8[5]); w.w = pk2(bf_lo(raw.w) * w8[6], bf_hi(raw.w) * w8[7]);
            af[nd][ks] = mk_frag(w);
        }
    }
    const unsigned onew = (fr == 0) ? 0x3F803F80u : 0u;
#pragma unroll
    for (int ne = 0; ne < 9; ++ne) {
        bf16x8 bfr[2];
#pragma unroll
        for (int ks = 0; ks < 2; ++ks) {
            if (ne < 8) bfr[ks] = bv[ne < 8 ? ne : 0][ks];
            else { u32x4 w; w.x = onew; w.y = onew; w.z = onew; w.w = onew; bfr[ks] = mk_frag(w); }
        }
#pragma unroll
        for (int nd = 0; nd < 4; ++nd) {
            f32x4 acc = (f32x4){0.f, 0.f, 0.f, 0.f};
#pragma unroll
            for (int ks = 0; ks < 2; ++ks) acc = MFMA16(af[nd][ks], bfr[ks], acc);
            *(f32x4*)(U + (((size_t)hd * NCH + cc) * 144 + 16 * ne + fr) * 64 + 16 * nd + 4 * fq) = acc;
        }
    }
}
__device__ __forceinline__ void ph_mlstm_B(const Params& p, LAS unsigned char* lds, int tid, int G) {
    const float* U = (const float*)(p.ws + WS_U); const float* CHS = (const float*)(p.ws + WS_CHS);
    bf16_t* SNAP = (bf16_t*)(p.ws + WS_SNAP); float* MPREV = (float*)(p.ws + WS_CHS + 65536);
    LAS float* sDec = (LAS float*)lds; LAS float* sInj = sDec + 132;
    for (int b = blockIdx.x; b < 256; b += G) {
        const int hd = b >> 4, part = b & 15, dir = hd >> 3;
        __syncthreads();
        if (tid < NCH) { const int cc = dir ? (NCH - 1 - tid) : (tid < 4 ? 128 + tid : tid - 4); sDec[tid] = CHS[((size_t)hd * NCH + cc) * 2]; sInj[tid] = CHS[((size_t)hd * NCH + cc) * 2 + 1]; }
        __syncthreads();
        LAS float* sM = sInj + 132;
        if (tid == 0) { float m = 0.f;
            for (int step = 0; step < NCH; ++step) { sM[step] = m; m = fmaxf(sDec[step] + m, sInj[step]); } sM[NCH] = m; }
        __syncthreads();
        if (tid < NCH) { const int step = tid; const int cc = dir ? (NCH - 1 - step) : (step < 4 ? 128 + step : step - 4);
            const float FL = sDec[step], wm = sInj[step], m = sM[step], mn = sM[step + 1];
            if (part == 0) MPREV[hd * NCH + cc] = m;
            sDec[step] = expf(FL + m - mn); sInj[step] = expf(wm - mn); }
        __syncthreads();
        const int i0 = part * 512 + tid; const bool has2 = (part == 0 && tid < 64); const int i1 = 8192 + tid;
        float C0 = 0.f, C1 = 0.f;
#pragma unroll 1
        for (int s12 = 0; s12 < NCH; s12 += 22) {
            float u0[22], u1[22]; size_t base[22];
#pragma unroll
            for (int k = 0; k < 22; ++k) { const int step = s12 + k; const int cc = dir ? (NCH - 1 - step) : (step < 4 ? 128 + step : step - 4);
                base[k] = ((size_t)hd * NCH + cc) * 9216; u0[k] = U[base[k] + i0]; u1[k] = has2 ? U[base[k] + i1] : 0.f; }
#pragma unroll
            for (int k = 0; k < 22; ++k) {
                SNAP[base[k] + i0] = (bf16_t)(pk2(C0, 0.f) & 0xffff);
                if (has2) SNAP[base[k] + i1] = (bf16_t)(pk2(C1, 0.f) & 0xffff);
                const float decay = sDec[s12 + k], inj = sInj[s12 + k];
                C0 = decay * C0 + inj * u0[k]; C1 = decay * C1 + inj * u1[k]; }
        }
    }
}
__device__ __forceinline__ void mlstm_C_unit(const Params& p, int e_idx, int cc, int head, int tq, int lane) {
    asm volatile("" : "+v"(lane));
    const int fr = lane & 15, fq = lane >> 4, tok0 = cc * 64, tl = 16 * tq + fr;
    unsigned char* proj = p.ws + WS_PROJ;
    const bf16_t* AQ = (const bf16_t*)(proj + PJ_AQ); const bf16_t* AK = (const bf16_t*)(proj + PJ_AK); const bf16_t* AVT = (const bf16_t*)(proj + PJ_AVT);
    const bf16_t* AO = (const bf16_t*)(proj + PJ_AO); const float* Gt = (const float*)(proj + PJ_G);
    const bf16_t* SNAP = (const bf16_t*)(p.ws + WS_SNAP); const float* MPREV = (const float*)(p.ws + WS_CHS + 65536);
    bf16_t* MIX = (bf16_t*)(p.ws + WS_MIX);
    bf16x8 qf[2];
#pragma unroll
    for (int kd = 0; kd < 2; ++kd) qf[kd] = *(const bf16x8*)(AQ + (size_t)(tok0 + tl) * 512 + head * 64 + 32 * kd + 8 * fq);
    f32x4 s[4];
#pragma unroll
    for (int ns = 0; ns < 4; ++ns) { s[ns] = (f32x4){0.f, 0.f, 0.f, 0.f};
#pragma unroll
        for (int kd = 0; kd < 2; ++kd) { const bf16x8 kf = *(const bf16x8*)(AK + (size_t)(tok0 + 16 * ns + fr) * 512 + head * 64 + 32 * kd + 8 * fq); s[ns] = MFMA16(kf, qf[kd], s[ns]); } }
    f32x4 hs[8];
#pragma unroll
    for (int ne = 0; ne < 8; ++ne) hs[ne] = (f32x4){0.f, 0.f, 0.f, 0.f};
    const float* grow = Gt + (size_t)(tok0 + lane) * 32;
#pragma unroll
    for (int dir = 0; dir < 2; ++dir) {
        const int hd = dir * 8 + head;
        const float* GF = (const float*)(p.ws + WS_GF) + (size_t)hd * M + tok0;
        const float F_t = GF[tl], pm_t = GF[(size_t)32 * M + tl];
        const float inter = F_t + MPREV[hd * NCH + cc], mt = fmaxf(inter, F_t + pm_t);
        const float A_t = F_t - mt, a_t = expf(inter - mt), fl_t = expf(-mt);
        bf16x8 pf[2];
#pragma unroll
        for (int ks = 0; ks < 2; ++ks) { unsigned w[4];
#pragma unroll
            for (int hf = 0; hf < 2; ++hf) { const int ns = 2 * ks + hf; float ev[4];
                const f32x4 b4 = *(const f32x4*)(GF + (size_t)16 * M + 16 * ns + 4 * fq);
#pragma unroll
                for (int r = 0; r < 4; ++r) { const int sl = 16 * ns + 4 * fq + r;
                    const bool valid = dir ? (sl >= tl) : (sl <= tl);
                    ev[r] = s[ns][r] * expf(valid ? (A_t + b4[r]) : -INFINITY); }
                w[2 * hf] = pk2(ev[0], ev[1]); w[2 * hf + 1] = pk2(ev[2], ev[3]); }
            u32x4 ww; ww.x = w[0]; ww.y = w[1]; ww.z = w[2]; ww.w = w[3]; pf[ks] = mk_frag(ww); }
        const bf16_t* snap = SNAP + ((size_t)hd * NCH + cc) * 9216;
        float rden = 0.f;
#pragma unroll
        for (int it = 0; it < 9; ++it) {
            const int ne = (it == 0) ? 8 : it - 1;
            f32x4 acc = (f32x4){0.f, 0.f, 0.f, 0.f};
#pragma unroll
            for (int kd = 0; kd < 2; ++kd) {
                u32x4 cw = *(const u32x4*)(snap + (size_t)(16 * ne + fr) * 64 + 32 * kd + 8 * fq);
                if (ne == 8 && fr != 0) { cw.x = 0u; cw.y = 0u; cw.z = 0u; cw.w = 0u; }
                acc = MFMA16(mk_frag(cw), qf[kd], acc);
            }
            acc = acc * a_t;
#pragma unroll
            for (int ks = 0; ks < 2; ++ks) {
                u32x4 vw;
                if (ne < 8) { const bf16_t* vr = AVT + (size_t)(head * 128 + 16 * ne + fr) * M + tok0 + 32 * ks + 4 * fq;
                    const u32x2 a = *(const u32x2*)vr, b = *(const u32x2*)(vr + 16); vw.x = a.x; vw.y = a.y; vw.z = b.x; vw.w = b.y; }
                else { const unsigned onew = (fr == 0) ? 0x3F803F80u : 0u; vw.x = onew; vw.y = onew; vw.z = onew; vw.w = onew; }
                acc = MFMA16(mk_frag(vw), pf[ks], acc);
            }
            if (ne == 8) { const float den = __shfl(acc[0], fr); rden = 1.f / fmaxf(fabsf(den), fl_t); }
            else hs[ne] = hs[ne] + acc * rden;
        }
    }
    float ss = 0.f;
#pragma unroll
    for (int ne = 0; ne < 8; ++ne) ss += (hs[ne][0] * hs[ne][0] + hs[ne][1] * hs[ne][1]) + (hs[ne][2] * hs[ne][2] + hs[ne][3] * hs[ne][3]);
    ss += __shfl_xor(ss, 16); ss += __shfl_xor(ss, 32);
    const float rs = rsqrtf(ss * (1.f / 128.f) + EPS);
    const int tok = tok0 + tl;
#pragma unroll
    for (int ne = 0; ne < 8; ++ne) { const int col = head * 128 + 16 * ne + 4 * fq;
        const f32x4 g4 = *(const f32x4*)(p.ab_mh_g + (size_t)e_idx * 1024 + col);
        const u32x2 ow = *(const u32x2*)(AO + (size_t)tok * 1024 + col);
        const float o0 = bf_lo(ow.x), o1 = bf_hi(ow.x), o2 = bf_lo(ow.y), o3 = bf_hi(ow.y);
        const f32x4 v = hs[ne] * rs * g4;
        u32x2 w; w.x = pk2(v[0] / (1.f + expf(-o0)), v[1] / (1.f + expf(-o1))); w.y = pk2(v[2] / (1.f + expf(-o2)), v[3] / (1.f + expf(-o3)));
        *(u32x2*)(MIX + (size_t)tok * 2048 + col) = w; }
}

constexpr int MC_K = 0, MC_Q = 8192, MC_VT = 16384, MC_S = 34816  , MC_G = 71680  , MC_H = 73728  , MC_END = 106496;
__device__ __forceinline__ void mlstm_C_wg(const Params& p, int e_idx, LAS unsigned char* lds, int tid, int lane, int wave, int vcu, int G) {
    asm volatile("" : "+v"(lane));
    const int fr = lane & 15, fq = lane >> 4, tq = wave & 3, dir = wave >> 2, tl = 16 * tq + fr;
    unsigned char* proj = p.ws + WS_PROJ;
    const bf16_t* AQ = (const bf16_t*)(proj + PJ_AQ); const bf16_t* AK = (const bf16_t*)(proj + PJ_AK); const bf16_t* AVT = (const bf16_t*)(proj + PJ_AVT);
    const bf16_t* AO = (const bf16_t*)(proj + PJ_AO);
    const bf16_t* SNAP = (const bf16_t*)(p.ws + WS_SNAP); const float* MPREV = (const float*)(p.ws + WS_CHS + 65536);
    const float* GFg = (const float*)(p.ws + WS_GF);
    bf16_t* MIX = (bf16_t*)(p.ws + WS_MIX);
    const int row = tid >> 3, ch = tid & 7;
    u32x4 kv, qv, vv[2], sv[2][3]; float gv = 0.f;
#define MC_FETCH(U_) do { const int cc_ = (U_) >> 3, hd_ = (U_) & 7, t0_ = cc_ * 64; \
        kv = *(const u32x4*)(AK + (size_t)(t0_ + row) * 512 + hd_ * 64 + ch * 8); qv = *(const u32x4*)(AQ + (size_t)(t0_ + row) * 512 + hd_ * 64 + ch * 8); \
        _Pragma("unroll") for (int i = 0; i < 2; ++i) vv[i] = *(const u32x4*)(AVT + (size_t)(hd_ * 128 + row + 64 * i) * M + t0_ + ch * 8); \
        _Pragma("unroll") for (int d = 0; d < 2; ++d) _Pragma("unroll") for (int i = 0; i < 3; ++i) { const int q = tid + 512 * i, e = q >> 3; const u32x4 z = {0u, 0u, 0u, 0u}; \
            sv[d][i] = (q < 1152 && e < 129) ? *(const u32x4*)(SNAP + ((size_t)(d * 8 + hd_) * NCH + cc_) * 9216 + (size_t)e * 64 + ch * 8) : z; } \
        if (tid < 384) { const int which = tid >> 6, t = tid & 63, kind = which % 3, dd = which / 3; gv = GFg[((size_t)kind * 16 + dd * 8 + hd_) * M + t0_ + t]; } } while (0)
    int U = vcu;
    if (U < NCH * 8) MC_FETCH(U);
    for (; U < NCH * 8; U += G) {
    const int cc = U >> 3, head = U & 7, tok0 = cc * 64, hd = dir * 8 + head;
    __syncthreads();
    {
        *(LAS u32x4*)(lds + MC_K + row * 128 + ((ch ^ (row & 7)) << 4)) = kv;
        *(LAS u32x4*)(lds + MC_Q + row * 128 + ((ch ^ (row & 7)) << 4)) = qv;
#pragma unroll
        for (int i = 0; i < 2; ++i) { const int e = row + 64 * i; *(LAS u32x4*)(lds + MC_VT + e * 128 + ((ch ^ (e & 7)) << 4)) = vv[i]; }
        if (tid < 128) { const int e = 128 + row; const unsigned o1 = (e == 128) ? 0x3F803F80u : 0u; const u32x4 ov = {o1, o1, o1, o1}; *(LAS u32x4*)(lds + MC_VT + e * 128 + ((ch ^ (e & 7)) << 4)) = ov; }
#pragma unroll
        for (int d = 0; d < 2; ++d)
#pragma unroll
            for (int i = 0; i < 3; ++i) { const int q = tid + 512 * i, e = q >> 3; if (q < 1152) *(LAS u32x4*)(lds + MC_S + d * 18432 + e * 128 + ((ch ^ (e & 7)) << 4)) = sv[d][i]; }
        if (tid < 384) *(LAS float*)(lds + MC_G + tid * 4) = gv;
    }
    __syncthreads();
    if (U + G < NCH * 8) MC_FETCH(U + G);
    bf16x8 qf[2];
#pragma unroll
    for (int kd = 0; kd < 2; ++kd) qf[kd] = *(const LAS bf16x8*)(lds + MC_Q + tl * 128 + (((4 * kd + fq) ^ (tl & 7)) << 4));
    f32x4 s[4];
#pragma unroll
    for (int ns = 0; ns < 4; ++ns) { s[ns] = (f32x4){0.f, 0.f, 0.f, 0.f}; const int sr = 16 * ns + fr;
#pragma unroll
        for (int kd = 0; kd < 2; ++kd) { const bf16x8 kf = *(const LAS bf16x8*)(lds + MC_K + sr * 128 + (((4 * kd + fq) ^ (sr & 7)) << 4)); s[ns] = MFMA16(kf, qf[kd], s[ns]); } }
    const LAS float* G = (const LAS float*)(lds + MC_G + dir * 768);
    const float F_t = G[tl], pm_t = G[128 + tl];
    const float inter = F_t + MPREV[hd * NCH + cc], mt = fmaxf(inter, F_t + pm_t);
    const float A_t = F_t - mt, a_t = expf(inter - mt), fl_t = expf(-mt);
    bf16x8 pf[2];
#pragma unroll
    for (int ks = 0; ks < 2; ++ks) { unsigned w[4];
#pragma unroll
        for (int hf = 0; hf < 2; ++hf) { const int ns = 2 * ks + hf; float ev[4];
            const f32x4 b4 = *(const LAS f32x4*)(G + 64 + 16 * ns + 4 * fq);
#pragma unroll
            for (int r = 0; r < 4; ++r) { const int sl = 16 * ns + 4 * fq + r; const bool valid = dir ? (sl >= tl) : (sl <= tl);
                ev[r] = s[ns][r] * expf(valid ? (A_t + b4[r]) : -INFINITY); }
            w[2 * hf] = pk2(ev[0], ev[1]); w[2 * hf + 1] = pk2(ev[2], ev[3]); }
        u32x4 ww; ww.x = w[0]; ww.y = w[1]; ww.z = w[2]; ww.w = w[3]; pf[ks] = mk_frag(ww); }
    const LAS unsigned char* snap = lds + MC_S + dir * 18432;
    f32x4 hs[8]; float rden = 0.f;
#pragma unroll
    for (int g3 = 0; g3 < 3; ++g3) {
        bf16x8 cfr[3][2]; u32x4 vwr[3][2];
#pragma unroll
        for (int i3 = 0; i3 < 3; ++i3) { const int it = 3 * g3 + i3; const int ne = (it == 0) ? 8 : it - 1; const int er = 16 * ne + fr;
#pragma unroll
            for (int kd = 0; kd < 2; ++kd) cfr[i3][kd] = *(const LAS bf16x8*)(snap + er * 128 + (((4 * kd + fq) ^ (er & 7)) << 4));
#pragma unroll
            for (int ks = 0; ks < 2; ++ks) {
                const LAS unsigned char* vr = lds + MC_VT + er * 128 + 8 * (fq & 1);
                const u32x2 a = *(const LAS u32x2*)(vr + (((4 * ks + (fq >> 1)) ^ (er & 7)) << 4)), b = *(const LAS u32x2*)(vr + (((4 * ks + 2 + (fq >> 1)) ^ (er & 7)) << 4));
                vwr[i3][ks].x = a.x; vwr[i3][ks].y = a.y; vwr[i3][ks].z = b.x; vwr[i3][ks].w = b.y; } }
        __builtin_amdgcn_sched_barrier(0);
#pragma unroll
        for (int i3 = 0; i3 < 3; ++i3) { const int it = 3 * g3 + i3; const int ne = (it == 0) ? 8 : it - 1;
            f32x4 acc = (f32x4){0.f, 0.f, 0.f, 0.f};
#pragma unroll
            for (int kd = 0; kd < 2; ++kd) acc = MFMA16(cfr[i3][kd], qf[kd], acc);
            acc = acc * a_t;
#pragma unroll
            for (int ks = 0; ks < 2; ++ks) acc = MFMA16(mk_frag(vwr[i3][ks]), pf[ks], acc);
            if (ne == 8) { const float den = __shfl(acc[0], fr); rden = 1.f / fmaxf(fabsf(den), fl_t); }
            else hs[ne] = acc * rden; }
        __builtin_amdgcn_sched_barrier(0);
    }
    if (dir == 1) {
#pragma unroll
        for (int ne = 0; ne < 8; ++ne) *(LAS f32x4*)(lds + MC_H + tq * 8192 + ne * 1024 + lane * 16) = hs[ne];
    }
    __syncthreads();
    if (dir == 0) {
        float ss = 0.f;
#pragma unroll
        for (int ne = 0; ne < 8; ++ne) { hs[ne] = hs[ne] + *(const LAS f32x4*)(lds + MC_H + tq * 8192 + ne * 1024 + lane * 16);
            ss += (hs[ne][0] * hs[ne][0] + hs[ne][1] * hs[ne][1]) + (hs[ne][2] * hs[ne][2] + hs[ne][3] * hs[ne][3]); }
        ss = fq_sum(ss);
        const float rs = rsqrtf(ss * (1.f / 128.f) + EPS);
        const int tok = tok0 + tl;
        f32x4 g4a[8]; u32x2 owa[8];
#pragma unroll
        for (int ne = 0; ne < 8; ++ne) { const int col = head * 128 + 16 * ne + 4 * fq; g4a[ne] = *(const f32x4*)(p.ab_mh_g + (size_t)e_idx * 1024 + col); owa[ne] = *(const u32x2*)(AO + (size_t)tok * 1024 + col); }
        __builtin_amdgcn_sched_barrier(0);
#pragma unroll
        for (int ne = 0; ne < 8; ++ne) { const int col = head * 128 + 16 * ne + 4 * fq;
            const f32x4 g4 = g4a[ne];
            const u32x2 ow = owa[ne];
            const float o0 = bf_lo(ow.x), o1 = bf_hi(ow.x), o2 = bf_lo(ow.y), o3 = bf_hi(ow.y);
            const f32x4 v = hs[ne] * rs * g4;
            u32x2 w; w.x = pk2(v[0] / (1.f + expf(-o0)), v[1] / (1.f + expf(-o1))); w.y = pk2(v[2] / (1.f + expf(-o2)), v[3] / (1.f + expf(-o3)));
            *(u32x2*)(MIX + (size_t)tok * 2048 + col) = w; }
    }
    }
#undef MC_FETCH
}

#define CE_DESC(a, b) do { const float _x = fmaxf(a, b), _y = fminf(a, b); a = _x; b = _y; } while (0)
__device__ __forceinline__ void sort16_desc(float (&v)[16]) {
#pragma unroll
    for (int k = 2; k <= 16; k <<= 1)
#pragma unroll
        for (int j = k >> 1; j > 0; j >>= 1)
#pragma unroll
            for (int i = 0; i < 16; ++i) { const int l = i ^ j; if (l > i) { if ((i & k) == 0) CE_DESC(v[i], v[l]); else CE_DESC(v[l], v[i]); } }
}
__device__ __forceinline__ void merge16_desc(float (&a)[16], const float (&b)[16]) {
#pragma unroll
    for (int i = 0; i < 16; ++i) a[i] = fmaxf(a[i], b[15 - i]);
#pragma unroll
    for (int j = 8; j > 0; j >>= 1)
#pragma unroll
        for (int i = 0; i < 16; ++i) { const int l = i ^ j; if (l > i) CE_DESC(a[i], a[l]); }
}
__device__ __forceinline__ void ce_desc_p(float& va, int& pa, float& vb, int& pb) {
    float nva, nvb; int npa, npb;
    asm volatile("v_cmp_gt_f32 vcc, %5, %4\n\tv_cndmask_b32 %0, %4, %5, vcc\n\tv_cndmask_b32 %1, %5, %4, vcc\n\tv_cndmask_b32 %2, %6, %7, vcc\n\tv_cndmask_b32 %3, %7, %6, vcc"
                 : "=&v"(nva), "=&v"(nvb), "=&v"(npa), "=&v"(npb) : "v"(va), "v"(vb), "v"(pa), "v"(pb) : "vcc");
    va = nva; vb = nvb; pa = npa; pb = npb;
}
#define CE_DESC_P(va, pa, vb, pb) ce_desc_p(va, pa, vb, pb)
__device__ __forceinline__ void sort16p_desc(float (&v)[16], int (&q)[16]) {
#pragma unroll
    for (int k = 2; k <= 16; k <<= 1)
#pragma unroll
        for (int j = k >> 1; j > 0; j >>= 1)
#pragma unroll
            for (int i = 0; i < 16; ++i) { const int l = i ^ j; if (l > i) { if ((i & k) == 0) CE_DESC_P(v[i], q[i], v[l], q[l]); else CE_DESC_P(v[l], q[l], v[i], q[i]); } }
}
__device__ __forceinline__ void merge16p_desc(float (&a)[16], int (&qa)[16], const float (&b)[16], const int (&qb)[16]) {
#pragma unroll
    for (int i = 0; i < 16; ++i) { float tb = b[15 - i]; int tq = qb[15 - i]; ce_desc_p(a[i], qa[i], tb, tq); }
#pragma unroll
    for (int j = 8; j > 0; j >>= 1)
#pragma unroll
        for (int i = 0; i < 16; ++i) { const int l = i ^ j; if (l > i) CE_DESC_P(a[i], qa[i], a[l], qa[l]); }
}
#define CAND_G0(X) X(0,0) X(0,1) X(0,2) X(0,3) X(0,4) X(0,5) X(0,6) X(0,7) X(0,8) X(0,9) X(0,10) X(0,11) X(0,12) X(0,13) X(0,14) X(0,15)
#define CAND_G1(X) X(1,0) X(1,1) X(1,2) X(1,3) X(1,4) X(1,5) X(1,6) X(1,7) X(2,0) X(2,1) X(2,2) X(2,3) X(2,4) X(3,0) X(3,1) X(3,2)
#define CAND_G2(X) X(3,3) X(4,0) X(4,1) X(4,2) X(5,0) X(5,1) X(6,0) X(6,1) X(7,0) X(7,1) X(8,0) X(9,0) X(10,0) X(11,0) X(12,0) X(13,0)
#define CAND_G3(X) X(14,0) X(15,0)

__device__ __forceinline__ void peer_topk_unit(const Params& p, int l, int mt, int hh, int lane) {
    asm volatile("" : "+v"(lane));
    const int fr = lane & 15, fq = lane >> 4, row = mt * 16 + fr;
    const bf16_t* QP = (const bf16_t*)(p.ws + WS_QP); const bf16_t* KEYS = (const bf16_t*)(p.ws + WS_KEYS);
    float s1[16], s2[16]; int i1[16], i2[16];
#pragma unroll
    for (int p2 = 0; p2 < 2; ++p2) {
        bf16x8 qf[4];
#pragma unroll
        for (int kd = 0; kd < 4; ++kd) qf[kd] = *(const bf16x8*)(QP + (size_t)row * 2048 + hh * 256 + p2 * 128 + 32 * kd + 8 * fq);
        float a[16], b[16];
#pragma unroll
        for (int nh = 0; nh < 2; ++nh) {
            bf16x8 kf[4][4];
#pragma unroll
            for (int nb = 0; nb < 4; ++nb)
#pragma unroll
                for (int kd = 0; kd < 4; ++kd) kf[nb][kd] = *(const bf16x8*)(KEYS + ((((size_t)l * 8 + hh) * 2 + p2) * 128 + 16 * (4 * nh + nb) + fr) * 128 + 32 * kd + 8 * fq);
            __builtin_amdgcn_sched_barrier(0);
#pragma unroll
            for (int nb = 0; nb < 4; ++nb) { const int nk = 4 * nh + nb;
                f32x4 acc = (f32x4){0.f, 0.f, 0.f, 0.f};
#pragma unroll
                for (int kd = 0; kd < 4; ++kd) acc = MFMA16(kf[nb][kd], qf[kd], acc);
#pragma unroll
                for (int r = 0; r < 4; ++r) { const unsigned idx = 16 * nk + 4 * fq + r; const float v = __uint_as_float((__float_as_uint(acc[r]) & ~0x7Fu) | idx);
                    if (nk < 4) a[4 * nk + r] = v; else b[4 * (nk - 4) + r] = v; } }
            __builtin_amdgcn_sched_barrier(0);
        }
        sort16_desc(a); sort16_desc(b); merge16_desc(a, b);
#pragma unroll
        for (int i = 0; i < 16; ++i) b[i] = __shfl_xor(a[i], 16);
        __builtin_amdgcn_sched_barrier(0);
        merge16_desc(a, b);
#pragma unroll
        for (int i = 0; i < 16; ++i) b[i] = __shfl_xor(a[i], 32);
        __builtin_amdgcn_sched_barrier(0);
        merge16_desc(a, b);
#pragma unroll
        for (int i = 0; i < 16; ++i) { const unsigned bits = __float_as_uint(a[i]); const float v = __uint_as_float(bits & ~0x7Fu); const int id = (int)(bits & 0x7Fu);
            if (p2 == 0) { s1[i] = v; i1[i] = id; } else { s2[i] = v; i2[i] = id; } }
    }
    float tv[16], gv[16]; int tp[16], gp[16];
    { float v0[16], v1[16], v2[16]; int q0[16], q1[16], q2[16]; float v3a, v3b; int q3a, q3b;
      { int ci = 0;
#define CX(A, B) v0[ci] = s1[A] + s2[B]; q0[ci] = i1[A] * 128 + i2[B]; ++ci;
        CAND_G0(CX) }
#undef CX
      { int ci = 0;
#define CX(A, B) v1[ci] = s1[A] + s2[B]; q1[ci] = i1[A] * 128 + i2[B]; ++ci;
        CAND_G1(CX) }
#undef CX
      { int ci = 0;
#define CX(A, B) v2[ci] = s1[A] + s2[B]; q2[ci] = i1[A] * 128 + i2[B]; ++ci;
        CAND_G2(CX) }
#undef CX
      v3a = s1[14] + s2[0]; q3a = i1[14] * 128 + i2[0]; v3b = s1[15] + s2[0]; q3b = i1[15] * 128 + i2[0];
#pragma unroll
      for (int i = 0; i < 16; ++i) { const float w3 = i == 0 ? v3a : (i == 1 ? v3b : -1e30f); const int r3 = i == 0 ? q3a : (i == 1 ? q3b : 0);
          tv[i] = fq == 0 ? v0[i] : (fq == 1 ? v1[i] : (fq == 2 ? v2[i] : w3)); tp[i] = fq == 0 ? q0[i] : (fq == 1 ? q1[i] : (fq == 2 ? q2[i] : r3)); } }
    sort16p_desc(tv, tp);
#pragma unroll
    for (int i = 0; i < 16; ++i) { gv[i] = __shfl_xor(tv[i], 16); gp[i] = __shfl_xor(tp[i], 16); }
    __builtin_amdgcn_sched_barrier(0);
    merge16p_desc(tv, tp, gv, gp);
#pragma unroll
    for (int i = 0; i < 16; ++i) { gv[i] = __shfl_xor(tv[i], 32); gp[i] = __shfl_xor(tp[i], 32); }
    __builtin_amdgcn_sched_barrier(0);
    merge16p_desc(tv, tp, gv, gp);
    float sum = 0.f; const float tmx = tv[0];
#pragma unroll
    for (int i = 0; i < 16; ++i) { tv[i] = expf(tv[i] - tmx); sum += tv[i]; }
    const float rsum = 1.f / sum;
    if (fq == 0) {
        int* IDX = (int*)(p.ws + WS_IDX) + (size_t)row * 128 + hh * 16; float* GT = (float*)(p.ws + WS_GATE) + (size_t)row * 128 + hh * 16;
#pragma unroll
        for (int i = 0; i < 16; i += 4) {
            *(int4*)(IDX + i) = make_int4(tp[i], tp[i + 1], tp[i + 2], tp[i + 3]);
            *(f32x4*)(GT + i) = (f32x4){tv[i] * rsum, tv[i + 1] * rsum, tv[i + 2] * rsum, tv[i + 3] * rsum};
        }
    }
}

typedef int i32x4 __attribute__((ext_vector_type(4)));
__device__ __forceinline__ float gelu_erf(float x) { return 0.5f * x * (1.f + erff(x * 0.70710678118654752f)); }
typedef float f32x2 __attribute__((ext_vector_type(2)));
__device__ __forceinline__ void acc_row16(f32x2 (&y)[8], const i32x4 w, float cf) {
    const f32x2 cf2 = {cf, cf};
#pragma unroll
    for (int d = 0; d < 4; ++d) { const unsigned u = (unsigned)w[d];
        const f32x2 a = {(float)(u & 0xffu), (float)((u >> 8) & 0xffu)}, b = {(float)((u >> 16) & 0xffu), (float)(u >> 24)};
        y[2 * d] = __builtin_elementwise_fma(cf2, a, y[2 * d]); y[2 * d + 1] = __builtin_elementwise_fma(cf2, b, y[2 * d + 1]); }
}
template <int N> __device__ __forceinline__ void reduce_scatter_g(float (&y)[N]) {
#pragma unroll
    for (int i = 0; i < N; ++i) y[i] += __builtin_bit_cast(float, __builtin_amdgcn_mov_dpp(__builtin_bit_cast(int, y[i]), 0x128  , 0xf, 0xf, false));
#pragma unroll
    for (int i = 0; i < N / 2; ++i) { const auto r = __builtin_amdgcn_permlane16_swap(__float_as_uint(y[i]), __float_as_uint(y[N / 2 + i]), false, false); y[i] = __uint_as_float(r[0]) + __uint_as_float(r[1]); }
#pragma unroll
    for (int i = 0; i < N / 4; ++i) { const auto r = __builtin_amdgcn_permlane32_swap(__float_as_uint(y[i]), __float_as_uint(y[N / 4 + i]), false, false); y[i] = __uint_as_float(r[0]) + __uint_as_float(r[1]); }
}
__device__ __forceinline__ void dot_rows4(int (&yi)[16], const i32x4 a, const i32x4 b, const i32x4 c, const i32x4 d, int cq) {
#pragma unroll
    for (int k = 0; k < 4; ++k) {
        const unsigned ablo = __builtin_amdgcn_perm((unsigned)b[k], (unsigned)a[k], 0x05010400u), abhi = __builtin_amdgcn_perm((unsigned)b[k], (unsigned)a[k], 0x07030602u);
        const unsigned cdlo = __builtin_amdgcn_perm((unsigned)d[k], (unsigned)c[k], 0x05010400u), cdhi = __builtin_amdgcn_perm((unsigned)d[k], (unsigned)c[k], 0x07030602u);
        yi[4 * k + 0] = __builtin_amdgcn_sdot4((int)__builtin_amdgcn_perm(cdlo, ablo, 0x05040100u), cq, yi[4 * k + 0], false);
        yi[4 * k + 1] = __builtin_amdgcn_sdot4((int)__builtin_amdgcn_perm(cdlo, ablo, 0x07060302u), cq, yi[4 * k + 1], false);
        yi[4 * k + 2] = __builtin_amdgcn_sdot4((int)__builtin_amdgcn_perm(cdhi, abhi, 0x05040100u), cq, yi[4 * k + 2], false);
        yi[4 * k + 3] = __builtin_amdgcn_sdot4((int)__builtin_amdgcn_perm(cdhi, abhi, 0x07060302u), cq, yi[4 * k + 3], false);
    }
}
__device__ __forceinline__ void ph_peer_gather(const Params& p, int l, LAS unsigned char* lds, int lane, int wave, int vcu, int tid, bool dry  ) {
    asm volatile("" : "+v"(lane));
    const int g = lane >> 3, c = lane & 7, m0 = vcu * 33;
    LAS int* idxL = (LAS int*)lds;
    LAS float* gatL = (LAS float*)(lds + 16896);
    LAS float* coefL = (LAS float*)(lds + 33792);
    const int* IDX = (const int*)(p.ws + WS_IDX) + (size_t)m0 * 128; const float* GT = (const float*)(p.ws + WS_GATE) + (size_t)m0 * 128;
    __syncthreads();
    { int iv[9]; float gv[9];
#pragma unroll
      for (int k = 0; k < 9; ++k) { const int i = tid + 512 * k; const bool ok = i < 33 * 128; iv[k] = ok ? IDX[i] : 0; gv[k] = ok ? GT[i] : 0.f; }
#pragma unroll
      for (int k = 0; k < 9; ++k) { const int i = tid + 512 * k; if (i < 33 * 128) { idxL[i] = iv[k]; gatL[i] = gv[k]; } } }
    __syncthreads();
    const unsigned char* H8 = p.ws + WS_H8; const float* SH = (const float*)(p.ws + WS_SH); const float* HSQ = (const float*)(p.ws + WS_SH + 512 * 1024);
    const float* SU = (const float*)(p.ws + WS_SU) + l * 16384; const float* SV = (const float*)(p.ws + WS_SV) + l * 16384;
    const unsigned char* U8 = p.ws + WS_U8 + (size_t)l * (32 * MiB); const unsigned char* V8 = p.ws + WS_V8 + (size_t)l * (32 * MiB);
    const __amdgpu_buffer_rsrc_t ru = __builtin_amdgcn_make_buffer_rsrc((void*)U8, 0, 16 << 20, 0x00020000), rv = __builtin_amdgcn_make_buffer_rsrc((void*)V8, 0, 32 << 20, 0x00020000);
    float* DELTA = (float*)(p.ws + WS_DELTA);
    const float* gmod = (const float*)(p.ws + WS_MOD) + ((size_t)l * 2 + (m0 >= T ? 1 : 0)) * D6 + 5 * D;
    unsigned off[33][2];
#pragma unroll
    for (int ui = 0; ui < 33; ++ui)
#pragma unroll
        for (int i = 0; i < 2; ++i) { const int mi = ui < 32 ? 4 * wave + (ui >> 3) : 32, hd = ui < 32 ? (ui & 7) : wave;
            off[ui][i] = (unsigned)idxL[mi * 128 + hd * 16 + 8 * i + g] * 128u + 16u * c; }
    int acc[33][2];
#pragma unroll
    for (int ui = 0; ui < 33; ++ui) { acc[ui][0] = 0; acc[ui][1] = 0; }
#pragma unroll 1
    for (int j = 0; j < 8; ++j) {
        const int so = j << 21;
        i32x4 w[2][4][2], hq[2];
#define U_LOAD(B, U0) do { _Pragma("unroll") for (int uu_ = 0; uu_ < 4; ++uu_) _Pragma("unroll") for (int i_ = 0; i_ < 2; ++i_) if ((U0) + uu_ < 33) \
            w[B][uu_][i_] = __builtin_bit_cast(i32x4, __builtin_amdgcn_raw_buffer_load_b128(ru, off[(U0) + uu_][i_], so, 0)); } while (0)
#define H_LOAD(U0) do { const int mi_ = (U0) < 32 ? 4 * wave + ((U0) >> 3) : 32; const unsigned char* hb_ = H8 + (size_t)(m0 + mi_) * D + j * 256 + 32 * c; hq[0] = *(const i32x4*)hb_; hq[1] = *(const i32x4*)(hb_ + 16); } while (0)
        H_LOAD(0); U_LOAD(0, 0);
#pragma unroll
        for (int u0 = 0; u0 < 36; u0 += 4) {
            const int B = (u0 >> 2) & 1;
            if (u0 + 4 < 36) { if (B) U_LOAD(0, u0 + 4); else U_LOAD(1, u0 + 4); }
#pragma unroll
            for (int uu = 0; uu < 4; ++uu)
#pragma unroll
                for (int i = 0; i < 2; ++i) if (u0 + uu < 33) { const int ui = u0 + uu;
                    int a = acc[ui][i];
#pragma unroll
                    for (int k = 0; k < 4; ++k) { const unsigned ww = (unsigned)w[B][uu][i][k]; const i32x4 hh = hq[k >> 1];
                        a = __builtin_amdgcn_sdot4((int)(ww & 0x0F0F0F0Fu), hh[2 * (k & 1)], a, false); a = __builtin_amdgcn_sdot4((int)((ww >> 4) & 0x0F0F0F0Fu), hh[2 * (k & 1) + 1], a, false); }
                    acc[ui][i] = a; }
            if (B && u0 + 4 < 36) H_LOAD(u0 + 4);
            __builtin_amdgcn_sched_barrier(0);
        }
#undef H_LOAD
#undef U_LOAD
    }
#pragma unroll
    for (int ui = 0; ui < 33; ++ui)
#pragma unroll
        for (int i = 0; i < 2; ++i) { const int mi = ui < 32 ? 4 * wave + (ui >> 3) : 32, hd = ui < 32 ? (ui & 7) : wave, k = hd * 16 + 8 * i + g;
            int t = acc[ui][i]; t += __shfl_xor(t, 1); t += __shfl_xor(t, 2); t += __shfl_xor(t, 4);
            if (c == 0) coefL[mi * 128 + k] = (float)t; }
    __syncthreads();
    {
        float su[9], sv[9], hs[9], sh[9];
#pragma unroll
        for (int k = 0; k < 9; ++k) { const int it = tid + 512 * k; const bool ok = it < 33 * 128; const int mi = ok ? (it >> 7) : 0, e = ok ? idxL[it] : 0;
            su[k] = SU[e]; sv[k] = SV[e]; hs[k] = HSQ[m0 + mi]; sh[k] = SH[m0 + mi]; }
        __builtin_amdgcn_sched_barrier(0);
#pragma unroll
        for (int k = 0; k < 9; ++k) { const int it = tid + 512 * k;
            if (it < 33 * 128) { const float pd = (coefL[it] - 8.f * hs[k]) * su[k] * sh[k];
                coefL[it] = gatL[it] * gelu_erf(pd) * sv[k]; } }
    }
    __syncthreads();
    LAS int* cfqL = (LAS int*)(lds + 50688);
    LAS int* cfq32L = (LAS int*)(lds + 54912);
    LAS float* sTL = (LAS float*)(lds + 55040);
#pragma unroll 1
    for (int tk = 0; tk < 5; ++tk) {
        if (tk == 4 && wave != 0) break;
        const int mi = tk < 4 ? 4 * wave + tk : 32;
        const float am = wave_max(fmaxf(fabsf(coefL[mi * 128 + lane]), fabsf(coefL[mi * 128 + 64 + lane])));
        const float inv = am > 0.f ? 127.f / am : 0.f;
        if (lane == 0) sTL[mi] = am > 0.f ? am * (1.f / 127.f) : 0.f;
        if (lane < 32) { const int hq = lane >> 4, i = (lane >> 3) & 1, g_ = lane & 7; unsigned pk = 0;
#pragma unroll
            for (int uu = 0; uu < 4; ++uu) { const int q = (int)rintf(coefL[mi * 128 + (4 * hq + uu) * 16 + 8 * i + g_] * inv); pk |= ((unsigned)q & 0xffu) << (8 * uu); }
            cfqL[mi * 32 + lane] = (int)pk;
            if (tk == 4) { const int qd = lane >> 3; unsigned p2 = 0;
#pragma unroll
                for (int r = 0; r < 4; ++r) { const int q = (int)rintf(coefL[32 * 128 + 32 * qd + 8 * r + g_] * inv); p2 |= ((unsigned)q & 0xffu) << (8 * r); }
                cfq32L[lane] = (int)p2; } }
    }
    __syncthreads();
    i32x4 w[2][4][2]; int cfq[2][2];
#define V_LOAD(B, HB, SO) do { const int ts_ = (HB) >> 1, hq_ = (HB) & 1, mi_ = 4 * wave + ts_; _Pragma("unroll") for (int uu_ = 0; uu_ < 4; ++uu_) _Pragma("unroll") for (int i_ = 0; i_ < 2; ++i_) \
            w[B][uu_][i_] = __builtin_bit_cast(i32x4, __builtin_amdgcn_raw_buffer_load_b128(rv, off[ts_ * 8 + 4 * hq_ + uu_][i_], (SO), 0)); \
        cfq[B][0] = cfqL[mi_ * 32 + (hq_ * 2 + 0) * 8 + g]; cfq[B][1] = cfqL[mi_ * 32 + (hq_ * 2 + 1) * 8 + g]; } while (0)
    V_LOAD(0, 0, 0);
#pragma unroll 1
    for (int j = 0; j < 16; ++j) {
        const int so = j << 21;
        int yi[16];
#pragma unroll
        for (int hb = 0; hb < 8; ++hb) {
            const int B = hb & 1, ts = hb >> 1, mi = 4 * wave + ts;
            if (hb + 1 < 8) { if (B) V_LOAD(0, hb + 1, so); else V_LOAD(1, hb + 1, so); }
            else if (j + 1 < 16) V_LOAD(0, 0, (j + 1) << 21);
            if (!B) {
#pragma unroll
                for (int q = 0; q < 16; ++q) yi[q] = 0; }
#pragma unroll
            for (int i = 0; i < 2; ++i) dot_rows4(yi, w[B][0][i], w[B][1][i], w[B][2][i], w[B][3][i], cfq[B][i]);
            if (B) {
                float y[16];
#pragma unroll
                for (int q = 0; q < 16; ++q) y[q] = (float)yi[q];
                reduce_scatter_g<16>(y);
                const float st = sTL[mi];
                float* dp = DELTA + (size_t)(m0 + mi) * D + j * 128 + 16 * c + ((lane & 16) ? 8 : 0) + ((lane & 32) ? 4 : 0) + ((lane & 8) ? 2 : 0);
                { const bool b3 = (lane & 8) != 0; *(float2*)dp = make_float2((b3 ? y[2] : y[0]) * st, (b3 ? y[3] : y[1]) * st); }
            }
            __builtin_amdgcn_sched_barrier(0);
        }
#undef V_LOAD
    }
    {
        const float st = sTL[32];
        const int m = m0 + 32;
#pragma unroll 1
        for (int jj = 0; jj < 2; ++jj) { const int j = 2 * wave + jj; const int so = j << 21;
            int yi[16];
#pragma unroll
            for (int q = 0; q < 16; ++q) yi[q] = 0;
#pragma unroll
            for (int k0 = 0; k0 < 16; k0 += 8) {
                i32x4 w8[8];
#pragma unroll
                for (int kk = 0; kk < 8; ++kk) w8[kk] = __builtin_bit_cast(i32x4, __builtin_amdgcn_raw_buffer_load_b128(rv, (unsigned)idxL[32 * 128 + 8 * (k0 + kk) + g] * 128u + 16u * c, so, 0));
                const int c0 = cfq32L[(k0 / 4) * 8 + g], c1 = cfq32L[(k0 / 4 + 1) * 8 + g];
                dot_rows4(yi, w8[0], w8[1], w8[2], w8[3], c0); dot_rows4(yi, w8[4], w8[5], w8[6], w8[7], c1);
                __builtin_amdgcn_sched_barrier(0);
            }
            float y[16];
#pragma unroll
            for (int q = 0; q < 16; ++q) y[q] = (float)yi[q];
            reduce_scatter_g<16>(y);
            float* dp = DELTA + (size_t)m * D + j * 128 + 16 * c + ((lane & 16) ? 8 : 0) + ((lane & 32) ? 4 : 0) + ((lane & 8) ? 2 : 0);
            { const bool b3 = (lane & 8) != 0; *(float2*)dp = make_float2((b3 ? y[2] : y[0]) * st, (b3 ? y[3] : y[1]) * st); }
        }
    }
    (void)gmod;
    {
        asm volatile("s_waitcnt vmcnt(0)" ::: "memory");
        __syncthreads();
#pragma unroll 1
        for (int mi = wave; mi < 33; mi += NWAVES) peer_tail_row(p, l, m0 + mi, lane);
    }
    (void)dry;
}

__device__ __forceinline__ Params load_params(const CAS Params* k) {
    Params r;
#define LP(f) r.f = k->f;
    LP(x) LP(c) LP(ctx) LP(c_ctx) LP(ada_w) LP(ada_b) LP(norm1_g) LP(norm2_g) LP(ab_w_in) LP(ab_gate_b) LP(ab_mh_g) LP(ab_sink) LP(ab_w_out)
    LP(na_w_in) LP(na_rpb) LP(na_w_out) LP(peer_wq) LP(peer_keys) LP(peer_u) LP(peer_v) LP(final_g) LP(out) LP(ws) LP(ph_lo) LP(ph_hi) LP(grid)
#undef LP
    return r;
}
__device__ __forceinline__ int lane_id_opaque() { int x; asm volatile("v_mbcnt_lo_u32_b32 %0, -1, 0\n\tv_mbcnt_hi_u32_b32 %0, -1, %0" : "=v"(x)); return x; }
constexpr int PH_PER_LAYER = 10, PH_FINAL = 1 + DEPTH * PH_PER_LAYER, N_PHASES = PH_FINAL + 1;
template <unsigned PH_MASK> __global__ void __launch_bounds__(NWAVES * 64, 2) fwd_kernel(Params p) {
    extern __shared__ __attribute__((aligned(16))) unsigned char lds_raw[];
    LAS unsigned char* lds = (LAS unsigned char*)lds_raw;
    const int wave = __builtin_amdgcn_readfirstlane((int)threadIdx.x >> 6);
#define LANE_ID() lane_id_opaque()
#define KQ() const CAS Params* kq_ = (const CAS Params*)__builtin_amdgcn_kernarg_segment_ptr(); asm volatile("" : "+s"(kq_))
    volatile LAS unsigned* MISC = (volatile LAS unsigned*)(lds + LDS_MISC);
    if (wave == 0) MISC[LANE_ID()] = 0u;
    __syncthreads();
    { KQ(); (void)xcd_barrier_post((unsigned*)(kq_->ws + WS_CTL) + 4096, MISC + 8, wave * 64 + LANE_ID()); }
#ifdef STAMP_PROBE
#define STAMP_PRE(k) const unsigned long long st0_ = wall_clock64()
#define STAMP_POST(k) do { if (wave * 64 + LANE_ID() == 0) { KQ(); unsigned* sp_ = (unsigned*)(kq_->ws + WS_END); const unsigned long long st1_ = wall_clock64(); \
        sp_[(k) * 256 + blockIdx.x] = (unsigned)(st1_ - st0_); sp_[(64 + (k)) * 256 + blockIdx.x] = (unsigned)st0_; sp_[(128 + (k)) * 256 + blockIdx.x] = (unsigned)st1_; } } while (0)
#else
#define STAMP_PRE(k) do {} while (0)
#define STAMP_POST(k) do {} while (0)
#endif
#define PM(k) (((PH_MASK) >> (k)) & 1u)
#ifndef REP_MASK
#define REP_MASK 0u
#endif
#define REPEAT(k) for (int rep_ = 0; rep_ <= (int)(((REP_MASK) >> (k)) & 1u); ++rep_)
#define IN(k) ({ KQ(); const int k_ = (k); (kq_->ph_lo <= k_ && k_ < kq_->ph_hi); })
#define SEAM(k) do { KQ(); const int k_ = (k); if (kq_->ph_lo <= k_ && k_ + 1 < kq_->ph_hi) { XcdBarrier b_; b_.bar = (unsigned*)(kq_->ws + WS_CTL) + 4096; b_.x = xb_xcc_id(); b_.st = MISC + 8; \
        STAMP_PRE(k_); xcd_barrier(b_, wave * 64 + LANE_ID()); STAMP_POST(k_); } } while (0)
#define LAUNDER() KQ(); const Params pl = load_params(kq_); unsigned char* ws = pl.ws; int ll = LANE_ID(); asm volatile("" : "+v"(ll)); const int tid = wave * 64 + ll; \
    const int G = pl.grid, bx = blockIdx.x, vcu = (G % 8 == 0) ? (bx % 8) * (G / 8) + bx / 8 : bx, gw = vcu * NWAVES + wave, NGW = G * NWAVES; (void)ws; (void)ll; (void)tid; (void)vcu; (void)gw; (void)NGW
    if (PM(0) && IN(0)) REPEAT(0) { LAUNDER(); ph_prologue(pl, lds, tid, ll, wave, vcu, G); __syncthreads(); }
    SEAM(0);
    for (int l = 0; l < DEPTH; ++l) {
        const int pb = 1 + l * PH_PER_LAYER; const bool even = (l & 1) == 0; const int ei = l >> 1; const bool with_ctx = l < DEPTH - 1;
        if (PM(1) && IN(pb + 0) && l == 0) REPEAT(1) { LAUNDER(); ph_norm(pl, l, 0, ll, gw, NGW); ph_fold_wq(pl, lds, ll, wave, gw, NGW); }
        if (l == 0) SEAM(pb + 0);
        if (PM(2) && IN(pb + 1)) REPEAT(2) {
            LAUNDER();
            if (l == 0) ph_fold_bias(pl, ll, gw, NGW);
            const int N = even ? NAB : NNA;
            pg8::Gemm g{(const bf16_t*)(ws + WS_H), even ? (const bf16_t*)(ws + WS_WAB_IN) + (size_t)ei * NAB * D : (const bf16_t*)(ws + WS_WNA_IN) + (size_t)ei * NNA * D, M, N, D};
            pg8::StaticOrder S; S.init(M, N, G, bx);
            EpiInProj E{EpiEven{ws + WS_PROJ, pl.ab_gate_b + ei * 32, (const float2*)(ws + WS_ROPE)}, EpiOdd{ws + WS_PROJ}, even};
            pg8::gemm_phase<EpiInProj, pg8::StaticOrder, false>(lds, g, S, E, nullptr, tid);
            peer_convert_deferred(pl, l, bx, G, wave, ll);
        }
        SEAM(pb + 1);
        if (PM(3) && IN(pb + 2)) REPEAT(3) {
            LAUNDER();
            if (even) { ph_attn_even(pl, ei, with_ctx, lds, tid, ll, wave, vcu, G);
                for (int q = gw; q < NCH * 16; q += NGW) mlstm_A_unit(pl, q >> 4, q & 15, ll); }
            else ph_attn_odd(pl, ei, with_ctx, lds, tid, ll, wave, vcu, G);
        }
        SEAM(pb + 2);
        if (PM(4) && IN(pb + 3)) REPEAT(4) { LAUNDER(); if (even) ph_mlstm_B(pl, lds, tid, G); }
        if (even) SEAM(pb + 3);
        if (PM(5) && IN(pb + 4)) REPEAT(5) { LAUNDER(); if (even) mlstm_C_wg(pl, ei, lds, tid, ll, wave, vcu, G); }
        if (even) SEAM(pb + 4);
        if (PM(6) && IN(pb + 5)) {
            LAUNDER();
            const float* MODl = (const float*)(ws + WS_MOD) + (size_t)l * 2 * D6;
            pg8::Gemm g{(const bf16_t*)(ws + WS_MIX), even ? (const bf16_t*)(ws + WS_WAB_OUT) + (size_t)ei * D * D : (const bf16_t*)(ws + WS_WNA_OUT) + (size_t)ei * D * D, T, D, D};
            pg8::StaticOrder S; S.init(T, D, G, bx);
            EpiResid E{(float*)(ws + WS_X), MODl + 2 * D, MODl + D6 + 2 * D, l == 0 ? pl.x : (const float*)(ws + WS_X), l == 0 ? pl.ctx : (const float*)(ws + WS_X) + (size_t)T * D,
                       ws + WS_XB, (float*)(ws + WS_PART), (float*)(ws + WS_PARTC)};
            pg8::gemm_phase<EpiResid, pg8::StaticOrder, false>(lds, g, S, E, nullptr, tid);
            if (with_ctx) ctx_gemm(g.A, g.Bt, D, E, wave, ll, vcu, G);
        }
        SEAM(pb + 5);
        if (PM(8) && IN(pb + 7)) REPEAT(8) {
            LAUNDER();
            pg8::Gemm g{(const bf16_t*)(ws + WS_XB), (const bf16_t*)(ws + WS_WQ) + (size_t)l * D * D, T, D, D};
            pg8::StaticOrder S; S.init(T, D, G, bx);
            EpiQ E{(bf16_t*)(ws + WS_QP), (const float*)(ws + WS_PART), (const float*)(ws + WS_BQ) + (size_t)(l * 2) * D};
            pg8::gemm_phase<EpiQ, pg8::StaticOrder, false>(lds, g, S, E, nullptr, tid);
            const int cpc = G - 1 - vcu;
            if (with_ctx && cpc < 128) { int l2 = ll; asm volatile("" : "+v"(l2)); EpiQC Ec{(bf16_t*)(ws + WS_QP), (const float*)(ws + WS_PARTC), (const float*)(ws + WS_BQ) + (size_t)(l * 2 + 1) * D};
                ctx_gemm_piece<EpiQC, 2>(g.A, (const bf16_t*)(ws + WS_WQC) + (size_t)l * D * D, Ec, cpc & 15, cpc >> 4, wave, l2); }
            asm volatile("s_waitcnt vmcnt(0)" ::: "memory");
            __syncthreads();
            { pg8::Unit u; const bool has = S.next(0, u);
#pragma unroll 1
              for (int j = 0; j < 3; ++j) {
                  const bool ok = j < 2 ? has : (with_ctx && cpc < 128 && wave == 0);
                  const int mt = j < 2 ? u.pm * 16 + 8 * j + wave : 512 + (cpc & 15), hh = j < 2 ? u.pn : (cpc >> 4);
                  if (ok) peer_topk_unit(pl, l, mt, hh, ll); } }
            { int l3 = ll; asm volatile("" : "+v"(l3));
              if (!with_ctx) h8_rows<33>(pl, l, vcu * 33, l3, wave); else if (vcu < 128) h8_rows<66>(pl, l, vcu * 66, l3, wave); }
        }
        SEAM(pb + 7);
        if (PM(10) && IN(pb + 9)) REPEAT(10) { LAUNDER(); ph_peer_gather(pl, l, lds, ll, wave, vcu, tid, rep_ < (int)(((REP_MASK) >> 10) & 1u)); }
        if (l + 1 < DEPTH) SEAM(pb + 9);
    }
#ifdef STAMP_PROBE
    {
        { KQ(); XcdBarrier b_; b_.bar = (unsigned*)(kq_->ws + WS_CTL) + 4096; b_.x = xb_xcc_id(); b_.st = MISC + 8; xcd_barrier(b_, wave * 64 + LANE_ID()); }
        LAUNDER();
        const unsigned* ST = (const unsigned*)(ws + WS_END);
        float smean = 0.f, smax = 0.f;
        for (int w = ll; w < 256; w += 64) { const float d = (float)(ST[(64 + STAMP_SEL) * 256 + w] - ST[(128 + STAMP_PREV) * 256 + w]) * 0.01f; smean += d; smax = fmaxf(smax, d); }
        smean = wave_sum(smean) * (1.f / 256.f); smax = wave_max(smax);
        const float c1 = smax * 0.05f, c2 = 0.f; (void)smean;
        for (size_t i = (size_t)bx * 512 + tid; i < (size_t)T * D; i += (size_t)G * 512) pl.out[i] = c1 + c2;
    }
#endif
#undef IN
#undef SEAM
#undef LAUNDER
#undef LANE_ID
#undef KQ
#undef PM
}

#ifndef ONE_MASK
#define ONE_MASK 0xFFFu
#endif
#ifndef MK_ONE_LAUNCH
#define MK_ONE_LAUNCH 1
#endif
typedef void (*kern_t)(Params);
#if !MK_ONE_LAUNCH
static kern_t kern_for_bit(int b) {
    switch (b) {
        case 0: return fwd_kernel<1u << 0>; case 1: return fwd_kernel<1u << 1>; case 2: return fwd_kernel<1u << 2>; case 3: return fwd_kernel<1u << 3>;
        case 4: return fwd_kernel<1u << 4>; case 5: return fwd_kernel<1u << 5>; case 6: return fwd_kernel<1u << 6>; case 7: return fwd_kernel<1u << 7>;
        case 8: return fwd_kernel<1u << 8>; case 9: return fwd_kernel<1u << 9>; case 10: return fwd_kernel<1u << 10>; default: return fwd_kernel<1u << 11>;
    }
}
#endif
extern "C" void kernel_launch(void* const* d_in, const int* in_sizes, int n_in, void* d_out, int out_size, void* d_ws, size_t ws_size, hipStream_t stream) {
    static int grid = 0;
    if (grid == 0) {
        int dev = 0, cus = 0;
        if (n_in != 21 || ws_size < WS_END) { fprintf(stderr, "kernel_launch: unexpected inputs (n_in %d, ws %zu)\n", n_in, ws_size); grid = -1; return; }
        if (hipGetDevice(&dev) != hipSuccess || hipDeviceGetAttribute(&cus, hipDeviceAttributeMultiprocessorCount, dev) != hipSuccess) { grid = -1; return; }
#if MK_ONE_LAUNCH
        if (hipFuncSetAttribute((const void*)fwd_kernel<ONE_MASK>, hipFuncAttributeMaxDynamicSharedMemorySize, LDS_BYTES) != hipSuccess) { fprintf(stderr, "kernel_launch: hipFuncSetAttribute failed\n"); grid = -1; return; }
#else
        for (int b = 0; b < 12; ++b) if (hipFuncSetAttribute((const void*)kern_for_bit(b), hipFuncAttributeMaxDynamicSharedMemorySize, LDS_BYTES) != hipSuccess) { fprintf(stderr, "kernel_launch: hipFuncSetAttribute failed\n"); grid = -1; return; }
#endif
        (void)hipGetLastError();
        grid = cus;
    }
    if (grid < 0) return;
    (void)hipMemsetAsync((char*)d_ws + WS_CTL, 0, CTL_ZERO_BYTES, stream);
#ifdef STAMP_PROBE
    (void)hipMemsetAsync((char*)d_ws + WS_END, 0, 192 * 256 * 4, stream);
#endif
    Params p{};
    const float** pin = (const float**)&p;
    for (int i = 0; i < 21; ++i) pin[i] = (const float*)d_in[i];
    p.out = (float*)d_out; p.ws = (unsigned char*)d_ws; p.grid = grid; p.pad = 0;
#if MK_ONE_LAUNCH
    p.ph_lo = 0; p.ph_hi = N_PHASES;
    hipLaunchKernelGGL(fwd_kernel<ONE_MASK>, dim3(grid), dim3(NWAVES * 64), LDS_BYTES, stream, p);
#else
    for (int ph = 0; ph < N_PHASES; ++ph) {
        int bit = 0;
        if (ph == PH_FINAL) bit = 11;
        else if (ph >= 1) { const int l = (ph - 1) / PH_PER_LAYER, k = (ph - 1) % PH_PER_LAYER; if ((l & 1) && (k == 3 || k == 4)) continue; bit = 1 + k; }
        p.ph_lo = ph; p.ph_hi = ph + 1;
        hipLaunchKernelGGL(kern_for_bit(bit), dim3(grid), dim3(NWAVES * 64), LDS_BYTES, stream, p);
    }
#endif
}
```

```cpp
#include <hip/hip_runtime.h>
#include <cstdio>
#include <cstdint>
namespace pg8 {
#define PG8_LAS __attribute__((address_space(3)))
typedef unsigned short bf16_t;
typedef short bf16x8 __attribute__((ext_vector_type(8)));
typedef float f32x4 __attribute__((ext_vector_type(4)));
typedef unsigned u32x4 __attribute__((ext_vector_type(4)));
constexpr int BM = 256, BK = 64, HALF = 128, HTB = HALF * BK * 2  , STAGE_BYTES = 8 * HTB, NXCD = 8, WGM = 8;

__host__ __device__ __forceinline__ int lds_byte(int r, int c) { const int st = (r >> 4) * 2 + (c >> 5), rr = r & 15, cc = c & 31, ob = rr * 64 + cc * 2; return st * 1024 + (ob ^ (((ob >> 9) & 1) << 5)); }
__host__ __device__ __forceinline__ void stage_rc(int b, int& R, int& C) { const int st = b / 1024, sb = b % 1024, swz = sb ^ (((sb >> 9) & 1) << 5); R = (st >> 1) * 16 + swz / 64; C = (st & 1) * 32 + (swz % 64) / 2; }
__host__ __device__ __forceinline__ int perm32(int rho) { const int n = rho >> 4, i = rho & 15; return 8 * (i >> 2) + 4 * n + (i & 3); }

struct Unit { int pm, pn; };
struct Gemm { const bf16_t* A; const bf16_t* Bt; int M, N, K; };

struct StaticOrder {
    int nM, nN, nwg, G, c;
    __host__ __device__ void init(int M, int N, int G_, int c_) { nM = M / BM; nN = N / BM; nwg = nM * nN; G = G_; c = c_; }
    __host__ __device__ __forceinline__ bool next(int i, Unit& u) const {
        const long L = (long)i * G + c; if (L >= nwg) return false;
        int wgid = (int)L; { const int q = nwg / NXCD, r = nwg % NXCD, xcd = wgid % NXCD, off = wgid / NXCD; wgid = (xcd < r ? xcd * (q + 1) : r * (q + 1) + (xcd - r) * q) + off; }
        const int nig = WGM * nN, gid = wgid / nig, fm = gid * WGM, gsz = (nM - fm) < WGM ? (nM - fm) : WGM;
        u.pm = fm + ((wgid % nig) % gsz); u.pn = (wgid % nig) / gsz; return true;
    }
    __device__ __forceinline__ void a_ready(const Unit&) const {}
    __device__ __forceinline__ void done(const Unit&) const {}
};
__device__ __forceinline__ unsigned cvt_pk_bf16(float lo, float hi) { unsigned r; asm volatile("s_nop 1\n\tv_cvt_pk_bf16_f32 %0, %1, %2\n\ts_nop 1" : "=v"(r) : "v"(lo), "v"(hi)); return r; }
template <class Epi, class Sched, bool STAMP = false>
__device__ __forceinline__ void gemm_phase(PG8_LAS unsigned char* lds, const Gemm g, const Sched& S, const Epi& E, unsigned long long* stamps, int tid_in) {
    int tid_l = tid_in; asm volatile("" : "+v"(tid_l));
    const int tid = tid_l, wid = __builtin_amdgcn_readfirstlane(tid >> 6), lane = tid & 63, wr = wid >> 2, wc = wid & 3, fr = lane & 15, fq = lane >> 4;
    const int K = g.K, nt = K / BK;
    int ts_lo = 0, ts_hi = 0, nts = 0; const unsigned long long rt_entry = STAMP ? (unsigned long long)wall_clock64() : 0ull;
#define PG8_STAMP() do { if (STAMP && wid == 0 && nts < 64) { const unsigned long long _c = (unsigned long long)clock64(); \
        ts_lo = (lane == nts) ? (int)(unsigned)_c : ts_lo; ts_hi = (lane == nts) ? (int)(unsigned)(_c >> 32) : ts_hi; ++nts; } } while (0)
    PG8_STAMP();
    unsigned voffA[2], voffB[2];
#pragma unroll
    for (int i = 0; i < 2; ++i) { int R, C; stage_rc(tid * 16 + i * 8192, R, C); const int Rb = Epi::PERM ? ((R & ~31) + perm32(R & 31)) : R;
        voffA[i] = (unsigned)(R * K + C) * 2u; voffB[i] = (unsigned)(Rb * K + C) * 2u; }
    const size_t kstep = (size_t)(BK * 2);
    const size_t hstep = (size_t)HALF * K * 2;
    const size_t tstep = 2 * hstep;
    const unsigned ldsw = (unsigned)wid * 1024u;
    const int aoff = lds_byte(wr * 64 + fr, fq * 8), boff = lds_byte(wc * 32 + fr, fq * 8);
#define PG8_SA(b, h) (((b) * 2 + (h)) * HTB)
#define PG8_SB(b, h) ((4 + (b) * 2 + (h)) * HTB)
#define PG8_STAGE(bufoff, gbase, voff) do { _Pragma("unroll") for (int _i = 0; _i < 2; ++_i) \
        __builtin_amdgcn_global_load_lds((const unsigned*)((const char*)(gbase) + (voff)[_i]), (PG8_LAS unsigned*)(lds + (bufoff) + ldsw + _i * 8192), 16, 0, 0); } while (0)
#define PG8_LDA(dst, b, h) do { _Pragma("unroll") for (int m = 0; m < 4; ++m) _Pragma("unroll") for (int k = 0; k < 2; ++k) dst[m][k] = *(const PG8_LAS bf16x8*)(lds + PG8_SA(b, h) + aoff + m * 2048 + k * 1024); } while (0)
#define PG8_LDB(dst, b, h) do { _Pragma("unroll") for (int n = 0; n < 2; ++n) _Pragma("unroll") for (int k = 0; k < 2; ++k) dst[n][k] = *(const PG8_LAS bf16x8*)(lds + PG8_SB(b, h) + boff + n * 2048 + k * 1024); } while (0)
#define PG8_MMA(ai, bj, At, Bt) do { __builtin_amdgcn_s_setprio(1); _Pragma("unroll") for (int m = 0; m < 4; ++m) _Pragma("unroll") for (int n = 0; n < 2; ++n) _Pragma("unroll") for (int k = 0; k < 2; ++k) \
        acc[ai][bj][m][n] = __builtin_amdgcn_mfma_f32_16x16x32_bf16(Bt[n][k], At[m][k], acc[ai][bj][m][n], 0, 0, 0); __builtin_amdgcn_s_setprio(0); } while (0)
#define PG8_WAIT_V(n) asm volatile("s_waitcnt vmcnt(" #n ")" ::: "memory")
#define PG8_WAIT_L(n) asm volatile("s_waitcnt lgkmcnt(" #n ")" ::: "memory")
#define PG8_BAR __builtin_amdgcn_s_barrier()
#define PG8_SCHED __builtin_amdgcn_sched_barrier(0)
    Unit cur, nxt; int ui = 0;
    if (!S.next(0, cur)) return;
    f32x4 acc[2][2][4][2];
#pragma unroll
    for (int a = 0; a < 2; ++a)
#pragma unroll
        for (int b = 0; b < 2; ++b)
#pragma unroll
            for (int m = 0; m < 4; ++m)
#pragma unroll
                for (int n = 0; n < 2; ++n) acc[a][b][m][n] = (f32x4){0.f, 0.f, 0.f, 0.f};
    bf16x8 At[4][2], B0[2][2], B1[2][2];
    const char* cA = (const char*)g.A + (size_t)cur.pm * tstep; const char* cB = (const char*)g.Bt + (size_t)cur.pn * tstep;
    S.a_ready(cur);
    PG8_STAGE(PG8_SB(0, 0), cB, voffB); PG8_STAGE(PG8_SA(0, 0), cA, voffA); PG8_STAGE(PG8_SB(0, 1), cB + hstep, voffB); PG8_STAGE(PG8_SA(0, 1), cA + hstep, voffA);
    if (wr == 1) PG8_BAR;
    PG8_WAIT_V(4); PG8_BAR;
    PG8_STAGE(PG8_SB(1, 0), cB + kstep, voffB); PG8_STAGE(PG8_SA(1, 0), cA + kstep, voffA); PG8_STAGE(PG8_SB(1, 1), cB + hstep + kstep, voffB);
    PG8_WAIT_V(6); PG8_BAR;
    PG8_STAMP();
    for (;;) {
        const bool has_next = S.next(ui + 1, nxt);
        const char* nA = has_next ? (const char*)g.A + (size_t)nxt.pm * tstep : cA; const char* nB = has_next ? (const char*)g.Bt + (size_t)nxt.pn * tstep : cB;
        for (int t = 0; t < nt; t += 2) {
            const bool last = (t == nt - 2);
            const char* a1 = cA + (size_t)(t + 1) * kstep;
            const char* a2 = last ? nA : cA + (size_t)(t + 2) * kstep; const char* b2 = last ? nB : cB + (size_t)(t + 2) * kstep;
            const char* a3 = a2 + kstep; const char* b3 = b2 + kstep;
            if (last && has_next) S.a_ready(nxt);
            PG8_LDB(B0, 0, 0); PG8_SCHED; PG8_LDA(At, 0, 0); PG8_STAGE(PG8_SA(1, 1), a1 + hstep, voffA);
            PG8_WAIT_L(8); PG8_BAR; PG8_WAIT_L(0); PG8_MMA(0, 0, At, B0); PG8_BAR; PG8_SCHED;
            PG8_LDB(B1, 0, 1); PG8_STAGE(PG8_SB(0, 0), b2, voffB);
            PG8_BAR; PG8_WAIT_L(0); PG8_MMA(0, 1, At, B1); PG8_BAR;
            PG8_LDA(At, 0, 1); PG8_STAGE(PG8_SA(0, 0), a2, voffA);
            PG8_BAR; PG8_WAIT_L(0); PG8_MMA(1, 0, At, B0); PG8_BAR; PG8_SCHED;
            PG8_STAGE(PG8_SB(0, 1), b2 + hstep, voffB);
            PG8_WAIT_V(6); PG8_BAR; PG8_MMA(1, 1, At, B1); PG8_BAR;
            PG8_LDB(B0, 1, 0); PG8_SCHED; PG8_LDA(At, 1, 0); PG8_STAGE(PG8_SA(0, 1), a2 + hstep, voffA);
            PG8_WAIT_L(8); PG8_BAR; PG8_WAIT_L(0); PG8_MMA(0, 0, At, B0); PG8_BAR; PG8_SCHED;
            PG8_LDB(B1, 1, 1); PG8_STAGE(PG8_SB(1, 0), b3, voffB);
            PG8_BAR; PG8_WAIT_L(0); PG8_MMA(0, 1, At, B1); PG8_BAR;
            PG8_LDA(At, 1, 1); PG8_STAGE(PG8_SA(1, 0), a3, voffA);
            PG8_BAR; PG8_WAIT_L(0); PG8_MMA(1, 0, At, B0); PG8_BAR; PG8_SCHED;
            PG8_STAGE(PG8_SB(1, 1), b3 + hstep, voffB);
            PG8_WAIT_V(6); PG8_BAR; PG8_MMA(1, 1, At, B1); PG8_BAR;
        }
        PG8_STAMP();
        if constexpr (!Epi::AFTER_DRAIN) { E(acc, cur, wr, wc, fr, fq); S.done(cur); }
        PG8_STAMP();
        if (!has_next) break;
#pragma unroll
        for (int a = 0; a < 2; ++a)
#pragma unroll
            for (int b = 0; b < 2; ++b)
#pragma unroll
                for (int m = 0; m < 4; ++m)
#pragma unroll
                    for (int n = 0; n < 2; ++n) acc[a][b][m][n] = (f32x4){0.f, 0.f, 0.f, 0.f};
        cur = nxt; cA = nA; cB = nB; ++ui;
    }
    PG8_WAIT_V(0);
    if (wr == 0) PG8_BAR;
    PG8_BAR;
    if constexpr (Epi::AFTER_DRAIN) { E.fused(acc, cur, wr, wc, fr, fq, lds, wid, lane); S.done(cur); }
    PG8_STAMP();
    if (STAMP && wid == 0) { stamps[lane] = lane < nts ? (((unsigned long long)(unsigned)ts_hi << 32) | (unsigned)ts_lo) : 0ull;
        if (lane == 62) stamps[62] = rt_entry; if (lane == 63) stamps[63] = (unsigned long long)wall_clock64(); }
#undef PG8_STAMP
#undef PG8_SA
#undef PG8_SB
#undef PG8_STAGE
#undef PG8_LDA
#undef PG8_LDB
#undef PG8_MMA
#undef PG8_WAIT_V
#undef PG8_WAIT_L
#undef PG8_BAR
#undef PG8_SCHED
}
}

constexpr int D = 2048, T = 8192, LC = 256, M = T + LC, DEPTH = 4, D6 = 6 * D;
constexpr int NAB = 4864, NNA = 6144;
constexpr int NCH = M / 64;
constexpr float EPS = 1e-6f, LOG2E = 1.4426950408889634f;
constexpr int NWAVES = 8;

constexpr size_t MiB = 1u << 20;
constexpr size_t WS_CTL = 0, CTL_ZERO_BYTES = 32768;
constexpr size_t WS_MOD = 1 * MiB;
constexpr size_t WS_ROPE = 2 * MiB;
constexpr size_t WS_KEYS = 3 * MiB;
constexpr size_t WS_WAB_IN = 8 * MiB;
constexpr size_t WS_WAB_OUT = 46 * MiB;
constexpr size_t WS_WNA_IN = 62 * MiB;
constexpr size_t WS_WNA_OUT = 110 * MiB;
constexpr size_t WS_WQ = 126 * MiB;
constexpr size_t WS_X = 160 * MiB;
constexpr size_t WS_H = 226 * MiB;
constexpr size_t WS_PROJ = 260 * MiB;
constexpr size_t WS_MIX = 360 * MiB;
constexpr size_t WS_QP = 394 * MiB;
constexpr size_t WS_IDX = 428 * MiB;
constexpr size_t WS_GATE = 433 * MiB;
constexpr size_t WS_U = 440 * MiB;
constexpr size_t WS_SNAP = 516 * MiB;
constexpr size_t WS_CHS = 554 * MiB;
constexpr size_t WS_GF = 555 * MiB;
constexpr size_t WS_H8 = 564 * MiB;
constexpr size_t WS_SH = 581 * MiB;
constexpr size_t WS_SU = 582 * MiB;
constexpr size_t WS_SV = 583 * MiB;
constexpr size_t WS_U8 = 584 * MiB;
constexpr size_t WS_V8 = 712 * MiB;
constexpr size_t WS_WQC = 842 * MiB;
constexpr size_t WS_BQ = 866 * MiB;
constexpr size_t WS_XB = 868 * MiB;
constexpr size_t WS_PART = 902 * MiB;
constexpr size_t WS_PARTC = 903 * MiB;
constexpr size_t WS_PARTB = 904 * MiB;
constexpr size_t WS_DELTA = 906 * MiB;
constexpr size_t WS_END = 972 * MiB;
constexpr size_t PJ_Q = 0, PJ_K = 33 * MiB, PJ_VT = 66 * MiB;
constexpr size_t PJ_AQ = 0, PJ_AK = 9 * MiB, PJ_AKT = 18 * MiB, PJ_AVT = 27 * MiB, PJ_AO = 44 * MiB,
                 PJ_BQ = 61 * MiB, PJ_BK = 78 * MiB, PJ_BVT = 83 * MiB, PJ_G = 88 * MiB;
constexpr int LDS_BYTES = 147456;
constexpr int LDS_MISC = 131072;

#define LAS __attribute__((address_space(3)))
#define CAS __attribute__((address_space(4)))
typedef unsigned short bf16_t;
typedef short bf16x8 __attribute__((ext_vector_type(8)));
typedef float f32x4 __attribute__((ext_vector_type(4)));
typedef unsigned u32x4 __attribute__((ext_vector_type(4)));
typedef unsigned u32x2 __attribute__((ext_vector_type(2)));

struct Params {
    const float *x, *c, *ctx, *c_ctx, *ada_w, *ada_b, *norm1_g, *norm2_g, *ab_w_in, *ab_gate_b, *ab_mh_g, *ab_sink, *ab_w_out,
                *na_w_in, *na_rpb, *na_w_out, *peer_wq, *peer_keys, *peer_u, *peer_v, *final_g;
    float* out; unsigned char* ws; int ph_lo, ph_hi, grid, pad;
};

__device__ __forceinline__ float bf_lo(unsigned w) { return __uint_as_float(w << 16); }
__device__ __forceinline__ float bf_hi(unsigned w) { return __uint_as_float(w & 0xffff0000u); }
__device__ __forceinline__ unsigned pk2(float lo, float hi) { return pg8::cvt_pk_bf16(lo, hi); }
__device__ __forceinline__ float wave_sum(float v) {
#pragma unroll
    for (int o = 1; o < 64; o <<= 1) v += __shfl_xor(v, o);
    return v;
}
__device__ __forceinline__ float wave_max(float v) {
#pragma unroll
    for (int o = 1; o < 64; o <<= 1) v = fmaxf(v, __shfl_xor(v, o));
    return v;
}
__device__ __forceinline__ float scan_add(float x, int lane, int suffix) {
#pragma unroll
    for (int off = 1; off < 64; off <<= 1) {
        const float up = __shfl_up(x, off), dn = __shfl_down(x, off);
        const bool ok = suffix ? (lane + off < 64) : (lane >= off);
        x = ok ? x + (suffix ? dn : up) : x;
    }
    return x;
}
__device__ __forceinline__ float scan_max(float x, int lane, int suffix) {
#pragma unroll
    for (int off = 1; off < 64; off <<= 1) {
        const float up = __shfl_up(x, off), dn = __shfl_down(x, off);
        const bool ok = suffix ? (lane + off < 64) : (lane >= off);
        x = ok ? fmaxf(x, suffix ? dn : up) : x;
    }
    return x;
}
__device__ __forceinline__ float fq_max(float v) { v = fmaxf(v, __shfl_xor(v, 16)); return fmaxf(v, __shfl_xor(v, 32)); }
__device__ __forceinline__ float fq_sum(float v) { v += __shfl_xor(v, 16); return v + __shfl_xor(v, 32); }
__device__ __forceinline__ float log_sigmoid(float x) { return fminf(x, 0.f) - log1pf(expf(-fabsf(x))); }
__device__ __forceinline__ bf16x8 mk_frag(u32x4 w) { return __builtin_bit_cast(bf16x8, w); }
#define MFMA16(a, b, c) __builtin_amdgcn_mfma_f32_16x16x32_bf16((a), (b), (c), 0, 0, 0)

#define XB_TMO      128
#define XB_XCNT(j)  (256  + 64 * (j))
#define XB_XSUB(j)  (1280 + 64 * (j))
#define XB_XGEN(j)  (2304 + 64 * (j))
#define XB_TOP      3328
#define XB_TOPGEN   3392
#define XCD_BAR_WORDS 3456
#define XB_SPIN_CAP (1u << 22)
__device__ __forceinline__ unsigned xb_ld(unsigned* p)              { return __hip_atomic_load(p, __ATOMIC_RELAXED, __HIP_MEMORY_SCOPE_AGENT); }
__device__ __forceinline__ unsigned xb_add(unsigned* p, unsigned v) { return __hip_atomic_fetch_add(p, v, __ATOMIC_RELAXED, __HIP_MEMORY_SCOPE_AGENT); }
__device__ __forceinline__ unsigned xb_xcc_id() { return (unsigned)__builtin_amdgcn_s_getreg((3 << 11) | 20) & 0xFu; }
#define XB_SPIN(cond, bar) do { unsigned _sp = 0; while (cond) { __builtin_amdgcn_s_sleep(1); \
    if ((++_sp & 255u) == 0u) { if (xb_ld(&(bar)[XB_TMO])) break; if (_sp > XB_SPIN_CAP) { atomicAdd(&(bar)[XB_TMO], 1u); break; } } } } while (0)
struct XcdBarrier { unsigned* bar; unsigned x; volatile LAS unsigned* st; };
__device__ __forceinline__ XcdBarrier xcd_barrier_post(unsigned* bar, volatile LAS unsigned* st, int tid) {
    XcdBarrier b; b.bar = bar; b.x = xb_xcc_id(); b.st = st;
    if (tid == 0) (void)xb_add(&bar[XB_XCNT(b.x)], 1u);
    return b;
}
__device__ __forceinline__ void xcd_barrier_complete(unsigned* bar, unsigned x, unsigned& nloc, unsigned& nx) {
    const unsigned G = gridDim.x * gridDim.y * gridDim.z;
    unsigned sum, cnt, mine, sp = 0u;
    for (;;) {
        sum = 0u; cnt = 0u; mine = 0u;
#pragma unroll
        for (unsigned j = 0; j < 16; ++j) { const unsigned c = xb_ld(&bar[XB_XCNT(j)]); sum += c; cnt += (c > 0u) ? 1u : 0u; mine = (j == x) ? c : mine; }
        if (sum == G) break;
        __builtin_amdgcn_s_sleep(1);
        if ((++sp & 255u) == 0u) { if (xb_ld(&bar[XB_TMO])) break; if (sp > XB_SPIN_CAP) { atomicAdd(&bar[XB_TMO], 1u); break; } }
    }
    nloc = mine > 0u ? mine : 1u; nx = cnt > 0u ? cnt : 1u;
}
__device__ __forceinline__ void xcd_barrier(const XcdBarrier& b, int tid) {
    asm volatile("s_waitcnt vmcnt(0)" ::: "memory");
    __syncthreads();
    if (tid == 0) {
        unsigned* bar = b.bar;
        __builtin_amdgcn_s_waitcnt(0);
        unsigned nloc = b.st[0], nx = b.st[1];
        if (nloc == 0u) { xcd_barrier_complete(bar, b.x, nloc, nx); b.st[0] = nloc; b.st[1] = nx; }
        const unsigned old = xb_add(&bar[XB_XSUB(b.x)], 1u);
        const unsigned gen = old / nloc;
        if (old + 1u == (gen + 1u) * nloc) {
            __builtin_amdgcn_fence(__ATOMIC_RELEASE, "agent");
            asm volatile("s_waitcnt vmcnt(0)" ::: "memory");
            const unsigned og = xb_add(&bar[XB_TOP], 1u);
            const unsigned tg = og / nx;
            if (og + 1u == (tg + 1u) * nx) xb_add(&bar[XB_TOPGEN], 1u);
            else XB_SPIN(xb_ld(&bar[XB_TOPGEN]) == tg, bar);
            __builtin_amdgcn_fence(__ATOMIC_ACQUIRE, "agent");
            xb_add(&bar[XB_XGEN(b.x)], 1u);
            asm volatile("s_waitcnt vmcnt(0)" ::: "memory");
        } else {
            XB_SPIN(xb_ld(&bar[XB_XGEN(b.x)]) == gen, bar);
            __builtin_amdgcn_fence(__ATOMIC_ACQUIRE, "agent");
            asm volatile("s_waitcnt vmcnt(0)" ::: "memory");
        }
    }
    __syncthreads();
}

__device__ __forceinline__ void peer_convert_row(const Params& p, int l, int q, int lane) {
    const int tb = q >> 14, e = q & 16383;
    const f32x4* src = (const f32x4*)((tb ? p.peer_v : p.peer_u) + ((size_t)l * 16384 + e) * D) + lane;
    f32x4 v[8]; float am = 0.f;
#pragma unroll
    for (int j = 0; j < 8; ++j) { v[j] = src[64 * j]; am = fmaxf(am, fmaxf(fmaxf(fabsf(v[j].x), fabsf(v[j].y)), fmaxf(fabsf(v[j].z), fabsf(v[j].w)))); }
    am = wave_max(am);
    const float sc = am > 0.f ? am * (1.f / 127.f) : 1.f, inv = am > 0.f ? 127.f / am : 0.f;
    if (lane == 0) ((float*)(p.ws + (tb ? WS_SV : WS_SU)))[l * 16384 + e] = sc;
    unsigned char* dst = p.ws + (tb ? WS_V8 : WS_U8) + (size_t)l * (32 * MiB) + (size_t)e * 128 + 4 * (lane & 31);
    const unsigned flip = tb ? 0x80808080u : 0u;
#pragma unroll
    for (int j = 0; j < 8; ++j) {
        const int q0 = (int)rintf(v[j].x * inv), q1 = (int)rintf(v[j].y * inv), q2 = (int)rintf(v[j].z * inv), q3 = (int)rintf(v[j].w * inv);
        const unsigned w = ((unsigned)q0 & 0xffu) | (((unsigned)q1 & 0xffu) << 8) | (((unsigned)q2 & 0xffu) << 16) | (((unsigned)q3 & 0xffu) << 24);
        *(unsigned*)(dst + (size_t)(2 * j + (lane >> 5)) * (2 * MiB)) = w ^ flip;
    }
}
__device__ __forceinline__ const f32x4* peer_row_src(const Params& p, int l, int q, int lane) { return (const f32x4*)(((q >> 14) ? p.peer_v : p.peer_u) + ((size_t)l * 16384 + (q & 16383)) * D) + lane; }
__device__ __forceinline__ void peer_convert_rows(const Params& p, int l, int q0, int q1, int qs, int lane) {
    if (q0 >= q1) return;
    f32x4 nx[8];
    { const f32x4* src = peer_row_src(p, l, q0, lane);
#pragma unroll
      for (int j = 0; j < 8; ++j) nx[j] = __builtin_nontemporal_load(src + 64 * j); }
#pragma unroll 1
    for (int q = q0; q < q1; q += qs) {
        const int tb = q >> 14, e = q & 16383;
        f32x4 v[8]; float am = 0.f;
#pragma unroll
        for (int j = 0; j < 8; ++j) { v[j] = nx[j]; am = fmaxf(am, fmaxf(fmaxf(fabsf(v[j].x), fabsf(v[j].y)), fmaxf(fabsf(v[j].z), fabsf(v[j].w)))); }
        if (q + qs < q1) { const f32x4* src = peer_row_src(p, l, q + qs, lane);
#pragma unroll
            for (int j = 0; j < 8; ++j) nx[j] = __builtin_nontemporal_load(src + 64 * j); }
        am = wave_max(am);
        const float qm = tb ? 127.f : 7.f;
        const float sc = am > 0.f ? am / qm : 1.f, inv = am > 0.f ? qm / am : 0.f;
        if (lane == 0) ((float*)(p.ws + (tb ? WS_SV : WS_SU)))[l * 16384 + e] = sc;
        if (tb) {
            unsigned char* dst = p.ws + WS_V8 + (size_t)l * (32 * MiB) + (size_t)e * 128 + 4 * (lane & 31);
#pragma unroll
            for (int j = 0; j < 8; ++j) {
                const int q0_ = (int)rintf(v[j].x * inv), q1_ = (int)rintf(v[j].y * inv), q2_ = (int)rintf(v[j].z * inv), q3_ = (int)rintf(v[j].w * inv);
                const unsigned w = ((unsigned)q0_ & 0xffu) | (((unsigned)q1_ & 0xffu) << 8) | (((unsigned)q2_ & 0xffu) << 16) | (((unsigned)q3_ & 0xffu) << 24);
                *(unsigned*)(dst + (size_t)(2 * j + (lane >> 5)) * (2 * MiB)) = w;
            }
        } else {
            unsigned char* dst = p.ws + WS_U8 + (size_t)l * (32 * MiB) + (size_t)e * 128 + 4 * (lane >> 1);
#pragma unroll
            for (int j = 0; j < 8; ++j) {
                const int q0_ = (int)rintf(v[j].x * inv) + 8, q1_ = (int)rintf(v[j].y * inv) + 8, q2_ = (int)rintf(v[j].z * inv) + 8, q3_ = (int)rintf(v[j].w * inv) + 8;
                const unsigned w = (unsigned)q0_ | ((unsigned)q1_ << 8) | ((unsigned)q2_ << 16) | ((unsigned)q3_ << 24);
                const unsigned hi = (unsigned)__shfl_xor((int)w, 1);
                if (!(lane & 1)) *(unsigned*)(dst + (size_t)j * (2 * MiB)) = w | (hi << 4);
            }
        }
    }
}
constexpr int DEFQ_EVEN = 128, DEFQ_ODD = 96, IDLE_EVEN = 256 - (33 * 19) % 256, IDLE_ODD = 256 - (33 * 24) % 256;
__device__ __forceinline__ int peer_deferred_rows(int l, int G) { return (l == 0 || G != 256) ? 0 : (((l - 1) & 1) ? IDLE_ODD * DEFQ_ODD : IDLE_EVEN * DEFQ_EVEN); }
__device__ __forceinline__ void peer_convert_deferred(const Params& p, int l  , int bx, int G, int wave, int lane) {
    if (l + 1 >= DEPTH || G != 256) return;
    const int idle = (l & 1) ? IDLE_ODD : IDLE_EVEN, dq = (l & 1) ? DEFQ_ODD : DEFQ_EVEN, j = bx - (256 - idle);
    if (j < 0) return;
    peer_convert_rows(p, l + 1, j * dq + wave, (j + 1) * dq, NWAVES, lane);
}
struct ScaleOne { __device__ __forceinline__ float operator()(int) const { return 1.f; } };
template <class MapF, class ScaleF = ScaleOne>
__device__ __forceinline__ void transpose_item(const float* W, int Nsrc, int K, bf16_t* WT, int nblk, LAS float* scr, int item, int lane, MapF map, ScaleF ksc = ScaleF()) {
    const int kb = item / nblk, nb = item % nblk, k0 = 64 * kb, n0 = 32 * nb;
    const int sc = map(n0 + (lane & 31));
    float w[32];
#pragma unroll
    for (int i = 0; i < 32; ++i) w[i] = sc >= 0 ? __builtin_nontemporal_load(W + (size_t)(k0 + 2 * i + (lane >> 5)) * Nsrc + sc) : 0.f;
#pragma unroll
    for (int i = 0; i < 32; ++i) { const int kk = 2 * i + (lane >> 5); scr[kk * 33 + (lane & 31)] = w[i] * ksc(k0 + kk); }
    asm volatile("s_waitcnt lgkmcnt(0)" ::: "memory");
    const int c = lane & 7;
    float tt[4][8];
#pragma unroll
    for (int j = 0; j < 4; ++j) { const LAS float* s = scr + (8 * c) * 33 + (lane >> 3) + 8 * j;
#pragma unroll
        for (int r = 0; r < 8; ++r) tt[j][r] = s[r * 33]; }
    __builtin_amdgcn_sched_barrier(0);
#pragma unroll
    for (int j = 0; j < 4; ++j) { const int n = (lane >> 3) + 8 * j;
        u32x4 o; o.x = pk2(tt[j][0], tt[j][1]); o.y = pk2(tt[j][2], tt[j][3]); o.z = pk2(tt[j][4], tt[j][5]); o.w = pk2(tt[j][6], tt[j][7]);
        *(u32x4*)(WT + (size_t)(n0 + n) * K + k0 + 8 * c) = o; }
    asm volatile("s_waitcnt lgkmcnt(0)" ::: "memory");
}
struct MapId { __device__ __forceinline__ int operator()(int n) const { return n; } };
struct MapAB {
    __device__ __forceinline__ int operator()(int n) const {
        if (n < 3072) return n;
        if (n < 4352) { const int base_d = n < 4096 ? 3072 : 4096, base_s = n < 4096 ? 3104 : 4128; const int r = n - base_d, hh = r >> 7, pp = r & 127;
            const int i = 64 * (pp >> 6) + ((pp & 63) >> 1) + 32 * (pp & 1); return base_s + hh * 128 + i; }
        if (n < 4608) return 4384 + (n - 4352);
        if (n < 4640) return 3072 + (n - 4608);
        return -1;
    }
};
__device__ __forceinline__ float silu(float v) { return v / (1.f + expf(-v)); }
struct __attribute__((packed, aligned(4))) F3 { float a, b, c; };

__device__ __forceinline__ void ph_prologue(const Params& p, LAS unsigned char* lds, int tid, int lane, int wave, int vcu, int G) {
    const int gw = vcu * NWAVES + wave, NGW = G * NWAVES;
    const size_t gtid = (size_t)vcu * 512 + tid, gn = (size_t)G * 512;
    {
        const float2* ks = (const float2*)p.peer_keys; unsigned* kd = (unsigned*)(p.ws + WS_KEYS);
        for (size_t i = gtid; i < (size_t)4 * 8 * 2 * 128 * 128 / 2; i += gn) { const float2 v = ks[i]; kd[i] = pk2(v.x, v.y); }
    }
    {
        float2* rt = (float2*)(p.ws + WS_ROPE);
        for (size_t i = gtid; i < 128 * 32; i += gn) { const int pos = (int)(i >> 5), j = (int)(i & 31);
            const float freq = powf(10000.f, -(float)j / 32.f), ang = (float)pos * freq; rt[i] = make_float2(cosf(ang), sinf(ang)); }
    }
    {
        LAS float* sv = (LAS float*)lds;
        LAS float* red = (LAS float*)(lds + 16384);
        for (int i = tid; i < 2048; i += 512) { sv[i] = silu(p.c[i]); sv[2048 + i] = silu(p.c_ctx[i]); }
        __syncthreads();
        float* MOD = (float*)(p.ws + WS_MOD);
        for (int u = vcu; u < 4 * 64; u += G) {
            const int l = u >> 6, n0 = (u & 63) * 192;
            const float* wp = p.ada_w + ((size_t)l * 2048 + wave * 256) * D6 + n0 + 3 * lane;
            float a0x = 0.f, a0y = 0.f, a0z = 0.f, a1x = 0.f, a1y = 0.f, a1z = 0.f;
#pragma unroll 1
            for (int k = 0; k < 256; k += 16) {
                F3 wv[16];
#pragma unroll
                for (int j = 0; j < 16; ++j) wv[j] = *(const F3*)(wp + (size_t)(k + j) * D6);
#pragma unroll
                for (int j = 0; j < 16; ++j) { const float s0 = sv[wave * 256 + k + j], s1 = sv[2048 + wave * 256 + k + j];
                    a0x += s0 * wv[j].a; a0y += s0 * wv[j].b; a0z += s0 * wv[j].c; a1x += s1 * wv[j].a; a1y += s1 * wv[j].b; a1z += s1 * wv[j].c; }
            }
            { LAS float* r0 = red + (wave * 2 + 0) * 192 + 3 * lane; LAS float* r1 = red + (wave * 2 + 1) * 192 + 3 * lane;
              r0[0] = a0x; r0[1] = a0y; r0[2] = a0z; r1[0] = a1x; r1[1] = a1y; r1[2] = a1z; }
            __syncthreads();
            if (tid < 384) { const int which = tid >= 192 ? 1 : 0, col = tid - 192 * which; float s = 0.f;
#pragma unroll
                for (int w = 0; w < 8; ++w) s += red[(w * 2 + which) * 192 + col];
                MOD[((size_t)l * 2 + which) * D6 + n0 + col] = s + p.ada_b[(size_t)l * D6 + n0 + col]; }
            __syncthreads();
        }
    }
    {
        LAS float* scr = (LAS float*)(lds + wave * 16384);
        constexpr int I_ABI = 32 * (NAB / 32), I_SQ = 32 * (D / 32), I_NAI = 32 * (NNA / 32);
        constexpr int NITEMS = 2 * I_ABI + 2 * I_SQ + 2 * I_NAI + 2 * I_SQ;
        for (int it = gw; it < NITEMS; it += NGW) {
            int r = it;
            if (r < 2 * I_ABI) { const int e = r / I_ABI; r -= e * I_ABI;
                transpose_item(p.ab_w_in + (size_t)e * D * 4640, 4640, D, (bf16_t*)(p.ws + WS_WAB_IN) + (size_t)e * NAB * D, NAB / 32, scr, r, lane, MapAB()); continue; }
            r -= 2 * I_ABI;
            if (r < 2 * I_SQ) { const int e = r / I_SQ; r -= e * I_SQ;
                transpose_item(p.ab_w_out + (size_t)e * D * D, D, D, (bf16_t*)(p.ws + WS_WAB_OUT) + (size_t)e * D * D, D / 32, scr, r, lane, MapId()); continue; }
            r -= 2 * I_SQ;
            if (r < 2 * I_NAI) { const int e = r / I_NAI; r -= e * I_NAI;
                transpose_item(p.na_w_in + (size_t)e * D * NNA, NNA, D, (bf16_t*)(p.ws + WS_WNA_IN) + (size_t)e * NNA * D, NNA / 32, scr, r, lane, MapId()); continue; }
            r -= 2 * I_NAI;
            { const int e = r / I_SQ; r -= e * I_SQ;
                transpose_item(p.na_w_out + (size_t)e * D * D, D, D, (bf16_t*)(p.ws + WS_WNA_OUT) + (size_t)e * D * D, D / 32, scr, r, lane, MapId()); }
        }
    }
#pragma unroll 1
    for (int l = 0; l < DEPTH; ++l) peer_convert_rows(p, l, peer_deferred_rows(l, G) + gw, 32768, NGW, lane);
}
__device__ __forceinline__ void fold_item(const Params& p, int l, int item, LAS float* scr, int lane) {
    const int kb = item >> 6, nb = item & 63, k0 = 64 * kb, n0 = 32 * nb;
    const float* MOD = (const float*)(p.ws + WS_MOD) + (size_t)l * 2 * D6;
    const float* W = p.peer_wq + (size_t)l * D * D;
    LAS float* kv = scr + 2112;
    float w[32];
#pragma unroll
    for (int i = 0; i < 32; ++i) w[i] = __builtin_nontemporal_load(W + (size_t)(k0 + 2 * i + (lane >> 5)) * D + n0 + (lane & 31));
    { const int k = k0 + lane; const float g2 = p.norm2_g[(size_t)l * D + k], m4 = MOD[4 * D + k], m4c = MOD[D6 + 4 * D + k], m3 = MOD[3 * D + k], m3c = MOD[D6 + 3 * D + k];
      __builtin_amdgcn_sched_barrier(0);
      kv[lane] = g2 * (1.f + m4); kv[64 + lane] = g2 * (1.f + m4c); kv[128 + lane] = m3; kv[192 + lane] = m3c; }
    asm volatile("s_waitcnt lgkmcnt(0)" ::: "memory");
    float bl = 0.f, bc = 0.f;
#pragma unroll
    for (int i = 0; i < 32; ++i) { const int kk = 2 * i + (lane >> 5); bl += w[i] * kv[128 + kk]; bc += w[i] * kv[192 + kk]; }
    bl += __shfl_xor(bl, 32); bc += __shfl_xor(bc, 32);
    if (lane < 32) { float* PB = (float*)(p.ws + WS_PARTB) + ((size_t)(l * 2) * 32 + kb) * D + n0 + lane; PB[0] = bl; PB[(size_t)32 * D] = bc; }
    const int c = lane & 7;
#pragma unroll 1
    for (int v = 0; v < (l < DEPTH - 1 ? 2 : 1); ++v) {
        bf16_t* WT = (bf16_t*)(p.ws + (v ? WS_WQC : WS_WQ)) + (size_t)l * D * D;
        float kf[32];
#pragma unroll
        for (int i = 0; i < 32; ++i) kf[i] = kv[64 * v + 2 * i + (lane >> 5)];
        __builtin_amdgcn_sched_barrier(0);
#pragma unroll
        for (int i = 0; i < 32; ++i) { const int kk = 2 * i + (lane >> 5); scr[kk * 33 + (lane & 31)] = w[i] * kf[i]; }
        asm volatile("s_waitcnt lgkmcnt(0)" ::: "memory");
        float tt[4][8];
#pragma unroll
        for (int j = 0; j < 4; ++j) { const LAS float* s = scr + (8 * c) * 33 + (lane >> 3) + 8 * j;
#pragma unroll
            for (int r = 0; r < 8; ++r) tt[j][r] = s[r * 33]; }
        __builtin_amdgcn_sched_barrier(0);
#pragma unroll
        for (int j = 0; j < 4; ++j) { const int n = (lane >> 3) + 8 * j;
            u32x4 o; o.x = pk2(tt[j][0], tt[j][1]); o.y = pk2(tt[j][2], tt[j][3]); o.z = pk2(tt[j][4], tt[j][5]); o.w = pk2(tt[j][6], tt[j][7]);
            *(u32x4*)(WT + (size_t)(n0 + n) * D + k0 + 8 * c) = o; }
        asm volatile("s_waitcnt lgkmcnt(0)" ::: "memory");
    }
}
__device__ __forceinline__ void ph_fold_wq(const Params& p, LAS unsigned char* lds, int lane, int wave, int gw, int NGW) {
    LAS float* scr = (LAS float*)(lds + wave * 16384);
    for (int it = gw; it < DEPTH * 2048; it += NGW) fold_item(p, it >> 11, it & 2047, scr, lane);
}
__device__ __forceinline__ void ph_fold_bias(const Params& p, int lane, int gw, int NGW) {
    for (int i = gw * 64 + lane; i < DEPTH * 2 * D; i += NGW * 64) { const float* PB = (const float*)(p.ws + WS_PARTB) + (size_t)(i >> 11) * 32 * D + (i & 2047); float s = 0.f;
        float pv[32];
#pragma unroll
        for (int kb = 0; kb < 32; ++kb) pv[kb] = PB[(size_t)kb * D];
#pragma unroll
        for (int kb = 0; kb < 32; ++kb) s += pv[kb];
        ((float*)(p.ws + WS_BQ))[i] = s; }
}
__device__ __forceinline__ void norm_row(const Params& p, int l, int which, int m, int lane) {
    const float* gvec = (which ? p.norm2_g : p.norm1_g) + (size_t)l * D;
    const float* MOD = (const float*)(p.ws + WS_MOD) + (size_t)l * 2 * D6;
    const float* X = (const float*)(p.ws + WS_X); bf16_t* H = (bf16_t*)(p.ws + WS_H);
    {
        const float* mod = MOD + (m >= T ? D6 : 0) + (which ? 3 * D : 0);
        const float* xrow = (l == 0 && which == 0) ? (m < T ? p.x + (size_t)m * D : p.ctx + (size_t)(m - T) * D) : X + (size_t)m * D;
        const f32x4* xr = (const f32x4*)xrow + lane;
        f32x4 v[8]; float ss = 0.f;
#pragma unroll
        for (int j = 0; j < 8; ++j) { v[j] = xr[64 * j]; ss += (v[j].x * v[j].x + v[j].y * v[j].y) + (v[j].z * v[j].z + v[j].w * v[j].w); }
        ss = wave_sum(ss);
        const float rstd = rsqrtf(ss * (1.f / D) + EPS);
        f32x4 g4a[8], sha[8], sca[8];
#pragma unroll
        for (int j = 0; j < 8; ++j) { const int col = 256 * j + 4 * lane; g4a[j] = *(const f32x4*)(gvec + col); sha[j] = *(const f32x4*)(mod + col); sca[j] = *(const f32x4*)(mod + D + col); }
        __builtin_amdgcn_sched_barrier(0);
#pragma unroll
        for (int j = 0; j < 8; ++j) { const int col = 256 * j + 4 * lane;
            const f32x4 h = v[j] * rstd * g4a[j] * (sca[j] + 1.f) + sha[j]; v[j] = h;
            if (!which) { u32x2 o; o.x = pk2(h.x, h.y); o.y = pk2(h.z, h.w); *(u32x2*)(H + (size_t)m * D + col) = o; } }
        if (which) {
            float am = 0.f;
#pragma unroll
            for (int j = 0; j < 8; ++j) am = fmaxf(am, fmaxf(fmaxf(fabsf(v[j].x), fabsf(v[j].y)), fmaxf(fabsf(v[j].z), fabsf(v[j].w))));
            am = wave_max(am);
            const float inv = am > 0.f ? 127.f / am : 0.f;
            if (lane == 0) ((float*)(p.ws + WS_SH))[m] = am > 0.f ? am * (1.f / 127.f) : 1.f;
            unsigned char* h8 = p.ws + WS_H8 + (size_t)m * D + 4 * lane;
#pragma unroll
            for (int j = 0; j < 8; ++j) {
                const int q0 = (int)rintf(v[j].x * inv), q1 = (int)rintf(v[j].y * inv), q2 = (int)rintf(v[j].z * inv), q3 = (int)rintf(v[j].w * inv);
                *(unsigned*)(h8 + 256 * j) = ((unsigned)q0 & 0xffu) | (((unsigned)q1 & 0xffu) << 8) | (((unsigned)q2 & 0xffu) << 16) | (((unsigned)q3 & 0xffu) << 24);
            }
        }
    }
}
template <int NR> __device__ __forceinline__ void h8_rows(const Params& p, int l, int m0, int lane, int wave) {
    const float* gvec = p.norm2_g + (size_t)l * D;
    const float* MOD = (const float*)(p.ws + WS_MOD) + (size_t)l * 2 * D6 + 3 * D;
    const float* X = (const float*)(p.ws + WS_X);
    f32x4 nx[8];
    { const f32x4* xr = (const f32x4*)(X + (size_t)(m0 + wave) * D) + lane;
#pragma unroll
      for (int j = 0; j < 8; ++j) nx[j] = xr[64 * j]; }
#pragma unroll 1
    for (int mi = wave; mi < NR; mi += NWAVES) {
        const int m = m0 + mi; const float* mod = MOD + (m >= T ? D6 : 0);
        f32x4 v[8]; float ss = 0.f;
#pragma unroll
        for (int j = 0; j < 8; ++j) { v[j] = nx[j]; ss += (v[j].x * v[j].x + v[j].y * v[j].y) + (v[j].z * v[j].z + v[j].w * v[j].w); }
        if (mi + NWAVES < NR) { const f32x4* xr = (const f32x4*)(X + (size_t)(m + NWAVES) * D) + lane;
#pragma unroll
            for (int j = 0; j < 8; ++j) nx[j] = xr[64 * j]; }
        ss = wave_sum(ss);
        const float rstd = rsqrtf(ss * (1.f / D) + EPS);
        float am = 0.f;
        f32x4 g4a[8], sha[8], sca[8];
#pragma unroll
        for (int j = 0; j < 8; ++j) { const int col = 256 * j + 4 * lane; g4a[j] = *(const f32x4*)(gvec + col); sha[j] = *(const f32x4*)(mod + col); sca[j] = *(const f32x4*)(mod + D + col); }
        __builtin_amdgcn_sched_barrier(0);
#pragma unroll
        for (int j = 0; j < 8; ++j) {
            const f32x4 h = v[j] * rstd * g4a[j] * (sca[j] + 1.f) + sha[j]; v[j] = h;
            am = fmaxf(am, fmaxf(fmaxf(fabsf(h.x), fabsf(h.y)), fmaxf(fabsf(h.z), fabsf(h.w)))); }
        am = wave_max(am);
        const float inv = am > 0.f ? 127.f / am : 0.f;
        if (lane == 0) ((float*)(p.ws + WS_SH))[m] = am > 0.f ? am * (1.f / 127.f) : 1.f;
        unsigned char* h8 = p.ws + WS_H8 + (size_t)m * D + 4 * lane;
        int qs = 0;
#pragma unroll
        for (int j = 0; j < 8; ++j) {
            const int q0 = (int)rintf(v[j].x * inv), q1 = (int)rintf(v[j].y * inv), q2 = (int)rintf(v[j].z * inv), q3 = (int)rintf(v[j].w * inv);
            qs += (q0 + q1) + (q2 + q3);
            *(unsigned*)(h8 + 256 * j) = ((unsigned)q0 & 0xffu) | (((unsigned)q1 & 0xffu) << 8) | (((unsigned)q2 & 0xffu) << 16) | (((unsigned)q3 & 0xffu) << 24);
        }
        const float qsum = wave_sum((float)qs);
        if (lane == 0) ((float*)(p.ws + WS_SH + 512 * 1024))[m] = qsum;
    }
}
__device__ __forceinline__ void ph_norm(const Params& p, int l, int which, int lane, int gw, int NGW) {
    for (int m = gw; m < M; m += NGW) norm_row(p, l, which, m, lane);
}
__device__ __forceinline__ void final_row(const Params& p, int m, int lane) {
    const float* X = (const float*)(p.ws + WS_X);
    {
        const f32x4* xr = (const f32x4*)(X + (size_t)m * D) + lane;
        f32x4 v[8]; float ss = 0.f;
#pragma unroll
        for (int j = 0; j < 8; ++j) { v[j] = xr[64 * j]; ss += (v[j].x * v[j].x + v[j].y * v[j].y) + (v[j].z * v[j].z + v[j].w * v[j].w); }
        ss = wave_sum(ss);
        const float rstd = rsqrtf(ss * (1.f / D) + EPS);
#pragma unroll
        for (int j = 0; j < 8; ++j) { const int col = 256 * j + 4 * lane; const f32x4 g4 = *(const f32x4*)(p.final_g + col);
            *(f32x4*)(p.out + (size_t)m * D + col) = v[j] * rstd * g4; }
    }
}

#define AT(T, base, off) ((T*)((unsigned char*)(base) + (size_t)(unsigned)(off)))
__device__ __forceinline__ void peer_tail_row(const Params& p, int l, int m, int lane) {
    const float* MODl = (const float*)(p.ws + WS_MOD) + ((size_t)l * 2 + (m >= T ? 1 : 0)) * D6;
    f32x4* X4 = (f32x4*)((float*)(p.ws + WS_X) + (size_t)m * D) + lane;
    f32x4 v[8];
    {
        const f32x4* D4 = (const f32x4*)((const float*)(p.ws + WS_DELTA) + (size_t)m * D) + lane; const f32x4* G4 = (const f32x4*)(MODl + 5 * D) + lane;
        f32x4 dv[8], gv[8];
#pragma unroll
        for (int j = 0; j < 8; ++j) { v[j] = X4[64 * j]; dv[j] = D4[64 * j]; gv[j] = G4[64 * j]; }
        __builtin_amdgcn_sched_barrier(0);
#pragma unroll
        for (int j = 0; j < 8; ++j) v[j] = v[j] + gv[j] * dv[j];
    }
    const bool last = l + 1 >= DEPTH;
    if (last && m >= T) return;
    const float* MODn = (const float*)(p.ws + WS_MOD) + ((size_t)(last ? l : l + 1) * 2 + (m >= T ? 1 : 0)) * D6;
    const f32x4* NG = (const f32x4*)(last ? p.final_g : p.norm1_g + (size_t)(l + 1) * D) + lane;
    f32x4 g4[8], sh[8], sc[8];
#pragma unroll
    for (int j = 0; j < 8; ++j) { g4[j] = NG[64 * j]; if (!last) { sh[j] = ((const f32x4*)MODn + lane)[64 * j]; sc[j] = ((const f32x4*)(MODn + D) + lane)[64 * j]; } }
    __builtin_amdgcn_sched_barrier(0);
    float ss = 0.f;
#pragma unroll
    for (int j = 0; j < 8; ++j) { if (!last) X4[64 * j] = v[j]; ss += (v[j].x * v[j].x + v[j].y * v[j].y) + (v[j].z * v[j].z + v[j].w * v[j].w); }
    ss = wave_sum(ss);
    const float rstd = rsqrtf(ss * (1.f / D) + EPS);
    if (last) {
        f32x4* O4 = (f32x4*)(p.out + (size_t)m * D) + lane;
#pragma unroll
        for (int j = 0; j < 8; ++j) O4[64 * j] = v[j] * rstd * g4[j];
    } else {
        bf16_t* H = (bf16_t*)(p.ws + WS_H) + (size_t)m * D + 4 * lane;
#pragma unroll
        for (int j = 0; j < 8; ++j) { const f32x4 h = v[j] * rstd * g4[j] * (sc[j] + 1.f) + sh[j]; u32x2 o; o.x = pk2(h.x, h.y); o.y = pk2(h.z, h.w); *(u32x2*)(H + 256 * j) = o; }
    }
}
__device__ __forceinline__ void store4_bf16(unsigned char* base, unsigned off, f32x4 v) { u32x2 w; w.x = pk2(v[0], v[1]); w.y = pk2(v[2], v[3]); *AT(u32x2, base, off) = w; }
__device__ __forceinline__ void store4_T(unsigned char* base, unsigned off0  , f32x4 v) {
    const unsigned a = pk2(v[0], v[1]), b = pk2(v[2], v[3]);
    constexpr unsigned RS = (unsigned)M * 2u;
    *AT(bf16_t, base, off0 + 0 * RS) = (bf16_t)(a & 0xffff); *AT(bf16_t, base, off0 + 1 * RS) = (bf16_t)(a >> 16);
    *AT(bf16_t, base, off0 + 2 * RS) = (bf16_t)(b & 0xffff); *AT(bf16_t, base, off0 + 3 * RS) = (bf16_t)(b >> 16);
}
__device__ __forceinline__ void rope4(f32x4& v, const float2* rope, int row, int pp  ) {
    const int pos = (pp < 64) ? (row >> 6) : (row & 63), j0 = (pp & 63) >> 1;
    const f32x4 cs = *AT(const f32x4, rope, (unsigned)(pos * 32 + j0) * 8u);
    const float a0 = v[0], b0 = v[1], a1 = v[2], b1 = v[3];
    v[0] = a0 * cs[0] - b0 * cs[1]; v[1] = b0 * cs[0] + a0 * cs[1];
    v[2] = a1 * cs[2] - b1 * cs[3]; v[3] = b1 * cs[2] + a1 * cs[3];
}
__device__ __forceinline__ void store8_bf16(unsigned char* base, unsigned off, f32x4 v0, f32x4 v1) {
    u32x4 w; w.x = pk2(v0[0], v0[1]); w.y = pk2(v0[2], v0[3]); w.z = pk2(v1[0], v1[1]); w.w = pk2(v1[2], v1[3]);
    *AT(u32x4, base, off) = w;
}
__device__ __forceinline__ void store8_T(unsigned char* base, unsigned off0  , f32x4 v0, f32x4 v1) {
    const unsigned a = pk2(v0[0], v0[1]), b = pk2(v0[2], v0[3]), c = pk2(v1[0], v1[1]), d = pk2(v1[2], v1[3]);
    constexpr unsigned RS = (unsigned)M * 2u;
    *AT(bf16_t, base, off0 + 0 * RS) = (bf16_t)(a & 0xffff); *AT(bf16_t, base, off0 + 1 * RS) = (bf16_t)(a >> 16);
    *AT(bf16_t, base, off0 + 2 * RS) = (bf16_t)(b & 0xffff); *AT(bf16_t, base, off0 + 3 * RS) = (bf16_t)(b >> 16);
    *AT(bf16_t, base, off0 + 4 * RS) = (bf16_t)(c & 0xffff); *AT(bf16_t, base, off0 + 5 * RS) = (bf16_t)(c >> 16);
    *AT(bf16_t, base, off0 + 6 * RS) = (bf16_t)(d & 0xffff); *AT(bf16_t, base, off0 + 7 * RS) = (bf16_t)(d >> 16);
}
__device__ __forceinline__ void rope8(f32x4& v0, f32x4& v1, const float2* rope, int row, int pp  ) {
    const int pos = (pp < 64) ? (row >> 6) : (row & 63), j0 = (pp & 63) >> 1;
    const f32x4* t = AT(const f32x4, rope, (unsigned)(pos * 32 + j0) * 8u);
    const f32x4 c01 = t[0], c23 = t[1];
    const float a0 = v0[0], b0 = v0[1], a1 = v0[2], b1 = v0[3], a2 = v1[0], b2 = v1[1], a3 = v1[2], b3 = v1[3];
    v0[0] = a0 * c01[0] - b0 * c01[1]; v0[1] = b0 * c01[0] + a0 * c01[1];
    v0[2] = a1 * c01[2] - b1 * c01[3]; v0[3] = b1 * c01[2] + a1 * c01[3];
    v1[0] = a2 * c23[0] - b2 * c23[1]; v1[1] = b2 * c23[0] + a2 * c23[1];
    v1[2] = a3 * c23[2] - b3 * c23[3]; v1[3] = b3 * c23[2] + a3 * c23[3];
}
struct EpiEven {
    static constexpr bool PERM = true, AFTER_DRAIN = false;
    unsigned char* proj; const float* gate_b; const float2* rope;
    __device__ __forceinline__ void elem4(unsigned row, unsigned col0, f32x4 v) const {
        const unsigned pn = col0 >> 8;
        if (pn < 2) { store4_bf16(proj, (unsigned)PJ_AQ + (row * 512u + col0) * 2u, v * 0.125f); }
        else if (pn < 4) { const unsigned c = col0 - 512; store4_bf16(proj, (unsigned)PJ_AK + (row * 512u + c) * 2u, v); store4_T(proj, (unsigned)PJ_AKT + (c * (unsigned)M + row) * 2u, v); }
        else if (pn < 8) { store4_T(proj, (unsigned)PJ_AVT + ((col0 - 1024) * (unsigned)M + row) * 2u, v); }
        else if (pn < 12) { store4_bf16(proj, (unsigned)PJ_AO + (row * 1024u + (col0 - 2048)) * 2u, v); }
        else if (pn < 16) { const unsigned c = col0 - 3072; if (row < (unsigned)T) rope4(v, rope, row, c & 127); store4_bf16(proj, (unsigned)PJ_BQ + (row * 1024u + c) * 2u, v); }
        else if (pn == 16) { const unsigned c = col0 - 4096; if (row < (unsigned)T) rope4(v, rope, row, c & 127); store4_bf16(proj, (unsigned)PJ_BK + (row * 256u + c) * 2u, v); }
        else if (pn == 17) { store4_T(proj, (unsigned)PJ_BVT + ((col0 - 4352) * (unsigned)M + row) * 2u, v); }
        else { const unsigned c = col0 - 4608; if (c < 32) *AT(f32x4, proj, (unsigned)PJ_G + (row * 32u + c) * 4u) = v + *AT(const f32x4, gate_b, c * 4u); }
    }
    __device__ __forceinline__ void operator()(const f32x4 (&acc)[2][2][4][2], const pg8::Unit& u, int wr, int wc, int fr, int fq) const {
        const int pn = u.pn;
#pragma unroll
        for (int ai = 0; ai < 2; ++ai)
#pragma unroll
            for (int m = 0; m < 4; ++m) { const unsigned row = u.pm * 256 + ai * 128 + wr * 64 + m * 16 + fr;
#pragma unroll
                for (int bj = 0; bj < 2; ++bj) { const unsigned col0 = pn * 256 + bj * 128 + wc * 32 + 8 * fq;
                    f32x4 v0 = acc[ai][bj][m][0], v1 = acc[ai][bj][m][1];
                    if (pn < 2) { store8_bf16(proj, (unsigned)PJ_AQ + (row * 512u + col0) * 2u, v0 * 0.125f, v1 * 0.125f); }
                    else if (pn < 4) { const unsigned c = col0 - 512; store8_bf16(proj, (unsigned)PJ_AK + (row * 512u + c) * 2u, v0, v1); store8_T(proj, (unsigned)PJ_AKT + (c * (unsigned)M + row) * 2u, v0, v1); }
                    else if (pn < 8) { store8_T(proj, (unsigned)PJ_AVT + ((col0 - 1024) * (unsigned)M + row) * 2u, v0, v1); }
                    else if (pn < 12) { store8_bf16(proj, (unsigned)PJ_AO + (row * 1024u + (col0 - 2048)) * 2u, v0, v1); }
                    else if (pn < 16) { const unsigned c = col0 - 3072; if (row < (unsigned)T) rope8(v0, v1, rope, row, c & 127); store8_bf16(proj, (unsigned)PJ_BQ + (row * 1024u + c) * 2u, v0, v1); }
                    else if (pn == 16) { const unsigned c = col0 - 4096; if (row < (unsigned)T) rope8(v0, v1, rope, row, c & 127); store8_bf16(proj, (unsigned)PJ_BK + (row * 256u + c) * 2u, v0, v1); }
                    else if (pn == 17) { store8_T(proj, (unsigned)PJ_BVT + ((col0 - 4352) * (unsigned)M + row) * 2u, v0, v1); }
                    else { const unsigned c = col0 - 4608; if (c < 32) { const unsigned go = (unsigned)PJ_G + (row * 32u + c) * 4u;
                            *AT(f32x4, proj, go) = v0 + *AT(const f32x4, gate_b, c * 4u); *AT(f32x4, proj, go + 16u) = v1 + *AT(const f32x4, gate_b, c * 4u + 16u); } }
                } }
    }
};
struct EpiOdd {
    static constexpr bool PERM = true, AFTER_DRAIN = false;
    unsigned char* proj;
    __device__ __forceinline__ void elem4(unsigned row, unsigned col0, f32x4 v) const {
        const unsigned pn = col0 >> 8;
        if (pn < 8) store4_bf16(proj, (unsigned)PJ_Q + (row * 2048u + col0) * 2u, v);
        else if (pn < 16) store4_bf16(proj, (unsigned)PJ_K + (row * 2048u + (col0 - 2048)) * 2u, v);
        else store4_T(proj, (unsigned)PJ_VT + ((col0 - 4096) * (unsigned)M + row) * 2u, v);
    }
    __device__ __forceinline__ void operator()(const f32x4 (&acc)[2][2][4][2], const pg8::Unit& u, int wr, int wc, int fr, int fq) const {
        const int pn = u.pn;
#pragma unroll
        for (int ai = 0; ai < 2; ++ai)
#pragma unroll
            for (int m = 0; m < 4; ++m) { const unsigned row = u.pm * 256 + ai * 128 + wr * 64 + m * 16 + fr;
#pragma unroll
                for (int bj = 0; bj < 2; ++bj) { const unsigned col0 = pn * 256 + bj * 128 + wc * 32 + 8 * fq;
                    const f32x4 v0 = acc[ai][bj][m][0], v1 = acc[ai][bj][m][1];
                    if (pn < 8) store8_bf16(proj, (unsigned)PJ_Q + (row * 2048u + col0) * 2u, v0, v1);
                    else if (pn < 16) store8_bf16(proj, (unsigned)PJ_K + (row * 2048u + (col0 - 2048)) * 2u, v0, v1);
                    else store8_T(proj, (unsigned)PJ_VT + ((col0 - 4096) * (unsigned)M + row) * 2u, v0, v1);
                } }
    }
};
struct EpiResid {
    static constexpr bool PERM = true, AFTER_DRAIN = false;
    float* X; const float* gl; const float* gc; const float* srcl; const float* srcc;
    unsigned char* XB; float* part; float* partc;
    __device__ __forceinline__ void elem4(unsigned row, unsigned col0, f32x4 v) const {
        f32x4* xp = AT(f32x4, X, (row * (unsigned)D + col0) * 4u);
        const f32x4* sp = AT(const f32x4, srcc, ((row - (unsigned)T) * (unsigned)D + col0) * 4u);
        const f32x4 x = *sp + *AT(const f32x4, gc, col0 * 4u) * v;
        *xp = x; store4_bf16(XB, (row * (unsigned)D + col0) * 2u, x);
        const float s = fq_sum((x.x * x.x + x.y * x.y) + (x.z * x.z + x.w * x.w));
        if (((col0 >> 2) & 3u) == 0u) *AT(float, partc, ((row - (unsigned)T) * 128u + (col0 >> 4)) * 4u) = s;
    }
    __device__ __forceinline__ void operator()(const f32x4 (&acc)[2][2][4][2], const pg8::Unit& u, int wr, int wc, int fr, int fq) const {
        const float* g = (u.pm * 256 < T) ? gl : gc;
        f32x4 gg[2][2];
#pragma unroll
        for (int bj = 0; bj < 2; ++bj) { const unsigned col0 = u.pn * 256 + bj * 128 + wc * 32 + 8 * fq; gg[bj][0] = *AT(const f32x4, g, col0 * 4u); gg[bj][1] = *AT(const f32x4, g, col0 * 4u + 16u); }
#pragma unroll
        for (int ai = 0; ai < 2; ++ai) {
            f32x4 sv[4][2][2];
#pragma unroll
            for (int m = 0; m < 4; ++m) { const unsigned row = u.pm * 256 + ai * 128 + wr * 64 + m * 16 + fr;
#pragma unroll
                for (int bj = 0; bj < 2; ++bj) { const unsigned col0 = u.pn * 256 + bj * 128 + wc * 32 + 8 * fq;
                    const f32x4* sp = (u.pm * 256 < T) ? AT(const f32x4, srcl, (row * (unsigned)D + col0) * 4u) : AT(const f32x4, srcc, ((row - (unsigned)T) * (unsigned)D + col0) * 4u);
                    sv[m][bj][0] = sp[0]; sv[m][bj][1] = sp[1]; } }
            __builtin_amdgcn_sched_barrier(0);
#pragma unroll
            for (int m = 0; m < 4; ++m) { const unsigned row = u.pm * 256 + ai * 128 + wr * 64 + m * 16 + fr; float ssq = 0.f;
#pragma unroll
                for (int bj = 0; bj < 2; ++bj) { const unsigned col0 = u.pn * 256 + bj * 128 + wc * 32 + 8 * fq;
                    f32x4* xp = AT(f32x4, X, (row * (unsigned)D + col0) * 4u);
                    const f32x4 x0 = sv[m][bj][0] + gg[bj][0] * acc[ai][bj][m][0], x1 = sv[m][bj][1] + gg[bj][1] * acc[ai][bj][m][1];
                    xp[0] = x0; xp[1] = x1; store8_bf16(XB, (row * (unsigned)D + col0) * 2u, x0, x1);
                    ssq += ((x0.x * x0.x + x0.y * x0.y) + (x0.z * x0.z + x0.w * x0.w)) + ((x1.x * x1.x + x1.y * x1.y) + (x1.z * x1.z + x1.w * x1.w));
                }
                ssq = fq_sum(ssq);
                if (fq == 0) *AT(float, part, (row * 32u + u.pn * 4u + wc) * 4u) = ssq; }
            __builtin_amdgcn_sched_barrier(0);
        }
    }
};
struct EpiPlain {
    static constexpr bool PERM = true, AFTER_DRAIN = false;
    bf16_t* O;
    __device__ __forceinline__ void elem4(unsigned row, unsigned col0, f32x4 v) const { store4_bf16((unsigned char*)O, (row * (unsigned)D + col0) * 2u, v); }
    __device__ __forceinline__ void operator()(const f32x4 (&acc)[2][2][4][2], const pg8::Unit& u, int wr, int wc, int fr, int fq) const {
#pragma unroll
        for (int ai = 0; ai < 2; ++ai)
#pragma unroll
            for (int m = 0; m < 4; ++m) { const unsigned row = u.pm * 256 + ai * 128 + wr * 64 + m * 16 + fr;
#pragma unroll
                for (int bj = 0; bj < 2; ++bj) { const unsigned col0 = u.pn * 256 + bj * 128 + wc * 32 + 8 * fq;
                    store8_bf16((unsigned char*)O, (row * (unsigned)D + col0) * 2u, acc[ai][bj][m][0], acc[ai][bj][m][1]); } }
    }
};
struct EpiQ {
    static constexpr bool PERM = true, AFTER_DRAIN = false;
    bf16_t* O; const float* part; const float* bias;
    __device__ __forceinline__ void operator()(const f32x4 (&acc)[2][2][4][2], const pg8::Unit& u, int wr, int wc, int fr, int fq) const {
        f32x4 bb[2][2], pp[2][4][2];
#pragma unroll
        for (int bj = 0; bj < 2; ++bj) { const unsigned col0 = u.pn * 256 + bj * 128 + wc * 32 + 8 * fq; bb[bj][0] = *AT(const f32x4, bias, col0 * 4u); bb[bj][1] = *AT(const f32x4, bias, col0 * 4u + 16u); }
#pragma unroll
        for (int ai = 0; ai < 2; ++ai)
#pragma unroll
            for (int m = 0; m < 4; ++m) { const unsigned row = u.pm * 256 + ai * 128 + wr * 64 + m * 16 + fr;
                pp[ai][m][0] = *AT(const f32x4, part, (row * 32u + 8u * fq) * 4u); pp[ai][m][1] = *AT(const f32x4, part, (row * 32u + 8u * fq) * 4u + 16u); }
        __builtin_amdgcn_sched_barrier(0);
#pragma unroll
        for (int ai = 0; ai < 2; ++ai)
#pragma unroll
            for (int m = 0; m < 4; ++m) { const unsigned row = u.pm * 256 + ai * 128 + wr * 64 + m * 16 + fr;
                const f32x4 p0 = pp[ai][m][0], p1 = pp[ai][m][1];
                const float r = rsqrtf(fq_sum(((p0.x + p0.y) + (p0.z + p0.w)) + ((p1.x + p1.y) + (p1.z + p1.w))) * (1.f / D) + EPS);
#pragma unroll
                for (int bj = 0; bj < 2; ++bj) { const unsigned col0 = u.pn * 256 + bj * 128 + wc * 32 + 8 * fq;
                    store8_bf16((unsigned char*)O, (row * (unsigned)D + col0) * 2u, acc[ai][bj][m][0] * r + bb[bj][0], acc[ai][bj][m][1] * r + bb[bj][1]); } }
    }
};
struct EpiQC {
    bf16_t* O; const float* partc; const float* bias;
    __device__ __forceinline__ void elem4(unsigned row, unsigned col0, f32x4 v) const {
        const unsigned po = ((row - (unsigned)T) * 128u + 32u * ((col0 >> 2) & 3u)) * 4u; float sq = 0.f;
#pragma unroll
        for (int i = 0; i < 8; ++i) { const f32x4 t = *AT(const f32x4, partc, po + 16u * i); sq += (t.x + t.y) + (t.z + t.w); }
        const float r = rsqrtf(fq_sum(sq) * (1.f / D) + EPS);
        store4_bf16((unsigned char*)O, (row * (unsigned)D + col0) * 2u, v * r + *AT(const f32x4, bias, col0 * 4u)); }
};
struct EpiInProj {
    static constexpr bool PERM = true, AFTER_DRAIN = false;
    EpiEven ev; EpiOdd od; bool even;
    __device__ __forceinline__ void elem4(unsigned row, unsigned col0, f32x4 v) const { if (even) ev.elem4(row, col0, v); else od.elem4(row, col0, v); }
    __device__ __forceinline__ void operator()(const f32x4 (&acc)[2][2][4][2], const pg8::Unit& u, int wr, int wc, int fr, int fq) const {
        if (even) ev(acc, u, wr, wc, fr, fq); else od(acc, u, wr, wc, fr, fq);
    }
};
struct EpiOutQ {
    static constexpr bool PERM = true, AFTER_DRAIN = false;
    EpiResid rs; EpiPlain pl; bool resid;
    __device__ __forceinline__ void operator()(const f32x4 (&acc)[2][2][4][2], const pg8::Unit& u, int wr, int wc, int fr, int fq) const {
        if (resid) rs(acc, u, wr, wc, fr, fq); else pl(acc, u, wr, wc, fr, fq);
    }
};

template <class Epi, int NT  >
__device__ __forceinline__ void ctx_gemm_piece(const bf16_t* __restrict__ A, const bf16_t* __restrict__ Bt, const Epi& E, int rb, int cb, int wave, int lane) {
    const int fr = lane & 15, fq = lane >> 4;
    const bf16_t* ap = A + (size_t)(T + 16 * rb + fr) * D + 8 * fq;
    const bf16_t* bp = Bt + (size_t)(cb * 128 * NT + 16 * NT * wave + fr) * D + 8 * fq;
    f32x4 acc[NT];
#pragma unroll
    for (int n = 0; n < NT; ++n) acc[n] = (f32x4){0.f, 0.f, 0.f, 0.f};
    constexpr int KC = NT == 1 ? 16 : 8;
#pragma unroll 1
    for (int k0 = 0; k0 < D; k0 += 32 * KC) {
        bf16x8 af[KC], bfg[NT][KC];
#pragma unroll
        for (int kk = 0; kk < KC; ++kk) { af[kk] = *(const bf16x8*)(ap + k0 + 32 * kk);
#pragma unroll
            for (int n = 0; n < NT; ++n) bfg[n][kk] = *(const bf16x8*)(bp + (size_t)16 * n * D + k0 + 32 * kk); }
        __builtin_amdgcn_sched_barrier(0);
#pragma unroll
        for (int kk = 0; kk < KC; ++kk)
#pragma unroll
            for (int n = 0; n < NT; ++n) acc[n] = MFMA16(bfg[n][kk], af[kk], acc[n]);
    }
#pragma unroll
    for (int n = 0; n < NT; ++n) E.elem4((unsigned)(T + 16 * rb + fr), (unsigned)(cb * 128 * NT + 16 * NT * wave + 16 * n + 4 * fq), acc[n]);
}
template <class Epi>
__device__ __forceinline__ void ctx_gemm(const bf16_t* __restrict__ A, const bf16_t* __restrict__ Bt, int N, const Epi& E, int wave, int lane, int vcu, int G) {
    asm volatile("" : "+v"(lane));
    const int npc = 16 * (N >> 7);
    for (int pc = vcu; pc < npc; pc += G) ctx_gemm_piece<Epi, 1>(A, Bt, E, pc & 15, pc >> 4, wave, lane);
}

template <class TF>
__device__ __forceinline__ void attn_wave16(const bf16_t* __restrict__ Qh, int qstride, int qrow0,
                                            const bf16_t* __restrict__ Kh, int kstride, const bf16_t* __restrict__ VTh  ,
                                            int ntiles, const TF& tf, bool has_sink, float sink, float scale,
                                            bf16_t* __restrict__ Oh, int ostride, int lane) {
    asm volatile("" : "+v"(lane));
    const int fr = lane & 15, fq = lane >> 4;
    bf16x8 qf[4];
#pragma unroll
    for (int kd = 0; kd < 4; ++kd) qf[kd] = *(const bf16x8*)(Qh + (size_t)(qrow0 + fr) * qstride + 32 * kd + 8 * fq);
    f32x4 o[8];
#pragma unroll
    for (int nd = 0; nd < 8; ++nd) o[nd] = (f32x4){0.f, 0.f, 0.f, 0.f};
    float mrun = has_sink ? sink * LOG2E : -1e30f;
    float lrun = (has_sink && fq == 0) ? 1.f : 0.f;
    const float sc2 = scale * LOG2E;
    for (int ti = 0; ti < ntiles; ++ti) {
        const int tok0 = tf.tok0(ti);
        f32x4 s[2];
#pragma unroll
        for (int sub = 0; sub < 2; ++sub) {
            s[sub] = (f32x4){0.f, 0.f, 0.f, 0.f};
            int tk = tok0 + 16 * sub + fr; tk = tk < 0 ? 0 : (tk > M - 1 ? M - 1 : tk);
#pragma unroll
            for (int kd = 0; kd < 4; ++kd) { const bf16x8 kf = *(const bf16x8*)(Kh + (size_t)tk * kstride + 32 * kd + 8 * fq); s[sub] = MFMA16(kf, qf[kd], s[sub]); }
        }
        float pv[8]; float tmax = -INFINITY;
#pragma unroll
        for (int sub = 0; sub < 2; ++sub)
#pragma unroll
            for (int r = 0; r < 4; ++r) { const int ks = 16 * sub + 4 * fq + r; const float b = tf.bias(ti, ks);
                const float v = s[sub][r] * sc2 + b * LOG2E; pv[4 * sub + r] = v; tmax = fmaxf(tmax, v); }
        tmax = fmaxf(tmax, __shfl_xor(tmax, 16)); tmax = fmaxf(tmax, __shfl_xor(tmax, 32));
        const float mnew = fmaxf(mrun, tmax), alpha = exp2f(mrun - mnew);
        float ps = 0.f;
#pragma unroll
        for (int i = 0; i < 8; ++i) { pv[i] = exp2f(pv[i] - mnew); ps += pv[i]; }
        lrun = lrun * alpha + ps; mrun = mnew;
#pragma unroll
        for (int nd = 0; nd < 8; ++nd) o[nd] = o[nd] * alpha;
        u32x4 pw; pw.x = pk2(pv[0], pv[1]); pw.y = pk2(pv[2], pv[3]); pw.z = pk2(pv[4], pv[5]); pw.w = pk2(pv[6], pv[7]);
        const bf16x8 pf = mk_frag(pw);
        int t0 = tok0 + 4 * fq, t1 = tok0 + 16 + 4 * fq;
        t0 = t0 < 0 ? 0 : (t0 > M - 4 ? M - 4 : t0); t1 = t1 < 0 ? 0 : (t1 > M - 4 ? M - 4 : t1);
#pragma unroll
        for (int nd = 0; nd < 8; ++nd) { const bf16_t* vr = VTh + (size_t)(16 * nd + fr) * M;
            const u32x2 a = *(const u32x2*)(vr + t0), b = *(const u32x2*)(vr + t1);
            u32x4 w; w.x = a.x; w.y = a.y; w.z = b.x; w.w = b.y;
            o[nd] = MFMA16(mk_frag(w), pf, o[nd]); }
    }
    lrun += __shfl_xor(lrun, 16); lrun += __shfl_xor(lrun, 32);
    const float rl = 1.f / lrun;
#pragma unroll
    for (int nd = 0; nd < 8; ++nd) { const f32x4 v = o[nd] * rl; u32x2 w; w.x = pk2(v[0], v[1]); w.y = pk2(v[2], v[3]);
        *(u32x2*)(Oh + (size_t)(qrow0 + fr) * ostride + 16 * nd + 4 * fq) = w; }
}
struct TFCtxOnly {
    __device__ __forceinline__ int tok0(int ti) const { return T + 32 * ti; }
    __device__ __forceinline__ float bias(int, int) const { return 0.f; }
};
struct TFGqa {
    int jb, tq;
    __device__ __forceinline__ int tok0(int ti) const { return ti < 9 ? 16 * jb - 128 + 32 * ti : T + 32 * (ti - 9); }
    __device__ __forceinline__ float bias(int ti, int ks) const {
        if (ti >= 9) return 0.f;
        const int kp = 16 * jb - 128 + 32 * ti + ks, d = kp - tq;
        return (kp >= 0 && kp < T && d <= 128 && d >= -128) ? 0.f : -INFINITY;
    }
};
struct TFNa {
    int r0, kc0, r, c, c0; const float* rpb;
    __device__ __forceinline__ int tok0(int ti) const { return ti < 8 ? 64 * (r0 + ti) + kc0 : T + 32 * (ti - 8); }
    __device__ __forceinline__ float bias(int ti, int ks) const {
        if (ti >= 8) return 0.f;
        const int kc = kc0 + ks;
        if (kc < c0 || kc >= c0 + 16) return -INFINITY;
        return rpb[(r0 + ti - r + 7) * 31 + (kc - c + 15)];
    }
};

#ifndef ATT_NB
#define ATT_NB 4
#endif
constexpr int ATT_KB = 16384, ATT_VROW = 136, ATT_BUF = ATT_KB + 128 * ATT_VROW;
template <class TF, int MODE = 0>
__device__ __forceinline__ void attn_wg(const TF& tf, const bf16_t* __restrict__ Qh, int qstride, int qrow0, int qrow1,
                                        const bf16_t* __restrict__ Kh, int kstride, const bf16_t* __restrict__ VTh,
                                        bool has_sink, float sink, float scale, bf16_t* __restrict__ Oh, int ostride, LAS unsigned char* lds, int tid, int lane, bool rt_false = false) {
    asm volatile("" : "+v"(lane));
    const int fr = lane & 15, fq = lane >> 4;
    bf16x8 qf[2][4];
#pragma unroll
    for (int qt = 0; qt < 2; ++qt)
#pragma unroll
        for (int kd = 0; kd < 4; ++kd) qf[qt][kd] = *(const bf16x8*)(Qh + (size_t)((qt ? qrow1 : qrow0) + fr) * qstride + 32 * kd + 8 * fq);
    f32x4 o[2][8]; float mrun[2], lrun[2];
#pragma unroll
    for (int qt = 0; qt < 2; ++qt) { mrun[qt] = has_sink ? sink * LOG2E : -1e30f; lrun[qt] = (has_sink && fq == 0) ? 1.f : 0.f;
#pragma unroll
        for (int nd = 0; nd < 8; ++nd) o[qt][nd] = (f32x4){0.f, 0.f, 0.f, 0.f}; }
    const float sc2 = scale * LOG2E;
    const int kr0 = tid >> 4, kch = tid & 15, vd0 = tid >> 3, vc8 = tid & 7;
    u32x4 kreg[2], vreg[2];
    const int nt = tf.ntiles();
#define ATT_LOAD(ti) do { const int t0_ = tf.tile_t0(ti); _Pragma("unroll") for (int i_ = 0; i_ < 2; ++i_) { \
        int tk_ = t0_ + kr0 + 32 * i_; tk_ = tk_ < 0 ? 0 : (tk_ > M - 1 ? M - 1 : tk_); kreg[i_] = *(const u32x4*)(Kh + (size_t)tk_ * kstride + 8 * kch); \
        int tv_ = t0_ + 8 * vc8; tv_ = tv_ < 0 ? 0 : (tv_ > M - 8 ? M - 8 : tv_); vreg[i_] = *(const u32x4*)(VTh + (size_t)(vd0 + 64 * i_) * M + tv_); } } while (0)
#define ATT_STORE(b) do { LAS unsigned char* bb_ = lds + (b) * ATT_BUF; _Pragma("unroll") for (int i_ = 0; i_ < 2; ++i_) { const int r_ = kr0 + 32 * i_; \
        *(LAS u32x4*)(bb_ + r_ * 256 + ((kch ^ (r_ & 15)) << 4)) = kreg[i_]; \
        LAS u32x2* vp_ = (LAS u32x2*)(bb_ + ATT_KB + (vd0 + 64 * i_) * ATT_VROW + 16 * vc8); u32x2 a_, b_; a_.x = vreg[i_].x; a_.y = vreg[i_].y; b_.x = vreg[i_].z; b_.y = vreg[i_].w; vp_[0] = a_; vp_[1] = b_; } } while (0)
    __syncthreads();
    ATT_LOAD(0); ATT_STORE(0);
    __syncthreads();
    for (int ti = 0; ti < nt; ++ti) {
        if (ti + 1 < nt && MODE != 2) ATT_LOAD(ti + 1);
        if (tf.active(ti) && MODE != 3) {
            const LAS unsigned char* kb = lds + (ti & 1) * ATT_BUF; const LAS unsigned char* vbase = kb + ATT_KB;
            const int ns = tf.nsteps(ti);
            for (int st = 0; st < ns; ++st) {
                int ws[2]; f32x4 s[2][2]; float pv[2][8], bs8[2][8], alpha[2];
#pragma unroll
                for (int qt = 0; qt < 2; ++qt) { ws[qt] = tf.win(ti, qt, st);
#pragma unroll
                    for (int sub = 0; sub < 2; ++sub) { s[qt][sub] = (f32x4){0.f, 0.f, 0.f, 0.f}; const int tl = ws[qt] + 16 * sub + fr;
#pragma unroll
                        for (int kd = 0; kd < 4; ++kd) { const bf16x8 kf = *(const LAS bf16x8*)(kb + tl * 256 + (((4 * kd + fq) ^ (tl & 15)) << 4)); s[qt][sub] = MFMA16(kf, qf[qt][kd], s[qt][sub]); } } }
#pragma unroll
                for (int qt = 0; qt < 2; ++qt) tf.bias8(ti, qt, ws[qt] + 4 * fq, bs8[qt]);
                float tmax[2];
#pragma unroll
                for (int qt = 0; qt < 2; ++qt) { tmax[qt] = -INFINITY;
#pragma unroll
                    for (int sub = 0; sub < 2; ++sub)
#pragma unroll
                        for (int r = 0; r < 4; ++r) { const float v = s[qt][sub][r] * sc2 + bs8[qt][4 * sub + r] * LOG2E; pv[qt][4 * sub + r] = v; tmax[qt] = fmaxf(tmax[qt], v); } }
                { const float t0 = __shfl_xor(tmax[0], 16), t1 = __shfl_xor(tmax[1], 16);
                  __builtin_amdgcn_sched_barrier(0);
                  tmax[0] = fmaxf(tmax[0], t0); tmax[1] = fmaxf(tmax[1], t1); }
                { const float t0 = __shfl_xor(tmax[0], 32), t1 = __shfl_xor(tmax[1], 32);
                  __builtin_amdgcn_sched_barrier(0);
                  tmax[0] = fmaxf(tmax[0], t0); tmax[1] = fmaxf(tmax[1], t1); }
                if (__builtin_amdgcn_ballot_w64(tmax[0] > mrun[0] + 8.f || tmax[1] > mrun[1] + 8.f) != 0ull) {
#pragma unroll
                    for (int qt = 0; qt < 2; ++qt) { const float mnew = fmaxf(mrun[qt], tmax[qt]); alpha[qt] = __builtin_amdgcn_exp2f(mrun[qt] - mnew); lrun[qt] *= alpha[qt]; mrun[qt] = mnew;
#pragma unroll
                        for (int nd = 0; nd < 8; ++nd) o[qt][nd] = o[qt][nd] * alpha[qt]; }
                }
#pragma unroll
                for (int qt = 0; qt < 2; ++qt) {
                    float ps = 0.f;
#pragma unroll
                    for (int i = 0; i < 8; ++i) { pv[qt][i] = __builtin_amdgcn_exp2f(pv[qt][i] - mrun[qt]); ps += pv[qt][i]; }
                    lrun[qt] += ps; }
                bf16x8 pf[2];
#pragma unroll
                for (int qt = 0; qt < 2; ++qt) { u32x4 pw; pw.x = pk2(pv[qt][0], pv[qt][1]); pw.y = pk2(pv[qt][2], pv[qt][3]); pw.z = pk2(pv[qt][4], pv[qt][5]); pw.w = pk2(pv[qt][6], pv[qt][7]); pf[qt] = mk_frag(pw); }
                constexpr int NB_ = ATT_NB;
#pragma unroll
                for (int nh = 0; nh < 8; nh += NB_) {
                    u32x4 vw[NB_][2];
#pragma unroll
                    for (int n4 = 0; n4 < NB_; ++n4)
#pragma unroll
                        for (int qt = 0; qt < 2; ++qt) { const LAS unsigned char* vr = vbase + (16 * (nh + n4) + fr) * ATT_VROW + 2 * (ws[qt] + 4 * fq);
                            const u32x2 a = *(const LAS u32x2*)vr, b2 = *(const LAS u32x2*)(vr + 32);
                            vw[n4][qt].x = a.x; vw[n4][qt].y = a.y; vw[n4][qt].z = b2.x; vw[n4][qt].w = b2.y; }
                    __builtin_amdgcn_sched_barrier(0);
#pragma unroll
                    for (int n4 = 0; n4 < NB_; ++n4)
#pragma unroll
                        for (int qt = 0; qt < 2; ++qt) o[qt][nh + n4] = MFMA16(mk_frag(vw[n4][qt]), pf[qt], o[qt][nh + n4]);
                    __builtin_amdgcn_sched_barrier(0);
                }
            }
        }
        if (ti + 1 < nt) ATT_STORE((ti + 1) & 1);
        __syncthreads();
    }
#undef ATT_LOAD
#undef ATT_STORE
    if (MODE == 0 || rt_false)
#pragma unroll
    for (int qt = 0; qt < 2; ++qt) {
        const float lt = fq_sum(lrun[qt]);
        const float rl = 1.f / lt;
#pragma unroll
        for (int nd = 0; nd < 8; ++nd) { const f32x4 v = o[qt][nd] * rl; u32x2 w; w.x = pk2(v[0], v[1]); w.y = pk2(v[2], v[3]);
            *(u32x2*)(Oh + (size_t)((qt ? qrow1 : qrow0) + fr) * ostride + 16 * nd + 4 * fq) = w; }
    }
}
struct TFCtxW {
    __device__ __forceinline__ int ntiles() const { return 4; }
    __device__ __forceinline__ int tile_t0(int ti) const { return T + 64 * ti; }
    __device__ __forceinline__ bool active(int) const { return true; }
    __device__ __forceinline__ int nsteps(int) const { return 2; }
    __device__ __forceinline__ int win(int, int, int st) const { return 32 * st; }
    __device__ __forceinline__ void bias8(int, int, int, float (&b)[8]) const {
#pragma unroll
        for (int i = 0; i < 8; ++i) b[i] = 0.f; }
};
struct TFGqaW {
    int jb64, q0;
    __device__ __forceinline__ int ntiles() const { return 9; }
    __device__ __forceinline__ int tile_t0(int ti) const { return ti < 5 ? 64 * jb64 - 128 + 64 * ti : T + 64 * (ti - 5); }
    __device__ __forceinline__ bool active(int) const { return true; }
    __device__ __forceinline__ int nsteps(int) const { return 2; }
    __device__ __forceinline__ int win(int, int, int st) const { return 32 * st; }
    __device__ __forceinline__ void bias8(int ti, int qt, int key0, float (&b)[8]) const {
        const bool plain = ti >= 5 || (ti >= 1 && ti <= 3 && 64 * jb64 - 128 + 64 * ti >= 0 && 64 * jb64 - 128 + 64 * ti + 63 < T);
        if (plain) {
#pragma unroll
            for (int i = 0; i < 8; ++i) b[i] = 0.f;
        } else {
#pragma unroll
            for (int i = 0; i < 8; ++i) { const int key = key0 + 16 * (i >> 2) + (i & 3); const int kp = 64 * jb64 - 128 + 64 * ti + key, d = kp - (q0 + 16 * qt);
                b[i] = (kp >= 0 && kp < T && d <= 128 && d >= -128) ? 0.f : -INFINITY; }
        }
    }
};
struct TFNaW {
    int rlo, nl, r, r0, hf, fr; const LAS float* rpb;
    __device__ __forceinline__ int ntiles() const { return nl + 4; }
    __device__ __forceinline__ int tile_t0(int ti) const { return ti < nl ? 64 * (rlo + ti) : T + 64 * (ti - nl); }
    __device__ __forceinline__ bool active(int ti) const { return ti >= nl || (rlo + ti >= r0 && rlo + ti < r0 + 8); }
    __device__ __forceinline__ int nsteps(int ti) const { return ti < nl ? 1 : 2; }
    __device__ __forceinline__ int win(int ti, int qt, int st) const { if (ti >= nl) return 32 * st; const int cq = 2 * hf + qt; return cq == 0 ? 0 : (cq == 1 ? 8 : (cq == 2 ? 24 : 32)); }
    __device__ __forceinline__ void bias8(int ti, int qt, int key0, float (&b)[8]) const {
        if (ti >= nl) {
#pragma unroll
            for (int i = 0; i < 8; ++i) b[i] = 0.f;
        } else {
            const int c = 32 * hf + 16 * qt + fr, c0 = c - 8 < 0 ? 0 : (c - 8 > 48 ? 48 : c - 8);
            const LAS float* row = rpb + (rlo + ti - r + 7) * 31;
#pragma unroll
            for (int i = 0; i < 8; ++i) { const int key = key0 + 16 * (i >> 2) + (i & 3); int off = key - c + 15; off = off < 0 ? 0 : (off > 30 ? 30 : off);
                const float v = row[off]; b[i] = ((unsigned)(key - c0) < 16u) ? v : -INFINITY; }
        }
    }
};

__device__ __forceinline__ void ph_attn_even(const Params& p, int e, bool with_ctx, LAS unsigned char* lds, int tid, int lane, int wave, int vcu, int G) {
    unsigned char* proj = p.ws + WS_PROJ;
    const bf16_t* BQ = (const bf16_t*)(proj + PJ_BQ); const bf16_t* BK = (const bf16_t*)(proj + PJ_BK); const bf16_t* BVT = (const bf16_t*)(proj + PJ_BVT);
    bf16_t* MIX = (bf16_t*)(p.ws + WS_MIX);
    const float scale = 0.08838834764831845f;
#ifdef ATT_PROBE
    for (int U = vcu; U < 256; U += G) {
        const int jb64 = U >> 1, kvh = U & 1, h = kvh * 4 + (wave & 3), hf = wave >> 2;
        TFGqaW tf; tf.jb64 = jb64; tf.q0 = 64 * jb64 + 32 * hf + (lane & 15);
        attn_wg<TFGqaW, ATT_PROBE>(tf, BQ + h * 128, 1024, 64 * jb64 + 32 * hf, 64 * jb64 + 32 * hf + 16, BK + kvh * 128, 256, BVT + (size_t)kvh * 128 * M, true, p.ab_sink[e * 8 + h], scale, MIX + 1024 + h * 128, 2048, lds, tid, lane, p.grid == 12345);
    }
#endif
    for (int U = vcu; U < 256; U += G) {
        const int jb64 = U >> 1, kvh = U & 1, h = kvh * 4 + (wave & 3), hf = wave >> 2;
        TFGqaW tf; tf.jb64 = jb64; tf.q0 = 64 * jb64 + 32 * hf + (lane & 15);
        attn_wg(tf, BQ + h * 128, 1024, 64 * jb64 + 32 * hf, 64 * jb64 + 32 * hf + 16, BK + kvh * 128, 256, BVT + (size_t)kvh * 128 * M, true, p.ab_sink[e * 8 + h], scale, MIX + 1024 + h * 128, 2048, lds, tid, lane);
    }
    if (with_ctx) for (int U = G - 1 - vcu; U < 8; U += G) {
        const int h = U, kvh = h >> 2;
        attn_wg(TFCtxW(), BQ + h * 128, 1024, T + 32 * wave, T + 32 * wave + 16, BK + kvh * 128, 256, BVT + (size_t)kvh * 128 * M, true, p.ab_sink[e * 8 + h], scale, MIX + 1024 + h * 128, 2048, lds, tid, lane);
    }
}
__device__ __forceinline__ void ph_attn_odd(const Params& p, int o, bool with_ctx, LAS unsigned char* lds, int tid, int lane, int wave, int vcu, int G) {
    unsigned char* proj = p.ws + WS_PROJ;
    const bf16_t* Q = (const bf16_t*)(proj + PJ_Q); const bf16_t* K = (const bf16_t*)(proj + PJ_K); const bf16_t* VT = (const bf16_t*)(proj + PJ_VT);
    bf16_t* MIX = (bf16_t*)(p.ws + WS_MIX);
    const float scale = 0.08838834764831845f;
#ifdef NA_PROBE
    for (int U = vcu; U < 512; U += G) {
        const int rg = U >> 4, h = U & 15, r = 4 * rg + (wave >> 1), hf = wave & 1;
        TFNaW tf; tf.r = r; tf.r0 = r - 4 < 0 ? 0 : (r - 4 > 120 ? 120 : r - 4); tf.hf = hf; tf.fr = lane & 15; tf.rpb = (const LAS float*)(lds + 2 * ATT_BUF);
        { const float* rsrc = p.na_rpb + ((size_t)o * 16 + h) * 15 * 31; __syncthreads(); if (tid < 465) ((LAS float*)(lds + 2 * ATT_BUF))[tid] = rsrc[tid]; }
        const int rl_ = 4 * rg - 4 < 0 ? 0 : (4 * rg - 4 > 120 ? 120 : 4 * rg - 4), rh_ = (4 * rg - 1 < 0 ? 0 : (4 * rg - 1 > 120 ? 120 : 4 * rg - 1)) + 7;
        tf.rlo = rl_; tf.nl = rh_ - rl_ + 1;
        attn_wg<TFNaW, 1>(tf, Q + h * 128, 2048, 64 * r + 32 * hf, 64 * r + 32 * hf + 16, K + h * 128, 2048, VT + (size_t)h * 128 * M, false, 0.f, scale, MIX + h * 128, 2048, lds, tid, lane, p.grid == 12345);
    }
#endif
    for (int U = vcu; U < 512; U += G) {
        const int rg = U >> 4, h = U & 15, r = 4 * rg + (wave >> 1), hf = wave & 1;
        TFNaW tf; tf.r = r; tf.r0 = r - 4 < 0 ? 0 : (r - 4 > 120 ? 120 : r - 4); tf.hf = hf; tf.fr = lane & 15; tf.rpb = (const LAS float*)(lds + 2 * ATT_BUF);
        { const float* rsrc = p.na_rpb + ((size_t)o * 16 + h) * 15 * 31; __syncthreads(); if (tid < 465) ((LAS float*)(lds + 2 * ATT_BUF))[tid] = rsrc[tid]; }
        const int rl_ = 4 * rg - 4 < 0 ? 0 : (4 * rg - 4 > 120 ? 120 : 4 * rg - 4), rh_ = (4 * rg - 1 < 0 ? 0 : (4 * rg - 1 > 120 ? 120 : 4 * rg - 1)) + 7;
        tf.rlo = rl_; tf.nl = rh_ - rl_ + 1;
        attn_wg(tf, Q + h * 128, 2048, 64 * r + 32 * hf, 64 * r + 32 * hf + 16, K + h * 128, 2048, VT + (size_t)h * 128 * M, false, 0.f, scale, MIX + h * 128, 2048, lds, tid, lane);
    }
    if (with_ctx) for (int U = G - 1 - vcu; U < 16; U += G) {
        const int h = U;
        attn_wg(TFCtxW(), Q + h * 128, 2048, T + 32 * wave, T + 32 * wave + 16, K + h * 128, 2048, VT + (size_t)h * 128 * M, false, 0.f, scale, MIX + h * 128, 2048, lds, tid, lane);
    }
}

__device__ __forceinline__ void mlstm_A_unit(const Params& p, int cc, int hd, int lane) {
    asm volatile("" : "+v"(lane));
    const int fr = lane & 15, fq = lane >> 4, dir = hd >> 3, head = hd & 7, tok0 = cc * 64;
    unsigned char* proj = p.ws + WS_PROJ;
    const bf16_t* AKT = (const bf16_t*)(proj + PJ_AKT); const bf16_t* AVT = (const bf16_t*)(proj + PJ_AVT); const float* Gt = (const float*)(proj + PJ_G);
    float* U = (float*)(p.ws + WS_U); float* CHS = (float*)(p.ws + WS_CHS);
    const float* grow = Gt + (size_t)(tok0 + lane) * 32;
    u32x4 rawk[2][4]; bf16x8 bv[8][2];
#pragma unroll
    for (int ks = 0; ks < 2; ++ks)
#pragma unroll
        for (int nd = 0; nd < 4; ++nd) rawk[ks][nd] = *(const u32x4*)(AKT + (size_t)(head * 64 + 16 * nd + fr) * M + tok0 + 32 * ks + 8 * fq);
#pragma unroll
    for (int ne = 0; ne < 8; ++ne)
#pragma unroll
        for (int ks = 0; ks < 2; ++ks) bv[ne][ks] = *(const bf16x8*)(AVT + (size_t)(head * 128 + 16 * ne + fr) * M + tok0 + 32 * ks + 8 * fq);
    const float ig = grow[(2 * dir) * 8 + head], lf_raw = grow[(2 * dir + 1) * 8 + head];
    __builtin_amdgcn_sched_barrier(0);
    const float lf = log_sigmoid(lf_raw);
    const float F = scan_add(lf, lane, dir);
    const float FL = __shfl(F, dir ? 0 : 63);
    const float wend = FL - F + ig, wmax = wave_max(wend), wv = expf(wend - wmax);
    if (lane == 0) { CHS[((size_t)hd * NCH + cc) * 2] = FL; CHS[((size_t)hd * NCH + cc) * 2 + 1] = wmax; }
    { float* GF = (float*)(p.ws + WS_GF); const float Bs_ = ig - F, pm_ = scan_max(Bs_, lane, dir); const size_t gi = (size_t)hd * M + tok0 + lane;
      GF[gi] = F; GF[(size_t)16 * M + gi] = Bs_; GF[(size_t)32 * M + gi] = pm_; }
    bf16x8 af[4][2];
#pragma unroll
    for (int ks = 0; ks < 2; ++ks) {
        float w8[8];
#pragma unroll
        for (int j = 0; j < 8; ++j) w8[j] = __shfl(wv, 32 * ks + 8 * fq + j);
#pragma unroll
        for (int nd = 0; nd < 4; ++nd) {
            const u32x4 raw = rawk[ks][nd];
            u32x4 w; w.x = pk2(bf_lo(raw.x) * w8[0], bf_hi(raw.x) * w8[1]); w.y = pk2(bf_lo(raw.y) * w8[2], bf_hi(raw.y) * w8[3]);
            w.z = pk2(bf_lo(raw.z) * w8[4], bf_hi(raw.z) * w8[5]); w.w = pk2(bf_lo(raw.w) * w8[6], bf_hi(raw.w) * w8[7]);
            af[nd][ks] = mk_frag(w);
        }
    }
    const unsigned onew = (fr == 0) ? 0x3F803F80u : 0u;
#pragma unroll
    for (int ne = 0; ne < 9; ++ne) {
        bf16x8 bfr[2];
#pragma unroll
        for (int ks = 0; ks < 2; ++ks) {
            if (ne < 8) bfr[ks] = bv[ne < 8 ? ne : 0][ks];
            else { u32x4 w; w.x = onew; w.y = onew; w.z = onew; w.w = onew; bfr[ks] = mk_frag(w); }
        }
#pragma unroll
        for (int nd = 0; nd < 4; ++nd) {
            f32x4 acc = (f32x4){0.f, 0.f, 0.f, 0.f};
#pragma unroll
            for (int ks = 0; ks < 2; ++ks) acc = MFMA16(af[nd][ks], bfr[ks], acc);
            *(f32x4*)(U + (((size_t)hd * NCH + cc) * 144 + 16 * ne + fr) * 64 + 16 * nd + 4 * fq) = acc;
        }
    }
}
__device__ __forceinline__ void ph_mlstm_B(const Params& p, LAS unsigned char* lds, int tid, int G) {
    const float* U = (const float*)(p.ws + WS_U); const float* CHS = (const float*)(p.ws + WS_CHS);
    bf16_t* SNAP = (bf16_t*)(p.ws + WS_SNAP); float* MPREV = (float*)(p.ws + WS_CHS + 65536);
    LAS float* sDec = (LAS float*)lds; LAS float* sInj = sDec + 132;
    for (int b = blockIdx.x; b < 256; b += G) {
        const int hd = b >> 4, part = b & 15, dir = hd >> 3;
        __syncthreads();
        if (tid < NCH) { const int cc = dir ? (NCH - 1 - tid) : (tid < 4 ? 128 + tid : tid - 4); sDec[tid] = CHS[((size_t)hd * NCH + cc) * 2]; sInj[tid] = CHS[((size_t)hd * NCH + cc) * 2 + 1]; }
        __syncthreads();
        LAS float* sM = sInj + 132;
        if (tid == 0) { float m = 0.f;
            for (int step = 0; step < NCH; ++step) { sM[step] = m; m = fmaxf(sDec[step] + m, sInj[step]); } sM[NCH] = m; }
        __syncthreads();
        if (tid < NCH) { const int step = tid; const int cc = dir ? (NCH - 1 - step) : (step < 4 ? 128 + step : step - 4);
            const float FL = sDec[step], wm = sInj[step], m = sM[step], mn = sM[step + 1];
            if (part == 0) MPREV[hd * NCH + cc] = m;
            sDec[step] = expf(FL + m - mn); sInj[step] = expf(wm - mn); }
        __syncthreads();
        const int i0 = part * 512 + tid; const bool has2 = (part == 0 && tid < 64); const int i1 = 8192 + tid;
        float C0 = 0.f, C1 = 0.f;
#pragma unroll 1
        for (int s12 = 0; s12 < NCH; s12 += 22) {
            float u0[22], u1[22]; size_t base[22];
#pragma unroll
            for (int k = 0; k < 22; ++k) { const int step = s12 + k; const int cc = dir ? (NCH - 1 - step) : (step < 4 ? 128 + step : step - 4);
                base[k] = ((size_t)hd * NCH + cc) * 9216; u0[k] = U[base[k] + i0]; u1[k] = has2 ? U[base[k] + i1] : 0.f; }
#pragma unroll
            for (int k = 0; k < 22; ++k) {
                SNAP[base[k] + i0] = (bf16_t)(pk2(C0, 0.f) & 0xffff);
                if (has2) SNAP[base[k] + i1] = (bf16_t)(pk2(C1, 0.f) & 0xffff);
                const float decay = sDec[s12 + k], inj = sInj[s12 + k];
                C0 = decay * C0 + inj * u0[k]; C1 = decay * C1 + inj * u1[k]; }
        }
    }
}
__device__ __forceinline__ void mlstm_C_unit(const Params& p, int e_idx, int cc, int head, int tq, int lane) {
    asm volatile("" : "+v"(lane));
    const int fr = lane & 15, fq = lane >> 4, tok0 = cc * 64, tl = 16 * tq + fr;
    unsigned char* proj = p.ws + WS_PROJ;
    const bf16_t* AQ = (const bf16_t*)(proj + PJ_AQ); const bf16_t* AK = (const bf16_t*)(proj + PJ_AK); const bf16_t* AVT = (const bf16_t*)(proj + PJ_AVT);
    const bf16_t* AO = (const bf16_t*)(proj + PJ_AO); const float* Gt = (const float*)(proj + PJ_G);
    const bf16_t* SNAP = (const bf16_t*)(p.ws + WS_SNAP); const float* MPREV = (const float*)(p.ws + WS_CHS + 65536);
    bf16_t* MIX = (bf16_t*)(p.ws + WS_MIX);
    bf16x8 qf[2];
#pragma unroll
    for (int kd = 0; kd < 2; ++kd) qf[kd] = *(const bf16x8*)(AQ + (size_t)(tok0 + tl) * 512 + head * 64 + 32 * kd + 8 * fq);
    f32x4 s[4];
#pragma unroll
    for (int ns = 0; ns < 4; ++ns) { s[ns] = (f32x4){0.f, 0.f, 0.f, 0.f};
#pragma unroll
        for (int kd = 0; kd < 2; ++kd) { const bf16x8 kf = *(const bf16x8*)(AK + (size_t)(tok0 + 16 * ns + fr) * 512 + head * 64 + 32 * kd + 8 * fq); s[ns] = MFMA16(kf, qf[kd], s[ns]); } }
    f32x4 hs[8];
#pragma unroll
    for (int ne = 0; ne < 8; ++ne) hs[ne] = (f32x4){0.f, 0.f, 0.f, 0.f};
    const float* grow = Gt + (size_t)(tok0 + lane) * 32;
#pragma unroll
    for (int dir = 0; dir < 2; ++dir) {
        const int hd = dir * 8 + head;
        const float* GF = (const float*)(p.ws + WS_GF) + (size_t)hd * M + tok0;
        const float F_t = GF[tl], pm_t = GF[(size_t)32 * M + tl];
        const float inter = F_t + MPREV[hd * NCH + cc], mt = fmaxf(inter, F_t + pm_t);
        const float A_t = F_t - mt, a_t = expf(inter - mt), fl_t = expf(-mt);
        bf16x8 pf[2];
#pragma unroll
        for (int ks = 0; ks < 2; ++ks) { unsigned w[4];
#pragma unroll
            for (int hf = 0; hf < 2; ++hf) { const int ns = 2 * ks + hf; float ev[4];
                const f32x4 b4 = *(const f32x4*)(GF + (size_t)16 * M + 16 * ns + 4 * fq);
#pragma unroll
                for (int r = 0; r < 4; ++r) { const int sl = 16 * ns + 4 * fq + r;
                    const bool valid = dir ? (sl >= tl) : (sl <= tl);
                    ev[r] = s[ns][r] * expf(valid ? (A_t + b4[r]) : -INFINITY); }
                w[2 * hf] = pk2(ev[0], ev[1]); w[2 * hf + 1] = pk2(ev[2], ev[3]); }
            u32x4 ww; ww.x = w[0]; ww.y = w[1]; ww.z = w[2]; ww.w = w[3]; pf[ks] = mk_frag(ww); }
        const bf16_t* snap = SNAP + ((size_t)hd * NCH + cc) * 9216;
        float rden = 0.f;
#pragma unroll
        for (int it = 0; it < 9; ++it) {
            const int ne = (it == 0) ? 8 : it - 1;
            f32x4 acc = (f32x4){0.f, 0.f, 0.f, 0.f};
#pragma unroll
            for (int kd = 0; kd < 2; ++kd) {
                u32x4 cw = *(const u32x4*)(snap + (size_t)(16 * ne + fr) * 64 + 32 * kd + 8 * fq);
                if (ne == 8 && fr != 0) { cw.x = 0u; cw.y = 0u; cw.z = 0u; cw.w = 0u; }
                acc = MFMA16(mk_frag(cw), qf[kd], acc);
            }
            acc = acc * a_t;
#pragma unroll
            for (int ks = 0; ks < 2; ++ks) {
                u32x4 vw;
                if (ne < 8) { const bf16_t* vr = AVT + (size_t)(head * 128 + 16 * ne + fr) * M + tok0 + 32 * ks + 4 * fq;
                    const u32x2 a = *(const u32x2*)vr, b = *(const u32x2*)(vr + 16); vw.x = a.x; vw.y = a.y; vw.z = b.x; vw.w = b.y; }
                else { const unsigned onew = (fr == 0) ? 0x3F803F80u : 0u; vw.x = onew; vw.y = onew; vw.z = onew; vw.w = onew; }
                acc = MFMA16(mk_frag(vw), pf[ks], acc);
            }
            if (ne == 8) { const float den = __shfl(acc[0], fr); rden = 1.f / fmaxf(fabsf(den), fl_t); }
            else hs[ne] = hs[ne] + acc * rden;
        }
    }
    float ss = 0.f;
#pragma unroll
    for (int ne = 0; ne < 8; ++ne) ss += (hs[ne][0] * hs[ne][0] + hs[ne][1] * hs[ne][1]) + (hs[ne][2] * hs[ne][2] + hs[ne][3] * hs[ne][3]);
    ss += __shfl_xor(ss, 16); ss += __shfl_xor(ss, 32);
    const float rs = rsqrtf(ss * (1.f / 128.f) + EPS);
    const int tok = tok0 + tl;
#pragma unroll
    for (int ne = 0; ne < 8; ++ne) { const int col = head * 128 + 16 * ne + 4 * fq;
        const f32x4 g4 = *(const f32x4*)(p.ab_mh_g + (size_t)e_idx * 1024 + col);
        const u32x2 ow = *(const u32x2*)(AO + (size_t)tok * 1024 + col);
        const float o0 = bf_lo(ow.x), o1 = bf_hi(ow.x), o2 = bf_lo(ow.y), o3 = bf_hi(ow.y);
        const f32x4 v = hs[ne] * rs * g4;
        u32x2 w; w.x = pk2(v[0] / (1.f + expf(-o0)), v[1] / (1.f + expf(-o1))); w.y = pk2(v[2] / (1.f + expf(-o2)), v[3] / (1.f + expf(-o3)));
        *(u32x2*)(MIX + (size_t)tok * 2048 + col) = w; }
}

constexpr int MC_K = 0, MC_Q = 8192, MC_VT = 16384, MC_S = 34816  , MC_G = 71680  , MC_H = 73728  , MC_END = 106496;
__device__ __forceinline__ void mlstm_C_wg(const Params& p, int e_idx, LAS unsigned char* lds, int tid, int lane, int wave, int vcu, int G) {
    asm volatile("" : "+v"(lane));
    const int fr = lane & 15, fq = lane >> 4, tq = wave & 3, dir = wave >> 2, tl = 16 * tq + fr;
    unsigned char* proj = p.ws + WS_PROJ;
    const bf16_t* AQ = (const bf16_t*)(proj + PJ_AQ); const bf16_t* AK = (const bf16_t*)(proj + PJ_AK); const bf16_t* AVT = (const bf16_t*)(proj + PJ_AVT);
    const bf16_t* AO = (const bf16_t*)(proj + PJ_AO);
    const bf16_t* SNAP = (const bf16_t*)(p.ws + WS_SNAP); const float* MPREV = (const float*)(p.ws + WS_CHS + 65536);
    const float* GFg = (const float*)(p.ws + WS_GF);
    bf16_t* MIX = (bf16_t*)(p.ws + WS_MIX);
    const int row = tid >> 3, ch = tid & 7;
    u32x4 kv, qv, vv[2], sv[2][3]; float gv = 0.f;
#define MC_FETCH(U_) do { const int cc_ = (U_) >> 3, hd_ = (U_) & 7, t0_ = cc_ * 64; \
        kv = *(const u32x4*)(AK + (size_t)(t0_ + row) * 512 + hd_ * 64 + ch * 8); qv = *(const u32x4*)(AQ + (size_t)(t0_ + row) * 512 + hd_ * 64 + ch * 8); \
        _Pragma("unroll") for (int i = 0; i < 2; ++i) vv[i] = *(const u32x4*)(AVT + (size_t)(hd_ * 128 + row + 64 * i) * M + t0_ + ch * 8); \
        _Pragma("unroll") for (int d = 0; d < 2; ++d) _Pragma("unroll") for (int i = 0; i < 3; ++i) { const int q = tid + 512 * i, e = q >> 3; const u32x4 z = {0u, 0u, 0u, 0u}; \
            sv[d][i] = (q < 1152 && e < 129) ? *(const u32x4*)(SNAP + ((size_t)(d * 8 + hd_) * NCH + cc_) * 9216 + (size_t)e * 64 + ch * 8) : z; } \
        if (tid < 384) { const int which = tid >> 6, t = tid & 63, kind = which % 3, dd = which / 3; gv = GFg[((size_t)kind * 16 + dd * 8 + hd_) * M + t0_ + t]; } } while (0)
    int U = vcu;
    if (U < NCH * 8) MC_FETCH(U);
    for (; U < NCH * 8; U += G) {
    const int cc = U >> 3, head = U & 7, tok0 = cc * 64, hd = dir * 8 + head;
    __syncthreads();
    {
        *(LAS u32x4*)(lds + MC_K + row * 128 + ((ch ^ (row & 7)) << 4)) = kv;
        *(LAS u32x4*)(lds + MC_Q + row * 128 + ((ch ^ (row & 7)) << 4)) = qv;
#pragma unroll
        for (int i = 0; i < 2; ++i) { const int e = row + 64 * i; *(LAS u32x4*)(lds + MC_VT + e * 128 + ((ch ^ (e & 7)) << 4)) = vv[i]; }
        if (tid < 128) { const int e = 128 + row; const unsigned o1 = (e == 128) ? 0x3F803F80u : 0u; const u32x4 ov = {o1, o1, o1, o1}; *(LAS u32x4*)(lds + MC_VT + e * 128 + ((ch ^ (e & 7)) << 4)) = ov; }
#pragma unroll
        for (int d = 0; d < 2; ++d)
#pragma unroll
            for (int i = 0; i < 3; ++i) { const int q = tid + 512 * i, e = q >> 3; if (q < 1152) *(LAS u32x4*)(lds + MC_S + d * 18432 + e * 128 + ((ch ^ (e & 7)) << 4)) = sv[d][i]; }
        if (tid < 384) *(LAS float*)(lds + MC_G + tid * 4) = gv;
    }
    __syncthreads();
    if (U + G < NCH * 8) MC_FETCH(U + G);
    bf16x8 qf[2];
#pragma unroll
    for (int kd = 0; kd < 2; ++kd) qf[kd] = *(const LAS bf16x8*)(lds + MC_Q + tl * 128 + (((4 * kd + fq) ^ (tl & 7)) << 4));
    f32x4 s[4];
#pragma unroll
    for (int ns = 0; ns < 4; ++ns) { s[ns] = (f32x4){0.f, 0.f, 0.f, 0.f}; const int sr = 16 * ns + fr;
#pragma unroll
        for (int kd = 0; kd < 2; ++kd) { const bf16x8 kf = *(const LAS bf16x8*)(lds + MC_K + sr * 128 + (((4 * kd + fq) ^ (sr & 7)) << 4)); s[ns] = MFMA16(kf, qf[kd], s[ns]); } }
    const LAS float* G = (const LAS float*)(lds + MC_G + dir * 768);
    const float F_t = G[tl], pm_t = G[128 + tl];
    const float inter = F_t + MPREV[hd * NCH + cc], mt = fmaxf(inter, F_t + pm_t);
    const float A_t = F_t - mt, a_t = expf(inter - mt), fl_t = expf(-mt);
    bf16x8 pf[2];
#pragma unroll
    for (int ks = 0; ks < 2; ++ks) { unsigned w[4];
#pragma unroll
        for (int hf = 0; hf < 2; ++hf) { const int ns = 2 * ks + hf; float ev[4];
            const f32x4 b4 = *(const LAS f32x4*)(G + 64 + 16 * ns + 4 * fq);
#pragma unroll
            for (int r = 0; r < 4; ++r) { const int sl = 16 * ns + 4 * fq + r; const bool valid = dir ? (sl >= tl) : (sl <= tl);
                ev[r] = s[ns][r] * expf(valid ? (A_t + b4[r]) : -INFINITY); }
            w[2 * hf] = pk2(ev[0], ev[1]); w[2 * hf + 1] = pk2(ev[2], ev[3]); }
        u32x4 ww; ww.x = w[0]; ww.y = w[1]; ww.z = w[2]; ww.w = w[3]; pf[ks] = mk_frag(ww); }
    const LAS unsigned char* snap = lds + MC_S + dir * 18432;
    f32x4 hs[8]; float rden = 0.f;
#pragma unroll
    for (int g3 = 0; g3 < 3; ++g3) {
        bf16x8 cfr[3][2]; u32x4 vwr[3][2];
#pragma unroll
        for (int i3 = 0; i3 < 3; ++i3) { const int it = 3 * g3 + i3; const int ne = (it == 0) ? 8 : it - 1; const int er = 16 * ne + fr;
#pragma unroll
            for (int kd = 0; kd < 2; ++kd) cfr[i3][kd] = *(const LAS bf16x8*)(snap + er * 128 + (((4 * kd + fq) ^ (er & 7)) << 4));
#pragma unroll
            for (int ks = 0; ks < 2; ++ks) {
                const LAS unsigned char* vr = lds + MC_VT + er * 128 + 8 * (fq & 1);
                const u32x2 a = *(const LAS u32x2*)(vr + (((4 * ks + (fq >> 1)) ^ (er & 7)) << 4)), b = *(const LAS u32x2*)(vr + (((4 * ks + 2 + (fq >> 1)) ^ (er & 7)) << 4));
                vwr[i3][ks].x = a.x; vwr[i3][ks].y = a.y; vwr[i3][ks].z = b.x; vwr[i3][ks].w = b.y; } }
        __builtin_amdgcn_sched_barrier(0);
#pragma unroll
        for (int i3 = 0; i3 < 3; ++i3) { const int it = 3 * g3 + i3; const int ne = (it == 0) ? 8 : it - 1;
            f32x4 acc = (f32x4){0.f, 0.f, 0.f, 0.f};
#pragma unroll
            for (int kd = 0; kd < 2; ++kd) acc = MFMA16(cfr[i3][kd], qf[kd], acc);
            acc = acc * a_t;
#pragma unroll
            for (int ks = 0; ks < 2; ++ks) acc = MFMA16(mk_frag(vwr[i3][ks]), pf[ks], acc);
            if (ne == 8) { const float den = __shfl(acc[0], fr); rden = 1.f / fmaxf(fabsf(den), fl_t); }
            else hs[ne] = acc * rden; }
        __builtin_amdgcn_sched_barrier(0);
    }
    if (dir == 1) {
#pragma unroll
        for (int ne = 0; ne < 8; ++ne) *(LAS f32x4*)(lds + MC_H + tq * 8192 + ne * 1024 + lane * 16) = hs[ne];
    }
    __syncthreads();
    if (dir == 0) {
        float ss = 0.f;
#pragma unroll
        for (int ne = 0; ne < 8; ++ne) { hs[ne] = hs[ne] + *(const LAS f32x4*)(lds + MC_H + tq * 8192 + ne * 1024 + lane * 16);
            ss += (hs[ne][0] * hs[ne][0] + hs[ne][1] * hs[ne][1]) + (hs[ne][2] * hs[ne][2] + hs[ne][3] * hs[ne][3]); }
        ss = fq_sum(ss);
        const float rs = rsqrtf(ss * (1.f / 128.f) + EPS);
        const int tok = tok0 + tl;
        f32x4 g4a[8]; u32x2 owa[8];
#pragma unroll
        for (int ne = 0; ne < 8; ++ne) { const int col = head * 128 + 16 * ne + 4 * fq; g4a[ne] = *(const f32x4*)(p.ab_mh_g + (size_t)e_idx * 1024 + col); owa[ne] = *(const u32x2*)(AO + (size_t)tok * 1024 + col); }
        __builtin_amdgcn_sched_barrier(0);
#pragma unroll
        for (int ne = 0; ne < 8; ++ne) { const int col = head * 128 + 16 * ne + 4 * fq;
            const f32x4 g4 = g4a[ne];
            const u32x2 ow = owa[ne];
            const float o0 = bf_lo(ow.x), o1 = bf_hi(ow.x), o2 = bf_lo(ow.y), o3 = bf_hi(ow.y);
            const f32x4 v = hs[ne] * rs * g4;
            u32x2 w; w.x = pk2(v[0] / (1.f + expf(-o0)), v[1] / (1.f + expf(-o1))); w.y = pk2(v[2] / (1.f + expf(-o2)), v[3] / (1.f + expf(-o3)));
            *(u32x2*)(MIX + (size_t)tok * 2048 + col) = w; }
    }
    }
#undef MC_FETCH
}

#define CE_DESC(a, b) do { const float _x = fmaxf(a, b), _y = fminf(a, b); a = _x; b = _y; } while (0)
__device__ __forceinline__ void sort16_desc(float (&v)[16]) {
#pragma unroll
    for (int k = 2; k <= 16; k <<= 1)
#pragma unroll
        for (int j = k >> 1; j > 0; j >>= 1)
#pragma unroll
            for (int i = 0; i < 16; ++i) { const int l = i ^ j; if (l > i) { if ((i & k) == 0) CE_DESC(v[i], v[l]); else CE_DESC(v[l], v[i]); } }
}
__device__ __forceinline__ void merge16_desc(float (&a)[16], const float (&b)[16]) {
#pragma unroll
    for (int i = 0; i < 16; ++i) a[i] = fmaxf(a[i], b[15 - i]);
#pragma unroll
    for (int j = 8; j > 0; j >>= 1)
#pragma unroll
        for (int i = 0; i < 16; ++i) { const int l = i ^ j; if (l > i) CE_DESC(a[i], a[l]); }
}
__device__ __forceinline__ void ce_desc_p(float& va, int& pa, float& vb, int& pb) {
    float nva, nvb; int npa, npb;
    asm volatile("v_cmp_gt_f32 vcc, %5, %4\n\tv_cndmask_b32 %0, %4, %5, vcc\n\tv_cndmask_b32 %1, %5, %4, vcc\n\tv_cndmask_b32 %2, %6, %7, vcc\n\tv_cndmask_b32 %3, %7, %6, vcc"
                 : "=&v"(nva), "=&v"(nvb), "=&v"(npa), "=&v"(npb) : "v"(va), "v"(vb), "v"(pa), "v"(pb) : "vcc");
    va = nva; vb = nvb; pa = npa; pb = npb;
}
#define CE_DESC_P(va, pa, vb, pb) ce_desc_p(va, pa, vb, pb)
__device__ __forceinline__ void sort16p_desc(float (&v)[16], int (&q)[16]) {
#pragma unroll
    for (int k = 2; k <= 16; k <<= 1)
#pragma unroll
        for (int j = k >> 1; j > 0; j >>= 1)
#pragma unroll
            for (int i = 0; i < 16; ++i) { const int l = i ^ j; if (l > i) { if ((i & k) == 0) CE_DESC_P(v[i], q[i], v[l], q[l]); else CE_DESC_P(v[l], q[l], v[i], q[i]); } }
}
__device__ __forceinline__ void merge16p_desc(float (&a)[16], int (&qa)[16], const float (&b)[16], const int (&qb)[16]) {
#pragma unroll
    for (int i = 0; i < 16; ++i) { float tb = b[15 - i]; int tq = qb[15 - i]; ce_desc_p(a[i], qa[i], tb, tq); }
#pragma unroll
    for (int j = 8; j > 0; j >>= 1)
#pragma unroll
        for (int i = 0; i < 16; ++i) { const int l = i ^ j; if (l > i) CE_DESC_P(a[i], qa[i], a[l], qa[l]); }
}
#define CAND_G0(X) X(0,0) X(0,1) X(0,2) X(0,3) X(0,4) X(0,5) X(0,6) X(0,7) X(0,8) X(0,9) X(0,10) X(0,11) X(0,12) X(0,13) X(0,14) X(0,15)
#define CAND_G1(X) X(1,0) X(1,1) X(1,2) X(1,3) X(1,4) X(1,5) X(1,6) X(1,7) X(2,0) X(2,1) X(2,2) X(2,3) X(2,4) X(3,0) X(3,1) X(3,2)
#define CAND_G2(X) X(3,3) X(4,0) X(4,1) X(4,2) X(5,0) X(5,1) X(6,0) X(6,1) X(7,0) X(7,1) X(8,0) X(9,0) X(10,0) X(11,0) X(12,0) X(13,0)
#define CAND_G3(X) X(14,0) X(15,0)

__device__ __forceinline__ void peer_topk_unit(const Params& p, int l, int mt, int hh, int lane) {
    asm volatile("" : "+v"(lane));
    const int fr = lane & 15, fq = lane >> 4, row = mt * 16 + fr;
    const bf16_t* QP = (const bf16_t*)(p.ws + WS_QP); const bf16_t* KEYS = (const bf16_t*)(p.ws + WS_KEYS);
    float s1[16], s2[16]; int i1[16], i2[16];
#pragma unroll
    for (int p2 = 0; p2 < 2; ++p2) {
        bf16x8 qf[4];
#pragma unroll
        for (int kd = 0; kd < 4; ++kd) qf[kd] = *(const bf16x8*)(QP + (size_t)row * 2048 + hh * 256 + p2 * 128 + 32 * kd + 8 * fq);
        float a[16], b[16];
#pragma unroll
        for (int nh = 0; nh < 2; ++nh) {
            bf16x8 kf[4][4];
#pragma unroll
            for (int nb = 0; nb < 4; ++nb)
#pragma unroll
                for (int kd = 0; kd < 4; ++kd) kf[nb][kd] = *(const bf16x8*)(KEYS + ((((size_t)l * 8 + hh) * 2 + p2) * 128 + 16 * (4 * nh + nb) + fr) * 128 + 32 * kd + 8 * fq);
            __builtin_amdgcn_sched_barrier(0);
#pragma unroll
            for (int nb = 0; nb < 4; ++nb) { const int nk = 4 * nh + nb;
                f32x4 acc = (f32x4){0.f, 0.f, 0.f, 0.f};
#pragma unroll
                for (int kd = 0; kd < 4; ++kd) acc = MFMA16(kf[nb][kd], qf[kd], acc);
#pragma unroll
                for (int r = 0; r < 4; ++r) { const unsigned idx = 16 * nk + 4 * fq + r; const float v = __uint_as_float((__float_as_uint(acc[r]) & ~0x7Fu) | idx);
                    if (nk < 4) a[4 * nk + r] = v; else b[4 * (nk - 4) + r] = v; } }
            __builtin_amdgcn_sched_barrier(0);
        }
        sort16_desc(a); sort16_desc(b); merge16_desc(a, b);
#pragma unroll
        for (int i = 0; i < 16; ++i) b[i] = __shfl_xor(a[i], 16);
        __builtin_amdgcn_sched_barrier(0);
        merge16_desc(a, b);
#pragma unroll
        for (int i = 0; i < 16; ++i) b[i] = __shfl_xor(a[i], 32);
        __builtin_amdgcn_sched_barrier(0);
        merge16_desc(a, b);
#pragma unroll
        for (int i = 0; i < 16; ++i) { const unsigned bits = __float_as_uint(a[i]); const float v = __uint_as_float(bits & ~0x7Fu); const int id = (int)(bits & 0x7Fu);
            if (p2 == 0) { s1[i] = v; i1[i] = id; } else { s2[i] = v; i2[i] = id; } }
    }
    float tv[16], gv[16]; int tp[16], gp[16];
    { float v0[16], v1[16], v2[16]; int q0[16], q1[16], q2[16]; float v3a, v3b; int q3a, q3b;
      { int ci = 0;
#define CX(A, B) v0[ci] = s1[A] + s2[B]; q0[ci] = i1[A] * 128 + i2[B]; ++ci;
        CAND_G0(CX) }
#undef CX
      { int ci = 0;
#define CX(A, B) v1[ci] = s1[A] + s2[B]; q1[ci] = i1[A] * 128 + i2[B]; ++ci;
        CAND_G1(CX) }
#undef CX
      { int ci = 0;
#define CX(A, B) v2[ci] = s1[A] + s2[B]; q2[ci] = i1[A] * 128 + i2[B]; ++ci;
        CAND_G2(CX) }
#undef CX
      v3a = s1[14] + s2[0]; q3a = i1[14] * 128 + i2[0]; v3b = s1[15] + s2[0]; q3b = i1[15] * 128 + i2[0];
#pragma unroll
      for (int i = 0; i < 16; ++i) { const float w3 = i == 0 ? v3a : (i == 1 ? v3b : -1e30f); const int r3 = i == 0 ? q3a : (i == 1 ? q3b : 0);
          tv[i] = fq == 0 ? v0[i] : (fq == 1 ? v1[i] : (fq == 2 ? v2[i] : w3)); tp[i] = fq == 0 ? q0[i] : (fq == 1 ? q1[i] : (fq == 2 ? q2[i] : r3)); } }
    sort16p_desc(tv, tp);
#pragma unroll
    for (int i = 0; i < 16; ++i) { gv[i] = __shfl_xor(tv[i], 16); gp[i] = __shfl_xor(tp[i], 16); }
    __builtin_amdgcn_sched_barrier(0);
    merge16p_desc(tv, tp, gv, gp);
#pragma unroll
    for (int i = 0; i < 16; ++i) { gv[i] = __shfl_xor(tv[i], 32); gp[i] = __shfl_xor(tp[i], 32); }
    __builtin_amdgcn_sched_barrier(0);
    merge16p_desc(tv, tp, gv, gp);
    float sum = 0.f; const float tmx = tv[0];
#pragma unroll
    for (int i = 0; i < 16; ++i) { tv[i] = expf(tv[i] - tmx); sum += tv[i]; }
    const float rsum = 1.f / sum;
    if (fq == 0) {
        int* IDX = (int*)(p.ws + WS_IDX) + (size_t)row * 128 + hh * 16; float* GT = (float*)(p.ws + WS_GATE) + (size_t)row * 128 + hh * 16;
#pragma unroll
        for (int i = 0; i < 16; i += 4) {
            *(int4*)(IDX + i) = make_int4(tp[i], tp[i + 1], tp[i + 2], tp[i + 3]);
            *(f32x4*)(GT + i) = (f32x4){tv[i] * rsum, tv[i + 1] * rsum, tv[i + 2] * rsum, tv[i + 3] * rsum};
        }
    }
}

typedef int i32x4 __attribute__((ext_vector_type(4)));
__device__ __forceinline__ float gelu_erf(float x) { return 0.5f * x * (1.f + erff(x * 0.70710678118654752f)); }
typedef float f32x2 __attribute__((ext_vector_type(2)));
__device__ __forceinline__ void acc_row16(f32x2 (&y)[8], const i32x4 w, float cf) {
    const f32x2 cf2 = {cf, cf};
#pragma unroll
    for (int d = 0; d < 4; ++d) { const unsigned u = (unsigned)w[d];
        const f32x2 a = {(float)(u & 0xffu), (float)((u >> 8) & 0xffu)}, b = {(float)((u >> 16) & 0xffu), (float)(u >> 24)};
        y[2 * d] = __builtin_elementwise_fma(cf2, a, y[2 * d]); y[2 * d + 1] = __builtin_elementwise_fma(cf2, b, y[2 * d + 1]); }
}
template <int N> __device__ __forceinline__ void reduce_scatter_g(float (&y)[N]) {
#pragma unroll
    for (int i = 0; i < N; ++i) y[i] += __builtin_bit_cast(float, __builtin_amdgcn_mov_dpp(__builtin_bit_cast(int, y[i]), 0x128  , 0xf, 0xf, false));
#pragma unroll
    for (int i = 0; i < N / 2; ++i) { const auto r = __builtin_amdgcn_permlane16_swap(__float_as_uint(y[i]), __float_as_uint(y[N / 2 + i]), false, false); y[i] = __uint_as_float(r[0]) + __uint_as_float(r[1]); }
#pragma unroll
    for (int i = 0; i < N / 4; ++i) { const auto r = __builtin_amdgcn_permlane32_swap(__float_as_uint(y[i]), __float_as_uint(y[N / 4 + i]), false, false); y[i] = __uint_as_float(r[0]) + __uint_as_float(r[1]); }
}
__device__ __forceinline__ void dot_rows4(int (&yi)[16], const i32x4 a, const i32x4 b, const i32x4 c, const i32x4 d, int cq) {
#pragma unroll
    for (int k = 0; k < 4; ++k) {
        const unsigned ablo = __builtin_amdgcn_perm((unsigned)b[k], (unsigned)a[k], 0x05010400u), abhi = __builtin_amdgcn_perm((unsigned)b[k], (unsigned)a[k], 0x07030602u);
        const unsigned cdlo = __builtin_amdgcn_perm((unsigned)d[k], (unsigned)c[k], 0x05010400u), cdhi = __builtin_amdgcn_perm((unsigned)d[k], (unsigned)c[k], 0x07030602u);
        yi[4 * k + 0] = __builtin_amdgcn_sdot4((int)__builtin_amdgcn_perm(cdlo, ablo, 0x05040100u), cq, yi[4 * k + 0], false);
        yi[4 * k + 1] = __builtin_amdgcn_sdot4((int)__builtin_amdgcn_perm(cdlo, ablo, 0x07060302u), cq, yi[4 * k + 1], false);
        yi[4 * k + 2] = __builtin_amdgcn_sdot4((int)__builtin_amdgcn_perm(cdhi, abhi, 0x05040100u), cq, yi[4 * k + 2], false);
        yi[4 * k + 3] = __builtin_amdgcn_sdot4((int)__builtin_amdgcn_perm(cdhi, abhi, 0x07060302u), cq, yi[4 * k + 3], false);
    }
}
__device__ __forceinline__ void ph_peer_gather(const Params& p, int l, LAS unsigned char* lds, int lane, int wave, int vcu, int tid, bool dry  ) {
    asm volatile("" : "+v"(lane));
    const int g = lane >> 3, c = lane & 7, m0 = vcu * 33;
    LAS int* idxL = (LAS int*)lds;
    LAS float* gatL = (LAS float*)(lds + 16896);
    LAS float* coefL = (LAS float*)(lds + 33792);
    const int* IDX = (const int*)(p.ws + WS_IDX) + (size_t)m0 * 128; const float* GT = (const float*)(p.ws + WS_GATE) + (size_t)m0 * 128;
    __syncthreads();
    { int iv[9]; float gv[9];
#pragma unroll
      for (int k = 0; k < 9; ++k) { const int i = tid + 512 * k; const bool ok = i < 33 * 128; iv[k] = ok ? IDX[i] : 0; gv[k] = ok ? GT[i] : 0.f; }
#pragma unroll
      for (int k = 0; k < 9; ++k) { const int i = tid + 512 * k; if (i < 33 * 128) { idxL[i] = iv[k]; gatL[i] = gv[k]; } } }
    __syncthreads();
    const unsigned char* H8 = p.ws + WS_H8; const float* SH = (const float*)(p.ws + WS_SH); const float* HSQ = (const float*)(p.ws + WS_SH + 512 * 1024);
    const float* SU = (const float*)(p.ws + WS_SU) + l * 16384; const float* SV = (const float*)(p.ws + WS_SV) + l * 16384;
    const unsigned char* U8 = p.ws + WS_U8 + (size_t)l * (32 * MiB); const unsigned char* V8 = p.ws + WS_V8 + (size_t)l * (32 * MiB);
    const __amdgpu_buffer_rsrc_t ru = __builtin_amdgcn_make_buffer_rsrc((void*)U8, 0, 16 << 20, 0x00020000), rv = __builtin_amdgcn_make_buffer_rsrc((void*)V8, 0, 32 << 20, 0x00020000);
    float* DELTA = (float*)(p.ws + WS_DELTA);
    const float* gmod = (const float*)(p.ws + WS_MOD) + ((size_t)l * 2 + (m0 >= T ? 1 : 0)) * D6 + 5 * D;
    unsigned off[33][2];
#pragma unroll
    for (int ui = 0; ui < 33; ++ui)
#pragma unroll
        for (int i = 0; i < 2; ++i) { const int mi = ui < 32 ? 4 * wave + (ui >> 3) : 32, hd = ui < 32 ? (ui & 7) : wave;
            off[ui][i] = (unsigned)idxL[mi * 128 + hd * 16 + 8 * i + g] * 128u + 16u * c; }
    int acc[33][2];
#pragma unroll
    for (int ui = 0; ui < 33; ++ui) { acc[ui][0] = 0; acc[ui][1] = 0; }
#pragma unroll 1
    for (int j = 0; j < 8; ++j) {
        const int so = j << 21;
        i32x4 w[2][4][2], hq[2];
#define U_LOAD(B, U0) do { _Pragma("unroll") for (int uu_ = 0; uu_ < 4; ++uu_) _Pragma("unroll") for (int i_ = 0; i_ < 2; ++i_) if ((U0) + uu_ < 33) \
            w[B][uu_][i_] = __builtin_bit_cast(i32x4, __builtin_amdgcn_raw_buffer_load_b128(ru, off[(U0) + uu_][i_], so, 0)); } while (0)
#define H_LOAD(U0) do { const int mi_ = (U0) < 32 ? 4 * wave + ((U0) >> 3) : 32; const unsigned char* hb_ = H8 + (size_t)(m0 + mi_) * D + j * 256 + 32 * c; hq[0] = *(const i32x4*)hb_; hq[1] = *(const i32x4*)(hb_ + 16); } while (0)
        H_LOAD(0); U_LOAD(0, 0);
#pragma unroll
        for (int u0 = 0; u0 < 36; u0 += 4) {
            const int B = (u0 >> 2) & 1;
            if (u0 + 4 < 36) { if (B) U_LOAD(0, u0 + 4); else U_LOAD(1, u0 + 4); }
#pragma unroll
            for (int uu = 0; uu < 4; ++uu)
#pragma unroll
                for (int i = 0; i < 2; ++i) if (u0 + uu < 33) { const int ui = u0 + uu;
                    int a = acc[ui][i];
#pragma unroll
                    for (int k = 0; k < 4; ++k) { const unsigned ww = (unsigned)w[B][uu][i][k]; const i32x4 hh = hq[k >> 1];
                        a = __builtin_amdgcn_sdot4((int)(ww & 0x0F0F0F0Fu), hh[2 * (k & 1)], a, false); a = __builtin_amdgcn_sdot4((int)((ww >> 4) & 0x0F0F0F0Fu), hh[2 * (k & 1) + 1], a, false); }
                    acc[ui][i] = a; }
            if (B && u0 + 4 < 36) H_LOAD(u0 + 4);
            __builtin_amdgcn_sched_barrier(0);
        }
#undef H_LOAD
#undef U_LOAD
    }
#pragma unroll
    for (int ui = 0; ui < 33; ++ui)
#pragma unroll
        for (int i = 0; i < 2; ++i) { const int mi = ui < 32 ? 4 * wave + (ui >> 3) : 32, hd = ui < 32 ? (ui & 7) : wave, k = hd * 16 + 8 * i + g;
            int t = acc[ui][i]; t += __shfl_xor(t, 1); t += __shfl_xor(t, 2); t += __shfl_xor(t, 4);
            if (c == 0) coefL[mi * 128 + k] = (float)t; }
    __syncthreads();
    {
        float su[9], sv[9], hs[9], sh[9];
#pragma unroll
        for (int k = 0; k < 9; ++k) { const int it = tid + 512 * k; const bool ok = it < 33 * 128; const int mi = ok ? (it >> 7) : 0, e = ok ? idxL[it] : 0;
            su[k] = SU[e]; sv[k] = SV[e]; hs[k] = HSQ[m0 + mi]; sh[k] = SH[m0 + mi]; }
        __builtin_amdgcn_sched_barrier(0);
#pragma unroll
        for (int k = 0; k < 9; ++k) { const int it = tid + 512 * k;
            if (it < 33 * 128) { const float pd = (coefL[it] - 8.f * hs[k]) * su[k] * sh[k];
                coefL[it] = gatL[it] * gelu_erf(pd) * sv[k]; } }
    }
    __syncthreads();
    LAS int* cfqL = (LAS int*)(lds + 50688);
    LAS int* cfq32L = (LAS int*)(lds + 54912);
    LAS float* sTL = (LAS float*)(lds + 55040);
#pragma unroll 1
    for (int tk = 0; tk < 5; ++tk) {
        if (tk == 4 && wave != 0) break;
        const int mi = tk < 4 ? 4 * wave + tk : 32;
        const float am = wave_max(fmaxf(fabsf(coefL[mi * 128 + lane]), fabsf(coefL[mi * 128 + 64 + lane])));
        const float inv = am > 0.f ? 127.f / am : 0.f;
        if (lane == 0) sTL[mi] = am > 0.f ? am * (1.f / 127.f) : 0.f;
        if (lane < 32) { const int hq = lane >> 4, i = (lane >> 3) & 1, g_ = lane & 7; unsigned pk = 0;
#pragma unroll
            for (int uu = 0; uu < 4; ++uu) { const int q = (int)rintf(coefL[mi * 128 + (4 * hq + uu) * 16 + 8 * i + g_] * inv); pk |= ((unsigned)q & 0xffu) << (8 * uu); }
            cfqL[mi * 32 + lane] = (int)pk;
            if (tk == 4) { const int qd = lane >> 3; unsigned p2 = 0;
#pragma unroll
                for (int r = 0; r < 4; ++r) { const int q = (int)rintf(coefL[32 * 128 + 32 * qd + 8 * r + g_] * inv); p2 |= ((unsigned)q & 0xffu) << (8 * r); }
                cfq32L[lane] = (int)p2; } }
    }
    __syncthreads();
    i32x4 w[2][4][2]; int cfq[2][2];
#define V_LOAD(B, HB, SO) do { const int ts_ = (HB) >> 1, hq_ = (HB) & 1, mi_ = 4 * wave + ts_; _Pragma("unroll") for (int uu_ = 0; uu_ < 4; ++uu_) _Pragma("unroll") for (int i_ = 0; i_ < 2; ++i_) \
            w[B][uu_][i_] = __builtin_bit_cast(i32x4, __builtin_amdgcn_raw_buffer_load_b128(rv, off[ts_ * 8 + 4 * hq_ + uu_][i_], (SO), 0)); \
        cfq[B][0] = cfqL[mi_ * 32 + (hq_ * 2 + 0) * 8 + g]; cfq[B][1] = cfqL[mi_ * 32 + (hq_ * 2 + 1) * 8 + g]; } while (0)
    V_LOAD(0, 0, 0);
#pragma unroll 1
    for (int j = 0; j < 16; ++j) {
        const int so = j << 21;
        int yi[16];
#pragma unroll
        for (int hb = 0; hb < 8; ++hb) {
            const int B = hb & 1, ts = hb >> 1, mi = 4 * wave + ts;
            if (hb + 1 < 8) { if (B) V_LOAD(0, hb + 1, so); else V_LOAD(1, hb + 1, so); }
            else if (j + 1 < 16) V_LOAD(0, 0, (j + 1) << 21);
            if (!B) {
#pragma unroll
                for (int q = 0; q < 16; ++q) yi[q] = 0; }
#pragma unroll
            for (int i = 0; i < 2; ++i) dot_rows4(yi, w[B][0][i], w[B][1][i], w[B][2][i], w[B][3][i], cfq[B][i]);
            if (B) {
                float y[16];
#pragma unroll
                for (int q = 0; q < 16; ++q) y[q] = (float)yi[q];
                reduce_scatter_g<16>(y);
                const float st = sTL[mi];
                float* dp = DELTA + (size_t)(m0 + mi) * D + j * 128 + 16 * c + ((lane & 16) ? 8 : 0) + ((lane & 32) ? 4 : 0) + ((lane & 8) ? 2 : 0);
                { const bool b3 = (lane & 8) != 0; *(float2*)dp = make_float2((b3 ? y[2] : y[0]) * st, (b3 ? y[3] : y[1]) * st); }
            }
            __builtin_amdgcn_sched_barrier(0);
        }
#undef V_LOAD
    }
    {
        const float st = sTL[32];
        const int m = m0 + 32;
#pragma unroll 1
        for (int jj = 0; jj < 2; ++jj) { const int j = 2 * wave + jj; const int so = j << 21;
            int yi[16];
#pragma unroll
            for (int q = 0; q < 16; ++q) yi[q] = 0;
#pragma unroll
            for (int k0 = 0; k0 < 16; k0 += 8) {
                i32x4 w8[8];
#pragma unroll
                for (int kk = 0; kk < 8; ++kk) w8[kk] = __builtin_bit_cast(i32x4, __builtin_amdgcn_raw_buffer_load_b128(rv, (unsigned)idxL[32 * 128 + 8 * (k0 + kk) + g] * 128u + 16u * c, so, 0));
                const int c0 = cfq32L[(k0 / 4) * 8 + g], c1 = cfq32L[(k0 / 4 + 1) * 8 + g];
                dot_rows4(yi, w8[0], w8[1], w8[2], w8[3], c0); dot_rows4(yi, w8[4], w8[5], w8[6], w8[7], c1);
                __builtin_amdgcn_sched_barrier(0);
            }
            float y[16];
#pragma unroll
            for (int q = 0; q < 16; ++q) y[q] = (float)yi[q];
            reduce_scatter_g<16>(y);
            float* dp = DELTA + (size_t)m * D + j * 128 + 16 * c + ((lane & 16) ? 8 : 0) + ((lane & 32) ? 4 : 0) + ((lane & 8) ? 2 : 0);
            { const bool b3 = (lane & 8) != 0; *(float2*)dp = make_float2((b3 ? y[2] : y[0]) * st, (b3 ? y[3] : y[1]) * st); }
        }
    }
    (void)gmod;
    {
        asm volatile("s_waitcnt vmcnt(0)" ::: "memory");
        __syncthreads();
#pragma unroll 1
        for (int mi = wave; mi < 33; mi += NWAVES) peer_tail_row(p, l, m0 + mi, lane);
    }
    (void)dry;
}

__device__ __forceinline__ Params load_params(const CAS Params* k) {
    Params r;
#define LP(f) r.f = k->f;
    LP(x) LP(c) LP(ctx) LP(c_ctx) LP(ada_w) LP(ada_b) LP(norm1_g) LP(norm2_g) LP(ab_w_in) LP(ab_gate_b) LP(ab_mh_g) LP(ab_sink) LP(ab_w_out)
    LP(na_w_in) LP(na_rpb) LP(na_w_out) LP(peer_wq) LP(peer_keys) LP(peer_u) LP(peer_v) LP(final_g) LP(out) LP(ws) LP(ph_lo) LP(ph_hi) LP(grid)
#undef LP
    return r;
}
__device__ __forceinline__ int lane_id_opaque() { int x; asm volatile("v_mbcnt_lo_u32_b32 %0, -1, 0\n\tv_mbcnt_hi_u32_b32 %0, -1, %0" : "=v"(x)); return x; }
constexpr int PH_PER_LAYER = 10, PH_FINAL = 1 + DEPTH * PH_PER_LAYER, N_PHASES = PH_FINAL + 1;
template <unsigned PH_MASK> __global__ void __launch_bounds__(NWAVES * 64, 2) fwd_kernel(Params p) {
    extern __shared__ __attribute__((aligned(16))) unsigned char lds_raw[];
    LAS unsigned char* lds = (LAS unsigned char*)lds_raw;
    const int wave = __builtin_amdgcn_readfirstlane((int)threadIdx.x >> 6);
#define LANE_ID() lane_id_opaque()
#define KQ() const CAS Params* kq_ = (const CAS Params*)__builtin_amdgcn_kernarg_segment_ptr(); asm volatile("" : "+s"(kq_))
    volatile LAS unsigned* MISC = (volatile LAS unsigned*)(lds + LDS_MISC);
    if (wave == 0) MISC[LANE_ID()] = 0u;
    __syncthreads();
    { KQ(); (void)xcd_barrier_post((unsigned*)(kq_->ws + WS_CTL) + 4096, MISC + 8, wave * 64 + LANE_ID()); }
#ifdef STAMP_PROBE
#define STAMP_PRE(k) const unsigned long long st0_ = wall_clock64()
#define STAMP_POST(k) do { if (wave * 64 + LANE_ID() == 0) { KQ(); unsigned* sp_ = (unsigned*)(kq_->ws + WS_END); const unsigned long long st1_ = wall_clock64(); \
        sp_[(k) * 256 + blockIdx.x] = (unsigned)(st1_ - st0_); sp_[(64 + (k)) * 256 + blockIdx.x] = (unsigned)st0_; sp_[(128 + (k)) * 256 + blockIdx.x] = (unsigned)st1_; } } while (0)
#else
#define STAMP_PRE(k) do {} while (0)
#define STAMP_POST(k) do {} while (0)
#endif
#define PM(k) (((PH_MASK) >> (k)) & 1u)
#ifndef REP_MASK
#define REP_MASK 0u
#endif
#define REPEAT(k) for (int rep_ = 0; rep_ <= (int)(((REP_MASK) >> (k)) & 1u); ++rep_)
#define IN(k) ({ KQ(); const int k_ = (k); (kq_->ph_lo <= k_ && k_ < kq_->ph_hi); })
#define SEAM(k) do { KQ(); const int k_ = (k); if (kq_->ph_lo <= k_ && k_ + 1 < kq_->ph_hi) { XcdBarrier b_; b_.bar = (unsigned*)(kq_->ws + WS_CTL) + 4096; b_.x = xb_xcc_id(); b_.st = MISC + 8; \
        STAMP_PRE(k_); xcd_barrier(b_, wave * 64 + LANE_ID()); STAMP_POST(k_); } } while (0)
#define LAUNDER() KQ(); const Params pl = load_params(kq_); unsigned char* ws = pl.ws; int ll = LANE_ID(); asm volatile("" : "+v"(ll)); const int tid = wave * 64 + ll; \
    const int G = pl.grid, bx = blockIdx.x, vcu = (G % 8 == 0) ? (bx % 8) * (G / 8) + bx / 8 : bx, gw = vcu * NWAVES + wave, NGW = G * NWAVES; (void)ws; (void)ll; (void)tid; (void)vcu; (void)gw; (void)NGW
    if (PM(0) && IN(0)) REPEAT(0) { LAUNDER(); ph_prologue(pl, lds, tid, ll, wave, vcu, G); __syncthreads(); }
    SEAM(0);
    for (int l = 0; l < DEPTH; ++l) {
        const int pb = 1 + l * PH_PER_LAYER; const bool even = (l & 1) == 0; const int ei = l >> 1; const bool with_ctx = l < DEPTH - 1;
        if (PM(1) && IN(pb + 0) && l == 0) REPEAT(1) { LAUNDER(); ph_norm(pl, l, 0, ll, gw, NGW); ph_fold_wq(pl, lds, ll, wave, gw, NGW); }
        if (l == 0) SEAM(pb + 0);
        if (PM(2) && IN(pb + 1)) REPEAT(2) {
            LAUNDER();
            if (l == 0) ph_fold_bias(pl, ll, gw, NGW);
            const int N = even ? NAB : NNA;
            pg8::Gemm g{(const bf16_t*)(ws + WS_H), even ? (const bf16_t*)(ws + WS_WAB_IN) + (size_t)ei * NAB * D : (const bf16_t*)(ws + WS_WNA_IN) + (size_t)ei * NNA * D, M, N, D};
            pg8::StaticOrder S; S.init(M, N, G, bx);
            EpiInProj E{EpiEven{ws + WS_PROJ, pl.ab_gate_b + ei * 32, (const float2*)(ws + WS_ROPE)}, EpiOdd{ws + WS_PROJ}, even};
            pg8::gemm_phase<EpiInProj, pg8::StaticOrder, false>(lds, g, S, E, nullptr, tid);
            peer_convert_deferred(pl, l, bx, G, wave, ll);
        }
        SEAM(pb + 1);
        if (PM(3) && IN(pb + 2)) REPEAT(3) {
            LAUNDER();
            if (even) { ph_attn_even(pl, ei, with_ctx, lds, tid, ll, wave, vcu, G);
                for (int q = gw; q < NCH * 16; q += NGW) mlstm_A_unit(pl, q >> 4, q & 15, ll); }
            else ph_attn_odd(pl, ei, with_ctx, lds, tid, ll, wave, vcu, G);
        }
        SEAM(pb + 2);
        if (PM(4) && IN(pb + 3)) REPEAT(4) { LAUNDER(); if (even) ph_mlstm_B(pl, lds, tid, G); }
        if (even) SEAM(pb + 3);
        if (PM(5) && IN(pb + 4)) REPEAT(5) { LAUNDER(); if (even) mlstm_C_wg(pl, ei, lds, tid, ll, wave, vcu, G); }
        if (even) SEAM(pb + 4);
        if (PM(6) && IN(pb + 5)) {
            LAUNDER();
            const float* MODl = (const float*)(ws + WS_MOD) + (size_t)l * 2 * D6;
            pg8::Gemm g{(const bf16_t*)(ws + WS_MIX), even ? (const bf16_t*)(ws + WS_WAB_OUT) + (size_t)ei * D * D : (const bf16_t*)(ws + WS_WNA_OUT) + (size_t)ei * D * D, T, D, D};
            pg8::StaticOrder S; S.init(T, D, G, bx);
            EpiResid E{(float*)(ws + WS_X), MODl + 2 * D, MODl + D6 + 2 * D, l == 0 ? pl.x : (const float*)(ws + WS_X), l == 0 ? pl.ctx : (const float*)(ws + WS_X) + (size_t)T * D,
                       ws + WS_XB, (float*)(ws + WS_PART), (float*)(ws + WS_PARTC)};
            pg8::gemm_phase<EpiResid, pg8::StaticOrder, false>(lds, g, S, E, nullptr, tid);
            if (with_ctx) ctx_gemm(g.A, g.Bt, D, E, wave, ll, vcu, G);
        }
        SEAM(pb + 5);
        if (PM(8) && IN(pb + 7)) REPEAT(8) {
            LAUNDER();
            pg8::Gemm g{(const bf16_t*)(ws + WS_XB), (const bf16_t*)(ws + WS_WQ) + (size_t)l * D * D, T, D, D};
            pg8::StaticOrder S; S.init(T, D, G, bx);
            EpiQ E{(bf16_t*)(ws + WS_QP), (const float*)(ws + WS_PART), (const float*)(ws + WS_BQ) + (size_t)(l * 2) * D};
            pg8::gemm_phase<EpiQ, pg8::StaticOrder, false>(lds, g, S, E, nullptr, tid);
            const int cpc = G - 1 - vcu;
            if (with_ctx && cpc < 128) { int l2 = ll; asm volatile("" : "+v"(l2)); EpiQC Ec{(bf16_t*)(ws + WS_QP), (const float*)(ws + WS_PARTC), (const float*)(ws + WS_BQ) + (size_t)(l * 2 + 1) * D};
                ctx_gemm_piece<EpiQC, 2>(g.A, (const bf16_t*)(ws + WS_WQC) + (size_t)l * D * D, Ec, cpc & 15, cpc >> 4, wave, l2); }
            asm volatile("s_waitcnt vmcnt(0)" ::: "memory");
            __syncthreads();
            { pg8::Unit u; const bool has = S.next(0, u);
#pragma unroll 1
              for (int j = 0; j < 3; ++j) {
                  const bool ok = j < 2 ? has : (with_ctx && cpc < 128 && wave == 0);
                  const int mt = j < 2 ? u.pm * 16 + 8 * j + wave : 512 + (cpc & 15), hh = j < 2 ? u.pn : (cpc >> 4);
                  if (ok) peer_topk_unit(pl, l, mt, hh, ll); } }
            { int l3 = ll; asm volatile("" : "+v"(l3));
              if (!with_ctx) h8_rows<33>(pl, l, vcu * 33, l3, wave); else if (vcu < 128) h8_rows<66>(pl, l, vcu * 66, l3, wave); }
        }
        SEAM(pb + 7);
        if (PM(10) && IN(pb + 9)) REPEAT(10) { LAUNDER(); ph_peer_gather(pl, l, lds, ll, wave, vcu, tid, rep_ < (int)(((REP_MASK) >> 10) & 1u)); }
        if (l + 1 < DEPTH) SEAM(pb + 9);
    }
#ifdef STAMP_PROBE
    {
        { KQ(); XcdBarrier b_; b_.bar = (unsigned*)(kq_->ws + WS_CTL) + 4096; b_.x = xb_xcc_id(); b_.st = MISC + 8; xcd_barrier(b_, wave * 64 + LANE_ID()); }
        LAUNDER();
        const unsigned* ST = (const unsigned*)(ws + WS_END);
        float smean = 0.f, smax = 0.f;
        for (int w = ll; w < 256; w += 64) { const float d = (float)(ST[(64 + STAMP_SEL) * 256 + w] - ST[(128 + STAMP_PREV) * 256 + w]) * 0.01f; smean += d; smax = fmaxf(smax, d); }
        smean = wave_sum(smean) * (1.f / 256.f); smax = wave_max(smax);
        const float c1 = smax * 0.05f, c2 = 0.f; (void)smean;
        for (size_t i = (size_t)bx * 512 + tid; i < (size_t)T * D; i += (size_t)G * 512) pl.out[i] = c1 + c2;
    }
#endif
#undef IN
#undef SEAM
#undef LAUNDER
#undef LANE_ID
#undef KQ
#undef PM
}

#ifndef ONE_MASK
#define ONE_MASK 0xFFFu
#endif
#ifndef MK_ONE_LAUNCH
#define MK_ONE_LAUNCH 1
#endif
typedef void (*kern_t)(Params);
#if !MK_ONE_LAUNCH
static kern_t kern_for_bit(int b) {
    switch (b) {
        case 0: return fwd_kernel<1u << 0>; case 1: return fwd_kernel<1u << 1>; case 2: return fwd_kernel<1u << 2>; case 3: return fwd_kernel<1u << 3>;
        case 4: return fwd_kernel<1u << 4>; case 5: return fwd_kernel<1u << 5>; case 6: return fwd_kernel<1u << 6>; case 7: return fwd_kernel<1u << 7>;
        case 8: return fwd_kernel<1u << 8>; case 9: return fwd_kernel<1u << 9>; case 10: return fwd_kernel<1u << 10>; default: return fwd_kernel<1u << 11>;
    }
}
#endif
extern "C" void kernel_launch(void* const* d_in, const int* in_sizes, int n_in, void* d_out, int out_size, void* d_ws, size_t ws_size, hipStream_t stream) {
    static int grid = 0;
    if (grid == 0) {
        int dev = 0, cus = 0;
        if (n_in != 21 || ws_size < WS_END) { fprintf(stderr, "kernel_launch: unexpected inputs (n_in %d, ws %zu)\n", n_in, ws_size); grid = -1; return; }
        if (hipGetDevice(&dev) != hipSuccess || hipDeviceGetAttribute(&cus, hipDeviceAttributeMultiprocessorCount, dev) != hipSuccess) { grid = -1; return; }
#if MK_ONE_LAUNCH
        if (hipFuncSetAttribute((const void*)fwd_kernel<ONE_MASK>, hipFuncAttributeMaxDynamicSharedMemorySize, LDS_BYTES) != hipSuccess) { fprintf(stderr, "kernel_launch: hipFuncSetAttribute failed\n"); grid = -1; return; }
#else
        for (int b = 0; b < 12; ++b) if (hipFuncSetAttribute((const void*)kern_for_bit(b), hipFuncAttributeMaxDynamicSharedMemorySize, LDS_BYTES) != hipSuccess) { fprintf(stderr, "kernel_launch: hipFuncSetAttribute failed\n"); grid = -1; return; }
#endif
        (void)hipGetLastError();
        grid = cus;
    }
    if (grid < 0) return;
    (void)hipMemsetAsync((char*)d_ws + WS_CTL, 0, CTL_ZERO_BYTES, stream);
#ifdef STAMP_PROBE
    (void)hipMemsetAsync((char*)d_ws + WS_END, 0, 192 * 256 * 4, stream);
#endif
    Params p{};
    const float** pin = (const float**)&p;
    for (int i = 0; i < 21; ++i) pin[i] = (const float*)d_in[i];
    p.out = (float*)d_out; p.ws = (unsigned char*)d_ws; p.grid = grid; p.pad = 0;
#if MK_ONE_LAUNCH
    p.ph_lo = 0; p.ph_hi = N_PHASES;
    hipLaunchKernelGGL(fwd_kernel<ONE_MASK>, dim3(grid), dim3(NWAVES * 64), LDS_BYTES, stream, p);
#else
    for (int ph = 0; ph < N_PHASES; ++ph) {
        int bit = 0;
        if (ph == PH_FINAL) bit = 11;
        else if (ph >= 1) { const int l = (ph - 1) / PH_PER_LAYER, k = (ph - 1) % PH_PER_LAYER; if ((l & 1) && (k == 3 || k == 4)) continue; bit = 1 + k; }
        p.ph_lo = ph; p.ph_hi = ph + 1;
        hipLaunchKernelGGL(kern_for_bit(bit), dim3(grid), dim3(NWAVES * 64), LDS_BYTES, stream, p);
    }
#endif
}
```

```cpp
#include <hip/hip_runtime.h>
#include <cstdio>
#include <cstdint>
namespace pg8 {
#define PG8_LAS __attribute__((address_space(3)))
typedef unsigned short bf16_t;
typedef short bf16x8 __attribute__((ext_vector_type(8)));
typedef float f32x4 __attribute__((ext_vector_type(4)));
typedef unsigned u32x4 __attribute__((ext_vector_type(4)));
constexpr int BM = 256, BK = 64, HALF = 128, HTB = HALF * BK * 2  , STAGE_BYTES = 8 * HTB, NXCD = 8, WGM = 8;

__host__ __device__ __forceinline__ int lds_byte(int r, int c) { const int st = (r >> 4) * 2 + (c >> 5), rr = r & 15, cc = c & 31, ob = rr * 64 + cc * 2; return st * 1024 + (ob ^ (((ob >> 9) & 1) << 5)); }
__host__ __device__ __forceinline__ void stage_rc(int b, int& R, int& C) { const int st = b / 1024, sb = b % 1024, swz = sb ^ (((sb >> 9) & 1) << 5); R = (st >> 1) * 16 + swz / 64; C = (st & 1) * 32 + (swz % 64) / 2; }
__host__ __device__ __forceinline__ int perm32(int rho) { const int n = rho >> 4, i = rho & 15; return 8 * (i >> 2) + 4 * n + (i & 3); }

struct Unit { int pm, pn; };
struct Gemm { const bf16_t* A; const bf16_t* Bt; int M, N, K; };

struct StaticOrder {
    int nM, nN, nwg, G, c;
    __host__ __device__ void init(int M, int N, int G_, int c_) { nM = M / BM; nN = N / BM; nwg = nM * nN; G = G_; c = c_; }
    __host__ __device__ __forceinline__ bool next(int i, Unit& u) const {
        const long L = (long)i * G + c; if (L >= nwg) return false;
        int wgid = (int)L; { const int q = nwg / NXCD, r = nwg % NXCD, xcd = wgid % NXCD, off = wgid / NXCD; wgid = (xcd < r ? xcd * (q + 1) : r * (q + 1) + (xcd - r) * q) + off; }
        const int nig = WGM * nN, gid = wgid / nig, fm = gid * WGM, gsz = (nM - fm) < WGM ? (nM - fm) : WGM;
        u.pm = fm + ((wgid % nig) % gsz); u.pn = (wgid % nig) / gsz; return true;
    }
    __device__ __forceinline__ void a_ready(const Unit&) const {}
    __device__ __forceinline__ void done(const Unit&) const {}
};
__device__ __forceinline__ unsigned cvt_pk_bf16(float lo, float hi) { unsigned r; asm volatile("s_nop 1\n\tv_cvt_pk_bf16_f32 %0, %1, %2\n\ts_nop 1" : "=v"(r) : "v"(lo), "v"(hi)); return r; }
template <class Epi, class Sched, bool STAMP = false>
__device__ __forceinline__ void gemm_phase(PG8_LAS unsigned char* lds, const Gemm g, const Sched& S, const Epi& E, unsigned long long* stamps, int tid_in) {
    int tid_l = tid_in; asm volatile("" : "+v"(tid_l));
    const int tid = tid_l, wid = __builtin_amdgcn_readfirstlane(tid >> 6), lane = tid & 63, wr = wid >> 2, wc = wid & 3, fr = lane & 15, fq = lane >> 4;
    const int K = g.K, nt = K / BK;
    int ts_lo = 0, ts_hi = 0, nts = 0; const unsigned long long rt_entry = STAMP ? (unsigned long long)wall_clock64() : 0ull;
#define PG8_STAMP() do { if (STAMP && wid == 0 && nts < 64) { const unsigned long long _c = (unsigned long long)clock64(); \
        ts_lo = (lane == nts) ? (int)(unsigned)_c : ts_lo; ts_hi = (lane == nts) ? (int)(unsigned)(_c >> 32) : ts_hi; ++nts; } } while (0)
    PG8_STAMP();
    unsigned voffA[2], voffB[2];
#pragma unroll
    for (int i = 0; i < 2; ++i) { int R, C; stage_rc(tid * 16 + i * 8192, R, C); const int Rb = Epi::PERM ? ((R & ~31) + perm32(R & 31)) : R;
        voffA[i] = (unsigned)(R * K + C) * 2u; voffB[i] = (unsigned)(Rb * K + C) * 2u; }
    const size_t kstep = (size_t)(BK * 2);
    const size_t hstep = (size_t)HALF * K * 2;
    const size_t tstep = 2 * hstep;
    const unsigned ldsw = (unsigned)wid * 1024u;
    const int aoff = lds_byte(wr * 64 + fr, fq * 8), boff = lds_byte(wc * 32 + fr, fq * 8);
#define PG8_SA(b, h) (((b) * 2 + (h)) * HTB)
#define PG8_SB(b, h) ((4 + (b) * 2 + (h)) * HTB)
#define PG8_STAGE(bufoff, gbase, voff) do { _Pragma("unroll") for (int _i = 0; _i < 2; ++_i) \
        __builtin_amdgcn_global_load_lds((const unsigned*)((const char*)(gbase) + (voff)[_i]), (PG8_LAS unsigned*)(lds + (bufoff) + ldsw + _i * 8192), 16, 0, 0); } while (0)
#define PG8_LDA(dst, b, h) do { _Pragma("unroll") for (int m = 0; m < 4; ++m) _Pragma("unroll") for (int k = 0; k < 2; ++k) dst[m][k] = *(const PG8_LAS bf16x8*)(lds + PG8_SA(b, h) + aoff + m * 2048 + k * 1024); } while (0)
#define PG8_LDB(dst, b, h) do { _Pragma("unroll") for (int n = 0; n < 2; ++n) _Pragma("unroll") for (int k = 0; k < 2; ++k) dst[n][k] = *(const PG8_LAS bf16x8*)(lds + PG8_SB(b, h) + boff + n * 2048 + k * 1024); } while (0)
#define PG8_MMA(ai, bj, At, Bt) do { __builtin_amdgcn_s_setprio(1); _Pragma("unroll") for (int m = 0; m < 4; ++m) _Pragma("unroll") for (int n = 0; n < 2; ++n) _Pragma("unroll") for (int k = 0; k < 2; ++k) \
        acc[ai][bj][m][n] = __builtin_amdgcn_mfma_f32_16x16x32_bf16(Bt[n][k], At[m][k], acc[ai][bj][m][n], 0, 0, 0); __builtin_amdgcn_s_setprio(0); } while (0)
#define PG8_WAIT_V(n) asm volatile("s_waitcnt vmcnt(" #n ")" ::: "memory")
#define PG8_WAIT_L(n) asm volatile("s_waitcnt lgkmcnt(" #n ")" ::: "memory")
#define PG8_BAR __builtin_amdgcn_s_barrier()
#define PG8_SCHED __builtin_amdgcn_sched_barrier(0)
    Unit cur, nxt; int ui = 0;
    if (!S.next(0, cur)) return;
    f32x4 acc[2][2][4][2];
#pragma unroll
    for (int a = 0; a < 2; ++a)
#pragma unroll
        for (int b = 0; b < 2; ++b)
#pragma unroll
            for (int m = 0; m < 4; ++m)
#pragma unroll
                for (int n = 0; n < 2; ++n) acc[a][b][m][n] = (f32x4){0.f, 0.f, 0.f, 0.f};
    bf16x8 At[4][2], B0[2][2], B1[2][2];
    const char* cA = (const char*)g.A + (size_t)cur.pm * tstep; const char* cB = (const char*)g.Bt + (size_t)cur.pn * tstep;
    S.a_ready(cur);
    PG8_STAGE(PG8_SB(0, 0), cB, voffB); PG8_STAGE(PG8_SA(0, 0), cA, voffA); PG8_STAGE(PG8_SB(0, 1), cB + hstep, voffB); PG8_STAGE(PG8_SA(0, 1), cA + hstep, voffA);
    if (wr == 1) PG8_BAR;
    PG8_WAIT_V(4); PG8_BAR;
    PG8_STAGE(PG8_SB(1, 0), cB + kstep, voffB); PG8_STAGE(PG8_SA(1, 0), cA + kstep, voffA); PG8_STAGE(PG8_SB(1, 1), cB + hstep + kstep, voffB);
    PG8_WAIT_V(6); PG8_BAR;
    PG8_STAMP();
    for (;;) {
        const bool has_next = S.next(ui + 1, nxt);
        const char* nA = has_next ? (const char*)g.A + (size_t)nxt.pm * tstep : cA; const char* nB = has_next ? (const char*)g.Bt + (size_t)nxt.pn * tstep : cB;
        for (int t = 0; t < nt; t += 2) {
            const bool last = (t == nt - 2);
            const char* a1 = cA + (size_t)(t + 1) * kstep;
            const char* a2 = last ? nA : cA + (size_t)(t + 2) * kstep; const char* b2 = last ? nB : cB + (size_t)(t + 2) * kstep;
            const char* a3 = a2 + kstep; const char* b3 = b2 + kstep;
            if (last && has_next) S.a_ready(nxt);
            PG8_LDB(B0, 0, 0); PG8_SCHED; PG8_LDA(At, 0, 0); PG8_STAGE(PG8_SA(1, 1), a1 + hstep, voffA);
            PG8_WAIT_L(8); PG8_BAR; PG8_WAIT_L(0); PG8_MMA(0, 0, At, B0); PG8_BAR; PG8_SCHED;
            PG8_LDB(B1, 0, 1); PG8_STAGE(PG8_SB(0, 0), b2, voffB);
            PG8_BAR; PG8_WAIT_L(0); PG8_MMA(0, 1, At, B1); PG8_BAR;
            PG8_LDA(At, 0, 1); PG8_STAGE(PG8_SA(0, 0), a2, voffA);
            PG8_BAR; PG8_WAIT_L(0); PG8_MMA(1, 0, At, B0); PG8_BAR; PG8_SCHED;
            PG8_STAGE(PG8_SB(0, 1), b2 + hstep, voffB);
            PG8_WAIT_V(6); PG8_BAR; PG8_MMA(1, 1, At, B1); PG8_BAR;
            PG8_LDB(B0, 1, 0); PG8_SCHED; PG8_LDA(At, 1, 0); PG8_STAGE(PG8_SA(0, 1), a2 + hstep, voffA);
            PG8_WAIT_L(8); PG8_BAR; PG8_WAIT_L(0); PG8_MMA(0, 0, At, B0); PG8_BAR; PG8_SCHED;
            PG8_LDB(B1, 1, 1); PG8_STAGE(PG8_SB(1, 0), b3, voffB);
            PG8_BAR; PG8_WAIT_L(0); PG8_MMA(0, 1, At, B1); PG8_BAR;
            PG8_LDA(At, 1, 1); PG8_STAGE(PG8_SA(1, 0), a3, voffA);
            PG8_BAR; PG8_WAIT_L(0); PG8_MMA(1, 0, At, B0); PG8_BAR; PG8_SCHED;
            PG8_STAGE(PG8_SB(1, 1), b3 + hstep, voffB);
            PG8_WAIT_V(6); PG8_BAR; PG8_MMA(1, 1, At, B1); PG8_BAR;
        }
        PG8_STAMP();
        if constexpr (!Epi::AFTER_DRAIN) { E(acc, cur, wr, wc, fr, fq); S.done(cur); }
        PG8_STAMP();
        if (!has_next) break;
#pragma unroll
        for (int a = 0; a < 2; ++a)
#pragma unroll
            for (int b = 0; b < 2; ++b)
#pragma unroll
                for (int m = 0; m < 4; ++m)
#pragma unroll
                    for (int n = 0; n < 2; ++n) acc[a][b][m][n] = (f32x4){0.f, 0.f, 0.f, 0.f};
        cur = nxt; cA = nA; cB = nB; ++ui;
    }
    PG8_WAIT_V(0);
    if (wr == 0) PG8_BAR;
    PG8_BAR;
    if constexpr (Epi::AFTER_DRAIN) { E.fused(acc, cur, wr, wc, fr, fq, lds, wid, lane); S.done(cur); }
    PG8_STAMP();
    if (STAMP && wid == 0) { stamps[lane] = lane < nts ? (((unsigned long long)(unsigned)ts_hi << 32) | (unsigned)ts_lo) : 0ull;
        if (lane == 62) stamps[62] = rt_entry; if (lane == 63) stamps[63] = (unsigned long long)wall_clock64(); }
#undef PG8_STAMP
#undef PG8_SA
#undef PG8_SB
#undef PG8_STAGE
#undef PG8_LDA
#undef PG8_LDB
#undef PG8_MMA
#undef PG8_WAIT_V
#undef PG8_WAIT_L
#undef PG8_BAR
#undef PG8_SCHED
}
}

constexpr int D = 2048, T = 8192, LC = 256, M = T + LC, DEPTH = 4, D6 = 6 * D;
constexpr int NAB = 4864, NNA = 6144;
constexpr int NCH = M / 64;
constexpr float EPS = 1e-6f, LOG2E = 1.4426950408889634f;
constexpr int NWAVES = 8;

constexpr size_t MiB = 1u << 20;
constexpr size_t WS_CTL = 0, CTL_ZERO_BYTES = 32768;
constexpr size_t WS_MOD = 1 * MiB;
constexpr size_t WS_ROPE = 2 * MiB;
constexpr size_t WS_KEYS = 3 * MiB;
constexpr size_t WS_WAB_IN = 8 * MiB;
constexpr size_t WS_WAB_OUT = 46 * MiB;
constexpr size_t WS_WNA_IN = 62 * MiB;
constexpr size_t WS_WNA_OUT = 110 * MiB;
constexpr size_t WS_WQ = 126 * MiB;
constexpr size_t WS_X = 160 * MiB;
constexpr size_t WS_H = 226 * MiB;
constexpr size_t WS_PROJ = 260 * MiB;
constexpr size_t WS_MIX = 360 * MiB;
constexpr size_t WS_QP = 394 * MiB;
constexpr size_t WS_IDX = 428 * MiB;
constexpr size_t WS_GATE = 433 * MiB;
constexpr size_t WS_U = 440 * MiB;
constexpr size_t WS_SNAP = 516 * MiB;
constexpr size_t WS_CHS = 554 * MiB;
constexpr size_t WS_GF = 555 * MiB;
constexpr size_t WS_H8 = 564 * MiB;
constexpr size_t WS_SH = 581 * MiB;
constexpr size_t WS_SU = 582 * MiB;
constexpr size_t WS_SV = 583 * MiB;
constexpr size_t WS_U8 = 584 * MiB;
constexpr size_t WS_V8 = 712 * MiB;
constexpr size_t WS_WQC = 842 * MiB;
constexpr size_t WS_BQ = 866 * MiB;
constexpr size_t WS_XB = 868 * MiB;
constexpr size_t WS_PART = 902 * MiB;
constexpr size_t WS_PARTC = 903 * MiB;
constexpr size_t WS_PARTB = 904 * MiB;
constexpr size_t WS_DELTA = 906 * MiB;
constexpr size_t WS_END = 972 * MiB;
constexpr size_t PJ_Q = 0, PJ_K = 33 * MiB, PJ_VT = 66 * MiB;
constexpr size_t PJ_AQ = 0, PJ_AK = 9 * MiB, PJ_AKT = 18 * MiB, PJ_AVT = 27 * MiB, PJ_AO = 44 * MiB,
                 PJ_BQ = 61 * MiB, PJ_BK = 78 * MiB, PJ_BVT = 83 * MiB, PJ_G = 88 * MiB;
constexpr int LDS_BYTES = 147456;
constexpr int LDS_MISC = 131072;

#define LAS __attribute__((address_space(3)))
#define CAS __attribute__((address_space(4)))
typedef unsigned short bf16_t;
typedef short bf16x8 __attribute__((ext_vector_type(8)));
typedef float f32x4 __attribute__((ext_vector_type(4)));
typedef unsigned u32x4 __attribute__((ext_vector_type(4)));
typedef unsigned u32x2 __attribute__((ext_vector_type(2)));

struct Params {
    const float *x, *c, *ctx, *c_ctx, *ada_w, *ada_b, *norm1_g, *norm2_g, *ab_w_in, *ab_gate_b, *ab_mh_g, *ab_sink, *ab_w_out,
                *na_w_in, *na_rpb, *na_w_out, *peer_wq, *peer_keys, *peer_u, *peer_v, *final_g;
    float* out; unsigned char* ws; int ph_lo, ph_hi, grid, pad;
};

__device__ __forceinline__ float bf_lo(unsigned w) { return __uint_as_float(w << 16); }
__device__ __forceinline__ float bf_hi(unsigned w) { return __uint_as_float(w & 0xffff0000u); }
__device__ __forceinline__ unsigned pk2(float lo, float hi) { return pg8::cvt_pk_bf16(lo, hi); }
__device__ __forceinline__ float wave_sum(float v) {
#pragma unroll
    for (int o = 1; o < 64; o <<= 1) v += __shfl_xor(v, o);
    return v;
}
__device__ __forceinline__ float wave_max(float v) {
#pragma unroll
    for (int o = 1; o < 64; o <<= 1) v = fmaxf(v, __shfl_xor(v, o));
    return v;
}
__device__ __forceinline__ float scan_add(float x, int lane, int suffix) {
#pragma unroll
    for (int off = 1; off < 64; off <<= 1) {
        const float up = __shfl_up(x, off), dn = __shfl_down(x, off);
        const bool ok = suffix ? (lane + off < 64) : (lane >= off);
        x = ok ? x + (suffix ? dn : up) : x;
    }
    return x;
}
__device__ __forceinline__ float scan_max(float x, int lane, int suffix) {
#pragma unroll
    for (int off = 1; off < 64; off <<= 1) {
        const float up = __shfl_up(x, off), dn = __shfl_down(x, off);
        const bool ok = suffix ? (lane + off < 64) : (lane >= off);
        x = ok ? fmaxf(x, suffix ? dn : up) : x;
    }
    return x;
}
__device__ __forceinline__ float fq_max(float v) { v = fmaxf(v, __shfl_xor(v, 16)); return fmaxf(v, __shfl_xor(v, 32)); }
__device__ __forceinline__ float fq_sum(float v) { v += __shfl_xor(v, 16); return v + __shfl_xor(v, 32); }
__device__ __forceinline__ float log_sigmoid(float x) { return fminf(x, 0.f) - log1pf(expf(-fabsf(x))); }
__device__ __forceinline__ bf16x8 mk_frag(u32x4 w) { return __builtin_bit_cast(bf16x8, w); }
#define MFMA16(a, b, c) __builtin_amdgcn_mfma_f32_16x16x32_bf16((a), (b), (c), 0, 0, 0)

#define XB_TMO      128
#define XB_XCNT(j)  (256  + 64 * (j))
#define XB_XSUB(j)  (1280 + 64 * (j))
#define XB_XGEN(j)  (2304 + 64 * (j))
#define XB_TOP      3328
#define XB_TOPGEN   3392
#define XCD_BAR_WORDS 3456
#define XB_SPIN_CAP (1u << 22)
__device__ __forceinline__ unsigned xb_ld(unsigned* p)              { return __hip_atomic_load(p, __ATOMIC_RELAXED, __HIP_MEMORY_SCOPE_AGENT); }
__device__ __forceinline__ unsigned xb_add(unsigned* p, unsigned v) { return __hip_atomic_fetch_add(p, v, __ATOMIC_RELAXED, __HIP_MEMORY_SCOPE_AGENT); }
__device__ __forceinline__ unsigned xb_xcc_id() { return (unsigned)__builtin_amdgcn_s_getreg((3 << 11) | 20) & 0xFu; }
#define XB_SPIN(cond, bar) do { unsigned _sp = 0; while (cond) { __builtin_amdgcn_s_sleep(1); \
    if ((++_sp & 255u) == 0u) { if (xb_ld(&(bar)[XB_TMO])) break; if (_sp > XB_SPIN_CAP) { atomicAdd(&(bar)[XB_TMO], 1u); break; } } } } while (0)
struct XcdBarrier { unsigned* bar; unsigned x; volatile LAS unsigned* st; };
__device__ __forceinline__ XcdBarrier xcd_barrier_post(unsigned* bar, volatile LAS unsigned* st, int tid) {
    XcdBarrier b; b.bar = bar; b.x = xb_xcc_id(); b.st = st;
    if (tid == 0) (void)xb_add(&bar[XB_XCNT(b.x)], 1u);
    return b;
}
__device__ __forceinline__ void xcd_barrier_complete(unsigned* bar, unsigned x, unsigned& nloc, unsigned& nx) {
    const unsigned G = gridDim.x * gridDim.y * gridDim.z;
    unsigned sum, cnt, mine, sp = 0u;
    for (;;) {
        sum = 0u; cnt = 0u; mine = 0u;
#pragma unroll
        for (unsigned j = 0; j < 16; ++j) { const unsigned c = xb_ld(&bar[XB_XCNT(j)]); sum += c; cnt += (c > 0u) ? 1u : 0u; mine = (j == x) ? c : mine; }
        if (sum == G) break;
        __builtin_amdgcn_s_sleep(1);
        if ((++sp & 255u) == 0u) { if (xb_ld(&bar[XB_TMO])) break; if (sp > XB_SPIN_CAP) { atomicAdd(&bar[XB_TMO], 1u); break; } }
    }
    nloc = mine > 0u ? mine : 1u; nx = cnt > 0u ? cnt : 1u;
}
__device__ __forceinline__ void xcd_barrier(const XcdBarrier& b, int tid) {
    asm volatile("s_waitcnt vmcnt(0)" ::: "memory");
    __syncthreads();
    if (tid == 0) {
        unsigned* bar = b.bar;
        __builtin_amdgcn_s_waitcnt(0);
        unsigned nloc = b.st[0], nx = b.st[1];
        if (nloc == 0u) { xcd_barrier_complete(bar, b.x, nloc, nx); b.st[0] = nloc; b.st[1] = nx; }
        const unsigned old = xb_add(&bar[XB_XSUB(b.x)], 1u);
        const unsigned gen = old / nloc;
        if (old + 1u == (gen + 1u) * nloc) {
            __builtin_amdgcn_fence(__ATOMIC_RELEASE, "agent");
            asm volatile("s_waitcnt vmcnt(0)" ::: "memory");
            const unsigned og = xb_add(&bar[XB_TOP], 1u);
            const unsigned tg = og / nx;
            if (og + 1u == (tg + 1u) * nx) xb_add(&bar[XB_TOPGEN], 1u);
            else XB_SPIN(xb_ld(&bar[XB_TOPGEN]) == tg, bar);
            __builtin_amdgcn_fence(__ATOMIC_ACQUIRE, "agent");
            xb_add(&bar[XB_XGEN(b.x)], 1u);
            asm volatile("s_waitcnt vmcnt(0)" ::: "memory");
        } else {
            XB_SPIN(xb_ld(&bar[XB_XGEN(b.x)]) == gen, bar);
            __builtin_amdgcn_fence(__ATOMIC_ACQUIRE, "agent");
            asm volatile("s_waitcnt vmcnt(0)" ::: "memory");
        }
    }
    __syncthreads();
}

__device__ __forceinline__ void peer_convert_row(const Params& p, int l, int q, int lane) {
    const int tb = q >> 14, e = q & 16383;
    const f32x4* src = (const f32x4*)((tb ? p.peer_v : p.peer_u) + ((size_t)l * 16384 + e) * D) + lane;
    f32x4 v[8]; float am = 0.f;
#pragma unroll
    for (int j = 0; j < 8; ++j) { v[j] = src[64 * j]; am = fmaxf(am, fmaxf(fmaxf(fabsf(v[j].x), fabsf(v[j].y)), fmaxf(fabsf(v[j].z), fabsf(v[j].w)))); }
    am = wave_max(am);
    const float sc = am > 0.f ? am * (1.f / 127.f) : 1.f, inv = am > 0.f ? 127.f / am : 0.f;
    if (lane == 0) ((float*)(p.ws + (tb ? WS_SV : WS_SU)))[l * 16384 + e] = sc;
    unsigned char* dst = p.ws + (tb ? WS_V8 : WS_U8) + (size_t)l * (32 * MiB) + (size_t)e * 128 + 4 * (lane & 31);
    const unsigned flip = tb ? 0x80808080u : 0u;
#pragma unroll
    for (int j = 0; j < 8; ++j) {
        const int q0 = (int)rintf(v[j].x * inv), q1 = (int)rintf(v[j].y * inv), q2 = (int)rintf(v[j].z * inv), q3 = (int)rintf(v[j].w * inv);
        const unsigned w = ((unsigned)q0 & 0xffu) | (((unsigned)q1 & 0xffu) << 8) | (((unsigned)q2 & 0xffu) << 16) | (((unsigned)q3 & 0xffu) << 24);
        *(unsigned*)(dst + (size_t)(2 * j + (lane >> 5)) * (2 * MiB)) = w ^ flip;
    }
}
__device__ __forceinline__ const f32x4* peer_row_src(const Params& p, int l, int q, int lane) { return (const f32x4*)(((q >> 14) ? p.peer_v : p.peer_u) + ((size_t)l * 16384 + (q & 16383)) * D) + lane; }
__device__ __forceinline__ void peer_convert_rows(const Params& p, int l, int q0, int q1, int qs, int lane) {
    if (q0 >= q1) return;
    f32x4 nx[8];
    { const f32x4* src = peer_row_src(p, l, q0, lane);
#pragma unroll
      for (int j = 0; j < 8; ++j) nx[j] = __builtin_nontemporal_load(src + 64 * j); }
#pragma unroll 1
    for (int q = q0; q < q1; q += qs) {
        const int tb = q >> 14, e = q & 16383;
        f32x4 v[8]; float am = 0.f;
#pragma unroll
        for (int j = 0; j < 8; ++j) { v[j] = nx[j]; am = fmaxf(am, fmaxf(fmaxf(fabsf(v[j].x), fabsf(v[j].y)), fmaxf(fabsf(v[j].z), fabsf(v[j].w)))); }
        if (q + qs < q1) { const f32x4* src = peer_row_src(p, l, q + qs, lane);
#pragma unroll
            for (int j = 0; j < 8; ++j) nx[j] = __builtin_nontemporal_load(src + 64 * j); }
        am = wave_max(am);
        const float qm = tb ? 127.f : 7.f;
        const float sc = am > 0.f ? am / qm : 1.f, inv = am > 0.f ? qm / am : 0.f;
        if (lane == 0) ((float*)(p.ws + (tb ? WS_SV : WS_SU)))[l * 16384 + e] = sc;
        if (tb) {
            unsigned char* dst = p.ws + WS_V8 + (size_t)l * (32 * MiB) + (size_t)e * 128 + 4 * (lane & 31);
#pragma unroll
            for (int j = 0; j < 8; ++j) {
                const int q0_ = (int)rintf(v[j].x * inv), q1_ = (int)rintf(v[j].y * inv), q2_ = (int)rintf(v[j].z * inv), q3_ = (int)rintf(v[j].w * inv);
                const unsigned w = ((unsigned)q0_ & 0xffu) | (((unsigned)q1_ & 0xffu) << 8) | (((unsigned)q2_ & 0xffu) << 16) | (((unsigned)q3_ & 0xffu) << 24);
                *(unsigned*)(dst + (size_t)(2 * j + (lane >> 5)) * (2 * MiB)) = w;
            }
        } else {
            unsigned char* dst = p.ws + WS_U8 + (size_t)l * (32 * MiB) + (size_t)e * 128 + 4 * (lane >> 1);
#pragma unroll
            for (int j = 0; j < 8; ++j) {
                const int q0_ = (int)rintf(v[j].x * inv) + 8, q1_ = (int)rintf(v[j].y * inv) + 8, q2_ = (int)rintf(v[j].z * inv) + 8, q3_ = (int)rintf(v[j].w * inv) + 8;
                const unsigned w = (unsigned)q0_ | ((unsigned)q1_ << 8) | ((unsigned)q2_ << 16) | ((unsigned)q3_ << 24);
                const unsigned hi = (unsigned)__shfl_xor((int)w, 1);
                if (!(lane & 1)) *(unsigned*)(dst + (size_t)j * (2 * MiB)) = w | (hi << 4);
            }
        }
    }
}
constexpr int DEFQ_EVEN = 128, DEFQ_ODD = 96, IDLE_EVEN = 256 - (33 * 19) % 256, IDLE_ODD = 256 - (33 * 24) % 256;
__device__ __forceinline__ int peer_deferred_rows(int l, int G) { return (l == 0 || G != 256) ? 0 : (((l - 1) & 1) ? IDLE_ODD * DEFQ_ODD : IDLE_EVEN * DEFQ_EVEN); }
__device__ __forceinline__ void peer_convert_deferred(const Params& p, int l  , int bx, int G, int wave, int lane) {
    if (l + 1 >= DEPTH || G != 256) return;
    const int idle = (l & 1) ? IDLE_ODD : IDLE_EVEN, dq = (l & 1) ? DEFQ_ODD : DEFQ_EVEN, j = bx - (256 - idle);
    if (j < 0) return;
    peer_convert_rows(p, l + 1, j * dq + wave, (j + 1) * dq, NWAVES, lane);
}
struct ScaleOne { __device__ __forceinline__ float operator()(int) const { return 1.f; } };
template <class MapF, class ScaleF = ScaleOne>
__device__ __forceinline__ void transpose_item(const float* W, int Nsrc, int K, bf16_t* WT, int nblk, LAS float* scr, int item, int lane, MapF map, ScaleF ksc = ScaleF()) {
    const int kb = item / nblk, nb = item % nblk, k0 = 64 * kb, n0 = 32 * nb;
    const int sc = map(n0 + (lane & 31));
    float w[32];
#pragma unroll
    for (int i = 0; i < 32; ++i) w[i] = sc >= 0 ? __builtin_nontemporal_load(W + (size_t)(k0 + 2 * i + (lane >> 5)) * Nsrc + sc) : 0.f;
#pragma unroll
    for (int i = 0; i < 32; ++i) { const int kk = 2 * i + (lane >> 5); scr[kk * 33 + (lane & 31)] = w[i] * ksc(k0 + kk); }
    asm volatile("s_waitcnt lgkmcnt(0)" ::: "memory");
    const int c = lane & 7;
    float tt[4][8];
#pragma unroll
    for (int j = 0; j < 4; ++j) { const LAS float* s = scr + (8 * c) * 33 + (lane >> 3) + 8 * j;
#pragma unroll
        for (int r = 0; r < 8; ++r) tt[j][r] = s[r * 33]; }
    __builtin_amdgcn_sched_barrier(0);
#pragma unroll
    for (int j = 0; j < 4; ++j) { const int n = (lane >> 3) + 8 * j;
        u32x4 o; o.x = pk2(tt[j][0], tt[j][1]); o.y = pk2(tt[j][2], tt[j][3]); o.z = pk2(tt[j][4], tt[j][5]); o.w = pk2(tt[j][6], tt[j][7]);
        *(u32x4*)(WT + (size_t)(n0 + n) * K + k0 + 8 * c) = o; }
    asm volatile("s_waitcnt lgkmcnt(0)" ::: "memory");
}
struct MapId { __device__ __forceinline__ int operator()(int n) const { return n; } };
struct MapAB {
    __device__ __forceinline__ int operator()(int n) const {
        if (n < 3072) return n;
        if (n < 4352) { const int base_d = n < 4096 ? 3072 : 4096, base_s = n < 4096 ? 3104 : 4128; const int r = n - base_d, hh = r >> 7, pp = r & 127;
            const int i = 64 * (pp >> 6) + ((pp & 63) >> 1) + 32 * (pp & 1); return base_s + hh * 128 + i; }
        if (n < 4608) return 4384 + (n - 4352);
        if (n < 4640) return 3072 + (n - 4608);
        return -1;
    }
};
__device__ __forceinline__ float silu(float v) { return v / (1.f + expf(-v)); }
struct __attribute__((packed, aligned(4))) F3 { float a, b, c; };

__device__ __forceinline__ void ph_prologue(const Params& p, LAS unsigned char* lds, int tid, int lane, int wave, int vcu, int G) {
    const int gw = vcu * NWAVES + wave, NGW = G * NWAVES;
    const size_t gtid = (size_t)vcu * 512 + tid, gn = (size_t)G * 512;
    {
        const float2* ks = (const float2*)p.peer_keys; unsigned* kd = (unsigned*)(p.ws + WS_KEYS);
        for (size_t i = gtid; i < (size_t)4 * 8 * 2 * 128 * 128 / 2; i += gn) { const float2 v = ks[i]; kd[i] = pk2(v.x, v.y); }
    }
    {
        float2* rt = (float2*)(p.ws + WS_ROPE);
        for (size_t i = gtid; i < 128 * 32; i += gn) { const int pos = (int)(i >> 5), j = (int)(i & 31);
            const float freq = powf(10000.f, -(float)j / 32.f), ang = (float)pos * freq; rt[i] = make_float2(cosf(ang), sinf(ang)); }
    }
    {
        LAS float* sv = (LAS float*)lds;
        LAS float* red = (LAS float*)(lds + 16384);
        for (int i = tid; i < 2048; i += 512) { sv[i] = silu(p.c[i]); sv[2048 + i] = silu(p.c_ctx[i]); }
        __syncthreads();
        float* MOD = (float*)(p.ws + WS_MOD);
        for (int u = vcu; u < 4 * 64; u += G) {
            const int l = u >> 6, n0 = (u & 63) * 192;
            const float* wp = p.ada_w + ((size_t)l * 2048 + wave * 256) * D6 + n0 + 3 * lane;
            float a0x = 0.f, a0y = 0.f, a0z = 0.f, a1x = 0.f, a1y = 0.f, a1z = 0.f;
#pragma unroll 1
            for (int k = 0; k < 256; k += 16) {
                F3 wv[16];
#pragma unroll
                for (int j = 0; j < 16; ++j) { const float* q_ = wp + (size_t)(k + j) * D6; wv[j].a = __builtin_nontemporal_load(q_); wv[j].b = __builtin_nontemporal_load(q_ + 1); wv[j].c = __builtin_nontemporal_load(q_ + 2); }
#pragma unroll
                for (int j = 0; j < 16; ++j) { const float s0 = sv[wave * 256 + k + j], s1 = sv[2048 + wave * 256 + k + j];
                    a0x += s0 * wv[j].a; a0y += s0 * wv[j].b; a0z += s0 * wv[j].c; a1x += s1 * wv[j].a; a1y += s1 * wv[j].b; a1z += s1 * wv[j].c; }
            }
            { LAS float* r0 = red + (wave * 2 + 0) * 192 + 3 * lane; LAS float* r1 = red + (wave * 2 + 1) * 192 + 3 * lane;
              r0[0] = a0x; r0[1] = a0y; r0[2] = a0z; r1[0] = a1x; r1[1] = a1y; r1[2] = a1z; }
            __syncthreads();
            if (tid < 384) { const int which = tid >= 192 ? 1 : 0, col = tid - 192 * which; float s = 0.f;
#pragma unroll
                for (int w = 0; w < 8; ++w) s += red[(w * 2 + which) * 192 + col];
                MOD[((size_t)l * 2 + which) * D6 + n0 + col] = s + p.ada_b[(size_t)l * D6 + n0 + col]; }
            __syncthreads();
        }
    }
    {
        LAS float* scr = (LAS float*)(lds + wave * 16384);
        constexpr int I_ABI = 32 * (NAB / 32), I_SQ = 32 * (D / 32), I_NAI = 32 * (NNA / 32);
        constexpr int NITEMS = 2 * I_ABI + 2 * I_SQ + 2 * I_NAI + 2 * I_SQ;
        for (int it = gw; it < NITEMS; it += NGW) {
            int r = it;
            if (r < 2 * I_ABI) { const int e = r / I_ABI; r -= e * I_ABI;
                transpose_item(p.ab_w_in + (size_t)e * D * 4640, 4640, D, (bf16_t*)(p.ws + WS_WAB_IN) + (size_t)e * NAB * D, NAB / 32, scr, r, lane, MapAB()); continue; }
            r -= 2 * I_ABI;
            if (r < 2 * I_SQ) { const int e = r / I_SQ; r -= e * I_SQ;
                transpose_item(p.ab_w_out + (size_t)e * D * D, D, D, (bf16_t*)(p.ws + WS_WAB_OUT) + (size_t)e * D * D, D / 32, scr, r, lane, MapId()); continue; }
            r -= 2 * I_SQ;
            if (r < 2 * I_NAI) { const int e = r / I_NAI; r -= e * I_NAI;
                transpose_item(p.na_w_in + (size_t)e * D * NNA, NNA, D, (bf16_t*)(p.ws + WS_WNA_IN) + (size_t)e * NNA * D, NNA / 32, scr, r, lane, MapId()); continue; }
            r -= 2 * I_NAI;
            { const int e = r / I_SQ; r -= e * I_SQ;
                transpose_item(p.na_w_out + (size_t)e * D * D, D, D, (bf16_t*)(p.ws + WS_WNA_OUT) + (size_t)e * D * D, D / 32, scr, r, lane, MapId()); }
        }
    }
#pragma unroll 1
    for (int l = 0; l < DEPTH; ++l) peer_convert_rows(p, l, peer_deferred_rows(l, G) + gw, 32768, NGW, lane);
}
__device__ __forceinline__ void fold_item(const Params& p, int l, int item, LAS float* scr, int lane) {
    const int kb = item >> 6, nb = item & 63, k0 = 64 * kb, n0 = 32 * nb;
    const float* MOD = (const float*)(p.ws + WS_MOD) + (size_t)l * 2 * D6;
    const float* W = p.peer_wq + (size_t)l * D * D;
    LAS float* kv = scr + 2112;
    float w[32];
#pragma unroll
    for (int i = 0; i < 32; ++i) w[i] = __builtin_nontemporal_load(W + (size_t)(k0 + 2 * i + (lane >> 5)) * D + n0 + (lane & 31));
    { const int k = k0 + lane; const float g2 = p.norm2_g[(size_t)l * D + k], m4 = MOD[4 * D + k], m4c = MOD[D6 + 4 * D + k], m3 = MOD[3 * D + k], m3c = MOD[D6 + 3 * D + k];
      __builtin_amdgcn_sched_barrier(0);
      kv[lane] = g2 * (1.f + m4); kv[64 + lane] = g2 * (1.f + m4c); kv[128 + lane] = m3; kv[192 + lane] = m3c; }
    asm volatile("s_waitcnt lgkmcnt(0)" ::: "memory");
    float bl = 0.f, bc = 0.f;
#pragma unroll
    for (int i = 0; i < 32; ++i) { const int kk = 2 * i + (lane >> 5); bl += w[i] * kv[128 + kk]; bc += w[i] * kv[192 + kk]; }
    bl += __shfl_xor(bl, 32); bc += __shfl_xor(bc, 32);
    if (lane < 32) { float* PB = (float*)(p.ws + WS_PARTB) + ((size_t)(l * 2) * 32 + kb) * D + n0 + lane; PB[0] = bl; PB[(size_t)32 * D] = bc; }
    const int c = lane & 7;
#pragma unroll 1
    for (int v = 0; v < (l < DEPTH - 1 ? 2 : 1); ++v) {
        bf16_t* WT = (bf16_t*)(p.ws + (v ? WS_WQC : WS_WQ)) + (size_t)l * D * D;
        float kf[32];
#pragma unroll
        for (int i = 0; i < 32; ++i) kf[i] = kv[64 * v + 2 * i + (lane >> 5)];
        __builtin_amdgcn_sched_barrier(0);
#pragma unroll
        for (int i = 0; i < 32; ++i) { const int kk = 2 * i + (lane >> 5); scr[kk * 33 + (lane & 31)] = w[i] * kf[i]; }
        asm volatile("s_waitcnt lgkmcnt(0)" ::: "memory");
        float tt[4][8];
#pragma unroll
        for (int j = 0; j < 4; ++j) { const LAS float* s = scr + (8 * c) * 33 + (lane >> 3) + 8 * j;
#pragma unroll
            for (int r = 0; r < 8; ++r) tt[j][r] = s[r * 33]; }
        __builtin_amdgcn_sched_barrier(0);
#pragma unroll
        for (int j = 0; j < 4; ++j) { const int n = (lane >> 3) + 8 * j;
            u32x4 o; o.x = pk2(tt[j][0], tt[j][1]); o.y = pk2(tt[j][2], tt[j][3]); o.z = pk2(tt[j][4], tt[j][5]); o.w = pk2(tt[j][6], tt[j][7]);
            *(u32x4*)(WT + (size_t)(n0 + n) * D + k0 + 8 * c) = o; }
        asm volatile("s_waitcnt lgkmcnt(0)" ::: "memory");
    }
}
__device__ __forceinline__ void ph_fold_wq(const Params& p, LAS unsigned char* lds, int lane, int wave, int gw, int NGW) {
    LAS float* scr = (LAS float*)(lds + wave * 16384);
    for (int it = gw; it < DEPTH * 2048; it += NGW) fold_item(p, it >> 11, it & 2047, scr, lane);
}
__device__ __forceinline__ void ph_fold_bias(const Params& p, int lane, int gw, int NGW) {
    for (int i = gw * 64 + lane; i < DEPTH * 2 * D; i += NGW * 64) { const float* PB = (const float*)(p.ws + WS_PARTB) + (size_t)(i >> 11) * 32 * D + (i & 2047); float s = 0.f;
        float pv[32];
#pragma unroll
        for (int kb = 0; kb < 32; ++kb) pv[kb] = PB[(size_t)kb * D];
#pragma unroll
        for (int kb = 0; kb < 32; ++kb) s += pv[kb];
        ((float*)(p.ws + WS_BQ))[i] = s; }
}
__device__ __forceinline__ void norm_row(const Params& p, int l, int which, int m, int lane) {
    const float* gvec = (which ? p.norm2_g : p.norm1_g) + (size_t)l * D;
    const float* MOD = (const float*)(p.ws + WS_MOD) + (size_t)l * 2 * D6;
    const float* X = (const float*)(p.ws + WS_X); bf16_t* H = (bf16_t*)(p.ws + WS_H);
    {
        const float* mod = MOD + (m >= T ? D6 : 0) + (which ? 3 * D : 0);
        const float* xrow = (l == 0 && which == 0) ? (m < T ? p.x + (size_t)m * D : p.ctx + (size_t)(m - T) * D) : X + (size_t)m * D;
        const f32x4* xr = (const f32x4*)xrow + lane;
        f32x4 v[8]; float ss = 0.f;
#pragma unroll
        for (int j = 0; j < 8; ++j) { v[j] = xr[64 * j]; ss += (v[j].x * v[j].x + v[j].y * v[j].y) + (v[j].z * v[j].z + v[j].w * v[j].w); }
        ss = wave_sum(ss);
        const float rstd = rsqrtf(ss * (1.f / D) + EPS);
        f32x4 g4a[8], sha[8], sca[8];
#pragma unroll
        for (int j = 0; j < 8; ++j) { const int col = 256 * j + 4 * lane; g4a[j] = *(const f32x4*)(gvec + col); sha[j] = *(const f32x4*)(mod + col); sca[j] = *(const f32x4*)(mod + D + col); }
        __builtin_amdgcn_sched_barrier(0);
#pragma unroll
        for (int j = 0; j < 8; ++j) { const int col = 256 * j + 4 * lane;
            const f32x4 h = v[j] * rstd * g4a[j] * (sca[j] + 1.f) + sha[j]; v[j] = h;
            if (!which) { u32x2 o; o.x = pk2(h.x, h.y); o.y = pk2(h.z, h.w); *(u32x2*)(H + (size_t)m * D + col) = o; } }
        if (which) {
            float am = 0.f;
#pragma unroll
            for (int j = 0; j < 8; ++j) am = fmaxf(am, fmaxf(fmaxf(fabsf(v[j].x), fabsf(v[j].y)), fmaxf(fabsf(v[j].z), fabsf(v[j].w))));
            am = wave_max(am);
            const float inv = am > 0.f ? 127.f / am : 0.f;
            if (lane == 0) ((float*)(p.ws + WS_SH))[m] = am > 0.f ? am * (1.f / 127.f) : 1.f;
            unsigned char* h8 = p.ws + WS_H8 + (size_t)m * D + 4 * lane;
#pragma unroll
            for (int j = 0; j < 8; ++j) {
                const int q0 = (int)rintf(v[j].x * inv), q1 = (int)rintf(v[j].y * inv), q2 = (int)rintf(v[j].z * inv), q3 = (int)rintf(v[j].w * inv);
                *(unsigned*)(h8 + 256 * j) = ((unsigned)q0 & 0xffu) | (((unsigned)q1 & 0xffu) << 8) | (((unsigned)q2 & 0xffu) << 16) | (((unsigned)q3 & 0xffu) << 24);
            }
        }
    }
}
template <int NR> __device__ __forceinline__ void h8_rows(const Params& p, int l, int m0, int lane, int wave) {
    const float* gvec = p.norm2_g + (size_t)l * D;
    const float* MOD = (const float*)(p.ws + WS_MOD) + (size_t)l * 2 * D6 + 3 * D;
    const float* X = (const float*)(p.ws + WS_X);
    f32x4 nx[8];
    { const f32x4* xr = (const f32x4*)(X + (size_t)(m0 + wave) * D) + lane;
#pragma unroll
      for (int j = 0; j < 8; ++j) nx[j] = xr[64 * j]; }
#pragma unroll 1
    for (int mi = wave; mi < NR; mi += NWAVES) {
        const int m = m0 + mi; const float* mod = MOD + (m >= T ? D6 : 0);
        f32x4 v[8]; float ss = 0.f;
#pragma unroll
        for (int j = 0; j < 8; ++j) { v[j] = nx[j]; ss += (v[j].x * v[j].x + v[j].y * v[j].y) + (v[j].z * v[j].z + v[j].w * v[j].w); }
        if (mi + NWAVES < NR) { const f32x4* xr = (const f32x4*)(X + (size_t)(m + NWAVES) * D) + lane;
#pragma unroll
            for (int j = 0; j < 8; ++j) nx[j] = xr[64 * j]; }
        ss = wave_sum(ss);
        const float rstd = rsqrtf(ss * (1.f / D) + EPS);
        float am = 0.f;
        f32x4 g4a[8], sha[8], sca[8];
#pragma unroll
        for (int j = 0; j < 8; ++j) { const int col = 256 * j + 4 * lane; g4a[j] = *(const f32x4*)(gvec + col); sha[j] = *(const f32x4*)(mod + col); sca[j] = *(const f32x4*)(mod + D + col); }
        __builtin_amdgcn_sched_barrier(0);
#pragma unroll
        for (int j = 0; j < 8; ++j) {
            const f32x4 h = v[j] * rstd * g4a[j] * (sca[j] + 1.f) + sha[j]; v[j] = h;
            am = fmaxf(am, fmaxf(fmaxf(fabsf(h.x), fabsf(h.y)), fmaxf(fabsf(h.z), fabsf(h.w)))); }
        am = wave_max(am);
        const float inv = am > 0.f ? 127.f / am : 0.f;
        if (lane == 0) ((float*)(p.ws + WS_SH))[m] = am > 0.f ? am * (1.f / 127.f) : 1.f;
        unsigned char* h8 = p.ws + WS_H8 + (size_t)m * D + 4 * lane;
        int qs = 0;
#pragma unroll
        for (int j = 0; j < 8; ++j) {
            const int q0 = (int)rintf(v[j].x * inv), q1 = (int)rintf(v[j].y * inv), q2 = (int)rintf(v[j].z * inv), q3 = (int)rintf(v[j].w * inv);
            qs += (q0 + q1) + (q2 + q3);
            *(unsigned*)(h8 + 256 * j) = ((unsigned)q0 & 0xffu) | (((unsigned)q1 & 0xffu) << 8) | (((unsigned)q2 & 0xffu) << 16) | (((unsigned)q3 & 0xffu) << 24);
        }
        const float qsum = wave_sum((float)qs);
        if (lane == 0) ((float*)(p.ws + WS_SH + 512 * 1024))[m] = qsum;
    }
}
__device__ __forceinline__ void ph_norm(const Params& p, int l, int which, int lane, int gw, int NGW) {
    for (int m = gw; m < M; m += NGW) norm_row(p, l, which, m, lane);
}
__device__ __forceinline__ void final_row(const Params& p, int m, int lane) {
    const float* X = (const float*)(p.ws + WS_X);
    {
        const f32x4* xr = (const f32x4*)(X + (size_t)m * D) + lane;
        f32x4 v[8]; float ss = 0.f;
#pragma unroll
        for (int j = 0; j < 8; ++j) { v[j] = xr[64 * j]; ss += (v[j].x * v[j].x + v[j].y * v[j].y) + (v[j].z * v[j].z + v[j].w * v[j].w); }
        ss = wave_sum(ss);
        const float rstd = rsqrtf(ss * (1.f / D) + EPS);
#pragma unroll
        for (int j = 0; j < 8; ++j) { const int col = 256 * j + 4 * lane; const f32x4 g4 = *(const f32x4*)(p.final_g + col);
            *(f32x4*)(p.out + (size_t)m * D + col) = v[j] * rstd * g4; }
    }
}

#define AT(T, base, off) ((T*)((unsigned char*)(base) + (size_t)(unsigned)(off)))
__device__ __forceinline__ void peer_tail_row(const Params& p, int l, int m, int lane) {
    const float* MODl = (const float*)(p.ws + WS_MOD) + ((size_t)l * 2 + (m >= T ? 1 : 0)) * D6;
    f32x4* X4 = (f32x4*)((float*)(p.ws + WS_X) + (size_t)m * D) + lane;
    f32x4 v[8];
    {
        const f32x4* D4 = (const f32x4*)((const float*)(p.ws + WS_DELTA) + (size_t)m * D) + lane; const f32x4* G4 = (const f32x4*)(MODl + 5 * D) + lane;
        f32x4 dv[8], gv[8];
#pragma unroll
        for (int j = 0; j < 8; ++j) { v[j] = X4[64 * j]; dv[j] = D4[64 * j]; gv[j] = G4[64 * j]; }
        __builtin_amdgcn_sched_barrier(0);
#pragma unroll
        for (int j = 0; j < 8; ++j) v[j] = v[j] + gv[j] * dv[j];
    }
    const bool last = l + 1 >= DEPTH;
    if (last && m >= T) return;
    const float* MODn = (const float*)(p.ws + WS_MOD) + ((size_t)(last ? l : l + 1) * 2 + (m >= T ? 1 : 0)) * D6;
    const f32x4* NG = (const f32x4*)(last ? p.final_g : p.norm1_g + (size_t)(l + 1) * D) + lane;
    f32x4 g4[8], sh[8], sc[8];
#pragma unroll
    for (int j = 0; j < 8; ++j) { g4[j] = NG[64 * j]; if (!last) { sh[j] = ((const f32x4*)MODn + lane)[64 * j]; sc[j] = ((const f32x4*)(MODn + D) + lane)[64 * j]; } }
    __builtin_amdgcn_sched_barrier(0);
    float ss = 0.f;
#pragma unroll
    for (int j = 0; j < 8; ++j) { if (!last) X4[64 * j] = v[j]; ss += (v[j].x * v[j].x + v[j].y * v[j].y) + (v[j].z * v[j].z + v[j].w * v[j].w); }
    ss = wave_sum(ss);
    const float rstd = rsqrtf(ss * (1.f / D) + EPS);
    if (last) {
        f32x4* O4 = (f32x4*)(p.out + (size_t)m * D) + lane;
#pragma unroll
        for (int j = 0; j < 8; ++j) O4[64 * j] = v[j] * rstd * g4[j];
    } else {
        bf16_t* H = (bf16_t*)(p.ws + WS_H) + (size_t)m * D + 4 * lane;
#pragma unroll
        for (int j = 0; j < 8; ++j) { const f32x4 h = v[j] * rstd * g4[j] * (sc[j] + 1.f) + sh[j]; u32x2 o; o.x = pk2(h.x, h.y); o.y = pk2(h.z, h.w); *(u32x2*)(H + 256 * j) = o; }
    }
}
__device__ __forceinline__ void store4_bf16(unsigned char* base, unsigned off, f32x4 v) { u32x2 w; w.x = pk2(v[0], v[1]); w.y = pk2(v[2], v[3]); *AT(u32x2, base, off) = w; }
__device__ __forceinline__ void store4_T(unsigned char* base, unsigned off0  , f32x4 v) {
    const unsigned a = pk2(v[0], v[1]), b = pk2(v[2], v[3]);
    constexpr unsigned RS = (unsigned)M * 2u;
    *AT(bf16_t, base, off0 + 0 * RS) = (bf16_t)(a & 0xffff); *AT(bf16_t, base, off0 + 1 * RS) = (bf16_t)(a >> 16);
    *AT(bf16_t, base, off0 + 2 * RS) = (bf16_t)(b & 0xffff); *AT(bf16_t, base, off0 + 3 * RS) = (bf16_t)(b >> 16);
}
__device__ __forceinline__ void rope4(f32x4& v, const float2* rope, int row, int pp  ) {
    const int pos = (pp < 64) ? (row >> 6) : (row & 63), j0 = (pp & 63) >> 1;
    const f32x4 cs = *AT(const f32x4, rope, (unsigned)(pos * 32 + j0) * 8u);
    const float a0 = v[0], b0 = v[1], a1 = v[2], b1 = v[3];
    v[0] = a0 * cs[0] - b0 * cs[1]; v[1] = b0 * cs[0] + a0 * cs[1];
    v[2] = a1 * cs[2] - b1 * cs[3]; v[3] = b1 * cs[2] + a1 * cs[3];
}
__device__ __forceinline__ void store8_bf16(unsigned char* base, unsigned off, f32x4 v0, f32x4 v1) {
    u32x4 w; w.x = pk2(v0[0], v0[1]); w.y = pk2(v0[2], v0[3]); w.z = pk2(v1[0], v1[1]); w.w = pk2(v1[2], v1[3]);
    *AT(u32x4, base, off) = w;
}
__device__ __forceinline__ void store8_T(unsigned char* base, unsigned off0  , f32x4 v0, f32x4 v1) {
    const unsigned a = pk2(v0[0], v0[1]), b = pk2(v0[2], v0[3]), c = pk2(v1[0], v1[1]), d = pk2(v1[2], v1[3]);
    constexpr unsigned RS = (unsigned)M * 2u;
    *AT(bf16_t, base, off0 + 0 * RS) = (bf16_t)(a & 0xffff); *AT(bf16_t, base, off0 + 1 * RS) = (bf16_t)(a >> 16);
    *AT(bf16_t, base, off0 + 2 * RS) = (bf16_t)(b & 0xffff); *AT(bf16_t, base, off0 + 3 * RS) = (bf16_t)(b >> 16);
    *AT(bf16_t, base, off0 + 4 * RS) = (bf16_t)(c & 0xffff); *AT(bf16_t, base, off0 + 5 * RS) = (bf16_t)(c >> 16);
    *AT(bf16_t, base, off0 + 6 * RS) = (bf16_t)(d & 0xffff); *AT(bf16_t, base, off0 + 7 * RS) = (bf16_t)(d >> 16);
}
__device__ __forceinline__ void rope8(f32x4& v0, f32x4& v1, const float2* rope, int row, int pp  ) {
    const int pos = (pp < 64) ? (row >> 6) : (row & 63), j0 = (pp & 63) >> 1;
    const f32x4* t = AT(const f32x4, rope, (unsigned)(pos * 32 + j0) * 8u);
    const f32x4 c01 = t[0], c23 = t[1];
    const float a0 = v0[0], b0 = v0[1], a1 = v0[2], b1 = v0[3], a2 = v1[0], b2 = v1[1], a3 = v1[2], b3 = v1[3];
    v0[0] = a0 * c01[0] - b0 * c01[1]; v0[1] = b0 * c01[0] + a0 * c01[1];
    v0[2] = a1 * c01[2] - b1 * c01[3]; v0[3] = b1 * c01[2] + a1 * c01[3];
    v1[0] = a2 * c23[0] - b2 * c23[1]; v1[1] = b2 * c23[0] + a2 * c23[1];
    v1[2] = a3 * c23[2] - b3 * c23[3]; v1[3] = b3 * c23[2] + a3 * c23[3];
}
struct EpiEven {
    static constexpr bool PERM = true, AFTER_DRAIN = false;
    unsigned char* proj; const float* gate_b; const float2* rope;
    __device__ __forceinline__ void elem4(unsigned row, unsigned col0, f32x4 v) const {
        const unsigned pn = col0 >> 8;
        if (pn < 2) { store4_bf16(proj, (unsigned)PJ_AQ + (row * 512u + col0) * 2u, v * 0.125f); }
        else if (pn < 4) { const unsigned c = col0 - 512; store4_bf16(proj, (unsigned)PJ_AK + (row * 512u + c) * 2u, v); store4_T(proj, (unsigned)PJ_AKT + (c * (unsigned)M + row) * 2u, v); }
        else if (pn < 8) { store4_T(proj, (unsigned)PJ_AVT + ((col0 - 1024) * (unsigned)M + row) * 2u, v); }
        else if (pn < 12) { store4_bf16(proj, (unsigned)PJ_AO + (row * 1024u + (col0 - 2048)) * 2u, v); }
        else if (pn < 16) { const unsigned c = col0 - 3072; if (row < (unsigned)T) rope4(v, rope, row, c & 127); store4_bf16(proj, (unsigned)PJ_BQ + (row * 1024u + c) * 2u, v); }
        else if (pn == 16) { const unsigned c = col0 - 4096; if (row < (unsigned)T) rope4(v, rope, row, c & 127); store4_bf16(proj, (unsigned)PJ_BK + (row * 256u + c) * 2u, v); }
        else if (pn == 17) { store4_T(proj, (unsigned)PJ_BVT + ((col0 - 4352) * (unsigned)M + row) * 2u, v); }
        else { const unsigned c = col0 - 4608; if (c < 32) *AT(f32x4, proj, (unsigned)PJ_G + (row * 32u + c) * 4u) = v + *AT(const f32x4, gate_b, c * 4u); }
    }
    __device__ __forceinline__ void operator()(const f32x4 (&acc)[2][2][4][2], const pg8::Unit& u, int wr, int wc, int fr, int fq) const {
        const int pn = u.pn;
#pragma unroll
        for (int ai = 0; ai < 2; ++ai)
#pragma unroll
            for (int m = 0; m < 4; ++m) { const unsigned row = u.pm * 256 + ai * 128 + wr * 64 + m * 16 + fr;
#pragma unroll
                for (int bj = 0; bj < 2; ++bj) { const unsigned col0 = pn * 256 + bj * 128 + wc * 32 + 8 * fq;
                    f32x4 v0 = acc[ai][bj][m][0], v1 = acc[ai][bj][m][1];
                    if (pn < 2) { store8_bf16(proj, (unsigned)PJ_AQ + (row * 512u + col0) * 2u, v0 * 0.125f, v1 * 0.125f); }
                    else if (pn < 4) { const unsigned c = col0 - 512; store8_bf16(proj, (unsigned)PJ_AK + (row * 512u + c) * 2u, v0, v1); store8_T(proj, (unsigned)PJ_AKT + (c * (unsigned)M + row) * 2u, v0, v1); }
                    else if (pn < 8) { store8_T(proj, (unsigned)PJ_AVT + ((col0 - 1024) * (unsigned)M + row) * 2u, v0, v1); }
                    else if (pn < 12) { store8_bf16(proj, (unsigned)PJ_AO + (row * 1024u + (col0 - 2048)) * 2u, v0, v1); }
                    else if (pn < 16) { const unsigned c = col0 - 3072; if (row < (unsigned)T) rope8(v0, v1, rope, row, c & 127); store8_bf16(proj, (unsigned)PJ_BQ + (row * 1024u + c) * 2u, v0, v1); }
                    else if (pn == 16) { const unsigned c = col0 - 4096; if (row < (unsigned)T) rope8(v0, v1, rope, row, c & 127); store8_bf16(proj, (unsigned)PJ_BK + (row * 256u + c) * 2u, v0, v1); }
                    else if (pn == 17) { store8_T(proj, (unsigned)PJ_BVT + ((col0 - 4352) * (unsigned)M + row) * 2u, v0, v1); }
                    else { const unsigned c = col0 - 4608; if (c < 32) { const unsigned go = (unsigned)PJ_G + (row * 32u + c) * 4u;
                            *AT(f32x4, proj, go) = v0 + *AT(const f32x4, gate_b, c * 4u); *AT(f32x4, proj, go + 16u) = v1 + *AT(const f32x4, gate_b, c * 4u + 16u); } }
                } }
    }
};
struct EpiOdd {
    static constexpr bool PERM = true, AFTER_DRAIN = false;
    unsigned char* proj;
    __device__ __forceinline__ void elem4(unsigned row, unsigned col0, f32x4 v) const {
        const unsigned pn = col0 >> 8;
        if (pn < 8) store4_bf16(proj, (unsigned)PJ_Q + (row * 2048u + col0) * 2u, v);
        else if (pn < 16) store4_bf16(proj, (unsigned)PJ_K + (row * 2048u + (col0 - 2048)) * 2u, v);
        else store4_T(proj, (unsigned)PJ_VT + ((col0 - 4096) * (unsigned)M + row) * 2u, v);
    }
    __device__ __forceinline__ void operator()(const f32x4 (&acc)[2][2][4][2], const pg8::Unit& u, int wr, int wc, int fr, int fq) const {
        const int pn = u.pn;
#pragma unroll
        for (int ai = 0; ai < 2; ++ai)
#pragma unroll
            for (int m = 0; m < 4; ++m) { const unsigned row = u.pm * 256 + ai * 128 + wr * 64 + m * 16 + fr;
#pragma unroll
                for (int bj = 0; bj < 2; ++bj) { const unsigned col0 = pn * 256 + bj * 128 + wc * 32 + 8 * fq;
                    const f32x4 v0 = acc[ai][bj][m][0], v1 = acc[ai][bj][m][1];
                    if (pn < 8) store8_bf16(proj, (unsigned)PJ_Q + (row * 2048u + col0) * 2u, v0, v1);
                    else if (pn < 16) store8_bf16(proj, (unsigned)PJ_K + (row * 2048u + (col0 - 2048)) * 2u, v0, v1);
                    else store8_T(proj, (unsigned)PJ_VT + ((col0 - 4096) * (unsigned)M + row) * 2u, v0, v1);
                } }
    }
};
struct EpiResid {
    static constexpr bool PERM = true, AFTER_DRAIN = false;
    float* X; const float* gl; const float* gc; const float* srcl; const float* srcc;
    unsigned char* XB; float* part; float* partc;
    __device__ __forceinline__ void elem4(unsigned row, unsigned col0, f32x4 v) const {
        f32x4* xp = AT(f32x4, X, (row * (unsigned)D + col0) * 4u);
        const f32x4* sp = AT(const f32x4, srcc, ((row - (unsigned)T) * (unsigned)D + col0) * 4u);
        const f32x4 x = *sp + *AT(const f32x4, gc, col0 * 4u) * v;
        *xp = x; store4_bf16(XB, (row * (unsigned)D + col0) * 2u, x);
        const float s = fq_sum((x.x * x.x + x.y * x.y) + (x.z * x.z + x.w * x.w));
        if (((col0 >> 2) & 3u) == 0u) *AT(float, partc, ((row - (unsigned)T) * 128u + (col0 >> 4)) * 4u) = s;
    }
    __device__ __forceinline__ void operator()(const f32x4 (&acc)[2][2][4][2], const pg8::Unit& u, int wr, int wc, int fr, int fq) const {
        const float* g = (u.pm * 256 < T) ? gl : gc;
        f32x4 gg[2][2];
#pragma unroll
        for (int bj = 0; bj < 2; ++bj) { const unsigned col0 = u.pn * 256 + bj * 128 + wc * 32 + 8 * fq; gg[bj][0] = *AT(const f32x4, g, col0 * 4u); gg[bj][1] = *AT(const f32x4, g, col0 * 4u + 16u); }
#pragma unroll
        for (int ai = 0; ai < 2; ++ai) {
            f32x4 sv[4][2][2];
#pragma unroll
            for (int m = 0; m < 4; ++m) { const unsigned row = u.pm * 256 + ai * 128 + wr * 64 + m * 16 + fr;
#pragma unroll
                for (int bj = 0; bj < 2; ++bj) { const unsigned col0 = u.pn * 256 + bj * 128 + wc * 32 + 8 * fq;
                    const f32x4* sp = (u.pm * 256 < T) ? AT(const f32x4, srcl, (row * (unsigned)D + col0) * 4u) : AT(const f32x4, srcc, ((row - (unsigned)T) * (unsigned)D + col0) * 4u);
                    sv[m][bj][0] = sp[0]; sv[m][bj][1] = sp[1]; } }
            __builtin_amdgcn_sched_barrier(0);
#pragma unroll
            for (int m = 0; m < 4; ++m) { const unsigned row = u.pm * 256 + ai * 128 + wr * 64 + m * 16 + fr; float ssq = 0.f;
#pragma unroll
                for (int bj = 0; bj < 2; ++bj) { const unsigned col0 = u.pn * 256 + bj * 128 + wc * 32 + 8 * fq;
                    f32x4* xp = AT(f32x4, X, (row * (unsigned)D + col0) * 4u);
                    const f32x4 x0 = sv[m][bj][0] + gg[bj][0] * acc[ai][bj][m][0], x1 = sv[m][bj][1] + gg[bj][1] * acc[ai][bj][m][1];
                    xp[0] = x0; xp[1] = x1; store8_bf16(XB, (row * (unsigned)D + col0) * 2u, x0, x1);
                    ssq += ((x0.x * x0.x + x0.y * x0.y) + (x0.z * x0.z + x0.w * x0.w)) + ((x1.x * x1.x + x1.y * x1.y) + (x1.z * x1.z + x1.w * x1.w));
                }
                ssq = fq_sum(ssq);
                if (fq == 0) *AT(float, part, (row * 32u + u.pn * 4u + wc) * 4u) = ssq; }
            __builtin_amdgcn_sched_barrier(0);
        }
    }
};
struct EpiPlain {
    static constexpr bool PERM = true, AFTER_DRAIN = false;
    bf16_t* O;
    __device__ __forceinline__ void elem4(unsigned row, unsigned col0, f32x4 v) const { store4_bf16((unsigned char*)O, (row * (unsigned)D + col0) * 2u, v); }
    __device__ __forceinline__ void operator()(const f32x4 (&acc)[2][2][4][2], const pg8::Unit& u, int wr, int wc, int fr, int fq) const {
#pragma unroll
        for (int ai = 0; ai < 2; ++ai)
#pragma unroll
            for (int m = 0; m < 4; ++m) { const unsigned row = u.pm * 256 + ai * 128 + wr * 64 + m * 16 + fr;
#pragma unroll
                for (int bj = 0; bj < 2; ++bj) { const unsigned col0 = u.pn * 256 + bj * 128 + wc * 32 + 8 * fq;
                    store8_bf16((unsigned char*)O, (row * (unsigned)D + col0) * 2u, acc[ai][bj][m][0], acc[ai][bj][m][1]); } }
    }
};
struct EpiQ {
    static constexpr bool PERM = true, AFTER_DRAIN = false;
    bf16_t* O; const float* part; const float* bias;
    __device__ __forceinline__ void operator()(const f32x4 (&acc)[2][2][4][2], const pg8::Unit& u, int wr, int wc, int fr, int fq) const {
        f32x4 bb[2][2], pp[2][4][2];
#pragma unroll
        for (int bj = 0; bj < 2; ++bj) { const unsigned col0 = u.pn * 256 + bj * 128 + wc * 32 + 8 * fq; bb[bj][0] = *AT(const f32x4, bias, col0 * 4u); bb[bj][1] = *AT(const f32x4, bias, col0 * 4u + 16u); }
#pragma unroll
        for (int ai = 0; ai < 2; ++ai)
#pragma unroll
            for (int m = 0; m < 4; ++m) { const unsigned row = u.pm * 256 + ai * 128 + wr * 64 + m * 16 + fr;
                pp[ai][m][0] = *AT(const f32x4, part, (row * 32u + 8u * fq) * 4u); pp[ai][m][1] = *AT(const f32x4, part, (row * 32u + 8u * fq) * 4u + 16u); }
        __builtin_amdgcn_sched_barrier(0);
#pragma unroll
        for (int ai = 0; ai < 2; ++ai)
#pragma unroll
            for (int m = 0; m < 4; ++m) { const unsigned row = u.pm * 256 + ai * 128 + wr * 64 + m * 16 + fr;
                const f32x4 p0 = pp[ai][m][0], p1 = pp[ai][m][1];
                const float r = rsqrtf(fq_sum(((p0.x + p0.y) + (p0.z + p0.w)) + ((p1.x + p1.y) + (p1.z + p1.w))) * (1.f / D) + EPS);
#pragma unroll
                for (int bj = 0; bj < 2; ++bj) { const unsigned col0 = u.pn * 256 + bj * 128 + wc * 32 + 8 * fq;
                    store8_bf16((unsigned char*)O, (row * (unsigned)D + col0) * 2u, acc[ai][bj][m][0] * r + bb[bj][0], acc[ai][bj][m][1] * r + bb[bj][1]); } }
    }
};
struct EpiQC {
    bf16_t* O; const float* partc; const float* bias;
    __device__ __forceinline__ void elem4(unsigned row, unsigned col0, f32x4 v) const {
        const unsigned po = ((row - (unsigned)T) * 128u + 32u * ((col0 >> 2) & 3u)) * 4u; float sq = 0.f;
#pragma unroll
        for (int i = 0; i < 8; ++i) { const f32x4 t = *AT(const f32x4, partc, po + 16u * i); sq += (t.x + t.y) + (t.z + t.w); }
        const float r = rsqrtf(fq_sum(sq) * (1.f / D) + EPS);
        store4_bf16((unsigned char*)O, (row * (unsigned)D + col0) * 2u, v * r + *AT(const f32x4, bias, col0 * 4u)); }
};
struct EpiInProj {
    static constexpr bool PERM = true, AFTER_DRAIN = false;
    EpiEven ev; EpiOdd od; bool even;
    __device__ __forceinline__ void elem4(unsigned row, unsigned col0, f32x4 v) const { if (even) ev.elem4(row, col0, v); else od.elem4(row, col0, v); }
    __device__ __forceinline__ void operator()(const f32x4 (&acc)[2][2][4][2], const pg8::Unit& u, int wr, int wc, int fr, int fq) const {
        if (even) ev(acc, u, wr, wc, fr, fq); else od(acc, u, wr, wc, fr, fq);
    }
};
struct EpiOutQ {
    static constexpr bool PERM = true, AFTER_DRAIN = false;
    EpiResid rs; EpiPlain pl; bool resid;
    __device__ __forceinline__ void operator()(const f32x4 (&acc)[2][2][4][2], const pg8::Unit& u, int wr, int wc, int fr, int fq) const {
        if (resid) rs(acc, u, wr, wc, fr, fq); else pl(acc, u, wr, wc, fr, fq);
    }
};

template <class Epi, int NT  >
__device__ __forceinline__ void ctx_gemm_piece(const bf16_t* __restrict__ A, const bf16_t* __restrict__ Bt, const Epi& E, int rb, int cb, int wave, int lane) {
    const int fr = lane & 15, fq = lane >> 4;
    const bf16_t* ap = A + (size_t)(T + 16 * rb + fr) * D + 8 * fq;
    const bf16_t* bp = Bt + (size_t)(cb * 128 * NT + 16 * NT * wave + fr) * D + 8 * fq;
    f32x4 acc[NT];
#pragma unroll
    for (int n = 0; n < NT; ++n) acc[n] = (f32x4){0.f, 0.f, 0.f, 0.f};
    constexpr int KC = NT == 1 ? 16 : 8;
#pragma unroll 1
    for (int k0 = 0; k0 < D; k0 += 32 * KC) {
        bf16x8 af[KC], bfg[NT][KC];
#pragma unroll
        for (int kk = 0; kk < KC; ++kk) { af[kk] = *(const bf16x8*)(ap + k0 + 32 * kk);
#pragma unroll
            for (int n = 0; n < NT; ++n) bfg[n][kk] = *(const bf16x8*)(bp + (size_t)16 * n * D + k0 + 32 * kk); }
        __builtin_amdgcn_sched_barrier(0);
#pragma unroll
        for (int kk = 0; kk < KC; ++kk)
#pragma unroll
            for (int n = 0; n < NT; ++n) acc[n] = MFMA16(bfg[n][kk], af[kk], acc[n]);
    }
#pragma unroll
    for (int n = 0; n < NT; ++n) E.elem4((unsigned)(T + 16 * rb + fr), (unsigned)(cb * 128 * NT + 16 * NT * wave + 16 * n + 4 * fq), acc[n]);
}
template <class Epi>
__device__ __forceinline__ void ctx_gemm(const bf16_t* __restrict__ A, const bf16_t* __restrict__ Bt, int N, const Epi& E, int wave, int lane, int vcu, int G) {
    asm volatile("" : "+v"(lane));
    const int npc = 16 * (N >> 7);
    for (int pc = vcu; pc < npc; pc += G) ctx_gemm_piece<Epi, 1>(A, Bt, E, pc & 15, pc >> 4, wave, lane);
}

template <class TF>
__device__ __forceinline__ void attn_wave16(const bf16_t* __restrict__ Qh, int qstride, int qrow0,
                                            const bf16_t* __restrict__ Kh, int kstride, const bf16_t* __restrict__ VTh  ,
                                            int ntiles, const TF& tf, bool has_sink, float sink, float scale,
                                            bf16_t* __restrict__ Oh, int ostride, int lane) {
    asm volatile("" : "+v"(lane));
    const int fr = lane & 15, fq = lane >> 4;
    bf16x8 qf[4];
#pragma unroll
    for (int kd = 0; kd < 4; ++kd) qf[kd] = *(const bf16x8*)(Qh + (size_t)(qrow0 + fr) * qstride + 32 * kd + 8 * fq);
    f32x4 o[8];
#pragma unroll
    for (int nd = 0; nd < 8; ++nd) o[nd] = (f32x4){0.f, 0.f, 0.f, 0.f};
    float mrun = has_sink ? sink * LOG2E : -1e30f;
    float lrun = (has_sink && fq == 0) ? 1.f : 0.f;
    const float sc2 = scale * LOG2E;
    for (int ti = 0; ti < ntiles; ++ti) {
        const int tok0 = tf.tok0(ti);
        f32x4 s[2];
#pragma unroll
        for (int sub = 0; sub < 2; ++sub) {
            s[sub] = (f32x4){0.f, 0.f, 0.f, 0.f};
            int tk = tok0 + 16 * sub + fr; tk = tk < 0 ? 0 : (tk > M - 1 ? M - 1 : tk);
#pragma unroll
            for (int kd = 0; kd < 4; ++kd) { const bf16x8 kf = *(const bf16x8*)(Kh + (size_t)tk * kstride + 32 * kd + 8 * fq); s[sub] = MFMA16(kf, qf[kd], s[sub]); }
        }
        float pv[8]; float tmax = -INFINITY;
#pragma unroll
        for (int sub = 0; sub < 2; ++sub)
#pragma unroll
            for (int r = 0; r < 4; ++r) { const int ks = 16 * sub + 4 * fq + r; const float b = tf.bias(ti, ks);
                const float v = s[sub][r] * sc2 + b * LOG2E; pv[4 * sub + r] = v; tmax = fmaxf(tmax, v); }
        tmax = fmaxf(tmax, __shfl_xor(tmax, 16)); tmax = fmaxf(tmax, __shfl_xor(tmax, 32));
        const float mnew = fmaxf(mrun, tmax), alpha = exp2f(mrun - mnew);
        float ps = 0.f;
#pragma unroll
        for (int i = 0; i < 8; ++i) { pv[i] = exp2f(pv[i] - mnew); ps += pv[i]; }
        lrun = lrun * alpha + ps; mrun = mnew;
#pragma unroll
        for (int nd = 0; nd < 8; ++nd) o[nd] = o[nd] * alpha;
        u32x4 pw; pw.x = pk2(pv[0], pv[1]); pw.y = pk2(pv[2], pv[3]); pw.z = pk2(pv[4], pv[5]); pw.w = pk2(pv[6], pv[7]);
        const bf16x8 pf = mk_frag(pw);
        int t0 = tok0 + 4 * fq, t1 = tok0 + 16 + 4 * fq;
        t0 = t0 < 0 ? 0 : (t0 > M - 4 ? M - 4 : t0); t1 = t1 < 0 ? 0 : (t1 > M - 4 ? M - 4 : t1);
#pragma unroll
        for (int nd = 0; nd < 8; ++nd) { const bf16_t* vr = VTh + (size_t)(16 * nd + fr) * M;
            const u32x2 a = *(const u32x2*)(vr + t0), b = *(const u32x2*)(vr + t1);
            u32x4 w; w.x = a.x; w.y = a.y; w.z = b.x; w.w = b.y;
            o[nd] = MFMA16(mk_frag(w), pf, o[nd]); }
    }
    lrun += __shfl_xor(lrun, 16); lrun += __shfl_xor(lrun, 32);
    const float rl = 1.f / lrun;
#pragma unroll
    for (int nd = 0; nd < 8; ++nd) { const f32x4 v = o[nd] * rl; u32x2 w; w.x = pk2(v[0], v[1]); w.y = pk2(v[2], v[3]);
        *(u32x2*)(Oh + (size_t)(qrow0 + fr) * ostride + 16 * nd + 4 * fq) = w; }
}
struct TFCtxOnly {
    __device__ __forceinline__ int tok0(int ti) const { return T + 32 * ti; }
    __device__ __forceinline__ float bias(int, int) const { return 0.f; }
};
struct TFGqa {
    int jb, tq;
    __device__ __forceinline__ int tok0(int ti) const { return ti < 9 ? 16 * jb - 128 + 32 * ti : T + 32 * (ti - 9); }
    __device__ __forceinline__ float bias(int ti, int ks) const {
        if (ti >= 9) return 0.f;
        const int kp = 16 * jb - 128 + 32 * ti + ks, d = kp - tq;
        return (kp >= 0 && kp < T && d <= 128 && d >= -128) ? 0.f : -INFINITY;
    }
};
struct TFNa {
    int r0, kc0, r, c, c0; const float* rpb;
    __device__ __forceinline__ int tok0(int ti) const { return ti < 8 ? 64 * (r0 + ti) + kc0 : T + 32 * (ti - 8); }
    __device__ __forceinline__ float bias(int ti, int ks) const {
        if (ti >= 8) return 0.f;
        const int kc = kc0 + ks;
        if (kc < c0 || kc >= c0 + 16) return -INFINITY;
        return rpb[(r0 + ti - r + 7) * 31 + (kc - c + 15)];
    }
};

#ifndef ATT_NB
#define ATT_NB 4
#endif
constexpr int ATT_KB = 16384, ATT_VROW = 136, ATT_BUF = ATT_KB + 128 * ATT_VROW;
template <class TF, int MODE = 0>
__device__ __forceinline__ void attn_wg(const TF& tf, const bf16_t* __restrict__ Qh, int qstride, int qrow0, int qrow1,
                                        const bf16_t* __restrict__ Kh, int kstride, const bf16_t* __restrict__ VTh,
                                        bool has_sink, float sink, float scale, bf16_t* __restrict__ Oh, int ostride, LAS unsigned char* lds, int tid, int lane, bool rt_false = false) {
    asm volatile("" : "+v"(lane));
    const int fr = lane & 15, fq = lane >> 4;
    bf16x8 qf[2][4];
#pragma unroll
    for (int qt = 0; qt < 2; ++qt)
#pragma unroll
        for (int kd = 0; kd < 4; ++kd) qf[qt][kd] = *(const bf16x8*)(Qh + (size_t)((qt ? qrow1 : qrow0) + fr) * qstride + 32 * kd + 8 * fq);
    f32x4 o[2][8]; float mrun[2], lrun[2];
#pragma unroll
    for (int qt = 0; qt < 2; ++qt) { mrun[qt] = has_sink ? sink * LOG2E : -1e30f; lrun[qt] = (has_sink && fq == 0) ? 1.f : 0.f;
#pragma unroll
        for (int nd = 0; nd < 8; ++nd) o[qt][nd] = (f32x4){0.f, 0.f, 0.f, 0.f}; }
    const float sc2 = scale * LOG2E;
    const int kr0 = tid >> 4, kch = tid & 15, vd0 = tid >> 3, vc8 = tid & 7;
    u32x4 kreg[2], vreg[2];
    const int nt = tf.ntiles();
#define ATT_LOAD(ti) do { const int t0_ = tf.tile_t0(ti); _Pragma("unroll") for (int i_ = 0; i_ < 2; ++i_) { \
        int tk_ = t0_ + kr0 + 32 * i_; tk_ = tk_ < 0 ? 0 : (tk_ > M - 1 ? M - 1 : tk_); kreg[i_] = *(const u32x4*)(Kh + (size_t)tk_ * kstride + 8 * kch); \
        int tv_ = t0_ + 8 * vc8; tv_ = tv_ < 0 ? 0 : (tv_ > M - 8 ? M - 8 : tv_); vreg[i_] = *(const u32x4*)(VTh + (size_t)(vd0 + 64 * i_) * M + tv_); } } while (0)
#define ATT_STORE(b) do { LAS unsigned char* bb_ = lds + (b) * ATT_BUF; _Pragma("unroll") for (int i_ = 0; i_ < 2; ++i_) { const int r_ = kr0 + 32 * i_; \
        *(LAS u32x4*)(bb_ + r_ * 256 + ((kch ^ (r_ & 15)) << 4)) = kreg[i_]; \
        LAS u32x2* vp_ = (LAS u32x2*)(bb_ + ATT_KB + (vd0 + 64 * i_) * ATT_VROW + 16 * vc8); u32x2 a_, b_; a_.x = vreg[i_].x; a_.y = vreg[i_].y; b_.x = vreg[i_].z; b_.y = vreg[i_].w; vp_[0] = a_; vp_[1] = b_; } } while (0)
    __syncthreads();
    ATT_LOAD(0); ATT_STORE(0);
    __syncthreads();
    for (int ti = 0; ti < nt; ++ti) {
        if (ti + 1 < nt && MODE != 2) ATT_LOAD(ti + 1);
        if (tf.active(ti) && MODE != 3) {
            const LAS unsigned char* kb = lds + (ti & 1) * ATT_BUF; const LAS unsigned char* vbase = kb + ATT_KB;
            const int ns = tf.nsteps(ti);
            for (int st = 0; st < ns; ++st) {
                int ws[2]; f32x4 s[2][2]; float pv[2][8], bs8[2][8], alpha[2];
#pragma unroll
                for (int qt = 0; qt < 2; ++qt) { ws[qt] = tf.win(ti, qt, st);
#pragma unroll
                    for (int sub = 0; sub < 2; ++sub) { s[qt][sub] = (f32x4){0.f, 0.f, 0.f, 0.f}; const int tl = ws[qt] + 16 * sub + fr;
#pragma unroll
                        for (int kd = 0; kd < 4; ++kd) { const bf16x8 kf = *(const LAS bf16x8*)(kb + tl * 256 + (((4 * kd + fq) ^ (tl & 15)) << 4)); s[qt][sub] = MFMA16(kf, qf[qt][kd], s[qt][sub]); } } }
#pragma unroll
                for (int qt = 0; qt < 2; ++qt) tf.bias8(ti, qt, ws[qt] + 4 * fq, bs8[qt]);
                float tmax[2];
#pragma unroll
                for (int qt = 0; qt < 2; ++qt) { tmax[qt] = -INFINITY;
#pragma unroll
                    for (int sub = 0; sub < 2; ++sub)
#pragma unroll
                        for (int r = 0; r < 4; ++r) { const float v = s[qt][sub][r] * sc2 + bs8[qt][4 * sub + r] * LOG2E; pv[qt][4 * sub + r] = v; tmax[qt] = fmaxf(tmax[qt], v); } }
                { const float t0 = __shfl_xor(tmax[0], 16), t1 = __shfl_xor(tmax[1], 16);
                  __builtin_amdgcn_sched_barrier(0);
                  tmax[0] = fmaxf(tmax[0], t0); tmax[1] = fmaxf(tmax[1], t1); }
                { const float t0 = __shfl_xor(tmax[0], 32), t1 = __shfl_xor(tmax[1], 32);
                  __builtin_amdgcn_sched_barrier(0);
                  tmax[0] = fmaxf(tmax[0], t0); tmax[1] = fmaxf(tmax[1], t1); }
                if (__builtin_amdgcn_ballot_w64(tmax[0] > mrun[0] + 8.f || tmax[1] > mrun[1] + 8.f) != 0ull) {
#pragma unroll
                    for (int qt = 0; qt < 2; ++qt) { const float mnew = fmaxf(mrun[qt], tmax[qt]); alpha[qt] = __builtin_amdgcn_exp2f(mrun[qt] - mnew); lrun[qt] *= alpha[qt]; mrun[qt] = mnew;
#pragma unroll
                        for (int nd = 0; nd < 8; ++nd) o[qt][nd] = o[qt][nd] * alpha[qt]; }
                }
#pragma unroll
                for (int qt = 0; qt < 2; ++qt) {
                    float ps = 0.f;
#pragma unroll
                    for (int i = 0; i < 8; ++i) { pv[qt][i] = __builtin_amdgcn_exp2f(pv[qt][i] - mrun[qt]); ps += pv[qt][i]; }
                    lrun[qt] += ps; }
                bf16x8 pf[2];
#pragma unroll
                for (int qt = 0; qt < 2; ++qt) { u32x4 pw; pw.x = pk2(pv[qt][0], pv[qt][1]); pw.y = pk2(pv[qt][2], pv[qt][3]); pw.z = pk2(pv[qt][4], pv[qt][5]); pw.w = pk2(pv[qt][6], pv[qt][7]); pf[qt] = mk_frag(pw); }
                constexpr int NB_ = ATT_NB;
#pragma unroll
                for (int nh = 0; nh < 8; nh += NB_) {
                    u32x4 vw[NB_][2];
#pragma unroll
                    for (int n4 = 0; n4 < NB_; ++n4)
#pragma unroll
                        for (int qt = 0; qt < 2; ++qt) { const LAS unsigned char* vr = vbase + (16 * (nh + n4) + fr) * ATT_VROW + 2 * (ws[qt] + 4 * fq);
                            const u32x2 a = *(const LAS u32x2*)vr, b2 = *(const LAS u32x2*)(vr + 32);
                            vw[n4][qt].x = a.x; vw[n4][qt].y = a.y; vw[n4][qt].z = b2.x; vw[n4][qt].w = b2.y; }
                    __builtin_amdgcn_sched_barrier(0);
#pragma unroll
                    for (int n4 = 0; n4 < NB_; ++n4)
#pragma unroll
                        for (int qt = 0; qt < 2; ++qt) o[qt][nh + n4] = MFMA16(mk_frag(vw[n4][qt]), pf[qt], o[qt][nh + n4]);
                    __builtin_amdgcn_sched_barrier(0);
                }
            }
        }
        if (ti + 1 < nt) ATT_STORE((ti + 1) & 1);
        __syncthreads();
    }
#undef ATT_LOAD
#undef ATT_STORE
    if (MODE == 0 || rt_false)
#pragma unroll
    for (int qt = 0; qt < 2; ++qt) {
        const float lt = fq_sum(lrun[qt]);
        const float rl = 1.f / lt;
#pragma unroll
        for (int nd = 0; nd < 8; ++nd) { const f32x4 v = o[qt][nd] * rl; u32x2 w; w.x = pk2(v[0], v[1]); w.y = pk2(v[2], v[3]);
            *(u32x2*)(Oh + (size_t)((qt ? qrow1 : qrow0) + fr) * ostride + 16 * nd + 4 * fq) = w; }
    }
}
struct TFCtxW {
    __device__ __forceinline__ int ntiles() const { return 4; }
    __device__ __forceinline__ int tile_t0(int ti) const { return T + 64 * ti; }
    __device__ __forceinline__ bool active(int) const { return true; }
    __device__ __forceinline__ int nsteps(int) const { return 2; }
    __device__ __forceinline__ int win(int, int, int st) const { return 32 * st; }
    __device__ __forceinline__ void bias8(int, int, int, float (&b)[8]) const {
#pragma unroll
        for (int i = 0; i < 8; ++i) b[i] = 0.f; }
};
struct TFGqaW {
    int jb64, q0;
    __device__ __forceinline__ int ntiles() const { return 9; }
    __device__ __forceinline__ int tile_t0(int ti) const { return ti < 5 ? 64 * jb64 - 128 + 64 * ti : T + 64 * (ti - 5); }
    __device__ __forceinline__ bool active(int) const { return true; }
    __device__ __forceinline__ int nsteps(int) const { return 2; }
    __device__ __forceinline__ int win(int, int, int st) const { return 32 * st; }
    __device__ __forceinline__ void bias8(int ti, int qt, int key0, float (&b)[8]) const {
        const bool plain = ti >= 5 || (ti >= 1 && ti <= 3 && 64 * jb64 - 128 + 64 * ti >= 0 && 64 * jb64 - 128 + 64 * ti + 63 < T);
        if (plain) {
#pragma unroll
            for (int i = 0; i < 8; ++i) b[i] = 0.f;
        } else {
#pragma unroll
            for (int i = 0; i < 8; ++i) { const int key = key0 + 16 * (i >> 2) + (i & 3); const int kp = 64 * jb64 - 128 + 64 * ti + key, d = kp - (q0 + 16 * qt);
                b[i] = (kp >= 0 && kp < T && d <= 128 && d >= -128) ? 0.f : -INFINITY; }
        }
    }
};
struct TFNaW {
    int rlo, nl, r, r0, hf, fr; const LAS float* rpb;
    __device__ __forceinline__ int ntiles() const { return nl + 4; }
    __device__ __forceinline__ int tile_t0(int ti) const { return ti < nl ? 64 * (rlo + ti) : T + 64 * (ti - nl); }
    __device__ __forceinline__ bool active(int ti) const { return ti >= nl || (rlo + ti >= r0 && rlo + ti < r0 + 8); }
    __device__ __forceinline__ int nsteps(int ti) const { return ti < nl ? 1 : 2; }
    __device__ __forceinline__ int win(int ti, int qt, int st) const { if (ti >= nl) return 32 * st; const int cq = 2 * hf + qt; return cq == 0 ? 0 : (cq == 1 ? 8 : (cq == 2 ? 24 : 32)); }
    __device__ __forceinline__ void bias8(int ti, int qt, int key0, float (&b)[8]) const {
        if (ti >= nl) {
#pragma unroll
            for (int i = 0; i < 8; ++i) b[i] = 0.f;
        } else {
            const int c = 32 * hf + 16 * qt + fr, c0 = c - 8 < 0 ? 0 : (c - 8 > 48 ? 48 : c - 8);
            const LAS float* row = rpb + (rlo + ti - r + 7) * 31;
#pragma unroll
            for (int i = 0; i < 8; ++i) { const int key = key0 + 16 * (i >> 2) + (i & 3); int off = key - c + 15; off = off < 0 ? 0 : (off > 30 ? 30 : off);
                const float v = row[off]; b[i] = ((unsigned)(key - c0) < 16u) ? v : -INFINITY; }
        }
    }
};

__device__ __forceinline__ void ph_attn_even(const Params& p, int e, bool with_ctx, LAS unsigned char* lds, int tid, int lane, int wave, int vcu, int G) {
    unsigned char* proj = p.ws + WS_PROJ;
    const bf16_t* BQ = (const bf16_t*)(proj + PJ_BQ); const bf16_t* BK = (const bf16_t*)(proj + PJ_BK); const bf16_t* BVT = (const bf16_t*)(proj + PJ_BVT);
    bf16_t* MIX = (bf16_t*)(p.ws + WS_MIX);
    const float scale = 0.08838834764831845f;
#ifdef ATT_PROBE
    for (int U = vcu; U < 256; U += G) {
        const int jb64 = U >> 1, kvh = U & 1, h = kvh * 4 + (wave & 3), hf = wave >> 2;
        TFGqaW tf; tf.jb64 = jb64; tf.q0 = 64 * jb64 + 32 * hf + (lane & 15);
        attn_wg<TFGqaW, ATT_PROBE>(tf, BQ + h * 128, 1024, 64 * jb64 + 32 * hf, 64 * jb64 + 32 * hf + 16, BK + kvh * 128, 256, BVT + (size_t)kvh * 128 * M, true, p.ab_sink[e * 8 + h], scale, MIX + 1024 + h * 128, 2048, lds, tid, lane, p.grid == 12345);
    }
#endif
    for (int U = vcu; U < 256; U += G) {
        const int jb64 = U >> 1, kvh = U & 1, h = kvh * 4 + (wave & 3), hf = wave >> 2;
        TFGqaW tf; tf.jb64 = jb64; tf.q0 = 64 * jb64 + 32 * hf + (lane & 15);
        attn_wg(tf, BQ + h * 128, 1024, 64 * jb64 + 32 * hf, 64 * jb64 + 32 * hf + 16, BK + kvh * 128, 256, BVT + (size_t)kvh * 128 * M, true, p.ab_sink[e * 8 + h], scale, MIX + 1024 + h * 128, 2048, lds, tid, lane);
    }
    if (with_ctx) for (int U = G - 1 - vcu; U < 8; U += G) {
        const int h = U, kvh = h >> 2;
        attn_wg(TFCtxW(), BQ + h * 128, 1024, T + 32 * wave, T + 32 * wave + 16, BK + kvh * 128, 256, BVT + (size_t)kvh * 128 * M, true, p.ab_sink[e * 8 + h], scale, MIX + 1024 + h * 128, 2048, lds, tid, lane);
    }
}
__device__ __forceinline__ void ph_attn_odd(const Params& p, int o, bool with_ctx, LAS unsigned char* lds, int tid, int lane, int wave, int vcu, int G) {
    unsigned char* proj = p.ws + WS_PROJ;
    const bf16_t* Q = (const bf16_t*)(proj + PJ_Q); const bf16_t* K = (const bf16_t*)(proj + PJ_K); const bf16_t* VT = (const bf16_t*)(proj + PJ_VT);
    bf16_t* MIX = (bf16_t*)(p.ws + WS_MIX);
    const float scale = 0.08838834764831845f;
#ifdef NA_PROBE
    for (int U = vcu; U < 512; U += G) {
        const int rg = U >> 4, h = U & 15, r = 4 * rg + (wave >> 1), hf = wave & 1;
        TFNaW tf; tf.r = r; tf.r0 = r - 4 < 0 ? 0 : (r - 4 > 120 ? 120 : r - 4); tf.hf = hf; tf.fr = lane & 15; tf.rpb = (const LAS float*)(lds + 2 * ATT_BUF);
        { const float* rsrc = p.na_rpb + ((size_t)o * 16 + h) * 15 * 31; __syncthreads(); if (tid < 465) ((LAS float*)(lds + 2 * ATT_BUF))[tid] = rsrc[tid]; }
        const int rl_ = 4 * rg - 4 < 0 ? 0 : (4 * rg - 4 > 120 ? 120 : 4 * rg - 4), rh_ = (4 * rg - 1 < 0 ? 0 : (4 * rg - 1 > 120 ? 120 : 4 * rg - 1)) + 7;
        tf.rlo = rl_; tf.nl = rh_ - rl_ + 1;
        attn_wg<TFNaW, 1>(tf, Q + h * 128, 2048, 64 * r + 32 * hf, 64 * r + 32 * hf + 16, K + h * 128, 2048, VT + (size_t)h * 128 * M, false, 0.f, scale, MIX + h * 128, 2048, lds, tid, lane, p.grid == 12345);
    }
#endif
    for (int U = vcu; U < 512; U += G) {
        const int rg = U >> 4, h = U & 15, r = 4 * rg + (wave >> 1), hf = wave & 1;
        TFNaW tf; tf.r = r; tf.r0 = r - 4 < 0 ? 0 : (r - 4 > 120 ? 120 : r - 4); tf.hf = hf; tf.fr = lane & 15; tf.rpb = (const LAS float*)(lds + 2 * ATT_BUF);
        { const float* rsrc = p.na_rpb + ((size_t)o * 16 + h) * 15 * 31; __syncthreads(); if (tid < 465) ((LAS float*)(lds + 2 * ATT_BUF))[tid] = rsrc[tid]; }
        const int rl_ = 4 * rg - 4 < 0 ? 0 : (4 * rg - 4 > 120 ? 120 : 4 * rg - 4), rh_ = (4 * rg - 1 < 0 ? 0 : (4 * rg - 1 > 120 ? 120 : 4 * rg - 1)) + 7;
        tf.rlo = rl_; tf.nl = rh_ - rl_ + 1;
        attn_wg(tf, Q + h * 128, 2048, 64 * r + 32 * hf, 64 * r + 32 * hf + 16, K + h * 128, 2048, VT + (size_t)h * 128 * M, false, 0.f, scale, MIX + h * 128, 2048, lds, tid, lane);
    }
    if (with_ctx) for (int U = G - 1 - vcu; U < 16; U += G) {
        const int h = U;
        attn_wg(TFCtxW(), Q + h * 128, 2048, T + 32 * wave, T + 32 * wave + 16, K + h * 128, 2048, VT + (size_t)h * 128 * M, false, 0.f, scale, MIX + h * 128, 2048, lds, tid, lane);
    }
}

__device__ __forceinline__ void mlstm_A_unit(const Params& p, int cc, int hd, int lane) {
    asm volatile("" : "+v"(lane));
    const int fr = lane & 15, fq = lane >> 4, dir = hd >> 3, head = hd & 7, tok0 = cc * 64;
    unsigned char* proj = p.ws + WS_PROJ;
    const bf16_t* AKT = (const bf16_t*)(proj + PJ_AKT); const bf16_t* AVT = (const bf16_t*)(proj + PJ_AVT); const float* Gt = (const float*)(proj + PJ_G);
    float* U = (float*)(p.ws + WS_U); float* CHS = (float*)(p.ws + WS_CHS);
    const float* grow = Gt + (size_t)(tok0 + lane) * 32;
    u32x4 rawk[2][4]; bf16x8 bv[8][2];
#pragma unroll
    for (int ks = 0; ks < 2; ++ks)
#pragma unroll
        for (int nd = 0; nd < 4; ++nd) rawk[ks][nd] = *(const u32x4*)(AKT + (size_t)(head * 64 + 16 * nd + fr) * M + tok0 + 32 * ks + 8 * fq);
#pragma unroll
    for (int ne = 0; ne < 8; ++ne)
#pragma unroll
        for (int ks = 0; ks < 2; ++ks) bv[ne][ks] = *(const bf16x8*)(AVT + (size_t)(head * 128 + 16 * ne + fr) * M + tok0 + 32 * ks + 8 * fq);
    const float ig = grow[(2 * dir) * 8 + head], lf_raw = grow[(2 * dir + 1) * 8 + head];
    __builtin_amdgcn_sched_barrier(0);
    const float lf = log_sigmoid(lf_raw);
    const float F = scan_add(lf, lane, dir);
    const float FL = __shfl(F, dir ? 0 : 63);
    const float wend = FL - F + ig, wmax = wave_max(wend), wv = expf(wend - wmax);
    if (lane == 0) { CHS[((size_t)hd * NCH + cc) * 2] = FL; CHS[((size_t)hd * NCH + cc) * 2 + 1] = wmax; }
    { float* GF = (float*)(p.ws + WS_GF); const float Bs_ = ig - F, pm_ = scan_max(Bs_, lane, dir); const size_t gi = (size_t)hd * M + tok0 + lane;
      GF[gi] = F; GF[(size_t)16 * M + gi] = Bs_; GF[(size_t)32 * M + gi] = pm_; }
    bf16x8 af[4][2];
#pragma unroll
    for (int ks = 0; ks < 2; ++ks) {
        float w8[8];
#pragma unroll
        for (int j = 0; j < 8; ++j) w8[j] = __shfl(wv, 32 * ks + 8 * fq + j);
#pragma unroll
        for (int nd = 0; nd < 4; ++nd) {
            const u32x4 raw = rawk[ks][nd];
            u32x4 w; w.x = pk2(bf_lo(raw.x) * w8[0], bf_hi(raw.x) * w8[1]); w.y = pk2(bf_lo(raw.y) * w8[2], bf_hi(raw.y) * w8[3]);
            w.z = pk2(bf_lo(raw.z) * w8[4], bf_hi(raw.z) * w8[5]); w.w = pk2(bf_lo(raw.w) * w8[6], bf_hi(raw.w) * w8[7]);
            af[nd][ks] = mk_frag(w);
        }
    }
    const unsigned onew = (fr == 0) ? 0x3F803F80u : 0u;
#pragma unroll
    for (int ne = 0; ne < 9; ++ne) {
        bf16x8 bfr[2];
#pragma unroll
        for (int ks = 0; ks < 2; ++ks) {
            if (ne < 8) bfr[ks] = bv[ne < 8 ? ne : 0][ks];
            else { u32x4 w; w.x = onew; w.y = onew; w.z = onew; w.w = onew; bfr[ks] = mk_frag(w); }
        }
#pragma unroll
        for (int nd = 0; nd < 4; ++nd) {
            f32x4 acc = (f32x4){0.f, 0.f, 0.f, 0.f};
#pragma unroll
            for (int ks = 0; ks < 2; ++ks) acc = MFMA16(af[nd][ks], bfr[ks], acc);
            *(f32x4*)(U + (((size_t)hd * NCH + cc) * 144 + 16 * ne + fr) * 64 + 16 * nd + 4 * fq) = acc;
        }
    }
}
__device__ __forceinline__ void ph_mlstm_B(const Params& p, LAS unsigned char* lds, int tid, int G) {
    const float* U = (const float*)(p.ws + WS_U); const float* CHS = (const float*)(p.ws + WS_CHS);
    bf16_t* SNAP = (bf16_t*)(p.ws + WS_SNAP); float* MPREV = (float*)(p.ws + WS_CHS + 65536);
    LAS float* sDec = (LAS float*)lds; LAS float* sInj = sDec + 132;
    for (int b = blockIdx.x; b < 256; b += G) {
        const int hd = b >> 4, part = b & 15, dir = hd >> 3;
        __syncthreads();
        if (tid < NCH) { const int cc = dir ? (NCH - 1 - tid) : (tid < 4 ? 128 + tid : tid - 4); sDec[tid] = CHS[((size_t)hd * NCH + cc) * 2]; sInj[tid] = CHS[((size_t)hd * NCH + cc) * 2 + 1]; }
        __syncthreads();
        LAS float* sM = sInj + 132;
        if (tid == 0) { float m = 0.f;
            for (int step = 0; step < NCH; ++step) { sM[step] = m; m = fmaxf(sDec[step] + m, sInj[step]); } sM[NCH] = m; }
        __syncthreads();
        if (tid < NCH) { const int step = tid; const int cc = dir ? (NCH - 1 - step) : (step < 4 ? 128 + step : step - 4);
            const float FL = sDec[step], wm = sInj[step], m = sM[step], mn = sM[step + 1];
            if (part == 0) MPREV[hd * NCH + cc] = m;
            sDec[step] = expf(FL + m - mn); sInj[step] = expf(wm - mn); }
        __syncthreads();
        const int i0 = part * 512 + tid; const bool has2 = (part == 0 && tid < 64); const int i1 = 8192 + tid;
        float C0 = 0.f, C1 = 0.f;
#pragma unroll 1
        for (int s12 = 0; s12 < NCH; s12 += 22) {
            float u0[22], u1[22]; size_t base[22];
#pragma unroll
            for (int k = 0; k < 22; ++k) { const int step = s12 + k; const int cc = dir ? (NCH - 1 - step) : (step < 4 ? 128 + step : step - 4);
                base[k] = ((size_t)hd * NCH + cc) * 9216; u0[k] = U[base[k] + i0]; u1[k] = has2 ? U[base[k] + i1] : 0.f; }
#pragma unroll
            for (int k = 0; k < 22; ++k) {
                SNAP[base[k] + i0] = (bf16_t)(pk2(C0, 0.f) & 0xffff);
                if (has2) SNAP[base[k] + i1] = (bf16_t)(pk2(C1, 0.f) & 0xffff);
                const float decay = sDec[s12 + k], inj = sInj[s12 + k];
                C0 = decay * C0 + inj * u0[k]; C1 = decay * C1 + inj * u1[k]; }
        }
    }
}
__device__ __forceinline__ void mlstm_C_unit(const Params& p, int e_idx, int cc, int head, int tq, int lane) {
    asm volatile("" : "+v"(lane));
    const int fr = lane & 15, fq = lane >> 4, tok0 = cc * 64, tl = 16 * tq + fr;
    unsigned char* proj = p.ws + WS_PROJ;
    const bf16_t* AQ = (const bf16_t*)(proj + PJ_AQ); const bf16_t* AK = (const bf16_t*)(proj + PJ_AK); const bf16_t* AVT = (const bf16_t*)(proj + PJ_AVT);
    const bf16_t* AO = (const bf16_t*)(proj + PJ_AO); const float* Gt = (const float*)(proj + PJ_G);
    const bf16_t* SNAP = (const bf16_t*)(p.ws + WS_SNAP); const float* MPREV = (const float*)(p.ws + WS_CHS + 65536);
    bf16_t* MIX = (bf16_t*)(p.ws + WS_MIX);
    bf16x8 qf[2];
#pragma unroll
    for (int kd = 0; kd < 2; ++kd) qf[kd] = *(const bf16x8*)(AQ + (size_t)(tok0 + tl) * 512 + head * 64 + 32 * kd + 8 * fq);
    f32x4 s[4];
#pragma unroll
    for (int ns = 0; ns < 4; ++ns) { s[ns] = (f32x4){0.f, 0.f, 0.f, 0.f};
#pragma unroll
        for (int kd = 0; kd < 2; ++kd) { const bf16x8 kf = *(const bf16x8*)(AK + (size_t)(tok0 + 16 * ns + fr) * 512 + head * 64 + 32 * kd + 8 * fq); s[ns] = MFMA16(kf, qf[kd], s[ns]); } }
    f32x4 hs[8];
#pragma unroll
    for (int ne = 0; ne < 8; ++ne) hs[ne] = (f32x4){0.f, 0.f, 0.f, 0.f};
    const float* grow = Gt + (size_t)(tok0 + lane) * 32;
#pragma unroll
    for (int dir = 0; dir < 2; ++dir) {
        const int hd = dir * 8 + head;
        const float* GF = (const float*)(p.ws + WS_GF) + (size_t)hd * M + tok0;
        const float F_t = GF[tl], pm_t = GF[(size_t)32 * M + tl];
        const float inter = F_t + MPREV[hd * NCH + cc], mt = fmaxf(inter, F_t + pm_t);
        const float A_t = F_t - mt, a_t = expf(inter - mt), fl_t = expf(-mt);
        bf16x8 pf[2];
#pragma unroll
        for (int ks = 0; ks < 2; ++ks) { unsigned w[4];
#pragma unroll
            for (int hf = 0; hf < 2; ++hf) { const int ns = 2 * ks + hf; float ev[4];
                const f32x4 b4 = *(const f32x4*)(GF + (size_t)16 * M + 16 * ns + 4 * fq);
#pragma unroll
                for (int r = 0; r < 4; ++r) { const int sl = 16 * ns + 4 * fq + r;
                    const bool valid = dir ? (sl >= tl) : (sl <= tl);
                    ev[r] = s[ns][r] * expf(valid ? (A_t + b4[r]) : -INFINITY); }
                w[2 * hf] = pk2(ev[0], ev[1]); w[2 * hf + 1] = pk2(ev[2], ev[3]); }
            u32x4 ww; ww.x = w[0]; ww.y = w[1]; ww.z = w[2]; ww.w = w[3]; pf[ks] = mk_frag(ww); }
        const bf16_t* snap = SNAP + ((size_t)hd * NCH + cc) * 9216;
        float rden = 0.f;
#pragma unroll
        for (int it = 0; it < 9; ++it) {
            const int ne = (it == 0) ? 8 : it - 1;
            f32x4 acc = (f32x4){0.f, 0.f, 0.f, 0.f};
#pragma unroll
            for (int kd = 0; kd < 2; ++kd) {
                u32x4 cw = *(const u32x4*)(snap + (size_t)(16 * ne + fr) * 64 + 32 * kd + 8 * fq);
                if (ne == 8 && fr != 0) { cw.x = 0u; cw.y = 0u; cw.z = 0u; cw.w = 0u; }
                acc = MFMA16(mk_frag(cw), qf[kd], acc);
            }
            acc = acc * a_t;
#pragma unroll
            for (int ks = 0; ks < 2; ++ks) {
                u32x4 vw;
                if (ne < 8) { const bf16_t* vr = AVT + (size_t)(head * 128 + 16 * ne + fr) * M + tok0 + 32 * ks + 4 * fq;
                    const u32x2 a = *(const u32x2*)vr, b = *(const u32x2*)(vr + 16); vw.x = a.x; vw.y = a.y; vw.z = b.x; vw.w = b.y; }
                else { const unsigned onew = (fr == 0) ? 0x3F803F80u : 0u; vw.x = onew; vw.y = onew; vw.z = onew; vw.w = onew; }
                acc = MFMA16(mk_frag(vw), pf[ks], acc);
            }
            if (ne == 8) { const float den = __shfl(acc[0], fr); rden = 1.f / fmaxf(fabsf(den), fl_t); }
            else hs[ne] = hs[ne] + acc * rden;
        }
    }
    float ss = 0.f;
#pragma unroll
    for (int ne = 0; ne < 8; ++ne) ss += (hs[ne][0] * hs[ne][0] + hs[ne][1] * hs[ne][1]) + (hs[ne][2] * hs[ne][2] + hs[ne][3] * hs[ne][3]);
    ss += __shfl_xor(ss, 16); ss += __shfl_xor(ss, 32);
    const float rs = rsqrtf(ss * (1.f / 128.f) + EPS);
    const int tok = tok0 + tl;
#pragma unroll
    for (int ne = 0; ne < 8; ++ne) { const int col = head * 128 + 16 * ne + 4 * fq;
        const f32x4 g4 = *(const f32x4*)(p.ab_mh_g + (size_t)e_idx * 1024 + col);
        const u32x2 ow = *(const u32x2*)(AO + (size_t)tok * 1024 + col);
        const float o0 = bf_lo(ow.x), o1 = bf_hi(ow.x), o2 = bf_lo(ow.y), o3 = bf_hi(ow.y);
        const f32x4 v = hs[ne] * rs * g4;
        u32x2 w; w.x = pk2(v[0] / (1.f + expf(-o0)), v[1] / (1.f + expf(-o1))); w.y = pk2(v[2] / (1.f + expf(-o2)), v[3] / (1.f + expf(-o3)));
        *(u32x2*)(MIX + (size_t)tok * 2048 + col) = w; }
}

constexpr int MC_K = 0, MC_Q = 8192, MC_VT = 16384, MC_S = 34816  , MC_G = 71680  , MC_H = 73728  , MC_END = 106496;
__device__ __forceinline__ void mlstm_C_wg(const Params& p, int e_idx, LAS unsigned char* lds, int tid, int lane, int wave, int vcu, int G) {
    asm volatile("" : "+v"(lane));
    const int fr = lane & 15, fq = lane >> 4, tq = wave & 3, dir = wave >> 2, tl = 16 * tq + fr;
    unsigned char* proj = p.ws + WS_PROJ;
    const bf16_t* AQ = (const bf16_t*)(proj + PJ_AQ); const bf16_t* AK = (const bf16_t*)(proj + PJ_AK); const bf16_t* AVT = (const bf16_t*)(proj + PJ_AVT);
    const bf16_t* AO = (const bf16_t*)(proj + PJ_AO);
    const bf16_t* SNAP = (const bf16_t*)(p.ws + WS_SNAP); const float* MPREV = (const float*)(p.ws + WS_CHS + 65536);
    const float* GFg = (const float*)(p.ws + WS_GF);
    bf16_t* MIX = (bf16_t*)(p.ws + WS_MIX);
    const int row = tid >> 3, ch = tid & 7;
    u32x4 kv, qv, vv[2], sv[2][3]; float gv = 0.f;
#define MC_FETCH(U_) do { const int cc_ = (U_) >> 3, hd_ = (U_) & 7, t0_ = cc_ * 64; \
        kv = *(const u32x4*)(AK + (size_t)(t0_ + row) * 512 + hd_ * 64 + ch * 8); qv = *(const u32x4*)(AQ + (size_t)(t0_ + row) * 512 + hd_ * 64 + ch * 8); \
        _Pragma("unroll") for (int i = 0; i < 2; ++i) vv[i] = *(const u32x4*)(AVT + (size_t)(hd_ * 128 + row + 64 * i) * M + t0_ + ch * 8); \
        _Pragma("unroll") for (int d = 0; d < 2; ++d) _Pragma("unroll") for (int i = 0; i < 3; ++i) { const int q = tid + 512 * i, e = q >> 3; const u32x4 z = {0u, 0u, 0u, 0u}; \
            sv[d][i] = (q < 1152 && e < 129) ? *(const u32x4*)(SNAP + ((size_t)(d * 8 + hd_) * NCH + cc_) * 9216 + (size_t)e * 64 + ch * 8) : z; } \
        if (tid < 384) { const int which = tid >> 6, t = tid & 63, kind = which % 3, dd = which / 3; gv = GFg[((size_t)kind * 16 + dd * 8 + hd_) * M + t0_ + t]; } } while (0)
    int U = vcu;
    if (U < NCH * 8) MC_FETCH(U);
    for (; U < NCH * 8; U += G) {
    const int cc = U >> 3, head = U & 7, tok0 = cc * 64, hd = dir * 8 + head;
    __syncthreads();
    {
        *(LAS u32x4*)(lds + MC_K + row * 128 + ((ch ^ (row & 7)) << 4)) = kv;
        *(LAS u32x4*)(lds + MC_Q + row * 128 + ((ch ^ (row & 7)) << 4)) = qv;
#pragma unroll
        for (int i = 0; i < 2; ++i) { const int e = row + 64 * i; *(LAS u32x4*)(lds + MC_VT + e * 128 + ((ch ^ (e & 7)) << 4)) = vv[i]; }
        if (tid < 128) { const int e = 128 + row; const unsigned o1 = (e == 128) ? 0x3F803F80u : 0u; const u32x4 ov = {o1, o1, o1, o1}; *(LAS u32x4*)(lds + MC_VT + e * 128 + ((ch ^ (e & 7)) << 4)) = ov; }
#pragma unroll
        for (int d = 0; d < 2; ++d)
#pragma unroll
            for (int i = 0; i < 3; ++i) { const int q = tid + 512 * i, e = q >> 3; if (q < 1152) *(LAS u32x4*)(lds + MC_S + d * 18432 + e * 128 + ((ch ^ (e & 7)) << 4)) = sv[d][i]; }
        if (tid < 384) *(LAS float*)(lds + MC_G + tid * 4) = gv;
    }
    __syncthreads();
    if (U + G < NCH * 8) MC_FETCH(U + G);
    bf16x8 qf[2];
#pragma unroll
    for (int kd = 0; kd < 2; ++kd) qf[kd] = *(const LAS bf16x8*)(lds + MC_Q + tl * 128 + (((4 * kd + fq) ^ (tl & 7)) << 4));
    f32x4 s[4];
#pragma unroll
    for (int ns = 0; ns < 4; ++ns) { s[ns] = (f32x4){0.f, 0.f, 0.f, 0.f}; const int sr = 16 * ns + fr;
#pragma unroll
        for (int kd = 0; kd < 2; ++kd) { const bf16x8 kf = *(const LAS bf16x8*)(lds + MC_K + sr * 128 + (((4 * kd + fq) ^ (sr & 7)) << 4)); s[ns] = MFMA16(kf, qf[kd], s[ns]); } }
    const LAS float* G = (const LAS float*)(lds + MC_G + dir * 768);
    const float F_t = G[tl], pm_t = G[128 + tl];
    const float inter = F_t + MPREV[hd * NCH + cc], mt = fmaxf(inter, F_t + pm_t);
    const float A_t = F_t - mt, a_t = expf(inter - mt), fl_t = expf(-mt);
    bf16x8 pf[2];
#pragma unroll
    for (int ks = 0; ks < 2; ++ks) { unsigned w[4];
#pragma unroll
        for (int hf = 0; hf < 2; ++hf) { const int ns = 2 * ks + hf; float ev[4];
            const f32x4 b4 = *(const LAS f32x4*)(G + 64 + 16 * ns + 4 * fq);
#pragma unroll
            for (int r = 0; r < 4; ++r) { const int sl = 16 * ns + 4 * fq + r; const bool valid = dir ? (sl >= tl) : (sl <= tl);
                ev[r] = s[ns][r] * expf(valid ? (A_t + b4[r]) : -INFINITY); }
            w[2 * hf] = pk2(ev[0], ev[1]); w[2 * hf + 1] = pk2(ev[2], ev[3]); }
        u32x4 ww; ww.x = w[0]; ww.y = w[1]; ww.z = w[2]; ww.w = w[3]; pf[ks] = mk_frag(ww); }
    const LAS unsigned char* snap = lds + MC_S + dir * 18432;
    f32x4 hs[8]; float rden = 0.f;
#pragma unroll
    for (int g3 = 0; g3 < 3; ++g3) {
        bf16x8 cfr[3][2]; u32x4 vwr[3][2];
#pragma unroll
        for (int i3 = 0; i3 < 3; ++i3) { const int it = 3 * g3 + i3; const int ne = (it == 0) ? 8 : it - 1; const int er = 16 * ne + fr;
#pragma unroll
            for (int kd = 0; kd < 2; ++kd) cfr[i3][kd] = *(const LAS bf16x8*)(snap + er * 128 + (((4 * kd + fq) ^ (er & 7)) << 4));
#pragma unroll
            for (int ks = 0; ks < 2; ++ks) {
                const LAS unsigned char* vr = lds + MC_VT + er * 128 + 8 * (fq & 1);
                const u32x2 a = *(const LAS u32x2*)(vr + (((4 * ks + (fq >> 1)) ^ (er & 7)) << 4)), b = *(const LAS u32x2*)(vr + (((4 * ks + 2 + (fq >> 1)) ^ (er & 7)) << 4));
                vwr[i3][ks].x = a.x; vwr[i3][ks].y = a.y; vwr[i3][ks].z = b.x; vwr[i3][ks].w = b.y; } }
        __builtin_amdgcn_sched_barrier(0);
#pragma unroll
        for (int i3 = 0; i3 < 3; ++i3) { const int it = 3 * g3 + i3; const int ne = (it == 0) ? 8 : it - 1;
            f32x4 acc = (f32x4){0.f, 0.f, 0.f, 0.f};
#pragma unroll
            for (int kd = 0; kd < 2; ++kd) acc = MFMA16(cfr[i3][kd], qf[kd], acc);
            acc = acc * a_t;
#pragma unroll
            for (int ks = 0; ks < 2; ++ks) acc = MFMA16(mk_frag(vwr[i3][ks]), pf[ks], acc);
            if (ne == 8) { const float den = __shfl(acc[0], fr); rden = 1.f / fmaxf(fabsf(den), fl_t); }
            else hs[ne] = acc * rden; }
        __builtin_amdgcn_sched_barrier(0);
    }
    if (dir == 1) {
#pragma unroll
        for (int ne = 0; ne < 8; ++ne) *(LAS f32x4*)(lds + MC_H + tq * 8192 + ne * 1024 + lane * 16) = hs[ne];
    }
    __syncthreads();
    if (dir == 0) {
        float ss = 0.f;
#pragma unroll
        for (int ne = 0; ne < 8; ++ne) { hs[ne] = hs[ne] + *(const LAS f32x4*)(lds + MC_H + tq * 8192 + ne * 1024 + lane * 16);
            ss += (hs[ne][0] * hs[ne][0] + hs[ne][1] * hs[ne][1]) + (hs[ne][2] * hs[ne][2] + hs[ne][3] * hs[ne][3]); }
        ss = fq_sum(ss);
        const float rs = rsqrtf(ss * (1.f / 128.f) + EPS);
        const int tok = tok0 + tl;
        f32x4 g4a[8]; u32x2 owa[8];
#pragma unroll
        for (int ne = 0; ne < 8; ++ne) { const int col = head * 128 + 16 * ne + 4 * fq; g4a[ne] = *(const f32x4*)(p.ab_mh_g + (size_t)e_idx * 1024 + col); owa[ne] = *(const u32x2*)(AO + (size_t)tok * 1024 + col); }
        __builtin_amdgcn_sched_barrier(0);
#pragma unroll
        for (int ne = 0; ne < 8; ++ne) { const int col = head * 128 + 16 * ne + 4 * fq;
            const f32x4 g4 = g4a[ne];
            const u32x2 ow = owa[ne];
            const float o0 = bf_lo(ow.x), o1 = bf_hi(ow.x), o2 = bf_lo(ow.y), o3 = bf_hi(ow.y);
            const f32x4 v = hs[ne] * rs * g4;
            u32x2 w; w.x = pk2(v[0] / (1.f + expf(-o0)), v[1] / (1.f + expf(-o1))); w.y = pk2(v[2] / (1.f + expf(-o2)), v[3] / (1.f + expf(-o3)));
            *(u32x2*)(MIX + (size_t)tok * 2048 + col) = w; }
    }
    }
#undef MC_FETCH
}

#define CE_DESC(a, b) do { const float _x = fmaxf(a, b), _y = fminf(a, b); a = _x; b = _y; } while (0)
__device__ __forceinline__ void sort16_desc(float (&v)[16]) {
#pragma unroll
    for (int k = 2; k <= 16; k <<= 1)
#pragma unroll
        for (int j = k >> 1; j > 0; j >>= 1)
#pragma unroll
            for (int i = 0; i < 16; ++i) { const int l = i ^ j; if (l > i) { if ((i & k) == 0) CE_DESC(v[i], v[l]); else CE_DESC(v[l], v[i]); } }
}
__device__ __forceinline__ void merge16_desc(float (&a)[16], const float (&b)[16]) {
#pragma unroll
    for (int i = 0; i < 16; ++i) a[i] = fmaxf(a[i], b[15 - i]);
#pragma unroll
    for (int j = 8; j > 0; j >>= 1)
#pragma unroll
        for (int i = 0; i < 16; ++i) { const int l = i ^ j; if (l > i) CE_DESC(a[i], a[l]); }
}
__device__ __forceinline__ void ce_desc_p(float& va, int& pa, float& vb, int& pb) {
    float nva, nvb; int npa, npb;
    asm volatile("v_cmp_gt_f32 vcc, %5, %4\n\tv_cndmask_b32 %0, %4, %5, vcc\n\tv_cndmask_b32 %1, %5, %4, vcc\n\tv_cndmask_b32 %2, %6, %7, vcc\n\tv_cndmask_b32 %3, %7, %6, vcc"
                 : "=&v"(nva), "=&v"(nvb), "=&v"(npa), "=&v"(npb) : "v"(va), "v"(vb), "v"(pa), "v"(pb) : "vcc");
    va = nva; vb = nvb; pa = npa; pb = npb;
}
#define CE_DESC_P(va, pa, vb, pb) ce_desc_p(va, pa, vb, pb)
__device__ __forceinline__ void sort16p_desc(float (&v)[16], int (&q)[16]) {
#pragma unroll
    for (int k = 2; k <= 16; k <<= 1)
#pragma unroll
        for (int j = k >> 1; j > 0; j >>= 1)
#pragma unroll
            for (int i = 0; i < 16; ++i) { const int l = i ^ j; if (l > i) { if ((i & k) == 0) CE_DESC_P(v[i], q[i], v[l], q[l]); else CE_DESC_P(v[l], q[l], v[i], q[i]); } }
}
__device__ __forceinline__ void merge16p_desc(float (&a)[16], int (&qa)[16], const float (&b)[16], const int (&qb)[16]) {
#pragma unroll
    for (int i = 0; i < 16; ++i) { float tb = b[15 - i]; int tq = qb[15 - i]; ce_desc_p(a[i], qa[i], tb, tq); }
#pragma unroll
    for (int j = 8; j > 0; j >>= 1)
#pragma unroll
        for (int i = 0; i < 16; ++i) { const int l = i ^ j; if (l > i) CE_DESC_P(a[i], qa[i], a[l], qa[l]); }
}
#define CAND_G0(X) X(0,0) X(0,1) X(0,2) X(0,3) X(0,4) X(0,5) X(0,6) X(0,7) X(0,8) X(0,9) X(0,10) X(0,11) X(0,12) X(0,13) X(0,14) X(0,15)
#define CAND_G1(X) X(1,0) X(1,1) X(1,2) X(1,3) X(1,4) X(1,5) X(1,6) X(1,7) X(2,0) X(2,1) X(2,2) X(2,3) X(2,4) X(3,0) X(3,1) X(3,2)
#define CAND_G2(X) X(3,3) X(4,0) X(4,1) X(4,2) X(5,0) X(5,1) X(6,0) X(6,1) X(7,0) X(7,1) X(8,0) X(9,0) X(10,0) X(11,0) X(12,0) X(13,0)
#define CAND_G3(X) X(14,0) X(15,0)

__device__ __forceinline__ void peer_topk_unit(const Params& p, int l, int mt, int hh, int lane) {
    asm volatile("" : "+v"(lane));
    const int fr = lane & 15, fq = lane >> 4, row = mt * 16 + fr;
    const bf16_t* QP = (const bf16_t*)(p.ws + WS_QP); const bf16_t* KEYS = (const bf16_t*)(p.ws + WS_KEYS);
    float s1[16], s2[16]; int i1[16], i2[16];
#pragma unroll
    for (int p2 = 0; p2 < 2; ++p2) {
        bf16x8 qf[4];
#pragma unroll
        for (int kd = 0; kd < 4; ++kd) qf[kd] = *(const bf16x8*)(QP + (size_t)row * 2048 + hh * 256 + p2 * 128 + 32 * kd + 8 * fq);
        float a[16], b[16];
#pragma unroll
        for (int nh = 0; nh < 2; ++nh) {
            bf16x8 kf[4][4];
#pragma unroll
            for (int nb = 0; nb < 4; ++nb)
#pragma unroll
                for (int kd = 0; kd < 4; ++kd) kf[nb][kd] = *(const bf16x8*)(KEYS + ((((size_t)l * 8 + hh) * 2 + p2) * 128 + 16 * (4 * nh + nb) + fr) * 128 + 32 * kd + 8 * fq);
            __builtin_amdgcn_sched_barrier(0);
#pragma unroll
            for (int nb = 0; nb < 4; ++nb) { const int nk = 4 * nh + nb;
                f32x4 acc = (f32x4){0.f, 0.f, 0.f, 0.f};
#pragma unroll
                for (int kd = 0; kd < 4; ++kd) acc = MFMA16(kf[nb][kd], qf[kd], acc);
#pragma unroll
                for (int r = 0; r < 4; ++r) { const unsigned idx = 16 * nk + 4 * fq + r; const float v = __uint_as_float((__float_as_uint(acc[r]) & ~0x7Fu) | idx);
                    if (nk < 4) a[4 * nk + r] = v; else b[4 * (nk - 4) + r] = v; } }
            __builtin_amdgcn_sched_barrier(0);
        }
        sort16_desc(a); sort16_desc(b); merge16_desc(a, b);
#pragma unroll
        for (int i = 0; i < 16; ++i) b[i] = __shfl_xor(a[i], 16);
        __builtin_amdgcn_sched_barrier(0);
        merge16_desc(a, b);
#pragma unroll
        for (int i = 0; i < 16; ++i) b[i] = __shfl_xor(a[i], 32);
        __builtin_amdgcn_sched_barrier(0);
        merge16_desc(a, b);
#pragma unroll
        for (int i = 0; i < 16; ++i) { const unsigned bits = __float_as_uint(a[i]); const float v = __uint_as_float(bits & ~0x7Fu); const int id = (int)(bits & 0x7Fu);
            if (p2 == 0) { s1[i] = v; i1[i] = id; } else { s2[i] = v; i2[i] = id; } }
    }
    float tv[16], gv[16]; int tp[16], gp[16];
    { float v0[16], v1[16], v2[16]; int q0[16], q1[16], q2[16]; float v3a, v3b; int q3a, q3b;
      { int ci = 0;
#define CX(A, B) v0[ci] = s1[A] + s2[B]; q0[ci] = i1[A] * 128 + i2[B]; ++ci;
        CAND_G0(CX) }
#undef CX
      { int ci = 0;
#define CX(A, B) v1[ci] = s1[A] + s2[B]; q1[ci] = i1[A] * 128 + i2[B]; ++ci;
        CAND_G1(CX) }
#undef CX
      { int ci = 0;
#define CX(A, B) v2[ci] = s1[A] + s2[B]; q2[ci] = i1[A] * 128 + i2[B]; ++ci;
        CAND_G2(CX) }
#undef CX
      v3a = s1[14] + s2[0]; q3a = i1[14] * 128 + i2[0]; v3b = s1[15] + s2[0]; q3b = i1[15] * 128 + i2[0];
#pragma unroll
      for (int i = 0; i < 16; ++i) { const float w3 = i == 0 ? v3a : (i == 1 ? v3b : -1e30f); const int r3 = i == 0 ? q3a : (i == 1 ? q3b : 0);
          tv[i] = fq == 0 ? v0[i] : (fq == 1 ? v1[i] : (fq == 2 ? v2[i] : w3)); tp[i] = fq == 0 ? q0[i] : (fq == 1 ? q1[i] : (fq == 2 ? q2[i] : r3)); } }
    sort16p_desc(tv, tp);
#pragma unroll
    for (int i = 0; i < 16; ++i) { gv[i] = __shfl_xor(tv[i], 16); gp[i] = __shfl_xor(tp[i], 16); }
    __builtin_amdgcn_sched_barrier(0);
    merge16p_desc(tv, tp, gv, gp);
#pragma unroll
    for (int i = 0; i < 16; ++i) { gv[i] = __shfl_xor(tv[i], 32); gp[i] = __shfl_xor(tp[i], 32); }
    __builtin_amdgcn_sched_barrier(0);
    merge16p_desc(tv, tp, gv, gp);
    float sum = 0.f; const float tmx = tv[0];
#pragma unroll
    for (int i = 0; i < 16; ++i) { tv[i] = expf(tv[i] - tmx); sum += tv[i]; }
    const float rsum = 1.f / sum;
    if (fq == 0) {
        int* IDX = (int*)(p.ws + WS_IDX) + (size_t)row * 128 + hh * 16; float* GT = (float*)(p.ws + WS_GATE) + (size_t)row * 128 + hh * 16;
#pragma unroll
        for (int i = 0; i < 16; i += 4) {
            *(int4*)(IDX + i) = make_int4(tp[i], tp[i + 1], tp[i + 2], tp[i + 3]);
            *(f32x4*)(GT + i) = (f32x4){tv[i] * rsum, tv[i + 1] * rsum, tv[i + 2] * rsum, tv[i + 3] * rsum};
        }
    }
}

typedef int i32x4 __attribute__((ext_vector_type(4)));
__device__ __forceinline__ float gelu_erf(float x) { return 0.5f * x * (1.f + erff(x * 0.70710678118654752f)); }
typedef float f32x2 __attribute__((ext_vector_type(2)));
__device__ __forceinline__ void acc_row16(f32x2 (&y)[8], const i32x4 w, float cf) {
    const f32x2 cf2 = {cf, cf};
#pragma unroll
    for (int d = 0; d < 4; ++d) { const unsigned u = (unsigned)w[d];
        const f32x2 a = {(float)(u & 0xffu), (float)((u >> 8) & 0xffu)}, b = {(float)((u >> 16) & 0xffu), (float)(u >> 24)};
        y[2 * d] = __builtin_elementwise_fma(cf2, a, y[2 * d]); y[2 * d + 1] = __builtin_elementwise_fma(cf2, b, y[2 * d + 1]); }
}
template <int N> __device__ __forceinline__ void reduce_scatter_g(float (&y)[N]) {
#pragma unroll
    for (int i = 0; i < N; ++i) y[i] += __builtin_bit_cast(float, __builtin_amdgcn_mov_dpp(__builtin_bit_cast(int, y[i]), 0x128  , 0xf, 0xf, false));
#pragma unroll
    for (int i = 0; i < N / 2; ++i) { const auto r = __builtin_amdgcn_permlane16_swap(__float_as_uint(y[i]), __float_as_uint(y[N / 2 + i]), false, false); y[i] = __uint_as_float(r[0]) + __uint_as_float(r[1]); }
#pragma unroll
    for (int i = 0; i < N / 4; ++i) { const auto r = __builtin_amdgcn_permlane32_swap(__float_as_uint(y[i]), __float_as_uint(y[N / 4 + i]), false, false); y[i] = __uint_as_float(r[0]) + __uint_as_float(r[1]); }
}
__device__ __forceinline__ void dot_rows4(int (&yi)[16], const i32x4 a, const i32x4 b, const i32x4 c, const i32x4 d, int cq) {
#pragma unroll
    for (int k = 0; k < 4; ++k) {
        const unsigned ablo = __builtin_amdgcn_perm((unsigned)b[k], (unsigned)a[k], 0x05010400u), abhi = __builtin_amdgcn_perm((unsigned)b[k], (unsigned)a[k], 0x07030602u);
        const unsigned cdlo = __builtin_amdgcn_perm((unsigned)d[k], (unsigned)c[k], 0x05010400u), cdhi = __builtin_amdgcn_perm((unsigned)d[k], (unsigned)c[k], 0x07030602u);
        yi[4 * k + 0] = __builtin_amdgcn_sdot4((int)__builtin_amdgcn_perm(cdlo, ablo, 0x05040100u), cq, yi[4 * k + 0], false);
        yi[4 * k + 1] = __builtin_amdgcn_sdot4((int)__builtin_amdgcn_perm(cdlo, ablo, 0x07060302u), cq, yi[4 * k + 1], false);
        yi[4 * k + 2] = __builtin_amdgcn_sdot4((int)__builtin_amdgcn_perm(cdhi, abhi, 0x05040100u), cq, yi[4 * k + 2], false);
        yi[4 * k + 3] = __builtin_amdgcn_sdot4((int)__builtin_amdgcn_perm(cdhi, abhi, 0x07060302u), cq, yi[4 * k + 3], false);
    }
}
__device__ __forceinline__ void ph_peer_gather(const Params& p, int l, LAS unsigned char* lds, int lane, int wave, int vcu, int tid, bool dry  ) {
    asm volatile("" : "+v"(lane));
    const int g = lane >> 3, c = lane & 7, m0 = vcu * 33;
    LAS int* idxL = (LAS int*)lds;
    LAS float* gatL = (LAS float*)(lds + 16896);
    LAS float* coefL = (LAS float*)(lds + 33792);
    const int* IDX = (const int*)(p.ws + WS_IDX) + (size_t)m0 * 128; const float* GT = (const float*)(p.ws + WS_GATE) + (size_t)m0 * 128;
    __syncthreads();
    { int iv[9]; float gv[9];
#pragma unroll
      for (int k = 0; k < 9; ++k) { const int i = tid + 512 * k; const bool ok = i < 33 * 128; iv[k] = ok ? IDX[i] : 0; gv[k] = ok ? GT[i] : 0.f; }
#pragma unroll
      for (int k = 0; k < 9; ++k) { const int i = tid + 512 * k; if (i < 33 * 128) { idxL[i] = iv[k]; gatL[i] = gv[k]; } } }
    __syncthreads();
    const unsigned char* H8 = p.ws + WS_H8; const float* SH = (const float*)(p.ws + WS_SH); const float* HSQ = (const float*)(p.ws + WS_SH + 512 * 1024);
    const float* SU = (const float*)(p.ws + WS_SU) + l * 16384; const float* SV = (const float*)(p.ws + WS_SV) + l * 16384;
    const unsigned char* U8 = p.ws + WS_U8 + (size_t)l * (32 * MiB); const unsigned char* V8 = p.ws + WS_V8 + (size_t)l * (32 * MiB);
    const __amdgpu_buffer_rsrc_t ru = __builtin_amdgcn_make_buffer_rsrc((void*)U8, 0, 16 << 20, 0x00020000), rv = __builtin_amdgcn_make_buffer_rsrc((void*)V8, 0, 32 << 20, 0x00020000);
    float* DELTA = (float*)(p.ws + WS_DELTA);
    const float* gmod = (const float*)(p.ws + WS_MOD) + ((size_t)l * 2 + (m0 >= T ? 1 : 0)) * D6 + 5 * D;
    unsigned off[33][2];
#pragma unroll
    for (int ui = 0; ui < 33; ++ui)
#pragma unroll
        for (int i = 0; i < 2; ++i) { const int mi = ui < 32 ? 4 * wave + (ui >> 3) : 32, hd = ui < 32 ? (ui & 7) : wave;
            off[ui][i] = (unsigned)idxL[mi * 128 + hd * 16 + 8 * i + g] * 128u + 16u * c; }
    int acc[33][2];
#pragma unroll
    for (int ui = 0; ui < 33; ++ui) { acc[ui][0] = 0; acc[ui][1] = 0; }
#pragma unroll 1
    for (int j = 0; j < 8; ++j) {
        const int so = j << 21;
        i32x4 w[2][4][2], hq[2];
#define U_LOAD(B, U0) do { _Pragma("unroll") for (int uu_ = 0; uu_ < 4; ++uu_) _Pragma("unroll") for (int i_ = 0; i_ < 2; ++i_) if ((U0) + uu_ < 33) \
            w[B][uu_][i_] = __builtin_bit_cast(i32x4, __builtin_amdgcn_raw_buffer_load_b128(ru, off[(U0) + uu_][i_], so, 0)); } while (0)
#define H_LOAD(U0) do { const int mi_ = (U0) < 32 ? 4 * wave + ((U0) >> 3) : 32; const unsigned char* hb_ = H8 + (size_t)(m0 + mi_) * D + j * 256 + 32 * c; hq[0] = *(const i32x4*)hb_; hq[1] = *(const i32x4*)(hb_ + 16); } while (0)
        H_LOAD(0); U_LOAD(0, 0);
#pragma unroll
        for (int u0 = 0; u0 < 36; u0 += 4) {
            const int B = (u0 >> 2) & 1;
            if (u0 + 4 < 36) { if (B) U_LOAD(0, u0 + 4); else U_LOAD(1, u0 + 4); }
#pragma unroll
            for (int uu = 0; uu < 4; ++uu)
#pragma unroll
                for (int i = 0; i < 2; ++i) if (u0 + uu < 33) { const int ui = u0 + uu;
                    int a = acc[ui][i];
#pragma unroll
                    for (int k = 0; k < 4; ++k) { const unsigned ww = (unsigned)w[B][uu][i][k]; const i32x4 hh = hq[k >> 1];
                        a = __builtin_amdgcn_sdot4((int)(ww & 0x0F0F0F0Fu), hh[2 * (k & 1)], a, false); a = __builtin_amdgcn_sdot4((int)((ww >> 4) & 0x0F0F0F0Fu), hh[2 * (k & 1) + 1], a, false); }
                    acc[ui][i] = a; }
            if (B && u0 + 4 < 36) H_LOAD(u0 + 4);
            __builtin_amdgcn_sched_barrier(0);
        }
#undef H_LOAD
#undef U_LOAD
    }
#pragma unroll
    for (int ui = 0; ui < 33; ++ui)
#pragma unroll
        for (int i = 0; i < 2; ++i) { const int mi = ui < 32 ? 4 * wave + (ui >> 3) : 32, hd = ui < 32 ? (ui & 7) : wave, k = hd * 16 + 8 * i + g;
            int t = acc[ui][i]; t += __shfl_xor(t, 1); t += __shfl_xor(t, 2); t += __shfl_xor(t, 4);
            if (c == 0) coefL[mi * 128 + k] = (float)t; }
    __syncthreads();
    {
        float su[9], sv[9], hs[9], sh[9];
#pragma unroll
        for (int k = 0; k < 9; ++k) { const int it = tid + 512 * k; const bool ok = it < 33 * 128; const int mi = ok ? (it >> 7) : 0, e = ok ? idxL[it] : 0;
            su[k] = SU[e]; sv[k] = SV[e]; hs[k] = HSQ[m0 + mi]; sh[k] = SH[m0 + mi]; }
        __builtin_amdgcn_sched_barrier(0);
#pragma unroll
        for (int k = 0; k < 9; ++k) { const int it = tid + 512 * k;
            if (it < 33 * 128) { const float pd = (coefL[it] - 8.f * hs[k]) * su[k] * sh[k];
                coefL[it] = gatL[it] * gelu_erf(pd) * sv[k]; } }
    }
    __syncthreads();
    LAS int* cfqL = (LAS int*)(lds + 50688);
    LAS int* cfq32L = (LAS int*)(lds + 54912);
    LAS float* sTL = (LAS float*)(lds + 55040);
#pragma unroll 1
    for (int tk = 0; tk < 5; ++tk) {
        if (tk == 4 && wave != 0) break;
        const int mi = tk < 4 ? 4 * wave + tk : 32;
        const float am = wave_max(fmaxf(fabsf(coefL[mi * 128 + lane]), fabsf(coefL[mi * 128 + 64 + lane])));
        const float inv = am > 0.f ? 127.f / am : 0.f;
        if (lane == 0) sTL[mi] = am > 0.f ? am * (1.f / 127.f) : 0.f;
        if (lane < 32) { const int hq = lane >> 4, i = (lane >> 3) & 1, g_ = lane & 7; unsigned pk = 0;
#pragma unroll
            for (int uu = 0; uu < 4; ++uu) { const int q = (int)rintf(coefL[mi * 128 + (4 * hq + uu) * 16 + 8 * i + g_] * inv); pk |= ((unsigned)q & 0xffu) << (8 * uu); }
            cfqL[mi * 32 + lane] = (int)pk;
            if (tk == 4) { const int qd = lane >> 3; unsigned p2 = 0;
#pragma unroll
                for (int r = 0; r < 4; ++r) { const int q = (int)rintf(coefL[32 * 128 + 32 * qd + 8 * r + g_] * inv); p2 |= ((unsigned)q & 0xffu) << (8 * r); }
                cfq32L[lane] = (int)p2; } }
    }
    __syncthreads();
    i32x4 w[2][4][2]; int cfq[2][2];
#define V_LOAD(B, HB, SO) do { const int ts_ = (HB) >> 1, hq_ = (HB) & 1, mi_ = 4 * wave + ts_; _Pragma("unroll") for (int uu_ = 0; uu_ < 4; ++uu_) _Pragma("unroll") for (int i_ = 0; i_ < 2; ++i_) \
            w[B][uu_][i_] = __builtin_bit_cast(i32x4, __builtin_amdgcn_raw_buffer_load_b128(rv, off[ts_ * 8 + 4 * hq_ + uu_][i_], (SO), 0)); \
        cfq[B][0] = cfqL[mi_ * 32 + (hq_ * 2 + 0) * 8 + g]; cfq[B][1] = cfqL[mi_ * 32 + (hq_ * 2 + 1) * 8 + g]; } while (0)
    V_LOAD(0, 0, 0);
#pragma unroll 1
    for (int j = 0; j < 16; ++j) {
        const int so = j << 21;
        int yi[16];
#pragma unroll
        for (int hb = 0; hb < 8; ++hb) {
            const int B = hb & 1, ts = hb >> 1, mi = 4 * wave + ts;
            if (hb + 1 < 8) { if (B) V_LOAD(0, hb + 1, so); else V_LOAD(1, hb + 1, so); }
            else if (j + 1 < 16) V_LOAD(0, 0, (j + 1) << 21);
            if (!B) {
#pragma unroll
                for (int q = 0; q < 16; ++q) yi[q] = 0; }
#pragma unroll
            for (int i = 0; i < 2; ++i) dot_rows4(yi, w[B][0][i], w[B][1][i], w[B][2][i], w[B][3][i], cfq[B][i]);
            if (B) {
                float y[16];
#pragma unroll
                for (int q = 0; q < 16; ++q) y[q] = (float)yi[q];
                reduce_scatter_g<16>(y);
                const float st = sTL[mi];
                float* dp = DELTA + (size_t)(m0 + mi) * D + j * 128 + 16 * c + ((lane & 16) ? 8 : 0) + ((lane & 32) ? 4 : 0) + ((lane & 8) ? 2 : 0);
                { const bool b3 = (lane & 8) != 0; *(float2*)dp = make_float2((b3 ? y[2] : y[0]) * st, (b3 ? y[3] : y[1]) * st); }
            }
            __builtin_amdgcn_sched_barrier(0);
        }
#undef V_LOAD
    }
    {
        const float st = sTL[32];
        const int m = m0 + 32;
#pragma unroll 1
        for (int jj = 0; jj < 2; ++jj) { const int j = 2 * wave + jj; const int so = j << 21;
            int yi[16];
#pragma unroll
            for (int q = 0; q < 16; ++q) yi[q] = 0;
#pragma unroll
            for (int k0 = 0; k0 < 16; k0 += 8) {
                i32x4 w8[8];
#pragma unroll
                for (int kk = 0; kk < 8; ++kk) w8[kk] = __builtin_bit_cast(i32x4, __builtin_amdgcn_raw_buffer_load_b128(rv, (unsigned)idxL[32 * 128 + 8 * (k0 + kk) + g] * 128u + 16u * c, so, 0));
                const int c0 = cfq32L[(k0 / 4) * 8 + g], c1 = cfq32L[(k0 / 4 + 1) * 8 + g];
                dot_rows4(yi, w8[0], w8[1], w8[2], w8[3], c0); dot_rows4(yi, w8[4], w8[5], w8[6], w8[7], c1);
                __builtin_amdgcn_sched_barrier(0);
            }
            float y[16];
#pragma unroll
            for (int q = 0; q < 16; ++q) y[q] = (float)yi[q];
            reduce_scatter_g<16>(y);
            float* dp = DELTA + (size_t)m * D + j * 128 + 16 * c + ((lane & 16) ? 8 : 0) + ((lane & 32) ? 4 : 0) + ((lane & 8) ? 2 : 0);
            { const bool b3 = (lane & 8) != 0; *(float2*)dp = make_float2((b3 ? y[2] : y[0]) * st, (b3 ? y[3] : y[1]) * st); }
        }
    }
    (void)gmod;
    {
        asm volatile("s_waitcnt vmcnt(0)" ::: "memory");
        __syncthreads();
#pragma unroll 1
        for (int mi = wave; mi < 33; mi += NWAVES) peer_tail_row(p, l, m0 + mi, lane);
    }
    (void)dry;
}

__device__ __forceinline__ Params load_params(const CAS Params* k) {
    Params r;
#define LP(f) r.f = k->f;
    LP(x) LP(c) LP(ctx) LP(c_ctx) LP(ada_w) LP(ada_b) LP(norm1_g) LP(norm2_g) LP(ab_w_in) LP(ab_gate_b) LP(ab_mh_g) LP(ab_sink) LP(ab_w_out)
    LP(na_w_in) LP(na_rpb) LP(na_w_out) LP(peer_wq) LP(peer_keys) LP(peer_u) LP(peer_v) LP(final_g) LP(out) LP(ws) LP(ph_lo) LP(ph_hi) LP(grid)
#undef LP
    return r;
}
__device__ __forceinline__ int lane_id_opaque() { int x; asm volatile("v_mbcnt_lo_u32_b32 %0, -1, 0\n\tv_mbcnt_hi_u32_b32 %0, -1, %0" : "=v"(x)); return x; }
constexpr int PH_PER_LAYER = 10, PH_FINAL = 1 + DEPTH * PH_PER_LAYER, N_PHASES = PH_FINAL + 1;
template <unsigned PH_MASK> __global__ void __launch_bounds__(NWAVES * 64, 2) fwd_kernel(Params p) {
    extern __shared__ __attribute__((aligned(16))) unsigned char lds_raw[];
    LAS unsigned char* lds = (LAS unsigned char*)lds_raw;
    const int wave = __builtin_amdgcn_readfirstlane((int)threadIdx.x >> 6);
#define LANE_ID() lane_id_opaque()
#define KQ() const CAS Params* kq_ = (const CAS Params*)__builtin_amdgcn_kernarg_segment_ptr(); asm volatile("" : "+s"(kq_))
    volatile LAS unsigned* MISC = (volatile LAS unsigned*)(lds + LDS_MISC);
    if (wave == 0) MISC[LANE_ID()] = 0u;
    __syncthreads();
    { KQ(); (void)xcd_barrier_post((unsigned*)(kq_->ws + WS_CTL) + 4096, MISC + 8, wave * 64 + LANE_ID()); }
#ifdef STAMP_PROBE
#define STAMP_PRE(k) const unsigned long long st0_ = wall_clock64()
#define STAMP_POST(k) do { if (wave * 64 + LANE_ID() == 0) { KQ(); unsigned* sp_ = (unsigned*)(kq_->ws + WS_END); const unsigned long long st1_ = wall_clock64(); \
        sp_[(k) * 256 + blockIdx.x] = (unsigned)(st1_ - st0_); sp_[(64 + (k)) * 256 + blockIdx.x] = (unsigned)st0_; sp_[(128 + (k)) * 256 + blockIdx.x] = (unsigned)st1_; } } while (0)
#else
#define STAMP_PRE(k) do {} while (0)
#define STAMP_POST(k) do {} while (0)
#endif
#define PM(k) (((PH_MASK) >> (k)) & 1u)
#ifndef REP_MASK
#define REP_MASK 0u
#endif
#define REPEAT(k) for (int rep_ = 0; rep_ <= (int)(((REP_MASK) >> (k)) & 1u); ++rep_)
#define IN(k) ({ KQ(); const int k_ = (k); (kq_->ph_lo <= k_ && k_ < kq_->ph_hi); })
#define SEAM(k) do { KQ(); const int k_ = (k); if (kq_->ph_lo <= k_ && k_ + 1 < kq_->ph_hi) { XcdBarrier b_; b_.bar = (unsigned*)(kq_->ws + WS_CTL) + 4096; b_.x = xb_xcc_id(); b_.st = MISC + 8; \
        STAMP_PRE(k_); xcd_barrier(b_, wave * 64 + LANE_ID()); STAMP_POST(k_); } } while (0)
#define LAUNDER() KQ(); const Params pl = load_params(kq_); unsigned char* ws = pl.ws; int ll = LANE_ID(); asm volatile("" : "+v"(ll)); const int tid = wave * 64 + ll; \
    const int G = pl.grid, bx = blockIdx.x, vcu = (G % 8 == 0) ? (bx % 8) * (G / 8) + bx / 8 : bx, gw = vcu * NWAVES + wave, NGW = G * NWAVES; (void)ws; (void)ll; (void)tid; (void)vcu; (void)gw; (void)NGW
    if (PM(0) && IN(0)) REPEAT(0) { LAUNDER(); ph_prologue(pl, lds, tid, ll, wave, vcu, G); __syncthreads(); }
    SEAM(0);
    for (int l = 0; l < DEPTH; ++l) {
        const int pb = 1 + l * PH_PER_LAYER; const bool even = (l & 1) == 0; const int ei = l >> 1; const bool with_ctx = l < DEPTH - 1;
        if (PM(1) && IN(pb + 0) && l == 0) REPEAT(1) { LAUNDER(); ph_norm(pl, l, 0, ll, gw, NGW); ph_fold_wq(pl, lds, ll, wave, gw, NGW); }
        if (l == 0) SEAM(pb + 0);
        if (PM(2) && IN(pb + 1)) REPEAT(2) {
            LAUNDER();
            if (l == 0) ph_fold_bias(pl, ll, gw, NGW);
            const int N = even ? NAB : NNA;
            pg8::Gemm g{(const bf16_t*)(ws + WS_H), even ? (const bf16_t*)(ws + WS_WAB_IN) + (size_t)ei * NAB * D : (const bf16_t*)(ws + WS_WNA_IN) + (size_t)ei * NNA * D, M, N, D};
            pg8::StaticOrder S; S.init(M, N, G, bx);
            EpiInProj E{EpiEven{ws + WS_PROJ, pl.ab_gate_b + ei * 32, (const float2*)(ws + WS_ROPE)}, EpiOdd{ws + WS_PROJ}, even};
            pg8::gemm_phase<EpiInProj, pg8::StaticOrder, false>(lds, g, S, E, nullptr, tid);
            peer_convert_deferred(pl, l, bx, G, wave, ll);
        }
        SEAM(pb + 1);
        if (PM(3) && IN(pb + 2)) REPEAT(3) {
            LAUNDER();
            if (even) { ph_attn_even(pl, ei, with_ctx, lds, tid, ll, wave, vcu, G);
                for (int q = gw; q < NCH * 16; q += NGW) mlstm_A_unit(pl, q >> 4, q & 15, ll); }
            else ph_attn_odd(pl, ei, with_ctx, lds, tid, ll, wave, vcu, G);
        }
        SEAM(pb + 2);
        if (PM(4) && IN(pb + 3)) REPEAT(4) { LAUNDER(); if (even) ph_mlstm_B(pl, lds, tid, G); }
        if (even) SEAM(pb + 3);
        if (PM(5) && IN(pb + 4)) REPEAT(5) { LAUNDER(); if (even) mlstm_C_wg(pl, ei, lds, tid, ll, wave, vcu, G); }
        if (even) SEAM(pb + 4);
        if (PM(6) && IN(pb + 5)) {
            LAUNDER();
            const float* MODl = (const float*)(ws + WS_MOD) + (size_t)l * 2 * D6;
            pg8::Gemm g{(const bf16_t*)(ws + WS_MIX), even ? (const bf16_t*)(ws + WS_WAB_OUT) + (size_t)ei * D * D : (const bf16_t*)(ws + WS_WNA_OUT) + (size_t)ei * D * D, T, D, D};
            pg8::StaticOrder S; S.init(T, D, G, bx);
            EpiResid E{(float*)(ws + WS_X), MODl + 2 * D, MODl + D6 + 2 * D, l == 0 ? pl.x : (const float*)(ws + WS_X), l == 0 ? pl.ctx : (const float*)(ws + WS_X) + (size_t)T * D,
                       ws + WS_XB, (float*)(ws + WS_PART), (float*)(ws + WS_PARTC)};
            pg8::gemm_phase<EpiResid, pg8::StaticOrder, false>(lds, g, S, E, nullptr, tid);
            if (with_ctx) ctx_gemm(g.A, g.Bt, D, E, wave, ll, vcu, G);
        }
        SEAM(pb + 5);
        if (PM(8) && IN(pb + 7)) REPEAT(8) {
            LAUNDER();
            pg8::Gemm g{(const bf16_t*)(ws + WS_XB), (const bf16_t*)(ws + WS_WQ) + (size_t)l * D * D, T, D, D};
            pg8::StaticOrder S; S.init(T, D, G, bx);
            EpiQ E{(bf16_t*)(ws + WS_QP), (const float*)(ws + WS_PART), (const float*)(ws + WS_BQ) + (size_t)(l * 2) * D};
            pg8::gemm_phase<EpiQ, pg8::StaticOrder, false>(lds, g, S, E, nullptr, tid);
            const int cpc = G - 1 - vcu;
            if (with_ctx && cpc < 128) { int l2 = ll; asm volatile("" : "+v"(l2)); EpiQC Ec{(bf16_t*)(ws + WS_QP), (const float*)(ws + WS_PARTC), (const float*)(ws + WS_BQ) + (size_t)(l * 2 + 1) * D};
                ctx_gemm_piece<EpiQC, 2>(g.A, (const bf16_t*)(ws + WS_WQC) + (size_t)l * D * D, Ec, cpc & 15, cpc >> 4, wave, l2); }
            asm volatile("s_waitcnt vmcnt(0)" ::: "memory");
            __syncthreads();
            { pg8::Unit u; const bool has = S.next(0, u);
#pragma unroll 1
              for (int j = 0; j < 3; ++j) {
                  const bool ok = j < 2 ? has : (with_ctx && cpc < 128 && wave == 0);
                  const int mt = j < 2 ? u.pm * 16 + 8 * j + wave : 512 + (cpc & 15), hh = j < 2 ? u.pn : (cpc >> 4);
                  if (ok) peer_topk_unit(pl, l, mt, hh, ll); } }
            { int l3 = ll; asm volatile("" : "+v"(l3));
              if (!with_ctx) h8_rows<33>(pl, l, vcu * 33, l3, wave); else if (vcu < 128) h8_rows<66>(pl, l, vcu * 66, l3, wave); }
        }
        SEAM(pb + 7);
        if (PM(10) && IN(pb + 9)) REPEAT(10) { LAUNDER(); ph_peer_gather(pl, l, lds, ll, wave, vcu, tid, rep_ < (int)(((REP_MASK) >> 10) & 1u)); }
        if (l + 1 < DEPTH) SEAM(pb + 9);
    }
#ifdef STAMP_PROBE
    {
        { KQ(); XcdBarrier b_; b_.bar = (unsigned*)(kq_->ws + WS_CTL) + 4096; b_.x = xb_xcc_id(); b_.st = MISC + 8; xcd_barrier(b_, wave * 64 + LANE_ID()); }
        LAUNDER();
        const unsigned* ST = (const unsigned*)(ws + WS_END);
        float smean = 0.f, smax = 0.f;
        for (int w = ll; w < 256; w += 64) { const float d = (float)(ST[(64 + STAMP_SEL) * 256 + w] - ST[(128 + STAMP_PREV) * 256 + w]) * 0.01f; smean += d; smax = fmaxf(smax, d); }
        smean = wave_sum(smean) * (1.f / 256.f); smax = wave_max(smax);
        const float c1 = smax * 0.05f, c2 = 0.f; (void)smean;
        for (size_t i = (size_t)bx * 512 + tid; i < (size_t)T * D; i += (size_t)G * 512) pl.out[i] = c1 + c2;
    }
#endif
#undef IN
#undef SEAM
#undef LAUNDER
#undef LANE_ID
#undef KQ
#undef PM
}

#ifndef ONE_MASK
#define ONE_MASK 0xFFFu
#endif
#ifndef MK_ONE_LAUNCH
#define MK_ONE_LAUNCH 1
#endif
typedef void (*kern_t)(Params);
#if !MK_ONE_LAUNCH
static kern_t kern_for_bit(int b) {
    switch (b) {
        case 0: return fwd_kernel<1u << 0>; case 1: return fwd_kernel<1u << 1>; case 2: return fwd_kernel<1u << 2>; case 3: return fwd_kernel<1u << 3>;
        case 4: return fwd_kernel<1u << 4>; case 5: return fwd_kernel<1u << 5>; case 6: return fwd_kernel<1u << 6>; case 7: return fwd_kernel<1u << 7>;
        case 8: return fwd_kernel<1u << 8>; case 9: return fwd_kernel<1u << 9>; case 10: return fwd_kernel<1u << 10>; default: return fwd_kernel<1u << 11>;
    }
}
#endif
extern "C" void kernel_launch(void* const* d_in, const int* in_sizes, int n_in, void* d_out, int out_size, void* d_ws, size_t ws_size, hipStream_t stream) {
    static int grid = 0;
    if (grid == 0) {
        int dev = 0, cus = 0;
        if (n_in != 21 || ws_size < WS_END) { fprintf(stderr, "kernel_launch: unexpected inputs (n_in %d, ws %zu)\n", n_in, ws_size); grid = -1; return; }
        if (hipGetDevice(&dev) != hipSuccess || hipDeviceGetAttribute(&cus, hipDeviceAttributeMultiprocessorCount, dev) != hipSuccess) { grid = -1; return; }
#if MK_ONE_LAUNCH
        if (hipFuncSetAttribute((const void*)fwd_kernel<ONE_MASK>, hipFuncAttributeMaxDynamicSharedMemorySize, LDS_BYTES) != hipSuccess) { fprintf(stderr, "kernel_launch: hipFuncSetAttribute failed\n"); grid = -1; return; }
#else
        for (int b = 0; b < 12; ++b) if (hipFuncSetAttribute((const void*)kern_for_bit(b), hipFuncAttributeMaxDynamicSharedMemorySize, LDS_BYTES) != hipSuccess) { fprintf(stderr, "kernel_launch: hipFuncSetAttribute failed\n"); grid = -1; return; }
#endif
        (void)hipGetLastError();
        grid = cus;
    }
    if (grid < 0) return;
    (void)hipMemsetAsync((char*)d_ws + WS_CTL, 0, CTL_ZERO_BYTES, stream);
#ifdef STAMP_PROBE
    (void)hipMemsetAsync((char*)d_ws + WS_END, 0, 192 * 256 * 4, stream);
#endif
    Params p{};
    const float** pin = (const float**)&p;
    for (int i = 0; i < 21; ++i) pin[i] = (const float*)d_in[i];
    p.out = (float*)d_out; p.ws = (unsigned char*)d_ws; p.grid = grid; p.pad = 0;
#if MK_ONE_LAUNCH
    p.ph_lo = 0; p.ph_hi = N_PHASES;
    hipLaunchKernelGGL(fwd_kernel<ONE_MASK>, dim3(grid), dim3(NWAVES * 64), LDS_BYTES, stream, p);
#else
    for (int ph = 0; ph < N_PHASES; ++ph) {
        int bit = 0;
        if (ph == PH_FINAL) bit = 11;
        else if (ph >= 1) { const int l = (ph - 1) / PH_PER_LAYER, k = (ph - 1) % PH_PER_LAYER; if ((l & 1) && (k == 3 || k == 4)) continue; bit = 1 + k; }
        p.ph_lo = ph; p.ph_hi = ph + 1;
        hipLaunchKernelGGL(kern_for_bit(bit), dim3(grid), dim3(NWAVES * 64), LDS_BYTES, stream, p);
    }
#endif
}
```

```cpp
#include <hip/hip_runtime.h>
#include <cstdio>
#include <cstdint>
namespace pg8 {
#define PG8_LAS __attribute__((address_space(3)))
typedef unsigned short bf16_t;
typedef short bf16x8 __attribute__((ext_vector_type(8)));
typedef float f32x4 __attribute__((ext_vector_type(4)));
typedef unsigned u32x4 __attribute__((ext_vector_type(4)));
constexpr int BM = 256, BK = 64, HALF = 128, HTB = HALF * BK * 2  , STAGE_BYTES = 8 * HTB, NXCD = 8, WGM = 8;

__host__ __device__ __forceinline__ int lds_byte(int r, int c) { const int st = (r >> 4) * 2 + (c >> 5), rr = r & 15, cc = c & 31, ob = rr * 64 + cc * 2; return st * 1024 + (ob ^ (((ob >> 9) & 1) << 5)); }
__host__ __device__ __forceinline__ void stage_rc(int b, int& R, int& C) { const int st = b / 1024, sb = b % 1024, swz = sb ^ (((sb >> 9) & 1) << 5); R = (st >> 1) * 16 + swz / 64; C = (st & 1) * 32 + (swz % 64) / 2; }
__host__ __device__ __forceinline__ int perm32(int rho) { const int n = rho >> 4, i = rho & 15; return 8 * (i >> 2) + 4 * n + (i & 3); }

struct Unit { int pm, pn; };
struct Gemm { const bf16_t* A; const bf16_t* Bt; int M, N, K; };

struct StaticOrder {
    int nM, nN, nwg, G, c;
    __host__ __device__ void init(int M, int N, int G_, int c_) { nM = M / BM; nN = N / BM; nwg = nM * nN; G = G_; c = c_; }
    __host__ __device__ __forceinline__ bool next(int i, Unit& u) const {
        const long L = (long)i * G + c; if (L >= nwg) return false;
        int wgid = (int)L; { const int q = nwg / NXCD, r = nwg % NXCD, xcd = wgid % NXCD, off = wgid / NXCD; wgid = (xcd < r ? xcd * (q + 1) : r * (q + 1) + (xcd - r) * q) + off; }
        const int nig = WGM * nN, gid = wgid / nig, fm = gid * WGM, gsz = (nM - fm) < WGM ? (nM - fm) : WGM;
        u.pm = fm + ((wgid % nig) % gsz); u.pn = (wgid % nig) / gsz; return true;
    }
    __device__ __forceinline__ void a_ready(const Unit&) const {}
    __device__ __forceinline__ void done(const Unit&) const {}
};
__device__ __forceinline__ unsigned cvt_pk_bf16(float lo, float hi) { unsigned r; asm volatile("s_nop 1\n\tv_cvt_pk_bf16_f32 %0, %1, %2\n\ts_nop 1" : "=v"(r) : "v"(lo), "v"(hi)); return r; }
template <class Epi, class Sched, bool STAMP = false>
__device__ __forceinline__ void gemm_phase(PG8_LAS unsigned char* lds, const Gemm g, const Sched& S, const Epi& E, unsigned long long* stamps, int tid_in) {
    int tid_l = tid_in; asm volatile("" : "+v"(tid_l));
    const int tid = tid_l, wid = __builtin_amdgcn_readfirstlane(tid >> 6), lane = tid & 63, wr = wid >> 2, wc = wid & 3, fr = lane & 15, fq = lane >> 4;
    const int K = g.K, nt = K / BK;
    int ts_lo = 0, ts_hi = 0, nts = 0; const unsigned long long rt_entry = STAMP ? (unsigned long long)wall_clock64() : 0ull;
#define PG8_STAMP() do { if (STAMP && wid == 0 && nts < 64) { const unsigned long long _c = (unsigned long long)clock64(); \
        ts_lo = (lane == nts) ? (int)(unsigned)_c : ts_lo; ts_hi = (lane == nts) ? (int)(unsigned)(_c >> 32) : ts_hi; ++nts; } } while (0)
    PG8_STAMP();
    unsigned voffA[2], voffB[2];
#pragma unroll
    for (int i = 0; i < 2; ++i) { int R, C; stage_rc(tid * 16 + i * 8192, R, C); const int Rb = Epi::PERM ? ((R & ~31) + perm32(R & 31)) : R;
        voffA[i] = (unsigned)(R * K + C) * 2u; voffB[i] = (unsigned)(Rb * K + C) * 2u; }
    const size_t kstep = (size_t)(BK * 2);
    const size_t hstep = (size_t)HALF * K * 2;
    const size_t tstep = 2 * hstep;
    const unsigned ldsw = (unsigned)wid * 1024u;
    const int aoff = lds_byte(wr * 64 + fr, fq * 8), boff = lds_byte(wc * 32 + fr, fq * 8);
#define PG8_SA(b, h) (((b) * 2 + (h)) * HTB)
#define PG8_SB(b, h) ((4 + (b) * 2 + (h)) * HTB)
#define PG8_STAGE(bufoff, gbase, voff) do { _Pragma("unroll") for (int _i = 0; _i < 2; ++_i) \
        __builtin_amdgcn_global_load_lds((const unsigned*)((const char*)(gbase) + (voff)[_i]), (PG8_LAS unsigned*)(lds + (bufoff) + ldsw + _i * 8192), 16, 0, 0); } while (0)
#define PG8_LDA(dst, b, h) do { _Pragma("unroll") for (int m = 0; m < 4; ++m) _Pragma("unroll") for (int k = 0; k < 2; ++k) dst[m][k] = *(const PG8_LAS bf16x8*)(lds + PG8_SA(b, h) + aoff + m * 2048 + k * 1024); } while (0)
#define PG8_LDB(dst, b, h) do { _Pragma("unroll") for (int n = 0; n < 2; ++n) _Pragma("unroll") for (int k = 0; k < 2; ++k) dst[n][k] = *(const PG8_LAS bf16x8*)(lds + PG8_SB(b, h) + boff + n * 2048 + k * 1024); } while (0)
#define PG8_MMA(ai, bj, At, Bt) do { __builtin_amdgcn_s_setprio(1); _Pragma("unroll") for (int m = 0; m < 4; ++m) _Pragma("unroll") for (int n = 0; n < 2; ++n) _Pragma("unroll") for (int k = 0; k < 2; ++k) \
        acc[ai][bj][m][n] = __builtin_amdgcn_mfma_f32_16x16x32_bf16(Bt[n][k], At[m][k], acc[ai][bj][m][n], 0, 0, 0); __builtin_amdgcn_s_setprio(0); } while (0)
#define PG8_WAIT_V(n) asm volatile("s_waitcnt vmcnt(" #n ")" ::: "memory")
#define PG8_WAIT_L(n) asm volatile("s_waitcnt lgkmcnt(" #n ")" ::: "memory")
#define PG8_BAR __builtin_amdgcn_s_barrier()
#define PG8_SCHED __builtin_amdgcn_sched_barrier(0)
    Unit cur, nxt; int ui = 0;
    if (!S.next(0, cur)) return;
    f32x4 acc[2][2][4][2];
#pragma unroll
    for (int a = 0; a < 2; ++a)
#pragma unroll
        for (int b = 0; b < 2; ++b)
#pragma unroll
            for (int m = 0; m < 4; ++m)
#pragma unroll
                for (int n = 0; n < 2; ++n) acc[a][b][m][n] = (f32x4){0.f, 0.f, 0.f, 0.f};
    bf16x8 At[4][2], B0[2][2], B1[2][2];
    const char* cA = (const char*)g.A + (size_t)cur.pm * tstep; const char* cB = (const char*)g.Bt + (size_t)cur.pn * tstep;
    S.a_ready(cur);
    PG8_STAGE(PG8_SB(0, 0), cB, voffB); PG8_STAGE(PG8_SA(0, 0), cA, voffA); PG8_STAGE(PG8_SB(0, 1), cB + hstep, voffB); PG8_STAGE(PG8_SA(0, 1), cA + hstep, voffA);
    if (wr == 1) PG8_BAR;
    PG8_WAIT_V(4); PG8_BAR;
    PG8_STAGE(PG8_SB(1, 0), cB + kstep, voffB); PG8_STAGE(PG8_SA(1, 0), cA + kstep, voffA); PG8_STAGE(PG8_SB(1, 1), cB + hstep + kstep, voffB);
    PG8_WAIT_V(6); PG8_BAR;
    PG8_STAMP();
    for (;;) {
        const bool has_next = S.next(ui + 1, nxt);
        const char* nA = has_next ? (const char*)g.A + (size_t)nxt.pm * tstep : cA; const char* nB = has_next ? (const char*)g.Bt + (size_t)nxt.pn * tstep : cB;
        for (int t = 0; t < nt; t += 2) {
            const bool last = (t == nt - 2);
            const char* a1 = cA + (size_t)(t + 1) * kstep;
            const char* a2 = last ? nA : cA + (size_t)(t + 2) * kstep; const char* b2 = last ? nB : cB + (size_t)(t + 2) * kstep;
            const char* a3 = a2 + kstep; const char* b3 = b2 + kstep;
            if (last && has_next) S.a_ready(nxt);
            PG8_LDB(B0, 0, 0); PG8_SCHED; PG8_LDA(At, 0, 0); PG8_STAGE(PG8_SA(1, 1), a1 + hstep, voffA);
            PG8_WAIT_L(8); PG8_BAR; PG8_WAIT_L(0); PG8_MMA(0, 0, At, B0); PG8_BAR; PG8_SCHED;
            PG8_LDB(B1, 0, 1); PG8_STAGE(PG8_SB(0, 0), b2, voffB);
            PG8_BAR; PG8_WAIT_L(0); PG8_MMA(0, 1, At, B1); PG8_BAR;
            PG8_LDA(At, 0, 1); PG8_STAGE(PG8_SA(0, 0), a2, voffA);
            PG8_BAR; PG8_WAIT_L(0); PG8_MMA(1, 0, At, B0); PG8_BAR; PG8_SCHED;
            PG8_STAGE(PG8_SB(0, 1), b2 + hstep, voffB);
            PG8_WAIT_V(6); PG8_BAR; PG8_MMA(1, 1, At, B1); PG8_BAR;
            PG8_LDB(B0, 1, 0); PG8_SCHED; PG8_LDA(At, 1, 0); PG8_STAGE(PG8_SA(0, 1), a2 + hstep, voffA);
            PG8_WAIT_L(8); PG8_BAR; PG8_WAIT_L(0); PG8_MMA(0, 0, At, B0); PG8_BAR; PG8_SCHED;
            PG8_LDB(B1, 1, 1); PG8_STAGE(PG8_SB(1, 0), b3, voffB);
            PG8_BAR; PG8_WAIT_L(0); PG8_MMA(0, 1, At, B1); PG8_BAR;
            PG8_LDA(At, 1, 1); PG8_STAGE(PG8_SA(1, 0), a3, voffA);
            PG8_BAR; PG8_WAIT_L(0); PG8_MMA(1, 0, At, B0); PG8_BAR; PG8_SCHED;
            PG8_STAGE(PG8_SB(1, 1), b3 + hstep, voffB);
            PG8_WAIT_V(6); PG8_BAR; PG8_MMA(1, 1, At, B1); PG8_BAR;
        }
        PG8_STAMP();
        if constexpr (!Epi::AFTER_DRAIN) { E(acc, cur, wr, wc, fr, fq); S.done(cur); }
        PG8_STAMP();
        if (!has_next) break;
#pragma unroll
        for (int a = 0; a < 2; ++a)
#pragma unroll
            for (int b = 0; b < 2; ++b)
#pragma unroll
                for (int m = 0; m < 4; ++m)
#pragma unroll
                    for (int n = 0; n < 2; ++n) acc[a][b][m][n] = (f32x4){0.f, 0.f, 0.f, 0.f};
        cur = nxt; cA = nA; cB = nB; ++ui;
    }
    PG8_WAIT_V(0);
    if (wr == 0) PG8_BAR;
    PG8_BAR;
    if constexpr (Epi::AFTER_DRAIN) { E.fused(acc, cur, wr, wc, fr, fq, lds, wid, lane); S.done(cur); }
    PG8_STAMP();
    if (STAMP && wid == 0) { stamps[lane] = lane < nts ? (((unsigned long long)(unsigned)ts_hi << 32) | (unsigned)ts_lo) : 0ull;
        if (lane == 62) stamps[62] = rt_entry; if (lane == 63) stamps[63] = (unsigned long long)wall_clock64(); }
#undef PG8_STAMP
#undef PG8_SA
#undef PG8_SB
#undef PG8_STAGE
#undef PG8_LDA
#undef PG8_LDB
#undef PG8_MMA
#undef PG8_WAIT_V
#undef PG8_WAIT_L
#undef PG8_BAR
#undef PG8_SCHED
}
}

constexpr int D = 2048, T = 8192, LC = 256, M = T + LC, DEPTH = 4, D6 = 6 * D;
constexpr int NAB = 4864, NNA = 6144;
constexpr int NCH = M / 64;
constexpr float EPS = 1e-6f, LOG2E = 1.4426950408889634f;
constexpr int NWAVES = 8;

constexpr size_t MiB = 1u << 20;
constexpr size_t WS_CTL = 0, CTL_ZERO_BYTES = 32768;
constexpr size_t WS_MOD = 1 * MiB;
constexpr size_t WS_ROPE = 2 * MiB;
constexpr size_t WS_KEYS = 3 * MiB;
constexpr size_t WS_WAB_IN = 8 * MiB;
constexpr size_t WS_WAB_OUT = 46 * MiB;
constexpr size_t WS_WNA_IN = 62 * MiB;
constexpr size_t WS_WNA_OUT = 110 * MiB;
constexpr size_t WS_WQ = 126 * MiB;
constexpr size_t WS_X = 160 * MiB;
constexpr size_t WS_H = 226 * MiB;
constexpr size_t WS_PROJ = 260 * MiB;
constexpr size_t WS_MIX = 360 * MiB;
constexpr size_t WS_QP = 394 * MiB;
constexpr size_t WS_IDX = 428 * MiB;
constexpr size_t WS_GATE = 433 * MiB;
constexpr size_t WS_U = 440 * MiB;
constexpr size_t WS_SNAP = 516 * MiB;
constexpr size_t WS_CHS = 554 * MiB;
constexpr size_t WS_GF = 555 * MiB;
constexpr size_t WS_H8 = 564 * MiB;
constexpr size_t WS_SH = 581 * MiB;
constexpr size_t WS_SU = 582 * MiB;
constexpr size_t WS_SV = 583 * MiB;
constexpr size_t WS_U8 = 584 * MiB;
constexpr size_t WS_V8 = 712 * MiB;
constexpr size_t WS_WQC = 842 * MiB;
constexpr size_t WS_BQ = 866 * MiB;
constexpr size_t WS_XB = 868 * MiB;
constexpr size_t WS_PART = 902 * MiB;
constexpr size_t WS_PARTC = 903 * MiB;
constexpr size_t WS_PARTB = 904 * MiB;
constexpr size_t WS_DELTA = 906 * MiB;
constexpr size_t WS_END = 972 * MiB;
constexpr size_t PJ_Q = 0, PJ_K = 33 * MiB, PJ_VT = 66 * MiB;
constexpr size_t PJ_AQ = 0, PJ_AK = 9 * MiB, PJ_AKT = 18 * MiB, PJ_AVT = 27 * MiB, PJ_AO = 44 * MiB,
                 PJ_BQ = 61 * MiB, PJ_BK = 78 * MiB, PJ_BVT = 83 * MiB, PJ_G = 88 * MiB;
constexpr int LDS_BYTES = 147456;
constexpr int LDS_MISC = 131072;

#define LAS __attribute__((address_space(3)))
#define CAS __attribute__((address_space(4)))
typedef unsigned short bf16_t;
typedef short bf16x8 __attribute__((ext_vector_type(8)));
typedef float f32x4 __attribute__((ext_vector_type(4)));
typedef unsigned u32x4 __attribute__((ext_vector_type(4)));
typedef unsigned u32x2 __attribute__((ext_vector_type(2)));

struct Params {
    const float *x, *c, *ctx, *c_ctx, *ada_w, *ada_b, *norm1_g, *norm2_g, *ab_w_in, *ab_gate_b, *ab_mh_g, *ab_sink, *ab_w_out,
                *na_w_in, *na_rpb, *na_w_out, *peer_wq, *peer_keys, *peer_u, *peer_v, *final_g;
    float* out; unsigned char* ws; int ph_lo, ph_hi, grid, pad;
};

__device__ __forceinline__ float bf_lo(unsigned w) { return __uint_as_float(w << 16); }
__device__ __forceinline__ float bf_hi(unsigned w) { return __uint_as_float(w & 0xffff0000u); }
__device__ __forceinline__ unsigned pk2(float lo, float hi) { return pg8::cvt_pk_bf16(lo, hi); }
__device__ __forceinline__ float wave_sum(float v) {
#pragma unroll
    for (int o = 1; o < 64; o <<= 1) v += __shfl_xor(v, o);
    return v;
}
__device__ __forceinline__ float wave_max(float v) {
#pragma unroll
    for (int o = 1; o < 64; o <<= 1) v = fmaxf(v, __shfl_xor(v, o));
    return v;
}
__device__ __forceinline__ float scan_add(float x, int lane, int suffix) {
#pragma unroll
    for (int off = 1; off < 64; off <<= 1) {
        const float up = __shfl_up(x, off), dn = __shfl_down(x, off);
        const bool ok = suffix ? (lane + off < 64) : (lane >= off);
        x = ok ? x + (suffix ? dn : up) : x;
    }
    return x;
}
__device__ __forceinline__ float scan_max(float x, int lane, int suffix) {
#pragma unroll
    for (int off = 1; off < 64; off <<= 1) {
        const float up = __shfl_up(x, off), dn = __shfl_down(x, off);
        const bool ok = suffix ? (lane + off < 64) : (lane >= off);
        x = ok ? fmaxf(x, suffix ? dn : up) : x;
    }
    return x;
}
__device__ __forceinline__ float fq_max(float v) { v = fmaxf(v, __shfl_xor(v, 16)); return fmaxf(v, __shfl_xor(v, 32)); }
__device__ __forceinline__ float fq_sum(float v) { v += __shfl_xor(v, 16); return v + __shfl_xor(v, 32); }
__device__ __forceinline__ float log_sigmoid(float x) { return fminf(x, 0.f) - log1pf(expf(-fabsf(x))); }
__device__ __forceinline__ bf16x8 mk_frag(u32x4 w) { return __builtin_bit_cast(bf16x8, w); }
#define MFMA16(a, b, c) __builtin_amdgcn_mfma_f32_16x16x32_bf16((a), (b), (c), 0, 0, 0)

#define XB_TMO      128
#define XB_XCNT(j)  (256  + 64 * (j))
#define XB_XSUB(j)  (1280 + 64 * (j))
#define XB_XGEN(j)  (2304 + 64 * (j))
#define XB_TOP      3328
#define XB_TOPGEN   3392
#define XCD_BAR_WORDS 3456
#define XB_SPIN_CAP (1u << 22)
__device__ __forceinline__ unsigned xb_ld(unsigned* p)              { return __hip_atomic_load(p, __ATOMIC_RELAXED, __HIP_MEMORY_SCOPE_AGENT); }
__device__ __forceinline__ unsigned xb_add(unsigned* p, unsigned v) { return __hip_atomic_fetch_add(p, v, __ATOMIC_RELAXED, __HIP_MEMORY_SCOPE_AGENT); }
__device__ __forceinline__ unsigned xb_xcc_id() { return (unsigned)__builtin_amdgcn_s_getreg((3 << 11) | 20) & 0xFu; }
#define XB_SPIN(cond, bar) do { unsigned _sp = 0; while (cond) { __builtin_amdgcn_s_sleep(1); \
    if ((++_sp & 255u) == 0u) { if (xb_ld(&(bar)[XB_TMO])) break; if (_sp > XB_SPIN_CAP) { atomicAdd(&(bar)[XB_TMO], 1u); break; } } } } while (0)
struct XcdBarrier { unsigned* bar; unsigned x; volatile LAS unsigned* st; };
__device__ __forceinline__ XcdBarrier xcd_barrier_post(unsigned* bar, volatile LAS unsigned* st, int tid) {
    XcdBarrier b; b.bar = bar; b.x = xb_xcc_id(); b.st = st;
    if (tid == 0) (void)xb_add(&bar[XB_XCNT(b.x)], 1u);
    return b;
}
__device__ __forceinline__ void xcd_barrier_complete(unsigned* bar, unsigned x, unsigned& nloc, unsigned& nx) {
    const unsigned G = gridDim.x * gridDim.y * gridDim.z;
    unsigned sum, cnt, mine, sp = 0u;
    for (;;) {
        sum = 0u; cnt = 0u; mine = 0u;
#pragma unroll
        for (unsigned j = 0; j < 16; ++j) { const unsigned c = xb_ld(&bar[XB_XCNT(j)]); sum += c; cnt += (c > 0u) ? 1u : 0u; mine = (j == x) ? c : mine; }
        if (sum == G) break;
        __builtin_amdgcn_s_sleep(1);
        if ((++sp & 255u) == 0u) { if (xb_ld(&bar[XB_TMO])) break; if (sp > XB_SPIN_CAP) { atomicAdd(&bar[XB_TMO], 1u); break; } }
    }
    nloc = mine > 0u ? mine : 1u; nx = cnt > 0u ? cnt : 1u;
}
__device__ __forceinline__ void xcd_barrier(const XcdBarrier& b, int tid) {
    asm volatile("s_waitcnt vmcnt(0)" ::: "memory");
    __syncthreads();
    if (tid == 0) {
        unsigned* bar = b.bar;
        __builtin_amdgcn_s_waitcnt(0);
        unsigned nloc = b.st[0], nx = b.st[1];
        if (nloc == 0u) { xcd_barrier_complete(bar, b.x, nloc, nx); b.st[0] = nloc; b.st[1] = nx; }
        const unsigned old = xb_add(&bar[XB_XSUB(b.x)], 1u);
        const unsigned gen = old / nloc;
        if (old + 1u == (gen + 1u) * nloc) {
            __builtin_amdgcn_fence(__ATOMIC_RELEASE, "agent");
            asm volatile("s_waitcnt vmcnt(0)" ::: "memory");
            const unsigned og = xb_add(&bar[XB_TOP], 1u);
            const unsigned tg = og / nx;
            if (og + 1u == (tg + 1u) * nx) xb_add(&bar[XB_TOPGEN], 1u);
            else XB_SPIN(xb_ld(&bar[XB_TOPGEN]) == tg, bar);
            __builtin_amdgcn_fence(__ATOMIC_ACQUIRE, "agent");
            xb_add(&bar[XB_XGEN(b.x)], 1u);
            asm volatile("s_waitcnt vmcnt(0)" ::: "memory");
        } else {
            XB_SPIN(xb_ld(&bar[XB_XGEN(b.x)]) == gen, bar);
            __builtin_amdgcn_fence(__ATOMIC_ACQUIRE, "agent");
            asm volatile("s_waitcnt vmcnt(0)" ::: "memory");
        }
    }
    __syncthreads();
}

__device__ __forceinline__ void peer_convert_row(const Params& p, int l, int q, int lane) {
    const int tb = q >> 14, e = q & 16383;
    const f32x4* src = (const f32x4*)((tb ? p.peer_v : p.peer_u) + ((size_t)l * 16384 + e) * D) + lane;
    f32x4 v[8]; float am = 0.f;
#pragma unroll
    for (int j = 0; j < 8; ++j) { v[j] = src[64 * j]; am = fmaxf(am, fmaxf(fmaxf(fabsf(v[j].x), fabsf(v[j].y)), fmaxf(fabsf(v[j].z), fabsf(v[j].w)))); }
    am = wave_max(am);
    const float sc = am > 0.f ? am * (1.f / 127.f) : 1.f, inv = am > 0.f ? 127.f / am : 0.f;
    if (lane == 0) ((float*)(p.ws + (tb ? WS_SV : WS_SU)))[l * 16384 + e] = sc;
    unsigned char* dst = p.ws + (tb ? WS_V8 : WS_U8) + (size_t)l * (32 * MiB) + (size_t)e * 128 + 4 * (lane & 31);
    const unsigned flip = tb ? 0x80808080u : 0u;
#pragma unroll
    for (int j = 0; j < 8; ++j) {
        const int q0 = (int)rintf(v[j].x * inv), q1 = (int)rintf(v[j].y * inv), q2 = (int)rintf(v[j].z * inv), q3 = (int)rintf(v[j].w * inv);
        const unsigned w = ((unsigned)q0 & 0xffu) | (((unsigned)q1 & 0xffu) << 8) | (((unsigned)q2 & 0xffu) << 16) | (((unsigned)q3 & 0xffu) << 24);
        *(unsigned*)(dst + (size_t)(2 * j + (lane >> 5)) * (2 * MiB)) = w ^ flip;
    }
}
__device__ __forceinline__ const f32x4* peer_row_src(const Params& p, int l, int q, int lane) { return (const f32x4*)(((q >> 14) ? p.peer_v : p.peer_u) + ((size_t)l * 16384 + (q & 16383)) * D) + lane; }
__device__ __forceinline__ void peer_convert_rows(const Params& p, int l, int q0, int q1, int qs, int lane) {
    if (q0 >= q1) return;
    f32x4 nx[8];
    { const f32x4* src = peer_row_src(p, l, q0, lane);
#pragma unroll
      for (int j = 0; j < 8; ++j) nx[j] = __builtin_nontemporal_load(src + 64 * j); }
#pragma unroll 1
    for (int q = q0; q < q1; q += qs) {
        const int tb = q >> 14, e = q & 16383;
        f32x4 v[8]; float am = 0.f;
#pragma unroll
        for (int j = 0; j < 8; ++j) { v[j] = nx[j]; am = fmaxf(am, fmaxf(fmaxf(fabsf(v[j].x), fabsf(v[j].y)), fmaxf(fabsf(v[j].z), fabsf(v[j].w)))); }
        if (q + qs < q1) { const f32x4* src = peer_row_src(p, l, q + qs, lane);
#pragma unroll
            for (int j = 0; j < 8; ++j) nx[j] = __builtin_nontemporal_load(src + 64 * j); }
        am = wave_max(am);
        const float qm = tb ? 127.f : 7.f;
        const float sc = am > 0.f ? am / qm : 1.f, inv = am > 0.f ? qm / am : 0.f;
        if (lane == 0) ((float*)(p.ws + (tb ? WS_SV : WS_SU)))[l * 16384 + e] = sc;
        if (tb) {
            unsigned char* dst = p.ws + WS_V8 + (size_t)l * (32 * MiB) + (size_t)e * 128 + 4 * (lane & 31);
#pragma unroll
            for (int j = 0; j < 8; ++j) {
                const int q0_ = (int)rintf(v[j].x * inv), q1_ = (int)rintf(v[j].y * inv), q2_ = (int)rintf(v[j].z * inv), q3_ = (int)rintf(v[j].w * inv);
                const unsigned w = ((unsigned)q0_ & 0xffu) | (((unsigned)q1_ & 0xffu) << 8) | (((unsigned)q2_ & 0xffu) << 16) | (((unsigned)q3_ & 0xffu) << 24);
                *(unsigned*)(dst + (size_t)(2 * j + (lane >> 5)) * (2 * MiB)) = w;
            }
        } else {
            unsigned char* dst = p.ws + WS_U8 + (size_t)l * (32 * MiB) + (size_t)e * 128 + 4 * (lane >> 1);
#pragma unroll
            for (int j = 0; j < 8; ++j) {
                const int q0_ = (int)rintf(v[j].x * inv) + 8, q1_ = (int)rintf(v[j].y * inv) + 8, q2_ = (int)rintf(v[j].z * inv) + 8, q3_ = (int)rintf(v[j].w * inv) + 8;
                const unsigned w = (unsigned)q0_ | ((unsigned)q1_ << 8) | ((unsigned)q2_ << 16) | ((unsigned)q3_ << 24);
                const unsigned hi = (unsigned)__shfl_xor((int)w, 1);
                if (!(lane & 1)) *(unsigned*)(dst + (size_t)j * (2 * MiB)) = w | (hi << 4);
            }
        }
    }
}
constexpr int DEFQ_EVEN = 128, DEFQ_ODD = 96, IDLE_EVEN = 256 - (33 * 19) % 256, IDLE_ODD = 256 - (33 * 24) % 256;
__device__ __forceinline__ int peer_deferred_rows(int l, int G) { return (l == 0 || G != 256) ? 0 : (((l - 1) & 1) ? IDLE_ODD * DEFQ_ODD : IDLE_EVEN * DEFQ_EVEN); }
__device__ __forceinline__ void peer_convert_deferred(const Params& p, int l  , int bx, int G, int wave, int lane) {
    if (l + 1 >= DEPTH || G != 256) return;
    const int idle = (l & 1) ? IDLE_ODD : IDLE_EVEN, dq = (l & 1) ? DEFQ_ODD : DEFQ_EVEN, j = bx - (256 - idle);
    if (j < 0) return;
    peer_convert_rows(p, l + 1, j * dq + wave, (j + 1) * dq, NWAVES, lane);
}
struct ScaleOne { __device__ __forceinline__ float operator()(int) const { return 1.f; } };
template <class MapF, class ScaleF = ScaleOne>
__device__ __forceinline__ void transpose_item(const float* W, int Nsrc, int K, bf16_t* WT, int nblk, LAS float* scr, int item, int lane, MapF map, ScaleF ksc = ScaleF()) {
    const int kb = item / nblk, nb = item % nblk, k0 = 64 * kb, n0 = 32 * nb;
    const int sc = map(n0 + (lane & 31));
    float w[32];
#pragma unroll
    for (int i = 0; i < 32; ++i) w[i] = sc >= 0 ? __builtin_nontemporal_load(W + (size_t)(k0 + 2 * i + (lane >> 5)) * Nsrc + sc) : 0.f;
#pragma unroll
    for (int i = 0; i < 32; ++i) { const int kk = 2 * i + (lane >> 5); scr[kk * 33 + (lane & 31)] = w[i] * ksc(k0 + kk); }
    asm volatile("s_waitcnt lgkmcnt(0)" ::: "memory");
    const int c = lane & 7;
    float tt[4][8];
#pragma unroll
    for (int j = 0; j < 4; ++j) { const LAS float* s = scr + (8 * c) * 33 + (lane >> 3) + 8 * j;
#pragma unroll
        for (int r = 0; r < 8; ++r) tt[j][r] = s[r * 33]; }
    __builtin_amdgcn_sched_barrier(0);
#pragma unroll
    for (int j = 0; j < 4; ++j) { const int n = (lane >> 3) + 8 * j;
        u32x4 o; o.x = pk2(tt[j][0], tt[j][1]); o.y = pk2(tt[j][2], tt[j][3]); o.z = pk2(tt[j][4], tt[j][5]); o.w = pk2(tt[j][6], tt[j][7]);
        *(u32x4*)(WT + (size_t)(n0 + n) * K + k0 + 8 * c) = o; }
    asm volatile("s_waitcnt lgkmcnt(0)" ::: "memory");
}
struct MapId { __device__ __forceinline__ int operator()(int n) const { return n; } };
struct MapAB {
    __device__ __forceinline__ int operator()(int n) const {
        if (n < 3072) return n;
        if (n < 4352) { const int base_d = n < 4096 ? 3072 : 4096, base_s = n < 4096 ? 3104 : 4128; const int r = n - base_d, hh = r >> 7, pp = r & 127;
            const int i = 64 * (pp >> 6) + ((pp & 63) >> 1) + 32 * (pp & 1); return base_s + hh * 128 + i; }
        if (n < 4608) return 4384 + (n - 4352);
        if (n < 4640) return 3072 + (n - 4608);
        return -1;
    }
};
__device__ __forceinline__ float silu(float v) { return v / (1.f + expf(-v)); }
struct __attribute__((packed, aligned(4))) F3 { float a, b, c; };

__device__ __forceinline__ void ph_prologue(const Params& p, LAS unsigned char* lds, int tid, int lane, int wave, int vcu, int G) {
    const int gw = vcu * NWAVES + wave, NGW = G * NWAVES;
    const size_t gtid = (size_t)vcu * 512 + tid, gn = (size_t)G * 512;
    {
        const float2* ks = (const float2*)p.peer_keys; unsigned* kd = (unsigned*)(p.ws + WS_KEYS);
        for (size_t i = gtid; i < (size_t)4 * 8 * 2 * 128 * 128 / 2; i += gn) { const float2 v = ks[i]; kd[i] = pk2(v.x, v.y); }
    }
    {
        float2* rt = (float2*)(p.ws + WS_ROPE);
        for (size_t i = gtid; i < 128 * 32; i += gn) { const int pos = (int)(i >> 5), j = (int)(i & 31);
            const float freq = powf(10000.f, -(float)j / 32.f), ang = (float)pos * freq; rt[i] = make_float2(cosf(ang), sinf(ang)); }
    }
    {
        LAS float* sv = (LAS float*)lds;
        LAS float* red = (LAS float*)(lds + 16384);
        for (int i = tid; i < 2048; i += 512) { sv[i] = silu(p.c[i]); sv[2048 + i] = silu(p.c_ctx[i]); }
        __syncthreads();
        float* MOD = (float*)(p.ws + WS_MOD);
        for (int u = vcu; u < 4 * 64; u += G) {
            const int l = u >> 6, n0 = (u & 63) * 192;
            const float* wp = p.ada_w + ((size_t)l * 2048 + wave * 256) * D6 + n0 + 3 * lane;
            float a0x = 0.f, a0y = 0.f, a0z = 0.f, a1x = 0.f, a1y = 0.f, a1z = 0.f;
#pragma unroll 1
            for (int k = 0; k < 256; k += 16) {
                F3 wv[16];
#pragma unroll
                for (int j = 0; j < 16; ++j) { const float* q_ = wp + (size_t)(k + j) * D6; wv[j].a = __builtin_nontemporal_load(q_); wv[j].b = __builtin_nontemporal_load(q_ + 1); wv[j].c = __builtin_nontemporal_load(q_ + 2); }
#pragma unroll
                for (int j = 0; j < 16; ++j) { const float s0 = sv[wave * 256 + k + j], s1 = sv[2048 + wave * 256 + k + j];
                    a0x += s0 * wv[j].a; a0y += s0 * wv[j].b; a0z += s0 * wv[j].c; a1x += s1 * wv[j].a; a1y += s1 * wv[j].b; a1z += s1 * wv[j].c; }
            }
            { LAS float* r0 = red + (wave * 2 + 0) * 192 + 3 * lane; LAS float* r1 = red + (wave * 2 + 1) * 192 + 3 * lane;
              r0[0] = a0x; r0[1] = a0y; r0[2] = a0z; r1[0] = a1x; r1[1] = a1y; r1[2] = a1z; }
            __syncthreads();
            if (tid < 384) { const int which = tid >= 192 ? 1 : 0, col = tid - 192 * which; float s = 0.f;
#pragma unroll
                for (int w = 0; w < 8; ++w) s += red[(w * 2 + which) * 192 + col];
                MOD[((size_t)l * 2 + which) * D6 + n0 + col] = s + p.ada_b[(size_t)l * D6 + n0 + col]; }
            __syncthreads();
        }
    }
    {
        LAS float* scr = (LAS float*)(lds + wave * 16384);
        constexpr int I_ABI = 32 * (NAB / 32), I_SQ = 32 * (D / 32), I_NAI = 32 * (NNA / 32);
        constexpr int NITEMS = 2 * I_ABI + 2 * I_SQ + 2 * I_NAI + 2 * I_SQ;
        for (int it = gw; it < NITEMS; it += NGW) {
            int r = it;
            if (r < 2 * I_ABI) { const int e = r / I_ABI; r -= e * I_ABI;
                transpose_item(p.ab_w_in + (size_t)e * D * 4640, 4640, D, (bf16_t*)(p.ws + WS_WAB_IN) + (size_t)e * NAB * D, NAB / 32, scr, r, lane, MapAB()); continue; }
            r -= 2 * I_ABI;
            if (r < 2 * I_SQ) { const int e = r / I_SQ; r -= e * I_SQ;
                transpose_item(p.ab_w_out + (size_t)e * D * D, D, D, (bf16_t*)(p.ws + WS_WAB_OUT) + (size_t)e * D * D, D / 32, scr, r, lane, MapId()); continue; }
            r -= 2 * I_SQ;
            if (r < 2 * I_NAI) { const int e = r / I_NAI; r -= e * I_NAI;
                transpose_item(p.na_w_in + (size_t)e * D * NNA, NNA, D, (bf16_t*)(p.ws + WS_WNA_IN) + (size_t)e * NNA * D, NNA / 32, scr, r, lane, MapId()); continue; }
            r -= 2 * I_NAI;
            { const int e = r / I_SQ; r -= e * I_SQ;
                transpose_item(p.na_w_out + (size_t)e * D * D, D, D, (bf16_t*)(p.ws + WS_WNA_OUT) + (size_t)e * D * D, D / 32, scr, r, lane, MapId()); }
        }
    }
#pragma unroll 1
    for (int l = 0; l < DEPTH; ++l) peer_convert_rows(p, l, peer_deferred_rows(l, G) + gw, 32768, NGW, lane);
}
__device__ __forceinline__ void fold_item(const Params& p, int l, int item, LAS float* scr, int lane) {
    const int kb = item >> 6, nb = item & 63, k0 = 64 * kb, n0 = 32 * nb;
    const float* MOD = (const float*)(p.ws + WS_MOD) + (size_t)l * 2 * D6;
    const float* W = p.peer_wq + (size_t)l * D * D;
    LAS float* kv = scr + 2112;
    float w[32];
#pragma unroll
    for (int i = 0; i < 32; ++i) w[i] = __builtin_nontemporal_load(W + (size_t)(k0 + 2 * i + (lane >> 5)) * D + n0 + (lane & 31));
    { const int k = k0 + lane; const float g2 = p.norm2_g[(size_t)l * D + k], m4 = MOD[4 * D + k], m4c = MOD[D6 + 4 * D + k], m3 = MOD[3 * D + k], m3c = MOD[D6 + 3 * D + k];
      __builtin_amdgcn_sched_barrier(0);
      kv[lane] = g2 * (1.f + m4); kv[64 + lane] = g2 * (1.f + m4c); kv[128 + lane] = m3; kv[192 + lane] = m3c; }
    asm volatile("s_waitcnt lgkmcnt(0)" ::: "memory");
    float bl = 0.f, bc = 0.f;
#pragma unroll
    for (int i = 0; i < 32; ++i) { const int kk = 2 * i + (lane >> 5); bl += w[i] * kv[128 + kk]; bc += w[i] * kv[192 + kk]; }
    bl += __shfl_xor(bl, 32); bc += __shfl_xor(bc, 32);
    if (lane < 32) { float* PB = (float*)(p.ws + WS_PARTB) + ((size_t)(l * 2) * 32 + kb) * D + n0 + lane; PB[0] = bl; PB[(size_t)32 * D] = bc; }
    const int c = lane & 7;
#pragma unroll 1
    for (int v = 0; v < (l < DEPTH - 1 ? 2 : 1); ++v) {
        bf16_t* WT = (bf16_t*)(p.ws + (v ? WS_WQC : WS_WQ)) + (size_t)l * D * D;
        float kf[32];
#pragma unroll
        for (int i = 0; i < 32; ++i) kf[i] = kv[64 * v + 2 * i + (lane >> 5)];
        __builtin_amdgcn_sched_barrier(0);
#pragma unroll
        for (int i = 0; i < 32; ++i) { const int kk = 2 * i + (lane >> 5); scr[kk * 33 + (lane & 31)] = w[i] * kf[i]; }
        asm volatile("s_waitcnt lgkmcnt(0)" ::: "memory");
        float tt[4][8];
#pragma unroll
        for (int j = 0; j < 4; ++j) { const LAS float* s = scr + (8 * c) * 33 + (lane >> 3) + 8 * j;
#pragma unroll
            for (int r = 0; r < 8; ++r) tt[j][r] = s[r * 33]; }
        __builtin_amdgcn_sched_barrier(0);
#pragma unroll
        for (int j = 0; j < 4; ++j) { const int n = (lane >> 3) + 8 * j;
            u32x4 o; o.x = pk2(tt[j][0], tt[j][1]); o.y = pk2(tt[j][2], tt[j][3]); o.z = pk2(tt[j][4], tt[j][5]); o.w = pk2(tt[j][6], tt[j][7]);
            *(u32x4*)(WT + (size_t)(n0 + n) * D + k0 + 8 * c) = o; }
        asm volatile("s_waitcnt lgkmcnt(0)" ::: "memory");
    }
}
__device__ __forceinline__ void ph_fold_wq(const Params& p, LAS unsigned char* lds, int lane, int wave, int gw, int NGW) {
    LAS float* scr = (LAS float*)(lds + wave * 16384);
    for (int it = gw; it < DEPTH * 2048; it += NGW) fold_item(p, it >> 11, it & 2047, scr, lane);
}
__device__ __forceinline__ void ph_fold_bias(const Params& p, int lane, int gw, int NGW) {
    for (int i = gw * 64 + lane; i < DEPTH * 2 * D; i += NGW * 64) { const float* PB = (const float*)(p.ws + WS_PARTB) + (size_t)(i >> 11) * 32 * D + (i & 2047); float s = 0.f;
        float pv[32];
#pragma unroll
        for (int kb = 0; kb < 32; ++kb) pv[kb] = PB[(size_t)kb * D];
#pragma unroll
        for (int kb = 0; kb < 32; ++kb) s += pv[kb];
        ((float*)(p.ws + WS_BQ))[i] = s; }
}
__device__ __forceinline__ void norm_row(const Params& p, int l, int which, int m, int lane) {
    const float* gvec = (which ? p.norm2_g : p.norm1_g) + (size_t)l * D;
    const float* MOD = (const float*)(p.ws + WS_MOD) + (size_t)l * 2 * D6;
    const float* X = (const float*)(p.ws + WS_X); bf16_t* H = (bf16_t*)(p.ws + WS_H);
    {
        const float* mod = MOD + (m >= T ? D6 : 0) + (which ? 3 * D : 0);
        const float* xrow = (l == 0 && which == 0) ? (m < T ? p.x + (size_t)m * D : p.ctx + (size_t)(m - T) * D) : X + (size_t)m * D;
        const f32x4* xr = (const f32x4*)xrow + lane;
        f32x4 v[8]; float ss = 0.f;
#pragma unroll
        for (int j = 0; j < 8; ++j) { v[j] = xr[64 * j]; ss += (v[j].x * v[j].x + v[j].y * v[j].y) + (v[j].z * v[j].z + v[j].w * v[j].w); }
        ss = wave_sum(ss);
        const float rstd = rsqrtf(ss * (1.f / D) + EPS);
        f32x4 g4a[8], sha[8], sca[8];
#pragma unroll
        for (int j = 0; j < 8; ++j) { const int col = 256 * j + 4 * lane; g4a[j] = *(const f32x4*)(gvec + col); sha[j] = *(const f32x4*)(mod + col); sca[j] = *(const f32x4*)(mod + D + col); }
        __builtin_amdgcn_sched_barrier(0);
#pragma unroll
        for (int j = 0; j < 8; ++j) { const int col = 256 * j + 4 * lane;
            const f32x4 h = v[j] * rstd * g4a[j] * (sca[j] + 1.f) + sha[j]; v[j] = h;
            if (!which) { u32x2 o; o.x = pk2(h.x, h.y); o.y = pk2(h.z, h.w); *(u32x2*)(H + (size_t)m * D + col) = o; } }
        if (which) {
            float am = 0.f;
#pragma unroll
            for (int j = 0; j < 8; ++j) am = fmaxf(am, fmaxf(fmaxf(fabsf(v[j].x), fabsf(v[j].y)), fmaxf(fabsf(v[j].z), fabsf(v[j].w))));
            am = wave_max(am);
            const float inv = am > 0.f ? 127.f / am : 0.f;
            if (lane == 0) ((float*)(p.ws + WS_SH))[m] = am > 0.f ? am * (1.f / 127.f) : 1.f;
            unsigned char* h8 = p.ws + WS_H8 + (size_t)m * D + 4 * lane;
#pragma unroll
            for (int j = 0; j < 8; ++j) {
                const int q0 = (int)rintf(v[j].x * inv), q1 = (int)rintf(v[j].y * inv), q2 = (int)rintf(v[j].z * inv), q3 = (int)rintf(v[j].w * inv);
                *(unsigned*)(h8 + 256 * j) = ((unsigned)q0 & 0xffu) | (((unsigned)q1 & 0xffu) << 8) | (((unsigned)q2 & 0xffu) << 16) | (((unsigned)q3 & 0xffu) << 24);
            }
        }
    }
}
template <int NR> __device__ __forceinline__ void h8_rows(const Params& p, int l, int m0, int lane, int wave) {
    const float* gvec = p.norm2_g + (size_t)l * D;
    const float* MOD = (const float*)(p.ws + WS_MOD) + (size_t)l * 2 * D6 + 3 * D;
    const float* X = (const float*)(p.ws + WS_X);
    f32x4 nx[8];
    { const f32x4* xr = (const f32x4*)(X + (size_t)(m0 + wave) * D) + lane;
#pragma unroll
      for (int j = 0; j < 8; ++j) nx[j] = xr[64 * j]; }
#pragma unroll 1
    for (int mi = wave; mi < NR; mi += NWAVES) {
        const int m = m0 + mi; const float* mod = MOD + (m >= T ? D6 : 0);
        f32x4 v[8]; float ss = 0.f;
#pragma unroll
        for (int j = 0; j < 8; ++j) { v[j] = nx[j]; ss += (v[j].x * v[j].x + v[j].y * v[j].y) + (v[j].z * v[j].z + v[j].w * v[j].w); }
        if (mi + NWAVES < NR) { const f32x4* xr = (const f32x4*)(X + (size_t)(m + NWAVES) * D) + lane;
#pragma unroll
            for (int j = 0; j < 8; ++j) nx[j] = xr[64 * j]; }
        ss = wave_sum(ss);
        const float rstd = rsqrtf(ss * (1.f / D) + EPS);
        float am = 0.f;
        f32x4 g4a[8], sha[8], sca[8];
#pragma unroll
        for (int j = 0; j < 8; ++j) { const int col = 256 * j + 4 * lane; g4a[j] = *(const f32x4*)(gvec + col); sha[j] = *(const f32x4*)(mod + col); sca[j] = *(const f32x4*)(mod + D + col); }
        __builtin_amdgcn_sched_barrier(0);
#pragma unroll
        for (int j = 0; j < 8; ++j) {
            const f32x4 h = v[j] * rstd * g4a[j] * (sca[j] + 1.f) + sha[j]; v[j] = h;
            am = fmaxf(am, fmaxf(fmaxf(fabsf(h.x), fabsf(h.y)), fmaxf(fabsf(h.z), fabsf(h.w)))); }
        am = wave_max(am);
        const float inv = am > 0.f ? 127.f / am : 0.f;
        if (lane == 0) ((float*)(p.ws + WS_SH))[m] = am > 0.f ? am * (1.f / 127.f) : 1.f;
        unsigned char* h8 = p.ws + WS_H8 + (size_t)m * D + 4 * lane;
        int qs = 0;
#pragma unroll
        for (int j = 0; j < 8; ++j) {
            const int q0 = (int)rintf(v[j].x * inv), q1 = (int)rintf(v[j].y * inv), q2 = (int)rintf(v[j].z * inv), q3 = (int)rintf(v[j].w * inv);
            qs += (q0 + q1) + (q2 + q3);
            *(unsigned*)(h8 + 256 * j) = ((unsigned)q0 & 0xffu) | (((unsigned)q1 & 0xffu) << 8) | (((unsigned)q2 & 0xffu) << 16) | (((unsigned)q3 & 0xffu) << 24);
        }
        const float qsum = wave_sum((float)qs);
        if (lane == 0) ((float*)(p.ws + WS_SH + 512 * 1024))[m] = qsum;
    }
}
__device__ __forceinline__ void ph_norm(const Params& p, int l, int which, int lane, int gw, int NGW) {
    for (int m = gw; m < M; m += NGW) norm_row(p, l, which, m, lane);
}
__device__ __forceinline__ void final_row(const Params& p, int m, int lane) {
    const float* X = (const float*)(p.ws + WS_X);
    {
        const f32x4* xr = (const f32x4*)(X + (size_t)m * D) + lane;
        f32x4 v[8]; float ss = 0.f;
#pragma unroll
        for (int j = 0; j < 8; ++j) { v[j] = xr[64 * j]; ss += (v[j].x * v[j].x + v[j].y * v[j].y) + (v[j].z * v[j].z + v[j].w * v[j].w); }
        ss = wave_sum(ss);
        const float rstd = rsqrtf(ss * (1.f / D) + EPS);
#pragma unroll
        for (int j = 0; j < 8; ++j) { const int col = 256 * j + 4 * lane; const f32x4 g4 = *(const f32x4*)(p.final_g + col);
            *(f32x4*)(p.out + (size_t)m * D + col) = v[j] * rstd * g4; }
    }
}

#define AT(T, base, off) ((T*)((unsigned char*)(base) + (size_t)(unsigned)(off)))
__device__ __forceinline__ void peer_tail_row(const Params& p, int l, int m, int lane) {
    const float* MODl = (const float*)(p.ws + WS_MOD) + ((size_t)l * 2 + (m >= T ? 1 : 0)) * D6;
    f32x4* X4 = (f32x4*)((float*)(p.ws + WS_X) + (size_t)m * D) + lane;
    f32x4 v[8];
    {
        const f32x4* D4 = (const f32x4*)((const float*)(p.ws + WS_DELTA) + (size_t)m * D) + lane; const f32x4* G4 = (const f32x4*)(MODl + 5 * D) + lane;
        f32x4 dv[8], gv[8];
#pragma unroll
        for (int j = 0; j < 8; ++j) { v[j] = X4[64 * j]; dv[j] = __builtin_nontemporal_load(D4 + 64 * j); gv[j] = G4[64 * j]; }
        __builtin_amdgcn_sched_barrier(0);
#pragma unroll
        for (int j = 0; j < 8; ++j) v[j] = v[j] + gv[j] * dv[j];
    }
    const bool last = l + 1 >= DEPTH;
    if (last && m >= T) return;
    const float* MODn = (const float*)(p.ws + WS_MOD) + ((size_t)(last ? l : l + 1) * 2 + (m >= T ? 1 : 0)) * D6;
    const f32x4* NG = (const f32x4*)(last ? p.final_g : p.norm1_g + (size_t)(l + 1) * D) + lane;
    f32x4 g4[8], sh[8], sc[8];
#pragma unroll
    for (int j = 0; j < 8; ++j) { g4[j] = NG[64 * j]; if (!last) { sh[j] = ((const f32x4*)MODn + lane)[64 * j]; sc[j] = ((const f32x4*)(MODn + D) + lane)[64 * j]; } }
    __builtin_amdgcn_sched_barrier(0);
    float ss = 0.f;
#pragma unroll
    for (int j = 0; j < 8; ++j) { if (!last) X4[64 * j] = v[j]; ss += (v[j].x * v[j].x + v[j].y * v[j].y) + (v[j].z * v[j].z + v[j].w * v[j].w); }
    ss = wave_sum(ss);
    const float rstd = rsqrtf(ss * (1.f / D) + EPS);
    if (last) {
        f32x4* O4 = (f32x4*)(p.out + (size_t)m * D) + lane;
#pragma unroll
        for (int j = 0; j < 8; ++j) O4[64 * j] = v[j] * rstd * g4[j];
    } else {
        bf16_t* H = (bf16_t*)(p.ws + WS_H) + (size_t)m * D + 4 * lane;
#pragma unroll
        for (int j = 0; j < 8; ++j) { const f32x4 h = v[j] * rstd * g4[j] * (sc[j] + 1.f) + sh[j]; u32x2 o; o.x = pk2(h.x, h.y); o.y = pk2(h.z, h.w); *(u32x2*)(H + 256 * j) = o; }
    }
}
__device__ __forceinline__ void store4_bf16(unsigned char* base, unsigned off, f32x4 v) { u32x2 w; w.x = pk2(v[0], v[1]); w.y = pk2(v[2], v[3]); *AT(u32x2, base, off) = w; }
__device__ __forceinline__ void store4_T(unsigned char* base, unsigned off0  , f32x4 v) {
    const unsigned a = pk2(v[0], v[1]), b = pk2(v[2], v[3]);
    constexpr unsigned RS = (unsigned)M * 2u;
    *AT(bf16_t, base, off0 + 0 * RS) = (bf16_t)(a & 0xffff); *AT(bf16_t, base, off0 + 1 * RS) = (bf16_t)(a >> 16);
    *AT(bf16_t, base, off0 + 2 * RS) = (bf16_t)(b & 0xffff); *AT(bf16_t, base, off0 + 3 * RS) = (bf16_t)(b >> 16);
}
__device__ __forceinline__ void rope4(f32x4& v, const float2* rope, int row, int pp  ) {
    const int pos = (pp < 64) ? (row >> 6) : (row & 63), j0 = (pp & 63) >> 1;
    const f32x4 cs = *AT(const f32x4, rope, (unsigned)(pos * 32 + j0) * 8u);
    const float a0 = v[0], b0 = v[1], a1 = v[2], b1 = v[3];
    v[0] = a0 * cs[0] - b0 * cs[1]; v[1] = b0 * cs[0] + a0 * cs[1];
    v[2] = a1 * cs[2] - b1 * cs[3]; v[3] = b1 * cs[2] + a1 * cs[3];
}
__device__ __forceinline__ void store8_bf16(unsigned char* base, unsigned off, f32x4 v0, f32x4 v1) {
    u32x4 w; w.x = pk2(v0[0], v0[1]); w.y = pk2(v0[2], v0[3]); w.z = pk2(v1[0], v1[1]); w.w = pk2(v1[2], v1[3]);
    *AT(u32x4, base, off) = w;
}
__device__ __forceinline__ void store8_T(unsigned char* base, unsigned off0  , f32x4 v0, f32x4 v1) {
    const unsigned a = pk2(v0[0], v0[1]), b = pk2(v0[2], v0[3]), c = pk2(v1[0], v1[1]), d = pk2(v1[2], v1[3]);
    constexpr unsigned RS = (unsigned)M * 2u;
    *AT(bf16_t, base, off0 + 0 * RS) = (bf16_t)(a & 0xffff); *AT(bf16_t, base, off0 + 1 * RS) = (bf16_t)(a >> 16);
    *AT(bf16_t, base, off0 + 2 * RS) = (bf16_t)(b & 0xffff); *AT(bf16_t, base, off0 + 3 * RS) = (bf16_t)(b >> 16);
    *AT(bf16_t, base, off0 + 4 * RS) = (bf16_t)(c & 0xffff); *AT(bf16_t, base, off0 + 5 * RS) = (bf16_t)(c >> 16);
    *AT(bf16_t, base, off0 + 6 * RS) = (bf16_t)(d & 0xffff); *AT(bf16_t, base, off0 + 7 * RS) = (bf16_t)(d >> 16);
}
__device__ __forceinline__ void rope8(f32x4& v0, f32x4& v1, const float2* rope, int row, int pp  ) {
    const int pos = (pp < 64) ? (row >> 6) : (row & 63), j0 = (pp & 63) >> 1;
    const f32x4* t = AT(const f32x4, rope, (unsigned)(pos * 32 + j0) * 8u);
    const f32x4 c01 = t[0], c23 = t[1];
    const float a0 = v0[0], b0 = v0[1], a1 = v0[2], b1 = v0[3], a2 = v1[0], b2 = v1[1], a3 = v1[2], b3 = v1[3];
    v0[0] = a0 * c01[0] - b0 * c01[1]; v0[1] = b0 * c01[0] + a0 * c01[1];
    v0[2] = a1 * c01[2] - b1 * c01[3]; v0[3] = b1 * c01[2] + a1 * c01[3];
    v1[0] = a2 * c23[0] - b2 * c23[1]; v1[1] = b2 * c23[0] + a2 * c23[1];
    v1[2] = a3 * c23[2] - b3 * c23[3]; v1[3] = b3 * c23[2] + a3 * c23[3];
}
struct EpiEven {
    static constexpr bool PERM = true, AFTER_DRAIN = false;
    unsigned char* proj; const float* gate_b; const float2* rope;
    __device__ __forceinline__ void elem4(unsigned row, unsigned col0, f32x4 v) const {
        const unsigned pn = col0 >> 8;
        if (pn < 2) { store4_bf16(proj, (unsigned)PJ_AQ + (row * 512u + col0) * 2u, v * 0.125f); }
        else if (pn < 4) { const unsigned c = col0 - 512; store4_bf16(proj, (unsigned)PJ_AK + (row * 512u + c) * 2u, v); store4_T(proj, (unsigned)PJ_AKT + (c * (unsigned)M + row) * 2u, v); }
        else if (pn < 8) { store4_T(proj, (unsigned)PJ_AVT + ((col0 - 1024) * (unsigned)M + row) * 2u, v); }
        else if (pn < 12) { store4_bf16(proj, (unsigned)PJ_AO + (row * 1024u + (col0 - 2048)) * 2u, v); }
        else if (pn < 16) { const unsigned c = col0 - 3072; if (row < (unsigned)T) rope4(v, rope, row, c & 127); store4_bf16(proj, (unsigned)PJ_BQ + (row * 1024u + c) * 2u, v); }
        else if (pn == 16) { const unsigned c = col0 - 4096; if (row < (unsigned)T) rope4(v, rope, row, c & 127); store4_bf16(proj, (unsigned)PJ_BK + (row * 256u + c) * 2u, v); }
        else if (pn == 17) { store4_T(proj, (unsigned)PJ_BVT + ((col0 - 4352) * (unsigned)M + row) * 2u, v); }
        else { const unsigned c = col0 - 4608; if (c < 32) *AT(f32x4, proj, (unsigned)PJ_G + (row * 32u + c) * 4u) = v + *AT(const f32x4, gate_b, c * 4u); }
    }
    __device__ __forceinline__ void operator()(const f32x4 (&acc)[2][2][4][2], const pg8::Unit& u, int wr, int wc, int fr, int fq) const {
        const int pn = u.pn;
#pragma unroll
        for (int ai = 0; ai < 2; ++ai)
#pragma unroll
            for (int m = 0; m < 4; ++m) { const unsigned row = u.pm * 256 + ai * 128 + wr * 64 + m * 16 + fr;
#pragma unroll
                for (int bj = 0; bj < 2; ++bj) { const unsigned col0 = pn * 256 + bj * 128 + wc * 32 + 8 * fq;
                    f32x4 v0 = acc[ai][bj][m][0], v1 = acc[ai][bj][m][1];
                    if (pn < 2) { store8_bf16(proj, (unsigned)PJ_AQ + (row * 512u + col0) * 2u, v0 * 0.125f, v1 * 0.125f); }
                    else if (pn < 4) { const unsigned c = col0 - 512; store8_bf16(proj, (unsigned)PJ_AK + (row * 512u + c) * 2u, v0, v1); store8_T(proj, (unsigned)PJ_AKT + (c * (unsigned)M + row) * 2u, v0, v1); }
                    else if (pn < 8) { store8_T(proj, (unsigned)PJ_AVT + ((col0 - 1024) * (unsigned)M + row) * 2u, v0, v1); }
                    else if (pn < 12) { store8_bf16(proj, (unsigned)PJ_AO + (row * 1024u + (col0 - 2048)) * 2u, v0, v1); }
                    else if (pn < 16) { const unsigned c = col0 - 3072; if (row < (unsigned)T) rope8(v0, v1, rope, row, c & 127); store8_bf16(proj, (unsigned)PJ_BQ + (row * 1024u + c) * 2u, v0, v1); }
                    else if (pn == 16) { const unsigned c = col0 - 4096; if (row < (unsigned)T) rope8(v0, v1, rope, row, c & 127); store8_bf16(proj, (unsigned)PJ_BK + (row * 256u + c) * 2u, v0, v1); }
                    else if (pn == 17) { store8_T(proj, (unsigned)PJ_BVT + ((col0 - 4352) * (unsigned)M + row) * 2u, v0, v1); }
                    else { const unsigned c = col0 - 4608; if (c < 32) { const unsigned go = (unsigned)PJ_G + (row * 32u + c) * 4u;
                            *AT(f32x4, proj, go) = v0 + *AT(const f32x4, gate_b, c * 4u); *AT(f32x4, proj, go + 16u) = v1 + *AT(const f32x4, gate_b, c * 4u + 16u); } }
                } }
    }
};
struct EpiOdd {
    static constexpr bool PERM = true, AFTER_DRAIN = false;
    unsigned char* proj;
    __device__ __forceinline__ void elem4(unsigned row, unsigned col0, f32x4 v) const {
        const unsigned pn = col0 >> 8;
        if (pn < 8) store4_bf16(proj, (unsigned)PJ_Q + (row * 2048u + col0) * 2u, v);
        else if (pn < 16) store4_bf16(proj, (unsigned)PJ_K + (row * 2048u + (col0 - 2048)) * 2u, v);
        else store4_T(proj, (unsigned)PJ_VT + ((col0 - 4096) * (unsigned)M + row) * 2u, v);
    }
    __device__ __forceinline__ void operator()(const f32x4 (&acc)[2][2][4][2], const pg8::Unit& u, int wr, int wc, int fr, int fq) const {
        const int pn = u.pn;
#pragma unroll
        for (int ai = 0; ai < 2; ++ai)
#pragma unroll
            for (int m = 0; m < 4; ++m) { const unsigned row = u.pm * 256 + ai * 128 + wr * 64 + m * 16 + fr;
#pragma unroll
                for (int bj = 0; bj < 2; ++bj) { const unsigned col0 = pn * 256 + bj * 128 + wc * 32 + 8 * fq;
                    const f32x4 v0 = acc[ai][bj][m][0], v1 = acc[ai][bj][m][1];
                    if (pn < 8) store8_bf16(proj, (unsigned)PJ_Q + (row * 2048u + col0) * 2u, v0, v1);
                    else if (pn < 16) store8_bf16(proj, (unsigned)PJ_K + (row * 2048u + (col0 - 2048)) * 2u, v0, v1);
                    else store8_T(proj, (unsigned)PJ_VT + ((col0 - 4096) * (unsigned)M + row) * 2u, v0, v1);
                } }
    }
};
struct EpiResid {
    static constexpr bool PERM = true, AFTER_DRAIN = false;
    float* X; const float* gl; const float* gc; const float* srcl; const float* srcc;
    unsigned char* XB; float* part; float* partc;
    __device__ __forceinline__ void elem4(unsigned row, unsigned col0, f32x4 v) const {
        f32x4* xp = AT(f32x4, X, (row * (unsigned)D + col0) * 4u);
        const f32x4* sp = AT(const f32x4, srcc, ((row - (unsigned)T) * (unsigned)D + col0) * 4u);
        const f32x4 x = *sp + *AT(const f32x4, gc, col0 * 4u) * v;
        *xp = x; store4_bf16(XB, (row * (unsigned)D + col0) * 2u, x);
        const float s = fq_sum((x.x * x.x + x.y * x.y) + (x.z * x.z + x.w * x.w));
        if (((col0 >> 2) & 3u) == 0u) *AT(float, partc, ((row - (unsigned)T) * 128u + (col0 >> 4)) * 4u) = s;
    }
    __device__ __forceinline__ void operator()(const f32x4 (&acc)[2][2][4][2], const pg8::Unit& u, int wr, int wc, int fr, int fq) const {
        const float* g = (u.pm * 256 < T) ? gl : gc;
        f32x4 gg[2][2];
#pragma unroll
        for (int bj = 0; bj < 2; ++bj) { const unsigned col0 = u.pn * 256 + bj * 128 + wc * 32 + 8 * fq; gg[bj][0] = *AT(const f32x4, g, col0 * 4u); gg[bj][1] = *AT(const f32x4, g, col0 * 4u + 16u); }
#pragma unroll
        for (int ai = 0; ai < 2; ++ai) {
            f32x4 sv[4][2][2];
#pragma unroll
            for (int m = 0; m < 4; ++m) { const unsigned row = u.pm * 256 + ai * 128 + wr * 64 + m * 16 + fr;
#pragma unroll
                for (int bj = 0; bj < 2; ++bj) { const unsigned col0 = u.pn * 256 + bj * 128 + wc * 32 + 8 * fq;
                    const f32x4* sp = (u.pm * 256 < T) ? AT(const f32x4, srcl, (row * (unsigned)D + col0) * 4u) : AT(const f32x4, srcc, ((row - (unsigned)T) * (unsigned)D + col0) * 4u);
                    sv[m][bj][0] = __builtin_nontemporal_load(sp); sv[m][bj][1] = __builtin_nontemporal_load(sp + 1); } }
            __builtin_amdgcn_sched_barrier(0);
#pragma unroll
            for (int m = 0; m < 4; ++m) { const unsigned row = u.pm * 256 + ai * 128 + wr * 64 + m * 16 + fr; float ssq = 0.f;
#pragma unroll
                for (int bj = 0; bj < 2; ++bj) { const unsigned col0 = u.pn * 256 + bj * 128 + wc * 32 + 8 * fq;
                    f32x4* xp = AT(f32x4, X, (row * (unsigned)D + col0) * 4u);
                    const f32x4 x0 = sv[m][bj][0] + gg[bj][0] * acc[ai][bj][m][0], x1 = sv[m][bj][1] + gg[bj][1] * acc[ai][bj][m][1];
                    xp[0] = x0; xp[1] = x1; store8_bf16(XB, (row * (unsigned)D + col0) * 2u, x0, x1);
                    ssq += ((x0.x * x0.x + x0.y * x0.y) + (x0.z * x0.z + x0.w * x0.w)) + ((x1.x * x1.x + x1.y * x1.y) + (x1.z * x1.z + x1.w * x1.w));
                }
                ssq = fq_sum(ssq);
                if (fq == 0) *AT(float, part, (row * 32u + u.pn * 4u + wc) * 4u) = ssq; }
            __builtin_amdgcn_sched_barrier(0);
        }
    }
};
struct EpiPlain {
    static constexpr bool PERM = true, AFTER_DRAIN = false;
    bf16_t* O;
    __device__ __forceinline__ void elem4(unsigned row, unsigned col0, f32x4 v) const { store4_bf16((unsigned char*)O, (row * (unsigned)D + col0) * 2u, v); }
    __device__ __forceinline__ void operator()(const f32x4 (&acc)[2][2][4][2], const pg8::Unit& u, int wr, int wc, int fr, int fq) const {
#pragma unroll
        for (int ai = 0; ai < 2; ++ai)
#pragma unroll
            for (int m = 0; m < 4; ++m) { const unsigned row = u.pm * 256 + ai * 128 + wr * 64 + m * 16 + fr;
#pragma unroll
                for (int bj = 0; bj < 2; ++bj) { const unsigned col0 = u.pn * 256 + bj * 128 + wc * 32 + 8 * fq;
                    store8_bf16((unsigned char*)O, (row * (unsigned)D + col0) * 2u, acc[ai][bj][m][0], acc[ai][bj][m][1]); } }
    }
};
struct EpiQ {
    static constexpr bool PERM = true, AFTER_DRAIN = false;
    bf16_t* O; const float* part; const float* bias;
    __device__ __forceinline__ void operator()(const f32x4 (&acc)[2][2][4][2], const pg8::Unit& u, int wr, int wc, int fr, int fq) const {
        f32x4 bb[2][2], pp[2][4][2];
#pragma unroll
        for (int bj = 0; bj < 2; ++bj) { const unsigned col0 = u.pn * 256 + bj * 128 + wc * 32 + 8 * fq; bb[bj][0] = *AT(const f32x4, bias, col0 * 4u); bb[bj][1] = *AT(const f32x4, bias, col0 * 4u + 16u); }
#pragma unroll
        for (int ai = 0; ai < 2; ++ai)
#pragma unroll
            for (int m = 0; m < 4; ++m) { const unsigned row = u.pm * 256 + ai * 128 + wr * 64 + m * 16 + fr;
                pp[ai][m][0] = *AT(const f32x4, part, (row * 32u + 8u * fq) * 4u); pp[ai][m][1] = *AT(const f32x4, part, (row * 32u + 8u * fq) * 4u + 16u); }
        __builtin_amdgcn_sched_barrier(0);
#pragma unroll
        for (int ai = 0; ai < 2; ++ai)
#pragma unroll
            for (int m = 0; m < 4; ++m) { const unsigned row = u.pm * 256 + ai * 128 + wr * 64 + m * 16 + fr;
                const f32x4 p0 = pp[ai][m][0], p1 = pp[ai][m][1];
                const float r = rsqrtf(fq_sum(((p0.x + p0.y) + (p0.z + p0.w)) + ((p1.x + p1.y) + (p1.z + p1.w))) * (1.f / D) + EPS);
#pragma unroll
                for (int bj = 0; bj < 2; ++bj) { const unsigned col0 = u.pn * 256 + bj * 128 + wc * 32 + 8 * fq;
                    store8_bf16((unsigned char*)O, (row * (unsigned)D + col0) * 2u, acc[ai][bj][m][0] * r + bb[bj][0], acc[ai][bj][m][1] * r + bb[bj][1]); } }
    }
};
struct EpiQC {
    bf16_t* O; const float* partc; const float* bias;
    __device__ __forceinline__ void elem4(unsigned row, unsigned col0, f32x4 v) const {
        const unsigned po = ((row - (unsigned)T) * 128u + 32u * ((col0 >> 2) & 3u)) * 4u; float sq = 0.f;
#pragma unroll
        for (int i = 0; i < 8; ++i) { const f32x4 t = *AT(const f32x4, partc, po + 16u * i); sq += (t.x + t.y) + (t.z + t.w); }
        const float r = rsqrtf(fq_sum(sq) * (1.f / D) + EPS);
        store4_bf16((unsigned char*)O, (row * (unsigned)D + col0) * 2u, v * r + *AT(const f32x4, bias, col0 * 4u)); }
};
struct EpiInProj {
    static constexpr bool PERM = true, AFTER_DRAIN = false;
    EpiEven ev; EpiOdd od; bool even;
    __device__ __forceinline__ void elem4(unsigned row, unsigned col0, f32x4 v) const { if (even) ev.elem4(row, col0, v); else od.elem4(row, col0, v); }
    __device__ __forceinline__ void operator()(const f32x4 (&acc)[2][2][4][2], const pg8::Unit& u, int wr, int wc, int fr, int fq) const {
        if (even) ev(acc, u, wr, wc, fr, fq); else od(acc, u, wr, wc, fr, fq);
    }
};
struct EpiOutQ {
    static constexpr bool PERM = true, AFTER_DRAIN = false;
    EpiResid rs; EpiPlain pl; bool resid;
    __device__ __forceinline__ void operator()(const f32x4 (&acc)[2][2][4][2], const pg8::Unit& u, int wr, int wc, int fr, int fq) const {
        if (resid) rs(acc, u, wr, wc, fr, fq); else pl(acc, u, wr, wc, fr, fq);
    }
};

template <class Epi, int NT  >
__device__ __forceinline__ void ctx_gemm_piece(const bf16_t* __restrict__ A, const bf16_t* __restrict__ Bt, const Epi& E, int rb, int cb, int wave, int lane) {
    const int fr = lane & 15, fq = lane >> 4;
    const bf16_t* ap = A + (size_t)(T + 16 * rb + fr) * D + 8 * fq;
    const bf16_t* bp = Bt + (size_t)(cb * 128 * NT + 16 * NT * wave + fr) * D + 8 * fq;
    f32x4 acc[NT];
#pragma unroll
    for (int n = 0; n < NT; ++n) acc[n] = (f32x4){0.f, 0.f, 0.f, 0.f};
    constexpr int KC = NT == 1 ? 16 : 8;
#pragma unroll 1
    for (int k0 = 0; k0 < D; k0 += 32 * KC) {
        bf16x8 af[KC], bfg[NT][KC];
#pragma unroll
        for (int kk = 0; kk < KC; ++kk) { af[kk] = *(const bf16x8*)(ap + k0 + 32 * kk);
#pragma unroll
            for (int n = 0; n < NT; ++n) bfg[n][kk] = *(const bf16x8*)(bp + (size_t)16 * n * D + k0 + 32 * kk); }
        __builtin_amdgcn_sched_barrier(0);
#pragma unroll
        for (int kk = 0; kk < KC; ++kk)
#pragma unroll
            for (int n = 0; n < NT; ++n) acc[n] = MFMA16(bfg[n][kk], af[kk], acc[n]);
    }
#pragma unroll
    for (int n = 0; n < NT; ++n) E.elem4((unsigned)(T + 16 * rb + fr), (unsigned)(cb * 128 * NT + 16 * NT * wave + 16 * n + 4 * fq), acc[n]);
}
template <class Epi>
__device__ __forceinline__ void ctx_gemm(const bf16_t* __restrict__ A, const bf16_t* __restrict__ Bt, int N, const Epi& E, int wave, int lane, int vcu, int G) {
    asm volatile("" : "+v"(lane));
    const int npc = 16 * (N >> 7);
    for (int pc = vcu; pc < npc; pc += G) ctx_gemm_piece<Epi, 1>(A, Bt, E, pc & 15, pc >> 4, wave, lane);
}

template <class TF>
__device__ __forceinline__ void attn_wave16(const bf16_t* __restrict__ Qh, int qstride, int qrow0,
                                            const bf16_t* __restrict__ Kh, int kstride, const bf16_t* __restrict__ VTh  ,
                                            int ntiles, const TF& tf, bool has_sink, float sink, float scale,
                                            bf16_t* __restrict__ Oh, int ostride, int lane) {
    asm volatile("" : "+v"(lane));
    const int fr = lane & 15, fq = lane >> 4;
    bf16x8 qf[4];
#pragma unroll
    for (int kd = 0; kd < 4; ++kd) qf[kd] = *(const bf16x8*)(Qh + (size_t)(qrow0 + fr) * qstride + 32 * kd + 8 * fq);
    f32x4 o[8];
#pragma unroll
    for (int nd = 0; nd < 8; ++nd) o[nd] = (f32x4){0.f, 0.f, 0.f, 0.f};
    float mrun = has_sink ? sink * LOG2E : -1e30f;
    float lrun = (has_sink && fq == 0) ? 1.f : 0.f;
    const float sc2 = scale * LOG2E;
    for (int ti = 0; ti < ntiles; ++ti) {
        const int tok0 = tf.tok0(ti);
        f32x4 s[2];
#pragma unroll
        for (int sub = 0; sub < 2; ++sub) {
            s[sub] = (f32x4){0.f, 0.f, 0.f, 0.f};
            int tk = tok0 + 16 * sub + fr; tk = tk < 0 ? 0 : (tk > M - 1 ? M - 1 : tk);
#pragma unroll
            for (int kd = 0; kd < 4; ++kd) { const bf16x8 kf = *(const bf16x8*)(Kh + (size_t)tk * kstride + 32 * kd + 8 * fq); s[sub] = MFMA16(kf, qf[kd], s[sub]); }
        }
        float pv[8]; float tmax = -INFINITY;
#pragma unroll
        for (int sub = 0; sub < 2; ++sub)
#pragma unroll
            for (int r = 0; r < 4; ++r) { const int ks = 16 * sub + 4 * fq + r; const float b = tf.bias(ti, ks);
                const float v = s[sub][r] * sc2 + b * LOG2E; pv[4 * sub + r] = v; tmax = fmaxf(tmax, v); }
        tmax = fmaxf(tmax, __shfl_xor(tmax, 16)); tmax = fmaxf(tmax, __shfl_xor(tmax, 32));
        const float mnew = fmaxf(mrun, tmax), alpha = exp2f(mrun - mnew);
        float ps = 0.f;
#pragma unroll
        for (int i = 0; i < 8; ++i) { pv[i] = exp2f(pv[i] - mnew); ps += pv[i]; }
        lrun = lrun * alpha + ps; mrun = mnew;
#pragma unroll
        for (int nd = 0; nd < 8; ++nd) o[nd] = o[nd] * alpha;
        u32x4 pw; pw.x = pk2(pv[0], pv[1]); pw.y = pk2(pv[2], pv[3]); pw.z = pk2(pv[4], pv[5]); pw.w = pk2(pv[6], pv[7]);
        const bf16x8 pf = mk_frag(pw);
        int t0 = tok0 + 4 * fq, t1 = tok0 + 16 + 4 * fq;
        t0 = t0 < 0 ? 0 : (t0 > M - 4 ? M - 4 : t0); t1 = t1 < 0 ? 0 : (t1 > M - 4 ? M - 4 : t1);
#pragma unroll
        for (int nd = 0; nd < 8; ++nd) { const bf16_t* vr = VTh + (size_t)(16 * nd + fr) * M;
            const u32x2 a = *(const u32x2*)(vr + t0), b = *(const u32x2*)(vr + t1);
            u32x4 w; w.x = a.x; w.y = a.y; w.z = b.x; w.w = b.y;
            o[nd] = MFMA16(mk_frag(w), pf, o[nd]); }
    }
    lrun += __shfl_xor(lrun, 16); lrun += __shfl_xor(lrun, 32);
    const float rl = 1.f / lrun;
#pragma unroll
    for (int nd = 0; nd < 8; ++nd) { const f32x4 v = o[nd] * rl; u32x2 w; w.x = pk2(v[0], v[1]); w.y = pk2(v[2], v[3]);
        *(u32x2*)(Oh + (size_t)(qrow0 + fr) * ostride + 16 * nd + 4 * fq) = w; }
}
struct TFCtxOnly {
    __device__ __forceinline__ int tok0(int ti) const { return T + 32 * ti; }
    __device__ __forceinline__ float bias(int, int) const { return 0.f; }
};
struct TFGqa {
    int jb, tq;
    __device__ __forceinline__ int tok0(int ti) const { return ti < 9 ? 16 * jb - 128 + 32 * ti : T + 32 * (ti - 9); }
    __device__ __forceinline__ float bias(int ti, int ks) const {
        if (ti >= 9) return 0.f;
        const int kp = 16 * jb - 128 + 32 * ti + ks, d = kp - tq;
        return (kp >= 0 && kp < T && d <= 128 && d >= -128) ? 0.f : -INFINITY;
    }
};
struct TFNa {
    int r0, kc0, r, c, c0; const float* rpb;
    __device__ __forceinline__ int tok0(int ti) const { return ti < 8 ? 64 * (r0 + ti) + kc0 : T + 32 * (ti - 8); }
    __device__ __forceinline__ float bias(int ti, int ks) const {
        if (ti >= 8) return 0.f;
        const int kc = kc0 + ks;
        if (kc < c0 || kc >= c0 + 16) return -INFINITY;
        return rpb[(r0 + ti - r + 7) * 31 + (kc - c + 15)];
    }
};

#ifndef ATT_NB
#define ATT_NB 4
#endif
constexpr int ATT_KB = 16384, ATT_VROW = 136, ATT_BUF = ATT_KB + 128 * ATT_VROW;
template <class TF, int MODE = 0>
__device__ __forceinline__ void attn_wg(const TF& tf, const bf16_t* __restrict__ Qh, int qstride, int qrow0, int qrow1,
                                        const bf16_t* __restrict__ Kh, int kstride, const bf16_t* __restrict__ VTh,
                                        bool has_sink, float sink, float scale, bf16_t* __restrict__ Oh, int ostride, LAS unsigned char* lds, int tid, int lane, bool rt_false = false) {
    asm volatile("" : "+v"(lane));
    const int fr = lane & 15, fq = lane >> 4;
    bf16x8 qf[2][4];
#pragma unroll
    for (int qt = 0; qt < 2; ++qt)
#pragma unroll
        for (int kd = 0; kd < 4; ++kd) qf[qt][kd] = *(const bf16x8*)(Qh + (size_t)((qt ? qrow1 : qrow0) + fr) * qstride + 32 * kd + 8 * fq);
    f32x4 o[2][8]; float mrun[2], lrun[2];
#pragma unroll
    for (int qt = 0; qt < 2; ++qt) { mrun[qt] = has_sink ? sink * LOG2E : -1e30f; lrun[qt] = (has_sink && fq == 0) ? 1.f : 0.f;
#pragma unroll
        for (int nd = 0; nd < 8; ++nd) o[qt][nd] = (f32x4){0.f, 0.f, 0.f, 0.f}; }
    const float sc2 = scale * LOG2E;
    const int kr0 = tid >> 4, kch = tid & 15, vd0 = tid >> 3, vc8 = tid & 7;
    u32x4 kreg[2], vreg[2];
    const int nt = tf.ntiles();
#define ATT_LOAD(ti) do { const int t0_ = tf.tile_t0(ti); _Pragma("unroll") for (int i_ = 0; i_ < 2; ++i_) { \
        int tk_ = t0_ + kr0 + 32 * i_; tk_ = tk_ < 0 ? 0 : (tk_ > M - 1 ? M - 1 : tk_); kreg[i_] = *(const u32x4*)(Kh + (size_t)tk_ * kstride + 8 * kch); \
        int tv_ = t0_ + 8 * vc8; tv_ = tv_ < 0 ? 0 : (tv_ > M - 8 ? M - 8 : tv_); vreg[i_] = *(const u32x4*)(VTh + (size_t)(vd0 + 64 * i_) * M + tv_); } } while (0)
#define ATT_STORE(b) do { LAS unsigned char* bb_ = lds + (b) * ATT_BUF; _Pragma("unroll") for (int i_ = 0; i_ < 2; ++i_) { const int r_ = kr0 + 32 * i_; \
        *(LAS u32x4*)(bb_ + r_ * 256 + ((kch ^ (r_ & 15)) << 4)) = kreg[i_]; \
        LAS u32x2* vp_ = (LAS u32x2*)(bb_ + ATT_KB + (vd0 + 64 * i_) * ATT_VROW + 16 * vc8); u32x2 a_, b_; a_.x = vreg[i_].x; a_.y = vreg[i_].y; b_.x = vreg[i_].z; b_.y = vreg[i_].w; vp_[0] = a_; vp_[1] = b_; } } while (0)
    __syncthreads();
    ATT_LOAD(0); ATT_STORE(0);
    __syncthreads();
    for (int ti = 0; ti < nt; ++ti) {
        if (ti + 1 < nt && MODE != 2) ATT_LOAD(ti + 1);
        if (tf.active(ti) && MODE != 3) {
            const LAS unsigned char* kb = lds + (ti & 1) * ATT_BUF; const LAS unsigned char* vbase = kb + ATT_KB;
            const int ns = tf.nsteps(ti);
            for (int st = 0; st < ns; ++st) {
                int ws[2]; f32x4 s[2][2]; float pv[2][8], bs8[2][8], alpha[2];
#pragma unroll
                for (int qt = 0; qt < 2; ++qt) { ws[qt] = tf.win(ti, qt, st);
#pragma unroll
                    for (int sub = 0; sub < 2; ++sub) { s[qt][sub] = (f32x4){0.f, 0.f, 0.f, 0.f}; const int tl = ws[qt] + 16 * sub + fr;
#pragma unroll
                        for (int kd = 0; kd < 4; ++kd) { const bf16x8 kf = *(const LAS bf16x8*)(kb + tl * 256 + (((4 * kd + fq) ^ (tl & 15)) << 4)); s[qt][sub] = MFMA16(kf, qf[qt][kd], s[qt][sub]); } } }
#pragma unroll
                for (int qt = 0; qt < 2; ++qt) tf.bias8(ti, qt, ws[qt] + 4 * fq, bs8[qt]);
                float tmax[2];
#pragma unroll
                for (int qt = 0; qt < 2; ++qt) { tmax[qt] = -INFINITY;
#pragma unroll
                    for (int sub = 0; sub < 2; ++sub)
#pragma unroll
                        for (int r = 0; r < 4; ++r) { const float v = s[qt][sub][r] * sc2 + bs8[qt][4 * sub + r] * LOG2E; pv[qt][4 * sub + r] = v; tmax[qt] = fmaxf(tmax[qt], v); } }
                { const float t0 = __shfl_xor(tmax[0], 16), t1 = __shfl_xor(tmax[1], 16);
                  __builtin_amdgcn_sched_barrier(0);
                  tmax[0] = fmaxf(tmax[0], t0); tmax[1] = fmaxf(tmax[1], t1); }
                { const float t0 = __shfl_xor(tmax[0], 32), t1 = __shfl_xor(tmax[1], 32);
                  __builtin_amdgcn_sched_barrier(0);
                  tmax[0] = fmaxf(tmax[0], t0); tmax[1] = fmaxf(tmax[1], t1); }
                if (__builtin_amdgcn_ballot_w64(tmax[0] > mrun[0] + 8.f || tmax[1] > mrun[1] + 8.f) != 0ull) {
#pragma unroll
                    for (int qt = 0; qt < 2; ++qt) { const float mnew = fmaxf(mrun[qt], tmax[qt]); alpha[qt] = __builtin_amdgcn_exp2f(mrun[qt] - mnew); lrun[qt] *= alpha[qt]; mrun[qt] = mnew;
#pragma unroll
                        for (int nd = 0; nd < 8; ++nd) o[qt][nd] = o[qt][nd] * alpha[qt]; }
                }
#pragma unroll
                for (int qt = 0; qt < 2; ++qt) {
                    float ps = 0.f;
#pragma unroll
                    for (int i = 0; i < 8; ++i) { pv[qt][i] = __builtin_amdgcn_exp2f(pv[qt][i] - mrun[qt]); ps += pv[qt][i]; }
                    lrun[qt] += ps; }
                bf16x8 pf[2];
#pragma unroll
                for (int qt = 0; qt < 2; ++qt) { u32x4 pw; pw.x = pk2(pv[qt][0], pv[qt][1]); pw.y = pk2(pv[qt][2], pv[qt][3]); pw.z = pk2(pv[qt][4], pv[qt][5]); pw.w = pk2(pv[qt][6], pv[qt][7]); pf[qt] = mk_frag(pw); }
                constexpr int NB_ = ATT_NB;
#pragma unroll
                for (int nh = 0; nh < 8; nh += NB_) {
                    u32x4 vw[NB_][2];
#pragma unroll
                    for (int n4 = 0; n4 < NB_; ++n4)
#pragma unroll
                        for (int qt = 0; qt < 2; ++qt) { const LAS unsigned char* vr = vbase + (16 * (nh + n4) + fr) * ATT_VROW + 2 * (ws[qt] + 4 * fq);
                            const u32x2 a = *(const LAS u32x2*)vr, b2 = *(const LAS u32x2*)(vr + 32);
                            vw[n4][qt].x = a.x; vw[n4][qt].y = a.y; vw[n4][qt].z = b2.x; vw[n4][qt].w = b2.y; }
                    __builtin_amdgcn_sched_barrier(0);
#pragma unroll
                    for (int n4 = 0; n4 < NB_; ++n4)
#pragma unroll
                        for (int qt = 0; qt < 2; ++qt) o[qt][nh + n4] = MFMA16(mk_frag(vw[n4][qt]), pf[qt], o[qt][nh + n4]);
                    __builtin_amdgcn_sched_barrier(0);
                }
            }
        }
        if (ti + 1 < nt) ATT_STORE((ti + 1) & 1);
        __syncthreads();
    }
#undef ATT_LOAD
#undef ATT_STORE
    if (MODE == 0 || rt_false)
#pragma unroll
    for (int qt = 0; qt < 2; ++qt) {
        const float lt = fq_sum(lrun[qt]);
        const float rl = 1.f / lt;
#pragma unroll
        for (int nd = 0; nd < 8; ++nd) { const f32x4 v = o[qt][nd] * rl; u32x2 w; w.x = pk2(v[0], v[1]); w.y = pk2(v[2], v[3]);
            *(u32x2*)(Oh + (size_t)((qt ? qrow1 : qrow0) + fr) * ostride + 16 * nd + 4 * fq) = w; }
    }
}
struct TFCtxW {
    __device__ __forceinline__ int ntiles() const { return 4; }
    __device__ __forceinline__ int tile_t0(int ti) const { return T + 64 * ti; }
    __device__ __forceinline__ bool active(int) const { return true; }
    __device__ __forceinline__ int nsteps(int) const { return 2; }
    __device__ __forceinline__ int win(int, int, int st) const { return 32 * st; }
    __device__ __forceinline__ void bias8(int, int, int, float (&b)[8]) const {
#pragma unroll
        for (int i = 0; i < 8; ++i) b[i] = 0.f; }
};
struct TFGqaW {
    int jb64, q0;
    __device__ __forceinline__ int ntiles() const { return 9; }
    __device__ __forceinline__ int tile_t0(int ti) const { return ti < 5 ? 64 * jb64 - 128 + 64 * ti : T + 64 * (ti - 5); }
    __device__ __forceinline__ bool active(int) const { return true; }
    __device__ __forceinline__ int nsteps(int) const { return 2; }
    __device__ __forceinline__ int win(int, int, int st) const { return 32 * st; }
    __device__ __forceinline__ void bias8(int ti, int qt, int key0, float (&b)[8]) const {
        const bool plain = ti >= 5 || (ti >= 1 && ti <= 3 && 64 * jb64 - 128 + 64 * ti >= 0 && 64 * jb64 - 128 + 64 * ti + 63 < T);
        if (plain) {
#pragma unroll
            for (int i = 0; i < 8; ++i) b[i] = 0.f;
        } else {
#pragma unroll
            for (int i = 0; i < 8; ++i) { const int key = key0 + 16 * (i >> 2) + (i & 3); const int kp = 64 * jb64 - 128 + 64 * ti + key, d = kp - (q0 + 16 * qt);
                b[i] = (kp >= 0 && kp < T && d <= 128 && d >= -128) ? 0.f : -INFINITY; }
        }
    }
};
struct TFNaW {
    int rlo, nl, r, r0, hf, fr; const LAS float* rpb;
    __device__ __forceinline__ int ntiles() const { return nl + 4; }
    __device__ __forceinline__ int tile_t0(int ti) const { return ti < nl ? 64 * (rlo + ti) : T + 64 * (ti - nl); }
    __device__ __forceinline__ bool active(int ti) const { return ti >= nl || (rlo + ti >= r0 && rlo + ti < r0 + 8); }
    __device__ __forceinline__ int nsteps(int ti) const { return ti < nl ? 1 : 2; }
    __device__ __forceinline__ int win(int ti, int qt, int st) const { if (ti >= nl) return 32 * st; const int cq = 2 * hf + qt; return cq == 0 ? 0 : (cq == 1 ? 8 : (cq == 2 ? 24 : 32)); }
    __device__ __forceinline__ void bias8(int ti, int qt, int key0, float (&b)[8]) const {
        if (ti >= nl) {
#pragma unroll
            for (int i = 0; i < 8; ++i) b[i] = 0.f;
        } else {
            const int c = 32 * hf + 16 * qt + fr, c0 = c - 8 < 0 ? 0 : (c - 8 > 48 ? 48 : c - 8);
            const LAS float* row = rpb + (rlo + ti - r + 7) * 31;
#pragma unroll
            for (int i = 0; i < 8; ++i) { const int key = key0 + 16 * (i >> 2) + (i & 3); int off = key - c + 15; off = off < 0 ? 0 : (off > 30 ? 30 : off);
                const float v = row[off]; b[i] = ((unsigned)(key - c0) < 16u) ? v : -INFINITY; }
        }
    }
};

__device__ __forceinline__ void ph_attn_even(const Params& p, int e, bool with_ctx, LAS unsigned char* lds, int tid, int lane, int wave, int vcu, int G) {
    unsigned char* proj = p.ws + WS_PROJ;
    const bf16_t* BQ = (const bf16_t*)(proj + PJ_BQ); const bf16_t* BK = (const bf16_t*)(proj + PJ_BK); const bf16_t* BVT = (const bf16_t*)(proj + PJ_BVT);
    bf16_t* MIX = (bf16_t*)(p.ws + WS_MIX);
    const float scale = 0.08838834764831845f;
#ifdef ATT_PROBE
    for (int U = vcu; U < 256; U += G) {
        const int jb64 = U >> 1, kvh = U & 1, h = kvh * 4 + (wave & 3), hf = wave >> 2;
        TFGqaW tf; tf.jb64 = jb64; tf.q0 = 64 * jb64 + 32 * hf + (lane & 15);
        attn_wg<TFGqaW, ATT_PROBE>(tf, BQ + h * 128, 1024, 64 * jb64 + 32 * hf, 64 * jb64 + 32 * hf + 16, BK + kvh * 128, 256, BVT + (size_t)kvh * 128 * M, true, p.ab_sink[e * 8 + h], scale, MIX + 1024 + h * 128, 2048, lds, tid, lane, p.grid == 12345);
    }
#endif
    for (int U = vcu; U < 256; U += G) {
        const int jb64 = U >> 1, kvh = U & 1, h = kvh * 4 + (wave & 3), hf = wave >> 2;
        TFGqaW tf; tf.jb64 = jb64; tf.q0 = 64 * jb64 + 32 * hf + (lane & 15);
        attn_wg(tf, BQ + h * 128, 1024, 64 * jb64 + 32 * hf, 64 * jb64 + 32 * hf + 16, BK + kvh * 128, 256, BVT + (size_t)kvh * 128 * M, true, p.ab_sink[e * 8 + h], scale, MIX + 1024 + h * 128, 2048, lds, tid, lane);
    }
    if (with_ctx) for (int U = G - 1 - vcu; U < 8; U += G) {
        const int h = U, kvh = h >> 2;
        attn_wg(TFCtxW(), BQ + h * 128, 1024, T + 32 * wave, T + 32 * wave + 16, BK + kvh * 128, 256, BVT + (size_t)kvh * 128 * M, true, p.ab_sink[e * 8 + h], scale, MIX + 1024 + h * 128, 2048, lds, tid, lane);
    }
}
__device__ __forceinline__ void ph_attn_odd(const Params& p, int o, bool with_ctx, LAS unsigned char* lds, int tid, int lane, int wave, int vcu, int G) {
    unsigned char* proj = p.ws + WS_PROJ;
    const bf16_t* Q = (const bf16_t*)(proj + PJ_Q); const bf16_t* K = (const bf16_t*)(proj + PJ_K); const bf16_t* VT = (const bf16_t*)(proj + PJ_VT);
    bf16_t* MIX = (bf16_t*)(p.ws + WS_MIX);
    const float scale = 0.08838834764831845f;
#ifdef NA_PROBE
    for (int U = vcu; U < 512; U += G) {
        const int rg = U >> 4, h = U & 15, r = 4 * rg + (wave >> 1), hf = wave & 1;
        TFNaW tf; tf.r = r; tf.r0 = r - 4 < 0 ? 0 : (r - 4 > 120 ? 120 : r - 4); tf.hf = hf; tf.fr = lane & 15; tf.rpb = (const LAS float*)(lds + 2 * ATT_BUF);
        { const float* rsrc = p.na_rpb + ((size_t)o * 16 + h) * 15 * 31; __syncthreads(); if (tid < 465) ((LAS float*)(lds + 2 * ATT_BUF))[tid] = rsrc[tid]; }
        const int rl_ = 4 * rg - 4 < 0 ? 0 : (4 * rg - 4 > 120 ? 120 : 4 * rg - 4), rh_ = (4 * rg - 1 < 0 ? 0 : (4 * rg - 1 > 120 ? 120 : 4 * rg - 1)) + 7;
        tf.rlo = rl_; tf.nl = rh_ - rl_ + 1;
        attn_wg<TFNaW, 1>(tf, Q + h * 128, 2048, 64 * r + 32 * hf, 64 * r + 32 * hf + 16, K + h * 128, 2048, VT + (size_t)h * 128 * M, false, 0.f, scale, MIX + h * 128, 2048, lds, tid, lane, p.grid == 12345);
    }
#endif
    for (int U = vcu; U < 512; U += G) {
        const int rg = U >> 4, h = U & 15, r = 4 * rg + (wave >> 1), hf = wave & 1;
        TFNaW tf; tf.r = r; tf.r0 = r - 4 < 0 ? 0 : (r - 4 > 120 ? 120 : r - 4); tf.hf = hf; tf.fr = lane & 15; tf.rpb = (const LAS float*)(lds + 2 * ATT_BUF);
        { const float* rsrc = p.na_rpb + ((size_t)o * 16 + h) * 15 * 31; __syncthreads(); if (tid < 465) ((LAS float*)(lds + 2 * ATT_BUF))[tid] = rsrc[tid]; }
        const int rl_ = 4 * rg - 4 < 0 ? 0 : (4 * rg - 4 > 120 ? 120 : 4 * rg - 4), rh_ = (4 * rg - 1 < 0 ? 0 : (4 * rg - 1 > 120 ? 120 : 4 * rg - 1)) + 7;
        tf.rlo = rl_; tf.nl = rh_ - rl_ + 1;
        attn_wg(tf, Q + h * 128, 2048, 64 * r + 32 * hf, 64 * r + 32 * hf + 16, K + h * 128, 2048, VT + (size_t)h * 128 * M, false, 0.f, scale, MIX + h * 128, 2048, lds, tid, lane);
    }
    if (with_ctx) for (int U = G - 1 - vcu; U < 16; U += G) {
        const int h = U;
        attn_wg(TFCtxW(), Q + h * 128, 2048, T + 32 * wave, T + 32 * wave + 16, K + h * 128, 2048, VT + (size_t)h * 128 * M, false, 0.f, scale, MIX + h * 128, 2048, lds, tid, lane);
    }
}

__device__ __forceinline__ void mlstm_A_unit(const Params& p, int cc, int hd, int lane) {
    asm volatile("" : "+v"(lane));
    const int fr = lane & 15, fq = lane >> 4, dir = hd >> 3, head = hd & 7, tok0 = cc * 64;
    unsigned char* proj = p.ws + WS_PROJ;
    const bf16_t* AKT = (const bf16_t*)(proj + PJ_AKT); const bf16_t* AVT = (const bf16_t*)(proj + PJ_AVT); const float* Gt = (const float*)(proj + PJ_G);
    float* U = (float*)(p.ws + WS_U); float* CHS = (float*)(p.ws + WS_CHS);
    const float* grow = Gt + (size_t)(tok0 + lane) * 32;
    u32x4 rawk[2][4]; bf16x8 bv[8][2];
#pragma unroll
    for (int ks = 0; ks < 2; ++ks)
#pragma unroll
        for (int nd = 0; nd < 4; ++nd) rawk[ks][nd] = *(const u32x4*)(AKT + (size_t)(head * 64 + 16 * nd + fr) * M + tok0 + 32 * ks + 8 * fq);
#pragma unroll
    for (int ne = 0; ne < 8; ++ne)
#pragma unroll
        for (int ks = 0; ks < 2; ++ks) bv[ne][ks] = *(const bf16x8*)(AVT + (size_t)(head * 128 + 16 * ne + fr) * M + tok0 + 32 * ks + 8 * fq);
    const float ig = grow[(2 * dir) * 8 + head], lf_raw = grow[(2 * dir + 1) * 8 + head];
    __builtin_amdgcn_sched_barrier(0);
    const float lf = log_sigmoid(lf_raw);
    const float F = scan_add(lf, lane, dir);
    const float FL = __shfl(F, dir ? 0 : 63);
    const float wend = FL - F + ig, wmax = wave_max(wend), wv = expf(wend - wmax);
    if (lane == 0) { CHS[((size_t)hd * NCH + cc) * 2] = FL; CHS[((size_t)hd * NCH + cc) * 2 + 1] = wmax; }
    { float* GF = (float*)(p.ws + WS_GF); const float Bs_ = ig - F, pm_ = scan_max(Bs_, lane, dir); const size_t gi = (size_t)hd * M + tok0 + lane;
      GF[gi] = F; GF[(size_t)16 * M + gi] = Bs_; GF[(size_t)32 * M + gi] = pm_; }
    bf16x8 af[4][2];
#pragma unroll
    for (int ks = 0; ks < 2; ++ks) {
        float w8[8];
#pragma unroll
        for (int j = 0; j < 8; ++j) w8[j] = __shfl(wv, 32 * ks + 8 * fq + j);
#pragma unroll
        for (int nd = 0; nd < 4; ++nd) {
            const u32x4 raw = rawk[ks][nd];
            u32x4 w; w.x = pk2(bf_lo(raw.x) * w8[0], bf_hi(raw.x) * w8[1]); w.y = pk2(bf_lo(raw.y) * w8[2], bf_hi(raw.y) * w8[3]);
            w.z = pk2(bf_lo(raw.z) * w8[4], bf_hi(raw.z) * w8[5]); w.w = pk2(bf_lo(raw.w) * w8[6], bf_hi(raw.w) * w8[7]);
            af[nd][ks] = mk_frag(w);
        }
    }
    const unsigned onew = (fr == 0) ? 0x3F803F80u : 0u;
#pragma unroll
    for (int ne = 0; ne < 9; ++ne) {
        bf16x8 bfr[2];
#pragma unroll
        for (int ks = 0; ks < 2; ++ks) {
            if (ne < 8) bfr[ks] = bv[ne < 8 ? ne : 0][ks];
            else { u32x4 w; w.x = onew; w.y = onew; w.z = onew; w.w = onew; bfr[ks] = mk_frag(w); }
        }
#pragma unroll
        for (int nd = 0; nd < 4; ++nd) {
            f32x4 acc = (f32x4){0.f, 0.f, 0.f, 0.f};
#pragma unroll
            for (int ks = 0; ks < 2; ++ks) acc = MFMA16(af[nd][ks], bfr[ks], acc);
            *(f32x4*)(U + (((size_t)hd * NCH + cc) * 144 + 16 * ne + fr) * 64 + 16 * nd + 4 * fq) = acc;
        }
    }
}
__device__ __forceinline__ void ph_mlstm_B(const Params& p, LAS unsigned char* lds, int tid, int G) {
    const float* U = (const float*)(p.ws + WS_U); const float* CHS = (const float*)(p.ws + WS_CHS);
    bf16_t* SNAP = (bf16_t*)(p.ws + WS_SNAP); float* MPREV = (float*)(p.ws + WS_CHS + 65536);
    LAS float* sDec = (LAS float*)lds; LAS float* sInj = sDec + 132;
    for (int b = blockIdx.x; b < 256; b += G) {
        const int hd = b >> 4, part = b & 15, dir = hd >> 3;
        __syncthreads();
        if (tid < NCH) { const int cc = dir ? (NCH - 1 - tid) : (tid < 4 ? 128 + tid : tid - 4); sDec[tid] = CHS[((size_t)hd * NCH + cc) * 2]; sInj[tid] = CHS[((size_t)hd * NCH + cc) * 2 + 1]; }
        __syncthreads();
        LAS float* sM = sInj + 132;
        if (tid == 0) { float m = 0.f;
            for (int step = 0; step < NCH; ++step) { sM[step] = m; m = fmaxf(sDec[step] + m, sInj[step]); } sM[NCH] = m; }
        __syncthreads();
        if (tid < NCH) { const int step = tid; const int cc = dir ? (NCH - 1 - step) : (step < 4 ? 128 + step : step - 4);
            const float FL = sDec[step], wm = sInj[step], m = sM[step], mn = sM[step + 1];
            if (part == 0) MPREV[hd * NCH + cc] = m;
            sDec[step] = expf(FL + m - mn); sInj[step] = expf(wm - mn); }
        __syncthreads();
        const int i0 = part * 512 + tid; const bool has2 = (part == 0 && tid < 64); const int i1 = 8192 + tid;
        float C0 = 0.f, C1 = 0.f;
#pragma unroll 1
        for (int s12 = 0; s12 < NCH; s12 += 22) {
            float u0[22], u1[22]; size_t base[22];
#pragma unroll
            for (int k = 0; k < 22; ++k) { const int step = s12 + k; const int cc = dir ? (NCH - 1 - step) : (step < 4 ? 128 + step : step - 4);
                base[k] = ((size_t)hd * NCH + cc) * 9216; u0[k] = __builtin_nontemporal_load(U + base[k] + i0); u1[k] = has2 ? __builtin_nontemporal_load(U + base[k] + i1) : 0.f; }
#pragma unroll
            for (int k = 0; k < 22; ++k) {
                SNAP[base[k] + i0] = (bf16_t)(pk2(C0, 0.f) & 0xffff);
                if (has2) SNAP[base[k] + i1] = (bf16_t)(pk2(C1, 0.f) & 0xffff);
                const float decay = sDec[s12 + k], inj = sInj[s12 + k];
                C0 = decay * C0 + inj * u0[k]; C1 = decay * C1 + inj * u1[k]; }
        }
    }
}
__device__ __forceinline__ void mlstm_C_unit(const Params& p, int e_idx, int cc, int head, int tq, int lane) {
    asm volatile("" : "+v"(lane));
    const int fr = lane & 15, fq = lane >> 4, tok0 = cc * 64, tl = 16 * tq + fr;
    unsigned char* proj = p.ws + WS_PROJ;
    const bf16_t* AQ = (const bf16_t*)(proj + PJ_AQ); const bf16_t* AK = (const bf16_t*)(proj + PJ_AK); const bf16_t* AVT = (const bf16_t*)(proj + PJ_AVT);
    const bf16_t* AO = (const bf16_t*)(proj + PJ_AO); const float* Gt = (const float*)(proj + PJ_G);
    const bf16_t* SNAP = (const bf16_t*)(p.ws + WS_SNAP); const float* MPREV = (const float*)(p.ws + WS_CHS + 65536);
    bf16_t* MIX = (bf16_t*)(p.ws + WS_MIX);
    bf16x8 qf[2];
#pragma unroll
    for (int kd = 0; kd < 2; ++kd) qf[kd] = *(const bf16x8*)(AQ + (size_t)(tok0 + tl) * 512 + head * 64 + 32 * kd + 8 * fq);
    f32x4 s[4];
#pragma unroll
    for (int ns = 0; ns < 4; ++ns) { s[ns] = (f32x4){0.f, 0.f, 0.f, 0.f};
#pragma unroll
        for (int kd = 0; kd < 2; ++kd) { const bf16x8 kf = *(const bf16x8*)(AK + (size_t)(tok0 + 16 * ns + fr) * 512 + head * 64 + 32 * kd + 8 * fq); s[ns] = MFMA16(kf, qf[kd], s[ns]); } }
    f32x4 hs[8];
#pragma unroll
    for (int ne = 0; ne < 8; ++ne) hs[ne] = (f32x4){0.f, 0.f, 0.f, 0.f};
    const float* grow = Gt + (size_t)(tok0 + lane) * 32;
#pragma unroll
    for (int dir = 0; dir < 2; ++dir) {
        const int hd = dir * 8 + head;
        const float* GF = (const float*)(p.ws + WS_GF) + (size_t)hd * M + tok0;
        const float F_t = GF[tl], pm_t = GF[(size_t)32 * M + tl];
        const float inter = F_t + MPREV[hd * NCH + cc], mt = fmaxf(inter, F_t + pm_t);
        const float A_t = F_t - mt, a_t = expf(inter - mt), fl_t = expf(-mt);
        bf16x8 pf[2];
#pragma unroll
        for (int ks = 0; ks < 2; ++ks) { unsigned w[4];
#pragma unroll
            for (int hf = 0; hf < 2; ++hf) { const int ns = 2 * ks + hf; float ev[4];
                const f32x4 b4 = *(const f32x4*)(GF + (size_t)16 * M + 16 * ns + 4 * fq);
#pragma unroll
                for (int r = 0; r < 4; ++r) { const int sl = 16 * ns + 4 * fq + r;
                    const bool valid = dir ? (sl >= tl) : (sl <= tl);
                    ev[r] = s[ns][r] * expf(valid ? (A_t + b4[r]) : -INFINITY); }
                w[2 * hf] = pk2(ev[0], ev[1]); w[2 * hf + 1] = pk2(ev[2], ev[3]); }
            u32x4 ww; ww.x = w[0]; ww.y = w[1]; ww.z = w[2]; ww.w = w[3]; pf[ks] = mk_frag(ww); }
        const bf16_t* snap = SNAP + ((size_t)hd * NCH + cc) * 9216;
        float rden = 0.f;
#pragma unroll
        for (int it = 0; it < 9; ++it) {
            const int ne = (it == 0) ? 8 : it - 1;
            f32x4 acc = (f32x4){0.f, 0.f, 0.f, 0.f};
#pragma unroll
            for (int kd = 0; kd < 2; ++kd) {
                u32x4 cw = *(const u32x4*)(snap + (size_t)(16 * ne + fr) * 64 + 32 * kd + 8 * fq);
                if (ne == 8 && fr != 0) { cw.x = 0u; cw.y = 0u; cw.z = 0u; cw.w = 0u; }
                acc = MFMA16(mk_frag(cw), qf[kd], acc);
            }
            acc = acc * a_t;
#pragma unroll
            for (int ks = 0; ks < 2; ++ks) {
                u32x4 vw;
                if (ne < 8) { const bf16_t* vr = AVT + (size_t)(head * 128 + 16 * ne + fr) * M + tok0 + 32 * ks + 4 * fq;
                    const u32x2 a = *(const u32x2*)vr, b = *(const u32x2*)(vr + 16); vw.x = a.x; vw.y = a.y; vw.z = b.x; vw.w = b.y; }
                else { const unsigned onew = (fr == 0) ? 0x3F803F80u : 0u; vw.x = onew; vw.y = onew; vw.z = onew; vw.w = onew; }
                acc = MFMA16(mk_frag(vw), pf[ks], acc);
            }
            if (ne == 8) { const float den = __shfl(acc[0], fr); rden = 1.f / fmaxf(fabsf(den), fl_t); }
            else hs[ne] = hs[ne] + acc * rden;
        }
    }
    float ss = 0.f;
#pragma unroll
    for (int ne = 0; ne < 8; ++ne) ss += (hs[ne][0] * hs[ne][0] + hs[ne][1] * hs[ne][1]) + (hs[ne][2] * hs[ne][2] + hs[ne][3] * hs[ne][3]);
    ss += __shfl_xor(ss, 16); ss += __shfl_xor(ss, 32);
    const float rs = rsqrtf(ss * (1.f / 128.f) + EPS);
    const int tok = tok0 + tl;
#pragma unroll
    for (int ne = 0; ne < 8; ++ne) { const int col = head * 128 + 16 * ne + 4 * fq;
        const f32x4 g4 = *(const f32x4*)(p.ab_mh_g + (size_t)e_idx * 1024 + col);
        const u32x2 ow = *(const u32x2*)(AO + (size_t)tok * 1024 + col);
        const float o0 = bf_lo(ow.x), o1 = bf_hi(ow.x), o2 = bf_lo(ow.y), o3 = bf_hi(ow.y);
        const f32x4 v = hs[ne] * rs * g4;
        u32x2 w; w.x = pk2(v[0] / (1.f + expf(-o0)), v[1] / (1.f + expf(-o1))); w.y = pk2(v[2] / (1.f + expf(-o2)), v[3] / (1.f + expf(-o3)));
        *(u32x2*)(MIX + (size_t)tok * 2048 + col) = w; }
}

constexpr int MC_K = 0, MC_Q = 8192, MC_VT = 16384, MC_S = 34816  , MC_G = 71680  , MC_H = 73728  , MC_END = 106496;
__device__ __forceinline__ void mlstm_C_wg(const Params& p, int e_idx, LAS unsigned char* lds, int tid, int lane, int wave, int vcu, int G) {
    asm volatile("" : "+v"(lane));
    const int fr = lane & 15, fq = lane >> 4, tq = wave & 3, dir = wave >> 2, tl = 16 * tq + fr;
    unsigned char* proj = p.ws + WS_PROJ;
    const bf16_t* AQ = (const bf16_t*)(proj + PJ_AQ); const bf16_t* AK = (const bf16_t*)(proj + PJ_AK); const bf16_t* AVT = (const bf16_t*)(proj + PJ_AVT);
    const bf16_t* AO = (const bf16_t*)(proj + PJ_AO);
    const bf16_t* SNAP = (const bf16_t*)(p.ws + WS_SNAP); const float* MPREV = (const float*)(p.ws + WS_CHS + 65536);
    const float* GFg = (const float*)(p.ws + WS_GF);
    bf16_t* MIX = (bf16_t*)(p.ws + WS_MIX);
    const int row = tid >> 3, ch = tid & 7;
    u32x4 kv, qv, vv[2], sv[2][3]; float gv = 0.f;
#define MC_FETCH(U_) do { const int cc_ = (U_) >> 3, hd_ = (U_) & 7, t0_ = cc_ * 64; \
        kv = *(const u32x4*)(AK + (size_t)(t0_ + row) * 512 + hd_ * 64 + ch * 8); qv = *(const u32x4*)(AQ + (size_t)(t0_ + row) * 512 + hd_ * 64 + ch * 8); \
        _Pragma("unroll") for (int i = 0; i < 2; ++i) vv[i] = *(const u32x4*)(AVT + (size_t)(hd_ * 128 + row + 64 * i) * M + t0_ + ch * 8); \
        _Pragma("unroll") for (int d = 0; d < 2; ++d) _Pragma("unroll") for (int i = 0; i < 3; ++i) { const int q = tid + 512 * i, e = q >> 3; const u32x4 z = {0u, 0u, 0u, 0u}; \
            sv[d][i] = (q < 1152 && e < 129) ? *(const u32x4*)(SNAP + ((size_t)(d * 8 + hd_) * NCH + cc_) * 9216 + (size_t)e * 64 + ch * 8) : z; } \
        if (tid < 384) { const int which = tid >> 6, t = tid & 63, kind = which % 3, dd = which / 3; gv = GFg[((size_t)kind * 16 + dd * 8 + hd_) * M + t0_ + t]; } } while (0)
    int U = vcu;
    if (U < NCH * 8) MC_FETCH(U);
    for (; U < NCH * 8; U += G) {
    const int cc = U >> 3, head = U & 7, tok0 = cc * 64, hd = dir * 8 + head;
    __syncthreads();
    {
        *(LAS u32x4*)(lds + MC_K + row * 128 + ((ch ^ (row & 7)) << 4)) = kv;
        *(LAS u32x4*)(lds + MC_Q + row * 128 + ((ch ^ (row & 7)) << 4)) = qv;
#pragma unroll
        for (int i = 0; i < 2; ++i) { const int e = row + 64 * i; *(LAS u32x4*)(lds + MC_VT + e * 128 + ((ch ^ (e & 7)) << 4)) = vv[i]; }
        if (tid < 128) { const int e = 128 + row; const unsigned o1 = (e == 128) ? 0x3F803F80u : 0u; const u32x4 ov = {o1, o1, o1, o1}; *(LAS u32x4*)(lds + MC_VT + e * 128 + ((ch ^ (e & 7)) << 4)) = ov; }
#pragma unroll
        for (int d = 0; d < 2; ++d)
#pragma unroll
            for (int i = 0; i < 3; ++i) { const int q = tid + 512 * i, e = q >> 3; if (q < 1152) *(LAS u32x4*)(lds + MC_S + d * 18432 + e * 128 + ((ch ^ (e & 7)) << 4)) = sv[d][i]; }
        if (tid < 384) *(LAS float*)(lds + MC_G + tid * 4) = gv;
    }
    __syncthreads();
    if (U + G < NCH * 8) MC_FETCH(U + G);
    bf16x8 qf[2];
#pragma unroll
    for (int kd = 0; kd < 2; ++kd) qf[kd] = *(const LAS bf16x8*)(lds + MC_Q + tl * 128 + (((4 * kd + fq) ^ (tl & 7)) << 4));
    f32x4 s[4];
#pragma unroll
    for (int ns = 0; ns < 4; ++ns) { s[ns] = (f32x4){0.f, 0.f, 0.f, 0.f}; const int sr = 16 * ns + fr;
#pragma unroll
        for (int kd = 0; kd < 2; ++kd) { const bf16x8 kf = *(const LAS bf16x8*)(lds + MC_K + sr * 128 + (((4 * kd + fq) ^ (sr & 7)) << 4)); s[ns] = MFMA16(kf, qf[kd], s[ns]); } }
    const LAS float* G = (const LAS float*)(lds + MC_G + dir * 768);
    const float F_t = G[tl], pm_t = G[128 + tl];
    const float inter = F_t + MPREV[hd * NCH + cc], mt = fmaxf(inter, F_t + pm_t);
    const float A_t = F_t - mt, a_t = expf(inter - mt), fl_t = expf(-mt);
    bf16x8 pf[2];
#pragma unroll
    for (int ks = 0; ks < 2; ++ks) { unsigned w[4];
#pragma unroll
        for (int hf = 0; hf < 2; ++hf) { const int ns = 2 * ks + hf; float ev[4];
            const f32x4 b4 = *(const LAS f32x4*)(G + 64 + 16 * ns + 4 * fq);
#pragma unroll
            for (int r = 0; r < 4; ++r) { const int sl = 16 * ns + 4 * fq + r; const bool valid = dir ? (sl >= tl) : (sl <= tl);
                ev[r] = s[ns][r] * expf(valid ? (A_t + b4[r]) : -INFINITY); }
            w[2 * hf] = pk2(ev[0], ev[1]); w[2 * hf + 1] = pk2(ev[2], ev[3]); }
        u32x4 ww; ww.x = w[0]; ww.y = w[1]; ww.z = w[2]; ww.w = w[3]; pf[ks] = mk_frag(ww); }
    const LAS unsigned char* snap = lds + MC_S + dir * 18432;
    f32x4 hs[8]; float rden = 0.f;
#pragma unroll
    for (int g3 = 0; g3 < 3; ++g3) {
        bf16x8 cfr[3][2]; u32x4 vwr[3][2];
#pragma unroll
        for (int i3 = 0; i3 < 3; ++i3) { const int it = 3 * g3 + i3; const int ne = (it == 0) ? 8 : it - 1; const int er = 16 * ne + fr;
#pragma unroll
            for (int kd = 0; kd < 2; ++kd) cfr[i3][kd] = *(const LAS bf16x8*)(snap + er * 128 + (((4 * kd + fq) ^ (er & 7)) << 4));
#pragma unroll
            for (int ks = 0; ks < 2; ++ks) {
                const LAS unsigned char* vr = lds + MC_VT + er * 128 + 8 * (fq & 1);
                const u32x2 a = *(const LAS u32x2*)(vr + (((4 * ks + (fq >> 1)) ^ (er & 7)) << 4)), b = *(const LAS u32x2*)(vr + (((4 * ks + 2 + (fq >> 1)) ^ (er & 7)) << 4));
                vwr[i3][ks].x = a.x; vwr[i3][ks].y = a.y; vwr[i3][ks].z = b.x; vwr[i3][ks].w = b.y; } }
        __builtin_amdgcn_sched_barrier(0);
#pragma unroll
        for (int i3 = 0; i3 < 3; ++i3) { const int it = 3 * g3 + i3; const int ne = (it == 0) ? 8 : it - 1;
            f32x4 acc = (f32x4){0.f, 0.f, 0.f, 0.f};
#pragma unroll
            for (int kd = 0; kd < 2; ++kd) acc = MFMA16(cfr[i3][kd], qf[kd], acc);
            acc = acc * a_t;
#pragma unroll
            for (int ks = 0; ks < 2; ++ks) acc = MFMA16(mk_frag(vwr[i3][ks]), pf[ks], acc);
            if (ne == 8) { const float den = __shfl(acc[0], fr); rden = 1.f / fmaxf(fabsf(den), fl_t); }
            else hs[ne] = acc * rden; }
        __builtin_amdgcn_sched_barrier(0);
    }
    if (dir == 1) {
#pragma unroll
        for (int ne = 0; ne < 8; ++ne) *(LAS f32x4*)(lds + MC_H + tq * 8192 + ne * 1024 + lane * 16) = hs[ne];
    }
    __syncthreads();
    if (dir == 0) {
        float ss = 0.f;
#pragma unroll
        for (int ne = 0; ne < 8; ++ne) { hs[ne] = hs[ne] + *(const LAS f32x4*)(lds + MC_H + tq * 8192 + ne * 1024 + lane * 16);
            ss += (hs[ne][0] * hs[ne][0] + hs[ne][1] * hs[ne][1]) + (hs[ne][2] * hs[ne][2] + hs[ne][3] * hs[ne][3]); }
        ss = fq_sum(ss);
        const float rs = rsqrtf(ss * (1.f / 128.f) + EPS);
        const int tok = tok0 + tl;
        f32x4 g4a[8]; u32x2 owa[8];
#pragma unroll
        for (int ne = 0; ne < 8; ++ne) { const int col = head * 128 + 16 * ne + 4 * fq; g4a[ne] = *(const f32x4*)(p.ab_mh_g + (size_t)e_idx * 1024 + col); owa[ne] = *(const u32x2*)(AO + (size_t)tok * 1024 + col); }
        __builtin_amdgcn_sched_barrier(0);
#pragma unroll
        for (int ne = 0; ne < 8; ++ne) { const int col = head * 128 + 16 * ne + 4 * fq;
            const f32x4 g4 = g4a[ne];
            const u32x2 ow = owa[ne];
            const float o0 = bf_lo(ow.x), o1 = bf_hi(ow.x), o2 = bf_lo(ow.y), o3 = bf_hi(ow.y);
            const f32x4 v = hs[ne] * rs * g4;
            u32x2 w; w.x = pk2(v[0] / (1.f + expf(-o0)), v[1] / (1.f + expf(-o1))); w.y = pk2(v[2] / (1.f + expf(-o2)), v[3] / (1.f + expf(-o3)));
            *(u32x2*)(MIX + (size_t)tok * 2048 + col) = w; }
    }
    }
#undef MC_FETCH
}

#define CE_DESC(a, b) do { const float _x = fmaxf(a, b), _y = fminf(a, b); a = _x; b = _y; } while (0)
__device__ __forceinline__ void sort16_desc(float (&v)[16]) {
#pragma unroll
    for (int k = 2; k <= 16; k <<= 1)
#pragma unroll
        for (int j = k >> 1; j > 0; j >>= 1)
#pragma unroll
            for (int i = 0; i < 16; ++i) { const int l = i ^ j; if (l > i) { if ((i & k) == 0) CE_DESC(v[i], v[l]); else CE_DESC(v[l], v[i]); } }
}
__device__ __forceinline__ void merge16_desc(float (&a)[16], const float (&b)[16]) {
#pragma unroll
    for (int i = 0; i < 16; ++i) a[i] = fmaxf(a[i], b[15 - i]);
#pragma unroll
    for (int j = 8; j > 0; j >>= 1)
#pragma unroll
        for (int i = 0; i < 16; ++i) { const int l = i ^ j; if (l > i) CE_DESC(a[i], a[l]); }
}
__device__ __forceinline__ void ce_desc_p(float& va, int& pa, float& vb, int& pb) {
    float nva, nvb; int npa, npb;
    asm volatile("v_cmp_gt_f32 vcc, %5, %4\n\tv_cndmask_b32 %0, %4, %5, vcc\n\tv_cndmask_b32 %1, %5, %4, vcc\n\tv_cndmask_b32 %2, %6, %7, vcc\n\tv_cndmask_b32 %3, %7, %6, vcc"
                 : "=&v"(nva), "=&v"(nvb), "=&v"(npa), "=&v"(npb) : "v"(va), "v"(vb), "v"(pa), "v"(pb) : "vcc");
    va = nva; vb = nvb; pa = npa; pb = npb;
}
#define CE_DESC_P(va, pa, vb, pb) ce_desc_p(va, pa, vb, pb)
__device__ __forceinline__ void sort16p_desc(float (&v)[16], int (&q)[16]) {
#pragma unroll
    for (int k = 2; k <= 16; k <<= 1)
#pragma unroll
        for (int j = k >> 1; j > 0; j >>= 1)
#pragma unroll
            for (int i = 0; i < 16; ++i) { const int l = i ^ j; if (l > i) { if ((i & k) == 0) CE_DESC_P(v[i], q[i], v[l], q[l]); else CE_DESC_P(v[l], q[l], v[i], q[i]); } }
}
__device__ __forceinline__ void merge16p_desc(float (&a)[16], int (&qa)[16], const float (&b)[16], const int (&qb)[16]) {
#pragma unroll
    for (int i = 0; i < 16; ++i) { float tb = b[15 - i]; int tq = qb[15 - i]; ce_desc_p(a[i], qa[i], tb, tq); }
#pragma unroll
    for (int j = 8; j > 0; j >>= 1)
#pragma unroll
        for (int i = 0; i < 16; ++i) { const int l = i ^ j; if (l > i) CE_DESC_P(a[i], qa[i], a[l], qa[l]); }
}
#define CAND_G0(X) X(0,0) X(0,1) X(0,2) X(0,3) X(0,4) X(0,5) X(0,6) X(0,7) X(0,8) X(0,9) X(0,10) X(0,11) X(0,12) X(0,13) X(0,14) X(0,15)
#define CAND_G1(X) X(1,0) X(1,1) X(1,2) X(1,3) X(1,4) X(1,5) X(1,6) X(1,7) X(2,0) X(2,1) X(2,2) X(2,3) X(2,4) X(3,0) X(3,1) X(3,2)
#define CAND_G2(X) X(3,3) X(4,0) X(4,1) X(4,2) X(5,0) X(5,1) X(6,0) X(6,1) X(7,0) X(7,1) X(8,0) X(9,0) X(10,0) X(11,0) X(12,0) X(13,0)
#define CAND_G3(X) X(14,0) X(15,0)

__device__ __forceinline__ void peer_topk_unit(const Params& p, int l, int mt, int hh, int lane) {
    asm volatile("" : "+v"(lane));
    const int fr = lane & 15, fq = lane >> 4, row = mt * 16 + fr;
    const bf16_t* QP = (const bf16_t*)(p.ws + WS_QP); const bf16_t* KEYS = (const bf16_t*)(p.ws + WS_KEYS);
    float s1[16], s2[16]; int i1[16], i2[16];
#pragma unroll
    for (int p2 = 0; p2 < 2; ++p2) {
        bf16x8 qf[4];
#pragma unroll
        for (int kd = 0; kd < 4; ++kd) qf[kd] = *(const bf16x8*)(QP + (size_t)row * 2048 + hh * 256 + p2 * 128 + 32 * kd + 8 * fq);
        float a[16], b[16];
#pragma unroll
        for (int nh = 0; nh < 2; ++nh) {
            bf16x8 kf[4][4];
#pragma unroll
            for (int nb = 0; nb < 4; ++nb)
#pragma unroll
                for (int kd = 0; kd < 4; ++kd) kf[nb][kd] = *(const bf16x8*)(KEYS + ((((size_t)l * 8 + hh) * 2 + p2) * 128 + 16 * (4 * nh + nb) + fr) * 128 + 32 * kd + 8 * fq);
            __builtin_amdgcn_sched_barrier(0);
#pragma unroll
            for (int nb = 0; nb < 4; ++nb) { const int nk = 4 * nh + nb;
                f32x4 acc = (f32x4){0.f, 0.f, 0.f, 0.f};
#pragma unroll
                for (int kd = 0; kd < 4; ++kd) acc = MFMA16(kf[nb][kd], qf[kd], acc);
#pragma unroll
                for (int r = 0; r < 4; ++r) { const unsigned idx = 16 * nk + 4 * fq + r; const float v = __uint_as_float((__float_as_uint(acc[r]) & ~0x7Fu) | idx);
                    if (nk < 4) a[4 * nk + r] = v; else b[4 * (nk - 4) + r] = v; } }
            __builtin_amdgcn_sched_barrier(0);
        }
        sort16_desc(a); sort16_desc(b); merge16_desc(a, b);
#pragma unroll
        for (int i = 0; i < 16; ++i) b[i] = __shfl_xor(a[i], 16);
        __builtin_amdgcn_sched_barrier(0);
        merge16_desc(a, b);
#pragma unroll
        for (int i = 0; i < 16; ++i) b[i] = __shfl_xor(a[i], 32);
        __builtin_amdgcn_sched_barrier(0);
        merge16_desc(a, b);
#pragma unroll
        for (int i = 0; i < 16; ++i) { const unsigned bits = __float_as_uint(a[i]); const float v = __uint_as_float(bits & ~0x7Fu); const int id = (int)(bits & 0x7Fu);
            if (p2 == 0) { s1[i] = v; i1[i] = id; } else { s2[i] = v; i2[i] = id; } }
    }
    float tv[16], gv[16]; int tp[16], gp[16];
    { float v0[16], v1[16], v2[16]; int q0[16], q1[16], q2[16]; float v3a, v3b; int q3a, q3b;
      { int ci = 0;
#define CX(A, B) v0[ci] = s1[A] + s2[B]; q0[ci] = i1[A] * 128 + i2[B]; ++ci;
        CAND_G0(CX) }
#undef CX
      { int ci = 0;
#define CX(A, B) v1[ci] = s1[A] + s2[B]; q1[ci] = i1[A] * 128 + i2[B]; ++ci;
        CAND_G1(CX) }
#undef CX
      { int ci = 0;
#define CX(A, B) v2[ci] = s1[A] + s2[B]; q2[ci] = i1[A] * 128 + i2[B]; ++ci;
        CAND_G2(CX) }
#undef CX
      v3a = s1[14] + s2[0]; q3a = i1[14] * 128 + i2[0]; v3b = s1[15] + s2[0]; q3b = i1[15] * 128 + i2[0];
#pragma unroll
      for (int i = 0; i < 16; ++i) { const float w3 = i == 0 ? v3a : (i == 1 ? v3b : -1e30f); const int r3 = i == 0 ? q3a : (i == 1 ? q3b : 0);
          tv[i] = fq == 0 ? v0[i] : (fq == 1 ? v1[i] : (fq == 2 ? v2[i] : w3)); tp[i] = fq == 0 ? q0[i] : (fq == 1 ? q1[i] : (fq == 2 ? q2[i] : r3)); } }
    sort16p_desc(tv, tp);
#pragma unroll
    for (int i = 0; i < 16; ++i) { gv[i] = __shfl_xor(tv[i], 16); gp[i] = __shfl_xor(tp[i], 16); }
    __builtin_amdgcn_sched_barrier(0);
    merge16p_desc(tv, tp, gv, gp);
#pragma unroll
    for (int i = 0; i < 16; ++i) { gv[i] = __shfl_xor(tv[i], 32); gp[i] = __shfl_xor(tp[i], 32); }
    __builtin_amdgcn_sched_barrier(0);
    merge16p_desc(tv, tp, gv, gp);
    float sum = 0.f; const float tmx = tv[0];
#pragma unroll
    for (int i = 0; i < 16; ++i) { tv[i] = expf(tv[i] - tmx); sum += tv[i]; }
    const float rsum = 1.f / sum;
    if (fq == 0) {
        int* IDX = (int*)(p.ws + WS_IDX) + (size_t)row * 128 + hh * 16; float* GT = (float*)(p.ws + WS_GATE) + (size_t)row * 128 + hh * 16;
#pragma unroll
        for (int i = 0; i < 16; i += 4) {
            *(int4*)(IDX + i) = make_int4(tp[i], tp[i + 1], tp[i + 2], tp[i + 3]);
            *(f32x4*)(GT + i) = (f32x4){tv[i] * rsum, tv[i + 1] * rsum, tv[i + 2] * rsum, tv[i + 3] * rsum};
        }
    }
}

typedef int i32x4 __attribute__((ext_vector_type(4)));
__device__ __forceinline__ float gelu_erf(float x) { return 0.5f * x * (1.f + erff(x * 0.70710678118654752f)); }
typedef float f32x2 __attribute__((ext_vector_type(2)));
__device__ __forceinline__ void acc_row16(f32x2 (&y)[8], const i32x4 w, float cf) {
    const f32x2 cf2 = {cf, cf};
#pragma unroll
    for (int d = 0; d < 4; ++d) { const unsigned u = (unsigned)w[d];
        const f32x2 a = {(float)(u & 0xffu), (float)((u >> 8) & 0xffu)}, b = {(float)((u >> 16) & 0xffu), (float)(u >> 24)};
        y[2 * d] = __builtin_elementwise_fma(cf2, a, y[2 * d]); y[2 * d + 1] = __builtin_elementwise_fma(cf2, b, y[2 * d + 1]); }
}
template <int N> __device__ __forceinline__ void reduce_scatter_g(float (&y)[N]) {
#pragma unroll
    for (int i = 0; i < N; ++i) y[i] += __builtin_bit_cast(float, __builtin_amdgcn_mov_dpp(__builtin_bit_cast(int, y[i]), 0x128  , 0xf, 0xf, false));
#pragma unroll
    for (int i = 0; i < N / 2; ++i) { const auto r = __builtin_amdgcn_permlane16_swap(__float_as_uint(y[i]), __float_as_uint(y[N / 2 + i]), false, false); y[i] = __uint_as_float(r[0]) + __uint_as_float(r[1]); }
#pragma unroll
    for (int i = 0; i < N / 4; ++i) { const auto r = __builtin_amdgcn_permlane32_swap(__float_as_uint(y[i]), __float_as_uint(y[N / 4 + i]), false, false); y[i] = __uint_as_float(r[0]) + __uint_as_float(r[1]); }
}
__device__ __forceinline__ void dot_rows4(int (&yi)[16], const i32x4 a, const i32x4 b, const i32x4 c, const i32x4 d, int cq) {
#pragma unroll
    for (int k = 0; k < 4; ++k) {
        const unsigned ablo = __builtin_amdgcn_perm((unsigned)b[k], (unsigned)a[k], 0x05010400u), abhi = __builtin_amdgcn_perm((unsigned)b[k], (unsigned)a[k], 0x07030602u);
        const unsigned cdlo = __builtin_amdgcn_perm((unsigned)d[k], (unsigned)c[k], 0x05010400u), cdhi = __builtin_amdgcn_perm((unsigned)d[k], (unsigned)c[k], 0x07030602u);
        yi[4 * k + 0] = __builtin_amdgcn_sdot4((int)__builtin_amdgcn_perm(cdlo, ablo, 0x05040100u), cq, yi[4 * k + 0], false);
        yi[4 * k + 1] = __builtin_amdgcn_sdot4((int)__builtin_amdgcn_perm(cdlo, ablo, 0x07060302u), cq, yi[4 * k + 1], false);
        yi[4 * k + 2] = __builtin_amdgcn_sdot4((int)__builtin_amdgcn_perm(cdhi, abhi, 0x05040100u), cq, yi[4 * k + 2], false);
        yi[4 * k + 3] = __builtin_amdgcn_sdot4((int)__builtin_amdgcn_perm(cdhi, abhi, 0x07060302u), cq, yi[4 * k + 3], false);
    }
}
__device__ __forceinline__ void ph_peer_gather(const Params& p, int l, LAS unsigned char* lds, int lane, int wave, int vcu, int tid, bool dry  ) {
    asm volatile("" : "+v"(lane));
    const int g = lane >> 3, c = lane & 7, m0 = vcu * 33;
    LAS int* idxL = (LAS int*)lds;
    LAS float* gatL = (LAS float*)(lds + 16896);
    LAS float* coefL = (LAS float*)(lds + 33792);
    const int* IDX = (const int*)(p.ws + WS_IDX) + (size_t)m0 * 128; const float* GT = (const float*)(p.ws + WS_GATE) + (size_t)m0 * 128;
    __syncthreads();
    { int iv[9]; float gv[9];
#pragma unroll
      for (int k = 0; k < 9; ++k) { const int i = tid + 512 * k; const bool ok = i < 33 * 128; iv[k] = ok ? IDX[i] : 0; gv[k] = ok ? GT[i] : 0.f; }
#pragma unroll
      for (int k = 0; k < 9; ++k) { const int i = tid + 512 * k; if (i < 33 * 128) { idxL[i] = iv[k]; gatL[i] = gv[k]; } } }
    __syncthreads();
    const unsigned char* H8 = p.ws + WS_H8; const float* SH = (const float*)(p.ws + WS_SH); const float* HSQ = (const float*)(p.ws + WS_SH + 512 * 1024);
    const float* SU = (const float*)(p.ws + WS_SU) + l * 16384; const float* SV = (const float*)(p.ws + WS_SV) + l * 16384;
    const unsigned char* U8 = p.ws + WS_U8 + (size_t)l * (32 * MiB); const unsigned char* V8 = p.ws + WS_V8 + (size_t)l * (32 * MiB);
    const __amdgpu_buffer_rsrc_t ru = __builtin_amdgcn_make_buffer_rsrc((void*)U8, 0, 16 << 20, 0x00020000), rv = __builtin_amdgcn_make_buffer_rsrc((void*)V8, 0, 32 << 20, 0x00020000);
    float* DELTA = (float*)(p.ws + WS_DELTA);
    const float* gmod = (const float*)(p.ws + WS_MOD) + ((size_t)l * 2 + (m0 >= T ? 1 : 0)) * D6 + 5 * D;
    unsigned off[33][2];
#pragma unroll
    for (int ui = 0; ui < 33; ++ui)
#pragma unroll
        for (int i = 0; i < 2; ++i) { const int mi = ui < 32 ? 4 * wave + (ui >> 3) : 32, hd = ui < 32 ? (ui & 7) : wave;
            off[ui][i] = (unsigned)idxL[mi * 128 + hd * 16 + 8 * i + g] * 128u + 16u * c; }
    int acc[33][2];
#pragma unroll
    for (int ui = 0; ui < 33; ++ui) { acc[ui][0] = 0; acc[ui][1] = 0; }
#pragma unroll 1
    for (int j = 0; j < 8; ++j) {
        const int so = j << 21;
        i32x4 w[2][4][2], hq[2];
#define U_LOAD(B, U0) do { _Pragma("unroll") for (int uu_ = 0; uu_ < 4; ++uu_) _Pragma("unroll") for (int i_ = 0; i_ < 2; ++i_) if ((U0) + uu_ < 33) \
            w[B][uu_][i_] = __builtin_bit_cast(i32x4, __builtin_amdgcn_raw_buffer_load_b128(ru, off[(U0) + uu_][i_], so, 0)); } while (0)
#define H_LOAD(U0) do { const int mi_ = (U0) < 32 ? 4 * wave + ((U0) >> 3) : 32; const unsigned char* hb_ = H8 + (size_t)(m0 + mi_) * D + j * 256 + 32 * c; hq[0] = *(const i32x4*)hb_; hq[1] = *(const i32x4*)(hb_ + 16); } while (0)
        H_LOAD(0); U_LOAD(0, 0);
#pragma unroll
        for (int u0 = 0; u0 < 36; u0 += 4) {
            const int B = (u0 >> 2) & 1;
            if (u0 + 4 < 36) { if (B) U_LOAD(0, u0 + 4); else U_LOAD(1, u0 + 4); }
#pragma unroll
            for (int uu = 0; uu < 4; ++uu)
#pragma unroll
                for (int i = 0; i < 2; ++i) if (u0 + uu < 33) { const int ui = u0 + uu;
                    int a = acc[ui][i];
#pragma unroll
                    for (int k = 0; k < 4; ++k) { const unsigned ww = (unsigned)w[B][uu][i][k]; const i32x4 hh = hq[k >> 1];
                        a = __builtin_amdgcn_sdot4((int)(ww & 0x0F0F0F0Fu), hh[2 * (k & 1)], a, false); a = __builtin_amdgcn_sdot4((int)((ww >> 4) & 0x0F0F0F0Fu), hh[2 * (k & 1) + 1], a, false); }
                    acc[ui][i] = a; }
            if (B && u0 + 4 < 36) H_LOAD(u0 + 4);
            __builtin_amdgcn_sched_barrier(0);
        }
#undef H_LOAD
#undef U_LOAD
    }
#pragma unroll
    for (int ui = 0; ui < 33; ++ui)
#pragma unroll
        for (int i = 0; i < 2; ++i) { const int mi = ui < 32 ? 4 * wave + (ui >> 3) : 32, hd = ui < 32 ? (ui & 7) : wave, k = hd * 16 + 8 * i + g;
            int t = acc[ui][i]; t += __shfl_xor(t, 1); t += __shfl_xor(t, 2); t += __shfl_xor(t, 4);
            if (c == 0) coefL[mi * 128 + k] = (float)t; }
    __syncthreads();
    {
        float su[9], sv[9], hs[9], sh[9];
#pragma unroll
        for (int k = 0; k < 9; ++k) { const int it = tid + 512 * k; const bool ok = it < 33 * 128; const int mi = ok ? (it >> 7) : 0, e = ok ? idxL[it] : 0;
            su[k] = SU[e]; sv[k] = SV[e]; hs[k] = HSQ[m0 + mi]; sh[k] = SH[m0 + mi]; }
        __builtin_amdgcn_sched_barrier(0);
#pragma unroll
        for (int k = 0; k < 9; ++k) { const int it = tid + 512 * k;
            if (it < 33 * 128) { const float pd = (coefL[it] - 8.f * hs[k]) * su[k] * sh[k];
                coefL[it] = gatL[it] * gelu_erf(pd) * sv[k]; } }
    }
    __syncthreads();
    LAS int* cfqL = (LAS int*)(lds + 50688);
    LAS int* cfq32L = (LAS int*)(lds + 54912);
    LAS float* sTL = (LAS float*)(lds + 55040);
#pragma unroll 1
    for (int tk = 0; tk < 5; ++tk) {
        if (tk == 4 && wave != 0) break;
        const int mi = tk < 4 ? 4 * wave + tk : 32;
        const float am = wave_max(fmaxf(fabsf(coefL[mi * 128 + lane]), fabsf(coefL[mi * 128 + 64 + lane])));
        const float inv = am > 0.f ? 127.f / am : 0.f;
        if (lane == 0) sTL[mi] = am > 0.f ? am * (1.f / 127.f) : 0.f;
        if (lane < 32) { const int hq = lane >> 4, i = (lane >> 3) & 1, g_ = lane & 7; unsigned pk = 0;
#pragma unroll
            for (int uu = 0; uu < 4; ++uu) { const int q = (int)rintf(coefL[mi * 128 + (4 * hq + uu) * 16 + 8 * i + g_] * inv); pk |= ((unsigned)q & 0xffu) << (8 * uu); }
            cfqL[mi * 32 + lane] = (int)pk;
            if (tk == 4) { const int qd = lane >> 3; unsigned p2 = 0;
#pragma unroll
                for (int r = 0; r < 4; ++r) { const int q = (int)rintf(coefL[32 * 128 + 32 * qd + 8 * r + g_] * inv); p2 |= ((unsigned)q & 0xffu) << (8 * r); }
                cfq32L[lane] = (int)p2; } }
    }
    __syncthreads();
    i32x4 w[2][4][2]; int cfq[2][2];
#define V_LOAD(B, HB, SO) do { const int ts_ = (HB) >> 1, hq_ = (HB) & 1, mi_ = 4 * wave + ts_; _Pragma("unroll") for (int uu_ = 0; uu_ < 4; ++uu_) _Pragma("unroll") for (int i_ = 0; i_ < 2; ++i_) \
            w[B][uu_][i_] = __builtin_bit_cast(i32x4, __builtin_amdgcn_raw_buffer_load_b128(rv, off[ts_ * 8 + 4 * hq_ + uu_][i_], (SO), 0)); \
        cfq[B][0] = cfqL[mi_ * 32 + (hq_ * 2 + 0) * 8 + g]; cfq[B][1] = cfqL[mi_ * 32 + (hq_ * 2 + 1) * 8 + g]; } while (0)
    V_LOAD(0, 0, 0);
#pragma unroll 1
    for (int j = 0; j < 16; ++j) {
        const int so = j << 21;
        int yi[16];
#pragma unroll
        for (int hb = 0; hb < 8; ++hb) {
            const int B = hb & 1, ts = hb >> 1, mi = 4 * wave + ts;
            if (hb + 1 < 8) { if (B) V_LOAD(0, hb + 1, so); else V_LOAD(1, hb + 1, so); }
            else if (j + 1 < 16) V_LOAD(0, 0, (j + 1) << 21);
            if (!B) {
#pragma unroll
                for (int q = 0; q < 16; ++q) yi[q] = 0; }
#pragma unroll
            for (int i = 0; i < 2; ++i) dot_rows4(yi, w[B][0][i], w[B][1][i], w[B][2][i], w[B][3][i], cfq[B][i]);
            if (B) {
                float y[16];
#pragma unroll
                for (int q = 0; q < 16; ++q) y[q] = (float)yi[q];
                reduce_scatter_g<16>(y);
                const float st = sTL[mi];
                float* dp = DELTA + (size_t)(m0 + mi) * D + j * 128 + 16 * c + ((lane & 16) ? 8 : 0) + ((lane & 32) ? 4 : 0) + ((lane & 8) ? 2 : 0);
                { const bool b3 = (lane & 8) != 0; *(float2*)dp = make_float2((b3 ? y[2] : y[0]) * st, (b3 ? y[3] : y[1]) * st); }
            }
            __builtin_amdgcn_sched_barrier(0);
        }
#undef V_LOAD
    }
    {
        const float st = sTL[32];
        const int m = m0 + 32;
#pragma unroll 1
        for (int jj = 0; jj < 2; ++jj) { const int j = 2 * wave + jj; const int so = j << 21;
            int yi[16];
#pragma unroll
            for (int q = 0; q < 16; ++q) yi[q] = 0;
#pragma unroll
            for (int k0 = 0; k0 < 16; k0 += 8) {
                i32x4 w8[8];
#pragma unroll
                for (int kk = 0; kk < 8; ++kk) w8[kk] = __builtin_bit_cast(i32x4, __builtin_amdgcn_raw_buffer_load_b128(rv, (unsigned)idxL[32 * 128 + 8 * (k0 + kk) + g] * 128u + 16u * c, so, 0));
                const int c0 = cfq32L[(k0 / 4) * 8 + g], c1 = cfq32L[(k0 / 4 + 1) * 8 + g];
                dot_rows4(yi, w8[0], w8[1], w8[2], w8[3], c0); dot_rows4(yi, w8[4], w8[5], w8[6], w8[7], c1);
                __builtin_amdgcn_sched_barrier(0);
            }
            float y[16];
#pragma unroll
            for (int q = 0; q < 16; ++q) y[q] = (float)yi[q];
            reduce_scatter_g<16>(y);
            float* dp = DELTA + (size_t)m * D + j * 128 + 16 * c + ((lane & 16) ? 8 : 0) + ((lane & 32) ? 4 : 0) + ((lane & 8) ? 2 : 0);
            { const bool b3 = (lane & 8) != 0; *(float2*)dp = make_float2((b3 ? y[2] : y[0]) * st, (b3 ? y[3] : y[1]) * st); }
        }
    }
    (void)gmod;
    {
        asm volatile("s_waitcnt vmcnt(0)" ::: "memory");
        __syncthreads();
#pragma unroll 1
        for (int mi = wave; mi < 33; mi += NWAVES) peer_tail_row(p, l, m0 + mi, lane);
    }
    (void)dry;
}

__device__ __forceinline__ Params load_params(const CAS Params* k) {
    Params r;
#define LP(f) r.f = k->f;
    LP(x) LP(c) LP(ctx) LP(c_ctx) LP(ada_w) LP(ada_b) LP(norm1_g) LP(norm2_g) LP(ab_w_in) LP(ab_gate_b) LP(ab_mh_g) LP(ab_sink) LP(ab_w_out)
    LP(na_w_in) LP(na_rpb) LP(na_w_out) LP(peer_wq) LP(peer_keys) LP(peer_u) LP(peer_v) LP(final_g) LP(out) LP(ws) LP(ph_lo) LP(ph_hi) LP(grid)
#undef LP
    return r;
}
__device__ __forceinline__ int lane_id_opaque() { int x; asm volatile("v_mbcnt_lo_u32_b32 %0, -1, 0\n\tv_mbcnt_hi_u32_b32 %0, -1, %0" : "=v"(x)); return x; }
constexpr int PH_PER_LAYER = 10, PH_FINAL = 1 + DEPTH * PH_PER_LAYER, N_PHASES = PH_FINAL + 1;
template <unsigned PH_MASK> __global__ void __launch_bounds__(NWAVES * 64, 2) fwd_kernel(Params p) {
    extern __shared__ __attribute__((aligned(16))) unsigned char lds_raw[];
    LAS unsigned char* lds = (LAS unsigned char*)lds_raw;
    const int wave = __builtin_amdgcn_readfirstlane((int)threadIdx.x >> 6);
#define LANE_ID() lane_id_opaque()
#define KQ() const CAS Params* kq_ = (const CAS Params*)__builtin_amdgcn_kernarg_segment_ptr(); asm volatile("" : "+s"(kq_))
    volatile LAS unsigned* MISC = (volatile LAS unsigned*)(lds + LDS_MISC);
    if (wave == 0) MISC[LANE_ID()] = 0u;
    __syncthreads();
    { KQ(); (void)xcd_barrier_post((unsigned*)(kq_->ws + WS_CTL) + 4096, MISC + 8, wave * 64 + LANE_ID()); }
#ifdef STAMP_PROBE
#define STAMP_PRE(k) const unsigned long long st0_ = wall_clock64()
#define STAMP_POST(k) do { if (wave * 64 + LANE_ID() == 0) { KQ(); unsigned* sp_ = (unsigned*)(kq_->ws + WS_END); const unsigned long long st1_ = wall_clock64(); \
        sp_[(k) * 256 + blockIdx.x] = (unsigned)(st1_ - st0_); sp_[(64 + (k)) * 256 + blockIdx.x] = (unsigned)st0_; sp_[(128 + (k)) * 256 + blockIdx.x] = (unsigned)st1_; } } while (0)
#else
#define STAMP_PRE(k) do {} while (0)
#define STAMP_POST(k) do {} while (0)
#endif
#define PM(k) (((PH_MASK) >> (k)) & 1u)
#ifndef REP_MASK
#define REP_MASK 0u
#endif
#define REPEAT(k) for (int rep_ = 0; rep_ <= (int)(((REP_MASK) >> (k)) & 1u); ++rep_)
#define IN(k) ({ KQ(); const int k_ = (k); (kq_->ph_lo <= k_ && k_ < kq_->ph_hi); })
#define SEAM(k) do { KQ(); const int k_ = (k); if (kq_->ph_lo <= k_ && k_ + 1 < kq_->ph_hi) { XcdBarrier b_; b_.bar = (unsigned*)(kq_->ws + WS_CTL) + 4096; b_.x = xb_xcc_id(); b_.st = MISC + 8; \
        STAMP_PRE(k_); xcd_barrier(b_, wave * 64 + LANE_ID()); STAMP_POST(k_); } } while (0)
#define LAUNDER() KQ(); const Params pl = load_params(kq_); unsigned char* ws = pl.ws; int ll = LANE_ID(); asm volatile("" : "+v"(ll)); const int tid = wave * 64 + ll; \
    const int G = pl.grid, bx = blockIdx.x, vcu = (G % 8 == 0) ? (bx % 8) * (G / 8) + bx / 8 : bx, gw = vcu * NWAVES + wave, NGW = G * NWAVES; (void)ws; (void)ll; (void)tid; (void)vcu; (void)gw; (void)NGW
    if (PM(0) && IN(0)) REPEAT(0) { LAUNDER(); ph_prologue(pl, lds, tid, ll, wave, vcu, G); __syncthreads(); }
    SEAM(0);
    for (int l = 0; l < DEPTH; ++l) {
        const int pb = 1 + l * PH_PER_LAYER; const bool even = (l & 1) == 0; const int ei = l >> 1; const bool with_ctx = l < DEPTH - 1;
        if (PM(1) && IN(pb + 0) && l == 0) REPEAT(1) { LAUNDER(); ph_norm(pl, l, 0, ll, gw, NGW); ph_fold_wq(pl, lds, ll, wave, gw, NGW); }
        if (l == 0) SEAM(pb + 0);
        if (PM(2) && IN(pb + 1)) REPEAT(2) {
            LAUNDER();
            if (l == 0) ph_fold_bias(pl, ll, gw, NGW);
            const int N = even ? NAB : NNA;
            pg8::Gemm g{(const bf16_t*)(ws + WS_H), even ? (const bf16_t*)(ws + WS_WAB_IN) + (size_t)ei * NAB * D : (const bf16_t*)(ws + WS_WNA_IN) + (size_t)ei * NNA * D, M, N, D};
            pg8::StaticOrder S; S.init(M, N, G, bx);
            EpiInProj E{EpiEven{ws + WS_PROJ, pl.ab_gate_b + ei * 32, (const float2*)(ws + WS_ROPE)}, EpiOdd{ws + WS_PROJ}, even};
            pg8::gemm_phase<EpiInProj, pg8::StaticOrder, false>(lds, g, S, E, nullptr, tid);
            peer_convert_deferred(pl, l, bx, G, wave, ll);
        }
        SEAM(pb + 1);
        if (PM(3) && IN(pb + 2)) REPEAT(3) {
            LAUNDER();
            if (even) { ph_attn_even(pl, ei, with_ctx, lds, tid, ll, wave, vcu, G);
                for (int q = gw; q < NCH * 16; q += NGW) mlstm_A_unit(pl, q >> 4, q & 15, ll); }
            else ph_attn_odd(pl, ei, with_ctx, lds, tid, ll, wave, vcu, G);
        }
        SEAM(pb + 2);
        if (PM(4) && IN(pb + 3)) REPEAT(4) { LAUNDER(); if (even) ph_mlstm_B(pl, lds, tid, G); }
        if (even) SEAM(pb + 3);
        if (PM(5) && IN(pb + 4)) REPEAT(5) { LAUNDER(); if (even) mlstm_C_wg(pl, ei, lds, tid, ll, wave, vcu, G); }
        if (even) SEAM(pb + 4);
        if (PM(6) && IN(pb + 5)) {
            LAUNDER();
            const float* MODl = (const float*)(ws + WS_MOD) + (size_t)l * 2 * D6;
            pg8::Gemm g{(const bf16_t*)(ws + WS_MIX), even ? (const bf16_t*)(ws + WS_WAB_OUT) + (size_t)ei * D * D : (const bf16_t*)(ws + WS_WNA_OUT) + (size_t)ei * D * D, T, D, D};
            pg8::StaticOrder S; S.init(T, D, G, bx);
            EpiResid E{(float*)(ws + WS_X), MODl + 2 * D, MODl + D6 + 2 * D, l == 0 ? pl.x : (const float*)(ws + WS_X), l == 0 ? pl.ctx : (const float*)(ws + WS_X) + (size_t)T * D,
                       ws + WS_XB, (float*)(ws + WS_PART), (float*)(ws + WS_PARTC)};
            pg8::gemm_phase<EpiResid, pg8::StaticOrder, false>(lds, g, S, E, nullptr, tid);
            if (with_ctx) ctx_gemm(g.A, g.Bt, D, E, wave, ll, vcu, G);
        }
        SEAM(pb + 5);
        if (PM(8) && IN(pb + 7)) REPEAT(8) {
            LAUNDER();
            pg8::Gemm g{(const bf16_t*)(ws + WS_XB), (const bf16_t*)(ws + WS_WQ) + (size_t)l * D * D, T, D, D};
            pg8::StaticOrder S; S.init(T, D, G, bx);
            EpiQ E{(bf16_t*)(ws + WS_QP), (const float*)(ws + WS_PART), (const float*)(ws + WS_BQ) + (size_t)(l * 2) * D};
            pg8::gemm_phase<EpiQ, pg8::StaticOrder, false>(lds, g, S, E, nullptr, tid);
            const int cpc = G - 1 - vcu;
            if (with_ctx && cpc < 128) { int l2 = ll; asm volatile("" : "+v"(l2)); EpiQC Ec{(bf16_t*)(ws + WS_QP), (const float*)(ws + WS_PARTC), (const float*)(ws + WS_BQ) + (size_t)(l * 2 + 1) * D};
                ctx_gemm_piece<EpiQC, 2>(g.A, (const bf16_t*)(ws + WS_WQC) + (size_t)l * D * D, Ec, cpc & 15, cpc >> 4, wave, l2); }
            asm volatile("s_waitcnt vmcnt(0)" ::: "memory");
            __syncthreads();
            { pg8::Unit u; const bool has = S.next(0, u);
#pragma unroll 1
              for (int j = 0; j < 3; ++j) {
                  const bool ok = j < 2 ? has : (with_ctx && cpc < 128 && wave == 0);
                  const int mt = j < 2 ? u.pm * 16 + 8 * j + wave : 512 + (cpc & 15), hh = j < 2 ? u.pn : (cpc >> 4);
                  if (ok) peer_topk_unit(pl, l, mt, hh, ll); } }
            { int l3 = ll; asm volatile("" : "+v"(l3));
              if (!with_ctx) h8_rows<33>(pl, l, vcu * 33, l3, wave); else if (vcu < 128) h8_rows<66>(pl, l, vcu * 66, l3, wave); }
        }
        SEAM(pb + 7);
        if (PM(10) && IN(pb + 9)) REPEAT(10) { LAUNDER(); ph_peer_gather(pl, l, lds, ll, wave, vcu, tid, rep_ < (int)(((REP_MASK) >> 10) & 1u)); }
        if (l + 1 < DEPTH) SEAM(pb + 9);
    }
#ifdef STAMP_PROBE
    {
        { KQ(); XcdBarrier b_; b_.bar = (unsigned*)(kq_->ws + WS_CTL) + 4096; b_.x = xb_xcc_id(); b_.st = MISC + 8; xcd_barrier(b_, wave * 64 + LANE_ID()); }
        LAUNDER();
        const unsigned* ST = (const unsigned*)(ws + WS_END);
        float smean = 0.f, smax = 0.f;
        for (int w = ll; w < 256; w += 64) { const float d = (float)(ST[(64 + STAMP_SEL) * 256 + w] - ST[(128 + STAMP_PREV) * 256 + w]) * 0.01f; smean += d; smax = fmaxf(smax, d); }
        smean = wave_sum(smean) * (1.f / 256.f); smax = wave_max(smax);
        const float c1 = smax * 0.05f, c2 = 0.f; (void)smean;
        for (size_t i = (size_t)bx * 512 + tid; i < (size_t)T * D; i += (size_t)G * 512) pl.out[i] = c1 + c2;
    }
#endif
#undef IN
#undef SEAM
#undef LAUNDER
#undef LANE_ID
#undef KQ
#undef PM
}

#ifndef ONE_MASK
#define ONE_MASK 0xFFFu
#endif
#ifndef MK_ONE_LAUNCH
#define MK_ONE_LAUNCH 1
#endif
typedef void (*kern_t)(Params);
#if !MK_ONE_LAUNCH
static kern_t kern_for_bit(int b) {
    switch (b) {
        case 0: return fwd_kernel<1u << 0>; case 1: return fwd_kernel<1u << 1>; case 2: return fwd_kernel<1u << 2>; case 3: return fwd_kernel<1u << 3>;
        case 4: return fwd_kernel<1u << 4>; case 5: return fwd_kernel<1u << 5>; case 6: return fwd_kernel<1u << 6>; case 7: return fwd_kernel<1u << 7>;
        case 8: return fwd_kernel<1u << 8>; case 9: return fwd_kernel<1u << 9>; case 10: return fwd_kernel<1u << 10>; default: return fwd_kernel<1u << 11>;
    }
}
#endif
extern "C" void kernel_launch(void* const* d_in, const int* in_sizes, int n_in, void* d_out, int out_size, void* d_ws, size_t ws_size, hipStream_t stream) {
    static int grid = 0;
    if (grid == 0) {
        int dev = 0, cus = 0;
        if (n_in != 21 || ws_size < WS_END) { fprintf(stderr, "kernel_launch: unexpected inputs (n_in %d, ws %zu)\n", n_in, ws_size); grid = -1; return; }
        if (hipGetDevice(&dev) != hipSuccess || hipDeviceGetAttribute(&cus, hipDeviceAttributeMultiprocessorCount, dev) != hipSuccess) { grid = -1; return; }
#if MK_ONE_LAUNCH
        if (hipFuncSetAttribute((const void*)fwd_kernel<ONE_MASK>, hipFuncAttributeMaxDynamicSharedMemorySize, LDS_BYTES) != hipSuccess) { fprintf(stderr, "kernel_launch: hipFuncSetAttribute failed\n"); grid = -1; return; }
#else
        for (int b = 0; b < 12; ++b) if (hipFuncSetAttribute((const void*)kern_for_bit(b), hipFuncAttributeMaxDynamicSharedMemorySize, LDS_BYTES) != hipSuccess) { fprintf(stderr, "kernel_launch: hipFuncSetAttribute failed\n"); grid = -1; return; }
#endif
        (void)hipGetLastError();
        grid = cus;
    }
    if (grid < 0) return;
    (void)hipMemsetAsync((char*)d_ws + WS_CTL, 0, CTL_ZERO_BYTES, stream);
#ifdef STAMP_PROBE
    (void)hipMemsetAsync((char*)d_ws + WS_END, 0, 192 * 256 * 4, stream);
#endif
    Params p{};
    const float** pin = (const float**)&p;
    for (int i = 0; i < 21; ++i) pin[i] = (const float*)d_in[i];
    p.out = (float*)d_out; p.ws = (unsigned char*)d_ws; p.grid = grid; p.pad = 0;
#if MK_ONE_LAUNCH
    p.ph_lo = 0; p.ph_hi = N_PHASES;
    hipLaunchKernelGGL(fwd_kernel<ONE_MASK>, dim3(grid), dim3(NWAVES * 64), LDS_BYTES, stream, p);
#else
    for (int ph = 0; ph < N_PHASES; ++ph) {
        int bit = 0;
        if (ph == PH_FINAL) bit = 11;
        else if (ph >= 1) { const int l = (ph - 1) / PH_PER_LAYER, k = (ph - 1) % PH_PER_LAYER; if ((l & 1) && (k == 3 || k == 4)) continue; bit = 1 + k; }
        p.ph_lo = ph; p.ph_hi = ph + 1;
        hipLaunchKernelGGL(kern_for_bit(bit), dim3(grid), dim3(NWAVES * 64), LDS_BYTES, stream, p);
    }
#endif
}
```

```cpp
#include <hip/hip_runtime.h>
#include <cstdio>
#include <cstdint>
namespace pg8 {
#define PG8_LAS __attribute__((address_space(3)))
typedef unsigned short bf16_t;
typedef short bf16x8 __attribute__((ext_vector_type(8)));
typedef float f32x4 __attribute__((ext_vector_type(4)));
typedef unsigned u32x4 __attribute__((ext_vector_type(4)));
constexpr int BM = 256, BK = 64, HALF = 128, HTB = HALF * BK * 2  , STAGE_BYTES = 8 * HTB, NXCD = 8, WGM = 8;

__host__ __device__ __forceinline__ int lds_byte(int r, int c) { const int st = (r >> 4) * 2 + (c >> 5), rr = r & 15, cc = c & 31, ob = rr * 64 + cc * 2; return st * 1024 + (ob ^ (((ob >> 9) & 1) << 5)); }
__host__ __device__ __forceinline__ void stage_rc(int b, int& R, int& C) { const int st = b / 1024, sb = b % 1024, swz = sb ^ (((sb >> 9) & 1) << 5); R = (st >> 1) * 16 + swz / 64; C = (st & 1) * 32 + (swz % 64) / 2; }
__host__ __device__ __forceinline__ int perm32(int rho) { const int n = rho >> 4, i = rho & 15; return 8 * (i >> 2) + 4 * n + (i & 3); }

struct Unit { int pm, pn; };
struct Gemm { const bf16_t* A; const bf16_t* Bt; int M, N, K; };

struct StaticOrder {
    int nM, nN, nwg, G, c;
    __host__ __device__ void init(int M, int N, int G_, int c_) { nM = M / BM; nN = N / BM; nwg = nM * nN; G = G_; c = c_; }
    __host__ __device__ __forceinline__ bool next(int i, Unit& u) const {
        const long L = (long)i * G + c; if (L >= nwg) return false;
        int wgid = (int)L; { const int q = nwg / NXCD, r = nwg % NXCD, xcd = wgid % NXCD, off = wgid / NXCD; wgid = (xcd < r ? xcd * (q + 1) : r * (q + 1) + (xcd - r) * q) + off; }
        const int nig = WGM * nN, gid = wgid / nig, fm = gid * WGM, gsz = (nM - fm) < WGM ? (nM - fm) : WGM;
        u.pm = fm + ((wgid % nig) % gsz); u.pn = (wgid % nig) / gsz; return true;
    }
    __device__ __forceinline__ void a_ready(const Unit&) const {}
    __device__ __forceinline__ void done(const Unit&) const {}
};
__device__ __forceinline__ unsigned cvt_pk_bf16(float lo, float hi) { unsigned r; asm volatile("s_nop 1\n\tv_cvt_pk_bf16_f32 %0, %1, %2\n\ts_nop 1" : "=v"(r) : "v"(lo), "v"(hi)); return r; }
template <class Epi, class Sched, bool STAMP = false>
__device__ __forceinline__ void gemm_phase(PG8_LAS unsigned char* lds, const Gemm g, const Sched& S, const Epi& E, unsigned long long* stamps, int tid_in) {
    int tid_l = tid_in; asm volatile("" : "+v"(tid_l));
    const int tid = tid_l, wid = __builtin_amdgcn_readfirstlane(tid >> 6), lane = tid & 63, wr = wid >> 2, wc = wid & 3, fr = lane & 15, fq = lane >> 4;
    const int K = g.K, nt = K / BK;
    int ts_lo = 0, ts_hi = 0, nts = 0; const unsigned long long rt_entry = STAMP ? (unsigned long long)wall_clock64() : 0ull;
#define PG8_STAMP() do { if (STAMP && wid == 0 && nts < 64) { const unsigned long long _c = (unsigned long long)clock64(); \
        ts_lo = (lane == nts) ? (int)(unsigned)_c : ts_lo; ts_hi = (lane == nts) ? (int)(unsigned)(_c >> 32) : ts_hi; ++nts; } } while (0)
    PG8_STAMP();
    unsigned voffA[2], voffB[2];
#pragma unroll
    for (int i = 0; i < 2; ++i) { int R, C; stage_rc(tid * 16 + i * 8192, R, C); const int Rb = Epi::PERM ? ((R & ~31) + perm32(R & 31)) : R;
        voffA[i] = (unsigned)(R * K + C) * 2u; voffB[i] = (unsigned)(Rb * K + C) * 2u; }
    const size_t kstep = (size_t)(BK * 2);
    const size_t hstep = (size_t)HALF * K * 2;
    const size_t tstep = 2 * hstep;
    const unsigned ldsw = (unsigned)wid * 1024u;
    const int aoff = lds_byte(wr * 64 + fr, fq * 8), boff = lds_byte(wc * 32 + fr, fq * 8);
#define PG8_SA(b, h) (((b) * 2 + (h)) * HTB)
#define PG8_SB(b, h) ((4 + (b) * 2 + (h)) * HTB)
#define PG8_STAGE(bufoff, gbase, voff) do { _Pragma("unroll") for (int _i = 0; _i < 2; ++_i) \
        __builtin_amdgcn_global_load_lds((const unsigned*)((const char*)(gbase) + (voff)[_i]), (PG8_LAS unsigned*)(lds + (bufoff) + ldsw + _i * 8192), 16, 0, 0); } while (0)
#define PG8_LDA(dst, b, h) do { _Pragma("unroll") for (int m = 0; m < 4; ++m) _Pragma("unroll") for (int k = 0; k < 2; ++k) dst[m][k] = *(const PG8_LAS bf16x8*)(lds + PG8_SA(b, h) + aoff + m * 2048 + k * 1024); } while (0)
#define PG8_LDB(dst, b, h) do { _Pragma("unroll") for (int n = 0; n < 2; ++n) _Pragma("unroll") for (int k = 0; k < 2; ++k) dst[n][k] = *(const PG8_LAS bf16x8*)(lds + PG8_SB(b, h) + boff + n * 2048 + k * 1024); } while (0)
#define PG8_MMA(ai, bj, At, Bt) do { __builtin_amdgcn_s_setprio(1); _Pragma("unroll") for (int m = 0; m < 4; ++m) _Pragma("unroll") for (int n = 0; n < 2; ++n) _Pragma("unroll") for (int k = 0; k < 2; ++k) \
        acc[ai][bj][m][n] = __builtin_amdgcn_mfma_f32_16x16x32_bf16(Bt[n][k], At[m][k], acc[ai][bj][m][n], 0, 0, 0); __builtin_amdgcn_s_setprio(0); } while (0)
#define PG8_WAIT_V(n) asm volatile("s_waitcnt vmcnt(" #n ")" ::: "memory")
#define PG8_WAIT_L(n) asm volatile("s_waitcnt lgkmcnt(" #n ")" ::: "memory")
#define PG8_BAR __builtin_amdgcn_s_barrier()
#define PG8_SCHED __builtin_amdgcn_sched_barrier(0)
    Unit cur, nxt; int ui = 0;
    if (!S.next(0, cur)) return;
    f32x4 acc[2][2][4][2];
#pragma unroll
    for (int a = 0; a < 2; ++a)
#pragma unroll
        for (int b = 0; b < 2; ++b)
#pragma unroll
            for (int m = 0; m < 4; ++m)
#pragma unroll
                for (int n = 0; n < 2; ++n) acc[a][b][m][n] = (f32x4){0.f, 0.f, 0.f, 0.f};
    bf16x8 At[4][2], B0[2][2], B1[2][2];
    const char* cA = (const char*)g.A + (size_t)cur.pm * tstep; const char* cB = (const char*)g.Bt + (size_t)cur.pn * tstep;
    S.a_ready(cur);
    PG8_STAGE(PG8_SB(0, 0), cB, voffB); PG8_STAGE(PG8_SA(0, 0), cA, voffA); PG8_STAGE(PG8_SB(0, 1), cB + hstep, voffB); PG8_STAGE(PG8_SA(0, 1), cA + hstep, voffA);
    if (wr == 1) PG8_BAR;
    PG8_WAIT_V(4); PG8_BAR;
    PG8_STAGE(PG8_SB(1, 0), cB + kstep, voffB); PG8_STAGE(PG8_SA(1, 0), cA + kstep, voffA); PG8_STAGE(PG8_SB(1, 1), cB + hstep + kstep, voffB);
    PG8_WAIT_V(6); PG8_BAR;
    PG8_STAMP();
    for (;;) {
        const bool has_next = S.next(ui + 1, nxt);
        const char* nA = has_next ? (const char*)g.A + (size_t)nxt.pm * tstep : cA; const char* nB = has_next ? (const char*)g.Bt + (size_t)nxt.pn * tstep : cB;
        for (int t = 0; t < nt; t += 2) {
            const bool last = (t == nt - 2);
            const char* a1 = cA + (size_t)(t + 1) * kstep;
            const char* a2 = last ? nA : cA + (size_t)(t + 2) * kstep; const char* b2 = last ? nB : cB + (size_t)(t + 2) * kstep;
            const char* a3 = a2 + kstep; const char* b3 = b2 + kstep;
            if (last && has_next) S.a_ready(nxt);
            PG8_LDB(B0, 0, 0); PG8_SCHED; PG8_LDA(At, 0, 0); PG8_STAGE(PG8_SA(1, 1), a1 + hstep, voffA);
            PG8_WAIT_L(8); PG8_BAR; PG8_WAIT_L(0); PG8_MMA(0, 0, At, B0); PG8_BAR; PG8_SCHED;
            PG8_LDB(B1, 0, 1); PG8_STAGE(PG8_SB(0, 0), b2, voffB);
            PG8_BAR; PG8_WAIT_L(0); PG8_MMA(0, 1, At, B1); PG8_BAR;
            PG8_LDA(At, 0, 1); PG8_STAGE(PG8_SA(0, 0), a2, voffA);
            PG8_BAR; PG8_WAIT_L(0); PG8_MMA(1, 0, At, B0); PG8_BAR; PG8_SCHED;
            PG8_STAGE(PG8_SB(0, 1), b2 + hstep, voffB);
            PG8_WAIT_V(6); PG8_BAR; PG8_MMA(1, 1, At, B1); PG8_BAR;
            PG8_LDB(B0, 1, 0); PG8_SCHED; PG8_LDA(At, 1, 0); PG8_STAGE(PG8_SA(0, 1), a2 + hstep, voffA);
            PG8_WAIT_L(8); PG8_BAR; PG8_WAIT_L(0); PG8_MMA(0, 0, At, B0); PG8_BAR; PG8_SCHED;
            PG8_LDB(B1, 1, 1); PG8_STAGE(PG8_SB(1, 0), b3, voffB);
            PG8_BAR; PG8_WAIT_L(0); PG8_MMA(0, 1, At, B1); PG8_BAR;
            PG8_LDA(At, 1, 1); PG8_STAGE(PG8_SA(1, 0), a3, voffA);
            PG8_BAR; PG8_WAIT_L(0); PG8_MMA(1, 0, At, B0); PG8_BAR; PG8_SCHED;
            PG8_STAGE(PG8_SB(1, 1), b3 + hstep, voffB);
            PG8_WAIT_V(6); PG8_BAR; PG8_MMA(1, 1, At, B1); PG8_BAR;
        }
        PG8_STAMP();
        if constexpr (!Epi::AFTER_DRAIN) { E(acc, cur, wr, wc, fr, fq); S.done(cur); }
        PG8_STAMP();
        if (!has_next) break;
#pragma unroll
        for (int a = 0; a < 2; ++a)
#pragma unroll
            for (int b = 0; b < 2; ++b)
#pragma unroll
                for (int m = 0; m < 4; ++m)
#pragma unroll
                    for (int n = 0; n < 2; ++n) acc[a][b][m][n] = (f32x4){0.f, 0.f, 0.f, 0.f};
        cur = nxt; cA = nA; cB = nB; ++ui;
    }
    PG8_WAIT_V(0);
    if (wr == 0) PG8_BAR;
    PG8_BAR;
    if constexpr (Epi::AFTER_DRAIN) { E.fused(acc, cur, wr, wc, fr, fq, lds, wid, lane); S.done(cur); }
    PG8_STAMP();
    if (STAMP && wid == 0) { stamps[lane] = lane < nts ? (((unsigned long long)(unsigned)ts_hi << 32) | (unsigned)ts_lo) : 0ull;
        if (lane == 62) stamps[62] = rt_entry; if (lane == 63) stamps[63] = (unsigned long long)wall_clock64(); }
#undef PG8_STAMP
#undef PG8_SA
#undef PG8_SB
#undef PG8_STAGE
#undef PG8_LDA
#undef PG8_LDB
#undef PG8_MMA
#undef PG8_WAIT_V
#undef PG8_WAIT_L
#undef PG8_BAR
#undef PG8_SCHED
}
}

constexpr int D = 2048, T = 8192, LC = 256, M = T + LC, DEPTH = 4, D6 = 6 * D;
constexpr int NAB = 4864, NNA = 6144;
constexpr int NCH = M / 64;
constexpr float EPS = 1e-6f, LOG2E = 1.4426950408889634f;
constexpr int NWAVES = 8;

constexpr size_t MiB = 1u << 20;
constexpr size_t WS_CTL = 0, CTL_ZERO_BYTES = 32768;
constexpr size_t WS_MOD = 1 * MiB;
constexpr size_t WS_ROPE = 2 * MiB;
constexpr size_t WS_KEYS = 3 * MiB;
constexpr size_t WS_WAB_IN = 8 * MiB;
constexpr size_t WS_WAB_OUT = 46 * MiB;
constexpr size_t WS_WNA_IN = 62 * MiB;
constexpr size_t WS_WNA_OUT = 110 * MiB;
constexpr size_t WS_WQ = 126 * MiB;
constexpr size_t WS_X = 160 * MiB;
constexpr size_t WS_H = 226 * MiB;
constexpr size_t WS_PROJ = 260 * MiB;
constexpr size_t WS_MIX = 360 * MiB;
constexpr size_t WS_QP = 394 * MiB;
constexpr size_t WS_IDX = 428 * MiB;
constexpr size_t WS_GATE = 433 * MiB;
constexpr size_t WS_U = 440 * MiB;
constexpr size_t WS_SNAP = 516 * MiB;
constexpr size_t WS_CHS = 554 * MiB;
constexpr size_t WS_GF = 555 * MiB;
constexpr size_t WS_H8 = 564 * MiB;
constexpr size_t WS_SH = 581 * MiB;
constexpr size_t WS_SU = 582 * MiB;
constexpr size_t WS_SV = 583 * MiB;
constexpr size_t WS_U8 = 584 * MiB;
constexpr size_t WS_V8 = 712 * MiB;
constexpr size_t WS_WQC = 842 * MiB;
constexpr size_t WS_BQ = 866 * MiB;
constexpr size_t WS_XB = 868 * MiB;
constexpr size_t WS_PART = 902 * MiB;
constexpr size_t WS_PARTC = 903 * MiB;
constexpr size_t WS_PARTB = 904 * MiB;
constexpr size_t WS_DELTA = 906 * MiB;
constexpr size_t WS_END = 972 * MiB;
constexpr size_t PJ_Q = 0, PJ_K = 33 * MiB, PJ_VT = 66 * MiB;
constexpr size_t PJ_AQ = 0, PJ_AK = 9 * MiB, PJ_AKT = 18 * MiB, PJ_AVT = 27 * MiB, PJ_AO = 44 * MiB,
                 PJ_BQ = 61 * MiB, PJ_BK = 78 * MiB, PJ_BVT = 83 * MiB, PJ_G = 88 * MiB;
constexpr int LDS_BYTES = 147456;
constexpr int LDS_MISC = 131072;

#define LAS __attribute__((address_space(3)))
#define CAS __attribute__((address_space(4)))
typedef unsigned short bf16_t;
typedef short bf16x8 __attribute__((ext_vector_type(8)));
typedef float f32x4 __attribute__((ext_vector_type(4)));
typedef unsigned u32x4 __attribute__((ext_vector_type(4)));
typedef unsigned u32x2 __attribute__((ext_vector_type(2)));

struct Params {
    const float *x, *c, *ctx, *c_ctx, *ada_w, *ada_b, *norm1_g, *norm2_g, *ab_w_in, *ab_gate_b, *ab_mh_g, *ab_sink, *ab_w_out,
                *na_w_in, *na_rpb, *na_w_out, *peer_wq, *peer_keys, *peer_u, *peer_v, *final_g;
    float* out; unsigned char* ws; int ph_lo, ph_hi, grid, pad;
};

__device__ __forceinline__ float bf_lo(unsigned w) { return __uint_as_float(w << 16); }
__device__ __forceinline__ float bf_hi(unsigned w) { return __uint_as_float(w & 0xffff0000u); }
__device__ __forceinline__ unsigned pk2(float lo, float hi) { return pg8::cvt_pk_bf16(lo, hi); }
__device__ __forceinline__ float wave_sum(float v) {
#pragma unroll
    for (int o = 1; o < 64; o <<= 1) v += __shfl_xor(v, o);
    return v;
}
__device__ __forceinline__ float wave_max(float v) {
#pragma unroll
    for (int o = 1; o < 64; o <<= 1) v = fmaxf(v, __shfl_xor(v, o));
    return v;
}
__device__ __forceinline__ float scan_add(float x, int lane, int suffix) {
#pragma unroll
    for (int off = 1; off < 64; off <<= 1) {
        const float up = __shfl_up(x, off), dn = __shfl_down(x, off);
        const bool ok = suffix ? (lane + off < 64) : (lane >= off);
        x = ok ? x + (suffix ? dn : up) : x;
    }
    return x;
}
__device__ __forceinline__ float scan_max(float x, int lane, int suffix) {
#pragma unroll
    for (int off = 1; off < 64; off <<= 1) {
        const float up = __shfl_up(x, off), dn = __shfl_down(x, off);
        const bool ok = suffix ? (lane + off < 64) : (lane >= off);
        x = ok ? fmaxf(x, suffix ? dn : up) : x;
    }
    return x;
}
__device__ __forceinline__ float fq_max(float v) { v = fmaxf(v, __shfl_xor(v, 16)); return fmaxf(v, __shfl_xor(v, 32)); }
__device__ __forceinline__ float fq_sum(float v) { v += __shfl_xor(v, 16); return v + __shfl_xor(v, 32); }
__device__ __forceinline__ float log_sigmoid(float x) { return fminf(x, 0.f) - log1pf(expf(-fabsf(x))); }
__device__ __forceinline__ bf16x8 mk_frag(u32x4 w) { return __builtin_bit_cast(bf16x8, w); }
#define MFMA16(a, b, c) __builtin_amdgcn_mfma_f32_16x16x32_bf16((a), (b), (c), 0, 0, 0)

#define XB_TMO      128
#define XB_XCNT(j)  (256  + 64 * (j))
#define XB_XSUB(j)  (1280 + 64 * (j))
#define XB_XGEN(j)  (2304 + 64 * (j))
#define XB_TOP      3328
#define XB_TOPGEN   3392
#define XCD_BAR_WORDS 3456
#define XB_SPIN_CAP (1u << 22)
__device__ __forceinline__ unsigned xb_ld(unsigned* p)              { return __hip_atomic_load(p, __ATOMIC_RELAXED, __HIP_MEMORY_SCOPE_AGENT); }
__device__ __forceinline__ unsigned xb_add(unsigned* p, unsigned v) { return __hip_atomic_fetch_add(p, v, __ATOMIC_RELAXED, __HIP_MEMORY_SCOPE_AGENT); }
__device__ __forceinline__ unsigned xb_xcc_id() { return (unsigned)__builtin_amdgcn_s_getreg((3 << 11) | 20) & 0xFu; }
#define XB_SPIN(cond, bar) do { unsigned _sp = 0; while (cond) { __builtin_amdgcn_s_sleep(1); \
    if ((++_sp & 255u) == 0u) { if (xb_ld(&(bar)[XB_TMO])) break; if (_sp > XB_SPIN_CAP) { atomicAdd(&(bar)[XB_TMO], 1u); break; } } } } while (0)
struct XcdBarrier { unsigned* bar; unsigned x; volatile LAS unsigned* st; };
__device__ __forceinline__ XcdBarrier xcd_barrier_post(unsigned* bar, volatile LAS unsigned* st, int tid) {
    XcdBarrier b; b.bar = bar; b.x = xb_xcc_id(); b.st = st;
    if (tid == 0) (void)xb_add(&bar[XB_XCNT(b.x)], 1u);
    return b;
}
__device__ __forceinline__ void xcd_barrier_complete(unsigned* bar, unsigned x, unsigned& nloc, unsigned& nx) {
    const unsigned G = gridDim.x * gridDim.y * gridDim.z;
    unsigned sum, cnt, mine, sp = 0u;
    for (;;) {
        sum = 0u; cnt = 0u; mine = 0u;
#pragma unroll
        for (unsigned j = 0; j < 16; ++j) { const unsigned c = xb_ld(&bar[XB_XCNT(j)]); sum += c; cnt += (c > 0u) ? 1u : 0u; mine = (j == x) ? c : mine; }
        if (sum == G) break;
        __builtin_amdgcn_s_sleep(1);
        if ((++sp & 255u) == 0u) { if (xb_ld(&bar[XB_TMO])) break; if (sp > XB_SPIN_CAP) { atomicAdd(&bar[XB_TMO], 1u); break; } }
    }
    nloc = mine > 0u ? mine : 1u; nx = cnt > 0u ? cnt : 1u;
}
__device__ __forceinline__ void xcd_barrier(const XcdBarrier& b, int tid) {
    asm volatile("s_waitcnt vmcnt(0)" ::: "memory");
    __syncthreads();
    if (tid == 0) {
        unsigned* bar = b.bar;
        __builtin_amdgcn_s_waitcnt(0);
        unsigned nloc = b.st[0], nx = b.st[1];
        if (nloc == 0u) { xcd_barrier_complete(bar, b.x, nloc, nx); b.st[0] = nloc; b.st[1] = nx; }
        const unsigned old = xb_add(&bar[XB_XSUB(b.x)], 1u);
        const unsigned gen = old / nloc;
        if (old + 1u == (gen + 1u) * nloc) {
            __builtin_amdgcn_fence(__ATOMIC_RELEASE, "agent");
            asm volatile("s_waitcnt vmcnt(0)" ::: "memory");
            const unsigned og = xb_add(&bar[XB_TOP], 1u);
            const unsigned tg = og / nx;
            if (og + 1u == (tg + 1u) * nx) xb_add(&bar[XB_TOPGEN], 1u);
            else XB_SPIN(xb_ld(&bar[XB_TOPGEN]) == tg, bar);
            __builtin_amdgcn_fence(__ATOMIC_ACQUIRE, "agent");
            xb_add(&bar[XB_XGEN(b.x)], 1u);
            asm volatile("s_waitcnt vmcnt(0)" ::: "memory");
        } else {
            XB_SPIN(xb_ld(&bar[XB_XGEN(b.x)]) == gen, bar);
            __builtin_amdgcn_fence(__ATOMIC_ACQUIRE, "agent");
            asm volatile("s_waitcnt vmcnt(0)" ::: "memory");
        }
    }
    __syncthreads();
}

__device__ __forceinline__ void peer_convert_row(const Params& p, int l, int q, int lane) {
    const int tb = q >> 14, e = q & 16383;
    const f32x4* src = (const f32x4*)((tb ? p.peer_v : p.peer_u) + ((size_t)l * 16384 + e) * D) + lane;
    f32x4 v[8]; float am = 0.f;
#pragma unroll
    for (int j = 0; j < 8; ++j) { v[j] = src[64 * j]; am = fmaxf(am, fmaxf(fmaxf(fabsf(v[j].x), fabsf(v[j].y)), fmaxf(fabsf(v[j].z), fabsf(v[j].w)))); }
    am = wave_max(am);
    const float sc = am > 0.f ? am * (1.f / 127.f) : 1.f, inv = am > 0.f ? 127.f / am : 0.f;
    if (lane == 0) ((float*)(p.ws + (tb ? WS_SV : WS_SU)))[l * 16384 + e] = sc;
    unsigned char* dst = p.ws + (tb ? WS_V8 : WS_U8) + (size_t)l * (32 * MiB) + (size_t)e * 128 + 4 * (lane & 31);
    const unsigned flip = tb ? 0x80808080u : 0u;
#pragma unroll
    for (int j = 0; j < 8; ++j) {
        const int q0 = (int)rintf(v[j].x * inv), q1 = (int)rintf(v[j].y * inv), q2 = (int)rintf(v[j].z * inv), q3 = (int)rintf(v[j].w * inv);
        const unsigned w = ((unsigned)q0 & 0xffu) | (((unsigned)q1 & 0xffu) << 8) | (((unsigned)q2 & 0xffu) << 16) | (((unsigned)q3 & 0xffu) << 24);
        *(unsigned*)(dst + (size_t)(2 * j + (lane >> 5)) * (2 * MiB)) = w ^ flip;
    }
}
__device__ __forceinline__ const f32x4* peer_row_src(const Params& p, int l, int q, int lane) { return (const f32x4*)(((q >> 14) ? p.peer_v : p.peer_u) + ((size_t)l * 16384 + (q & 16383)) * D) + lane; }
__device__ __forceinline__ void peer_convert_rows(const Params& p, int l, int q0, int q1, int qs, int lane) {
    if (q0 >= q1) return;
    f32x4 nx[8];
    { const f32x4* src = peer_row_src(p, l, q0, lane);
#pragma unroll
      for (int j = 0; j < 8; ++j) nx[j] = __builtin_nontemporal_load(src + 64 * j); }
#pragma unroll 1
    for (int q = q0; q < q1; q += qs) {
        const int tb = q >> 14, e = q & 16383;
        f32x4 v[8]; float am = 0.f;
#pragma unroll
        for (int j = 0; j < 8; ++j) { v[j] = nx[j]; am = fmaxf(am, fmaxf(fmaxf(fabsf(v[j].x), fabsf(v[j].y)), fmaxf(fabsf(v[j].z), fabsf(v[j].w)))); }
        if (q + qs < q1) { const f32x4* src = peer_row_src(p, l, q + qs, lane);
#pragma unroll
            for (int j = 0; j < 8; ++j) nx[j] = __builtin_nontemporal_load(src + 64 * j); }
        am = wave_max(am);
        const float qm = tb ? 127.f : 7.f;
        const float sc = am > 0.f ? am / qm : 1.f, inv = am > 0.f ? qm / am : 0.f;
        if (lane == 0) ((float*)(p.ws + (tb ? WS_SV : WS_SU)))[l * 16384 + e] = sc;
        if (tb) {
            unsigned char* dst = p.ws + WS_V8 + (size_t)l * (32 * MiB) + (size_t)e * 128 + 4 * (lane & 31);
#pragma unroll
            for (int j = 0; j < 8; ++j) {
                const int q0_ = (int)rintf(v[j].x * inv), q1_ = (int)rintf(v[j].y * inv), q2_ = (int)rintf(v[j].z * inv), q3_ = (int)rintf(v[j].w * inv);
                const unsigned w = ((unsigned)q0_ & 0xffu) | (((unsigned)q1_ & 0xffu) << 8) | (((unsigned)q2_ & 0xffu) << 16) | (((unsigned)q3_ & 0xffu) << 24);
                *(unsigned*)(dst + (size_t)(2 * j + (lane >> 5)) * (2 * MiB)) = w;
            }
        } else {
            unsigned char* dst = p.ws + WS_U8 + (size_t)l * (32 * MiB) + (size_t)e * 128 + 4 * (lane >> 1);
#pragma unroll
            for (int j = 0; j < 8; ++j) {
                const int q0_ = (int)rintf(v[j].x * inv) + 8, q1_ = (int)rintf(v[j].y * inv) + 8, q2_ = (int)rintf(v[j].z * inv) + 8, q3_ = (int)rintf(v[j].w * inv) + 8;
                const unsigned w = (unsigned)q0_ | ((unsigned)q1_ << 8) | ((unsigned)q2_ << 16) | ((unsigned)q3_ << 24);
                const unsigned hi = (unsigned)__shfl_xor((int)w, 1);
                if (!(lane & 1)) *(unsigned*)(dst + (size_t)j * (2 * MiB)) = w | (hi << 4);
            }
        }
    }
}
constexpr int DEFQ_EVEN = 128, DEFQ_ODD = 96, IDLE_EVEN = 256 - (33 * 19) % 256, IDLE_ODD = 256 - (33 * 24) % 256;
__device__ __forceinline__ int peer_deferred_rows(int l, int G) { return (l == 0 || G != 256) ? 0 : (((l - 1) & 1) ? IDLE_ODD * DEFQ_ODD : IDLE_EVEN * DEFQ_EVEN); }
__device__ __forceinline__ void peer_convert_deferred(const Params& p, int l  , int bx, int G, int wave, int lane) {
    if (l + 1 >= DEPTH || G != 256) return;
    const int idle = (l & 1) ? IDLE_ODD : IDLE_EVEN, dq = (l & 1) ? DEFQ_ODD : DEFQ_EVEN, j = bx - (256 - idle);
    if (j < 0) return;
    peer_convert_rows(p, l + 1, j * dq + wave, (j + 1) * dq, NWAVES, lane);
}
struct ScaleOne { __device__ __forceinline__ float operator()(int) const { return 1.f; } };
template <class MapF, class ScaleF = ScaleOne>
__device__ __forceinline__ void transpose_item(const float* W, int Nsrc, int K, bf16_t* WT, int nblk, LAS float* scr, int item, int lane, MapF map, ScaleF ksc = ScaleF()) {
    const int kb = item / nblk, nb = item % nblk, k0 = 64 * kb, n0 = 32 * nb;
    const int sc = map(n0 + (lane & 31));
    float w[32];
#pragma unroll
    for (int i = 0; i < 32; ++i) w[i] = sc >= 0 ? __builtin_nontemporal_load(W + (size_t)(k0 + 2 * i + (lane >> 5)) * Nsrc + sc) : 0.f;
#pragma unroll
    for (int i = 0; i < 32; ++i) { const int kk = 2 * i + (lane >> 5); scr[kk * 33 + (lane & 31)] = w[i] * ksc(k0 + kk); }
    asm volatile("s_waitcnt lgkmcnt(0)" ::: "memory");
    const int c = lane & 7;
    float tt[4][8];
#pragma unroll
    for (int j = 0; j < 4; ++j) { const LAS float* s = scr + (8 * c) * 33 + (lane >> 3) + 8 * j;
#pragma unroll
        for (int r = 0; r < 8; ++r) tt[j][r] = s[r * 33]; }
    __builtin_amdgcn_sched_barrier(0);
#pragma unroll
    for (int j = 0; j < 4; ++j) { const int n = (lane >> 3) + 8 * j;
        u32x4 o; o.x = pk2(tt[j][0], tt[j][1]); o.y = pk2(tt[j][2], tt[j][3]); o.z = pk2(tt[j][4], tt[j][5]); o.w = pk2(tt[j][6], tt[j][7]);
        *(u32x4*)(WT + (size_t)(n0 + n) * K + k0 + 8 * c) = o; }
    asm volatile("s_waitcnt lgkmcnt(0)" ::: "memory");
}
struct MapId { __device__ __forceinline__ int operator()(int n) const { return n; } };
struct MapAB {
    __device__ __forceinline__ int operator()(int n) const {
        if (n < 3072) return n;
        if (n < 4352) { const int base_d = n < 4096 ? 3072 : 4096, base_s = n < 4096 ? 3104 : 4128; const int r = n - base_d, hh = r >> 7, pp = r & 127;
            const int i = 64 * (pp >> 6) + ((pp & 63) >> 1) + 32 * (pp & 1); return base_s + hh * 128 + i; }
        if (n < 4608) return 4384 + (n - 4352);
        if (n < 4640) return 3072 + (n - 4608);
        return -1;
    }
};
__device__ __forceinline__ float silu(float v) { return v / (1.f + expf(-v)); }
struct __attribute__((packed, aligned(4))) F3 { float a, b, c; };

__device__ __forceinline__ void ph_prologue(const Params& p, LAS unsigned char* lds, int tid, int lane, int wave, int vcu, int G) {
    const int gw = vcu * NWAVES + wave, NGW = G * NWAVES;
    const size_t gtid = (size_t)vcu * 512 + tid, gn = (size_t)G * 512;
    {
        const float2* ks = (const float2*)p.peer_keys; unsigned* kd = (unsigned*)(p.ws + WS_KEYS);
        for (size_t i = gtid; i < (size_t)4 * 8 * 2 * 128 * 128 / 2; i += gn) { const float2 v = ks[i]; kd[i] = pk2(v.x, v.y); }
    }
    {
        float2* rt = (float2*)(p.ws + WS_ROPE);
        for (size_t i = gtid; i < 128 * 32; i += gn) { const int pos = (int)(i >> 5), j = (int)(i & 31);
            const float freq = powf(10000.f, -(float)j / 32.f), ang = (float)pos * freq; rt[i] = make_float2(cosf(ang), sinf(ang)); }
    }
    {
        LAS float* sv = (LAS float*)lds;
        LAS float* red = (LAS float*)(lds + 16384);
        for (int i = tid; i < 2048; i += 512) { sv[i] = silu(p.c[i]); sv[2048 + i] = silu(p.c_ctx[i]); }
        __syncthreads();
        float* MOD = (float*)(p.ws + WS_MOD);
        for (int u = vcu; u < 4 * 64; u += G) {
            const int l = u >> 6, n0 = (u & 63) * 192;
            const float* wp = p.ada_w + ((size_t)l * 2048 + wave * 256) * D6 + n0 + 3 * lane;
            float a0x = 0.f, a0y = 0.f, a0z = 0.f, a1x = 0.f, a1y = 0.f, a1z = 0.f;
#pragma unroll 1
            for (int k = 0; k < 256; k += 16) {
                F3 wv[16];
#pragma unroll
                for (int j = 0; j < 16; ++j) { const float* q_ = wp + (size_t)(k + j) * D6; wv[j].a = __builtin_nontemporal_load(q_); wv[j].b = __builtin_nontemporal_load(q_ + 1); wv[j].c = __builtin_nontemporal_load(q_ + 2); }
#pragma unroll
                for (int j = 0; j < 16; ++j) { const float s0 = sv[wave * 256 + k + j], s1 = sv[2048 + wave * 256 + k + j];
                    a0x += s0 * wv[j].a; a0y += s0 * wv[j].b; a0z += s0 * wv[j].c; a1x += s1 * wv[j].a; a1y += s1 * wv[j].b; a1z += s1 * wv[j].c; }
            }
            { LAS float* r0 = red + (wave * 2 + 0) * 192 + 3 * lane; LAS float* r1 = red + (wave * 2 + 1) * 192 + 3 * lane;
              r0[0] = a0x; r0[1] = a0y; r0[2] = a0z; r1[0] = a1x; r1[1] = a1y; r1[2] = a1z; }
            __syncthreads();
            if (tid < 384) { const int which = tid >= 192 ? 1 : 0, col = tid - 192 * which; float s = 0.f;
#pragma unroll
                for (int w = 0; w < 8; ++w) s += red[(w * 2 + which) * 192 + col];
                MOD[((size_t)l * 2 + which) * D6 + n0 + col] = s + p.ada_b[(size_t)l * D6 + n0 + col]; }
            __syncthreads();
        }
    }
    {
        LAS float* scr = (LAS float*)(lds + wave * 16384);
        constexpr int I_ABI = 32 * (NAB / 32), I_SQ = 32 * (D / 32), I_NAI = 32 * (NNA / 32);
        constexpr int NITEMS = 2 * I_ABI + 2 * I_SQ + 2 * I_NAI + 2 * I_SQ;
        for (int it = gw; it < NITEMS; it += NGW) {
            int r = it;
            if (r < 2 * I_ABI) { const int e = r / I_ABI; r -= e * I_ABI;
                transpose_item(p.ab_w_in + (size_t)e * D * 4640, 4640, D, (bf16_t*)(p.ws + WS_WAB_IN) + (size_t)e * NAB * D, NAB / 32, scr, r, lane, MapAB()); continue; }
            r -= 2 * I_ABI;
            if (r < 2 * I_SQ) { const int e = r / I_SQ; r -= e * I_SQ;
                transpose_item(p.ab_w_out + (size_t)e * D * D, D, D, (bf16_t*)(p.ws + WS_WAB_OUT) + (size_t)e * D * D, D / 32, scr, r, lane, MapId()); continue; }
            r -= 2 * I_SQ;
            if (r < 2 * I_NAI) { const int e = r / I_NAI; r -= e * I_NAI;
                transpose_item(p.na_w_in + (size_t)e * D * NNA, NNA, D, (bf16_t*)(p.ws + WS_WNA_IN) + (size_t)e * NNA * D, NNA / 32, scr, r, lane, MapId()); continue; }
            r -= 2 * I_NAI;
            { const int e = r / I_SQ; r -= e * I_SQ;
                transpose_item(p.na_w_out + (size_t)e * D * D, D, D, (bf16_t*)(p.ws + WS_WNA_OUT) + (size_t)e * D * D, D / 32, scr, r, lane, MapId()); }
        }
    }
#pragma unroll 1
    for (int l = 0; l < DEPTH; ++l) peer_convert_rows(p, l, peer_deferred_rows(l, G) + gw, 32768, NGW, lane);
}
__device__ __forceinline__ void fold_item(const Params& p, int l, int item, LAS float* scr, int lane) {
    const int kb = item >> 6, nb = item & 63, k0 = 64 * kb, n0 = 32 * nb;
    const float* MOD = (const float*)(p.ws + WS_MOD) + (size_t)l * 2 * D6;
    const float* W = p.peer_wq + (size_t)l * D * D;
    LAS float* kv = scr + 2112;
    float w[32];
#pragma unroll
    for (int i = 0; i < 32; ++i) w[i] = __builtin_nontemporal_load(W + (size_t)(k0 + 2 * i + (lane >> 5)) * D + n0 + (lane & 31));
    { const int k = k0 + lane; const float g2 = p.norm2_g[(size_t)l * D + k], m4 = MOD[4 * D + k], m4c = MOD[D6 + 4 * D + k], m3 = MOD[3 * D + k], m3c = MOD[D6 + 3 * D + k];
      __builtin_amdgcn_sched_barrier(0);
      kv[lane] = g2 * (1.f + m4); kv[64 + lane] = g2 * (1.f + m4c); kv[128 + lane] = m3; kv[192 + lane] = m3c; }
    asm volatile("s_waitcnt lgkmcnt(0)" ::: "memory");
    float bl = 0.f, bc = 0.f;
#pragma unroll
    for (int i = 0; i < 32; ++i) { const int kk = 2 * i + (lane >> 5); bl += w[i] * kv[128 + kk]; bc += w[i] * kv[192 + kk]; }
    bl += __shfl_xor(bl, 32); bc += __shfl_xor(bc, 32);
    if (lane < 32) { float* PB = (float*)(p.ws + WS_PARTB) + ((size_t)(l * 2) * 32 + kb) * D + n0 + lane; PB[0] = bl; PB[(size_t)32 * D] = bc; }
    const int c = lane & 7;
#pragma unroll 1
    for (int v = 0; v < (l < DEPTH - 1 ? 2 : 1); ++v) {
        bf16_t* WT = (bf16_t*)(p.ws + (v ? WS_WQC : WS_WQ)) + (size_t)l * D * D;
        float kf[32];
#pragma unroll
        for (int i = 0; i < 32; ++i) kf[i] = kv[64 * v + 2 * i + (lane >> 5)];
        __builtin_amdgcn_sched_barrier(0);
#pragma unroll
        for (int i = 0; i < 32; ++i) { const int kk = 2 * i + (lane >> 5); scr[kk * 33 + (lane & 31)] = w[i] * kf[i]; }
        asm volatile("s_waitcnt lgkmcnt(0)" ::: "memory");
        float tt[4][8];
#pragma unroll
        for (int j = 0; j < 4; ++j) { const LAS float* s = scr + (8 * c) * 33 + (lane >> 3) + 8 * j;
#pragma unroll
            for (int r = 0; r < 8; ++r) tt[j][r] = s[r * 33]; }
        __builtin_amdgcn_sched_barrier(0);
#pragma unroll
        for (int j = 0; j < 4; ++j) { const int n = (lane >> 3) + 8 * j;
            u32x4 o; o.x = pk2(tt[j][0], tt[j][1]); o.y = pk2(tt[j][2], tt[j][3]); o.z = pk2(tt[j][4], tt[j][5]); o.w = pk2(tt[j][6], tt[j][7]);
            *(u32x4*)(WT + (size_t)(n0 + n) * D + k0 + 8 * c) = o; }
        asm volatile("s_waitcnt lgkmcnt(0)" ::: "memory");
    }
}
__device__ __forceinline__ void ph_fold_wq(const Params& p, LAS unsigned char* lds, int lane, int wave, int gw, int NGW) {
    LAS float* scr = (LAS float*)(lds + wave * 16384);
    for (int it = gw; it < DEPTH * 2048; it += NGW) fold_item(p, it >> 11, it & 2047, scr, lane);
}
__device__ __forceinline__ void ph_fold_bias(const Params& p, int lane, int gw, int NGW) {
    for (int i = gw * 64 + lane; i < DEPTH * 2 * D; i += NGW * 64) { const float* PB = (const float*)(p.ws + WS_PARTB) + (size_t)(i >> 11) * 32 * D + (i & 2047); float s = 0.f;
        float pv[32];
#pragma unroll
        for (int kb = 0; kb < 32; ++kb) pv[kb] = PB[(size_t)kb * D];
#pragma unroll
        for (int kb = 0; kb < 32; ++kb) s += pv[kb];
        ((float*)(p.ws + WS_BQ))[i] = s; }
}
__device__ __forceinline__ void norm_row(const Params& p, int l, int which, int m, int lane) {
    const float* gvec = (which ? p.norm2_g : p.norm1_g) + (size_t)l * D;
    const float* MOD = (const float*)(p.ws + WS_MOD) + (size_t)l * 2 * D6;
    const float* X = (const float*)(p.ws + WS_X); bf16_t* H = (bf16_t*)(p.ws + WS_H);
    {
        const float* mod = MOD + (m >= T ? D6 : 0) + (which ? 3 * D : 0);
        const float* xrow = (l == 0 && which == 0) ? (m < T ? p.x + (size_t)m * D : p.ctx + (size_t)(m - T) * D) : X + (size_t)m * D;
        const f32x4* xr = (const f32x4*)xrow + lane;
        f32x4 v[8]; float ss = 0.f;
#pragma unroll
        for (int j = 0; j < 8; ++j) { v[j] = xr[64 * j]; ss += (v[j].x * v[j].x + v[j].y * v[j].y) + (v[j].z * v[j].z + v[j].w * v[j].w); }
        ss = wave_sum(ss);
        const float rstd = rsqrtf(ss * (1.f / D) + EPS);
        f32x4 g4a[8], sha[8], sca[8];
#pragma unroll
        for (int j = 0; j < 8; ++j) { const int col = 256 * j + 4 * lane; g4a[j] = *(const f32x4*)(gvec + col); sha[j] = *(const f32x4*)(mod + col); sca[j] = *(const f32x4*)(mod + D + col); }
        __builtin_amdgcn_sched_barrier(0);
#pragma unroll
        for (int j = 0; j < 8; ++j) { const int col = 256 * j + 4 * lane;
            const f32x4 h = v[j] * rstd * g4a[j] * (sca[j] + 1.f) + sha[j]; v[j] = h;
            if (!which) { u32x2 o; o.x = pk2(h.x, h.y); o.y = pk2(h.z, h.w); *(u32x2*)(H + (size_t)m * D + col) = o; } }
        if (which) {
            float am = 0.f;
#pragma unroll
            for (int j = 0; j < 8; ++j) am = fmaxf(am, fmaxf(fmaxf(fabsf(v[j].x), fabsf(v[j].y)), fmaxf(fabsf(v[j].z), fabsf(v[j].w))));
            am = wave_max(am);
            const float inv = am > 0.f ? 127.f / am : 0.f;
            if (lane == 0) ((float*)(p.ws + WS_SH))[m] = am > 0.f ? am * (1.f / 127.f) : 1.f;
            unsigned char* h8 = p.ws + WS_H8 + (size_t)m * D + 4 * lane;
#pragma unroll
            for (int j = 0; j < 8; ++j) {
                const int q0 = (int)rintf(v[j].x * inv), q1 = (int)rintf(v[j].y * inv), q2 = (int)rintf(v[j].z * inv), q3 = (int)rintf(v[j].w * inv);
                *(unsigned*)(h8 + 256 * j) = ((unsigned)q0 & 0xffu) | (((unsigned)q1 & 0xffu) << 8) | (((unsigned)q2 & 0xffu) << 16) | (((unsigned)q3 & 0xffu) << 24);
            }
        }
    }
}
template <int NR> __device__ __forceinline__ void h8_rows(const Params& p, int l, int m0, int lane, int wave) {
    const float* gvec = p.norm2_g + (size_t)l * D;
    const float* MOD = (const float*)(p.ws + WS_MOD) + (size_t)l * 2 * D6 + 3 * D;
    const float* X = (const float*)(p.ws + WS_X);
    f32x4 nx[8];
    { const f32x4* xr = (const f32x4*)(X + (size_t)(m0 + wave) * D) + lane;
#pragma unroll
      for (int j = 0; j < 8; ++j) nx[j] = xr[64 * j]; }
#pragma unroll 1
    for (int mi = wave; mi < NR; mi += NWAVES) {
        const int m = m0 + mi; const float* mod = MOD + (m >= T ? D6 : 0);
        f32x4 v[8]; float ss = 0.f;
#pragma unroll
        for (int j = 0; j < 8; ++j) { v[j] = nx[j]; ss += (v[j].x * v[j].x + v[j].y * v[j].y) + (v[j].z * v[j].z + v[j].w * v[j].w); }
        if (mi + NWAVES < NR) { const f32x4* xr = (const f32x4*)(X + (size_t)(m + NWAVES) * D) + lane;
#pragma unroll
            for (int j = 0; j < 8; ++j) nx[j] = xr[64 * j]; }
        ss = wave_sum(ss);
        const float rstd = rsqrtf(ss * (1.f / D) + EPS);
        float am = 0.f;
        f32x4 g4a[8], sha[8], sca[8];
#pragma unroll
        for (int j = 0; j < 8; ++j) { const int col = 256 * j + 4 * lane; g4a[j] = *(const f32x4*)(gvec + col); sha[j] = *(const f32x4*)(mod + col); sca[j] = *(const f32x4*)(mod + D + col); }
        __builtin_amdgcn_sched_barrier(0);
#pragma unroll
        for (int j = 0; j < 8; ++j) {
            const f32x4 h = v[j] * rstd * g4a[j] * (sca[j] + 1.f) + sha[j]; v[j] = h;
            am = fmaxf(am, fmaxf(fmaxf(fabsf(h.x), fabsf(h.y)), fmaxf(fabsf(h.z), fabsf(h.w)))); }
        am = wave_max(am);
        const float inv = am > 0.f ? 127.f / am : 0.f;
        if (lane == 0) ((float*)(p.ws + WS_SH))[m] = am > 0.f ? am * (1.f / 127.f) : 1.f;
        unsigned char* h8 = p.ws + WS_H8 + (size_t)m * D + 4 * lane;
        int qs = 0;
#pragma unroll
        for (int j = 0; j < 8; ++j) {
            const int q0 = (int)rintf(v[j].x * inv), q1 = (int)rintf(v[j].y * inv), q2 = (int)rintf(v[j].z * inv), q3 = (int)rintf(v[j].w * inv);
            qs += (q0 + q1) + (q2 + q3);
            *(unsigned*)(h8 + 256 * j) = ((unsigned)q0 & 0xffu) | (((unsigned)q1 & 0xffu) << 8) | (((unsigned)q2 & 0xffu) << 16) | (((unsigned)q3 & 0xffu) << 24);
        }
        const float qsum = wave_sum((float)qs);
        if (lane == 0) ((float*)(p.ws + WS_SH + 512 * 1024))[m] = qsum;
    }
}
__device__ __forceinline__ void ph_norm(const Params& p, int l, int which, int lane, int gw, int NGW) {
    for (int m = gw; m < M; m += NGW) norm_row(p, l, which, m, lane);
}
__device__ __forceinline__ void final_row(const Params& p, int m, int lane) {
    const float* X = (const float*)(p.ws + WS_X);
    {
        const f32x4* xr = (const f32x4*)(X + (size_t)m * D) + lane;
        f32x4 v[8]; float ss = 0.f;
#pragma unroll
        for (int j = 0; j < 8; ++j) { v[j] = xr[64 * j]; ss += (v[j].x * v[j].x + v[j].y * v[j].y) + (v[j].z * v[j].z + v[j].w * v[j].w); }
        ss = wave_sum(ss);
        const float rstd = rsqrtf(ss * (1.f / D) + EPS);
#pragma unroll
        for (int j = 0; j < 8; ++j) { const int col = 256 * j + 4 * lane; const f32x4 g4 = *(const f32x4*)(p.final_g + col);
            *(f32x4*)(p.out + (size_t)m * D + col) = v[j] * rstd * g4; }
    }
}

#define AT(T, base, off) ((T*)((unsigned char*)(base) + (size_t)(unsigned)(off)))
__device__ __forceinline__ void peer_tail_row(const Params& p, int l, int m, int lane) {
    const float* MODl = (const float*)(p.ws + WS_MOD) + ((size_t)l * 2 + (m >= T ? 1 : 0)) * D6;
    f32x4* X4 = (f32x4*)((float*)(p.ws + WS_X) + (size_t)m * D) + lane;
    f32x4 v[8];
    {
        const f32x4* D4 = (const f32x4*)((const float*)(p.ws + WS_DELTA) + (size_t)m * D) + lane; const f32x4* G4 = (const f32x4*)(MODl + 5 * D) + lane;
        f32x4 dv[8], gv[8];
#pragma unroll
        for (int j = 0; j < 8; ++j) { v[j] = X4[64 * j]; dv[j] = __builtin_nontemporal_load(D4 + 64 * j); gv[j] = G4[64 * j]; }
        __builtin_amdgcn_sched_barrier(0);
#pragma unroll
        for (int j = 0; j < 8; ++j) v[j] = v[j] + gv[j] * dv[j];
    }
    const bool last = l + 1 >= DEPTH;
    if (last && m >= T) return;
    const float* MODn = (const float*)(p.ws + WS_MOD) + ((size_t)(last ? l : l + 1) * 2 + (m >= T ? 1 : 0)) * D6;
    const f32x4* NG = (const f32x4*)(last ? p.final_g : p.norm1_g + (size_t)(l + 1) * D) + lane;
    f32x4 g4[8], sh[8], sc[8];
#pragma unroll
    for (int j = 0; j < 8; ++j) { g4[j] = NG[64 * j]; if (!last) { sh[j] = ((const f32x4*)MODn + lane)[64 * j]; sc[j] = ((const f32x4*)(MODn + D) + lane)[64 * j]; } }
    __builtin_amdgcn_sched_barrier(0);
    float ss = 0.f;
#pragma unroll
    for (int j = 0; j < 8; ++j) { if (!last) X4[64 * j] = v[j]; ss += (v[j].x * v[j].x + v[j].y * v[j].y) + (v[j].z * v[j].z + v[j].w * v[j].w); }
    ss = wave_sum(ss);
    const float rstd = rsqrtf(ss * (1.f / D) + EPS);
    if (last) {
        f32x4* O4 = (f32x4*)(p.out + (size_t)m * D) + lane;
#pragma unroll
        for (int j = 0; j < 8; ++j) O4[64 * j] = v[j] * rstd * g4[j];
    } else {
        bf16_t* H = (bf16_t*)(p.ws + WS_H) + (size_t)m * D + 4 * lane;
#pragma unroll
        for (int j = 0; j < 8; ++j) { const f32x4 h = v[j] * rstd * g4[j] * (sc[j] + 1.f) + sh[j]; u32x2 o; o.x = pk2(h.x, h.y); o.y = pk2(h.z, h.w); *(u32x2*)(H + 256 * j) = o; }
    }
}
__device__ __forceinline__ void store4_bf16(unsigned char* base, unsigned off, f32x4 v) { u32x2 w; w.x = pk2(v[0], v[1]); w.y = pk2(v[2], v[3]); *AT(u32x2, base, off) = w; }
__device__ __forceinline__ void store4_T(unsigned char* base, unsigned off0  , f32x4 v) {
    const unsigned a = pk2(v[0], v[1]), b = pk2(v[2], v[3]);
    constexpr unsigned RS = (unsigned)M * 2u;
    *AT(bf16_t, base, off0 + 0 * RS) = (bf16_t)(a & 0xffff); *AT(bf16_t, base, off0 + 1 * RS) = (bf16_t)(a >> 16);
    *AT(bf16_t, base, off0 + 2 * RS) = (bf16_t)(b & 0xffff); *AT(bf16_t, base, off0 + 3 * RS) = (bf16_t)(b >> 16);
}
__device__ __forceinline__ void rope4(f32x4& v, const float2* rope, int row, int pp  ) {
    const int pos = (pp < 64) ? (row >> 6) : (row & 63), j0 = (pp & 63) >> 1;
    const f32x4 cs = *AT(const f32x4, rope, (unsigned)(pos * 32 + j0) * 8u);
    const float a0 = v[0], b0 = v[1], a1 = v[2], b1 = v[3];
    v[0] = a0 * cs[0] - b0 * cs[1]; v[1] = b0 * cs[0] + a0 * cs[1];
    v[2] = a1 * cs[2] - b1 * cs[3]; v[3] = b1 * cs[2] + a1 * cs[3];
}
__device__ __forceinline__ void store8_bf16(unsigned char* base, unsigned off, f32x4 v0, f32x4 v1) {
    u32x4 w; w.x = pk2(v0[0], v0[1]); w.y = pk2(v0[2], v0[3]); w.z = pk2(v1[0], v1[1]); w.w = pk2(v1[2], v1[3]);
    *AT(u32x4, base, off) = w;
}
__device__ __forceinline__ void store8_T(unsigned char* base, unsigned off0  , f32x4 v0, f32x4 v1) {
    const unsigned a = pk2(v0[0], v0[1]), b = pk2(v0[2], v0[3]), c = pk2(v1[0], v1[1]), d = pk2(v1[2], v1[3]);
    constexpr unsigned RS = (unsigned)M * 2u;
    *AT(bf16_t, base, off0 + 0 * RS) = (bf16_t)(a & 0xffff); *AT(bf16_t, base, off0 + 1 * RS) = (bf16_t)(a >> 16);
    *AT(bf16_t, base, off0 + 2 * RS) = (bf16_t)(b & 0xffff); *AT(bf16_t, base, off0 + 3 * RS) = (bf16_t)(b >> 16);
    *AT(bf16_t, base, off0 + 4 * RS) = (bf16_t)(c & 0xffff); *AT(bf16_t, base, off0 + 5 * RS) = (bf16_t)(c >> 16);
    *AT(bf16_t, base, off0 + 6 * RS) = (bf16_t)(d & 0xffff); *AT(bf16_t, base, off0 + 7 * RS) = (bf16_t)(d >> 16);
}
__device__ __forceinline__ void rope8(f32x4& v0, f32x4& v1, const float2* rope, int row, int pp  ) {
    const int pos = (pp < 64) ? (row >> 6) : (row & 63), j0 = (pp & 63) >> 1;
    const f32x4* t = AT(const f32x4, rope, (unsigned)(pos * 32 + j0) * 8u);
    const f32x4 c01 = t[0], c23 = t[1];
    const float a0 = v0[0], b0 = v0[1], a1 = v0[2], b1 = v0[3], a2 = v1[0], b2 = v1[1], a3 = v1[2], b3 = v1[3];
    v0[0] = a0 * c01[0] - b0 * c01[1]; v0[1] = b0 * c01[0] + a0 * c01[1];
    v0[2] = a1 * c01[2] - b1 * c01[3]; v0[3] = b1 * c01[2] + a1 * c01[3];
    v1[0] = a2 * c23[0] - b2 * c23[1]; v1[1] = b2 * c23[0] + a2 * c23[1];
    v1[2] = a3 * c23[2] - b3 * c23[3]; v1[3] = b3 * c23[2] + a3 * c23[3];
}
struct EpiEven {
    static constexpr bool PERM = true, AFTER_DRAIN = false;
    unsigned char* proj; const float* gate_b; const float2* rope;
    __device__ __forceinline__ void elem4(unsigned row, unsigned col0, f32x4 v) const {
        const unsigned pn = col0 >> 8;
        if (pn < 2) { store4_bf16(proj, (unsigned)PJ_AQ + (row * 512u + col0) * 2u, v * 0.125f); }
        else if (pn < 4) { const unsigned c = col0 - 512; store4_bf16(proj, (unsigned)PJ_AK + (row * 512u + c) * 2u, v); store4_T(proj, (unsigned)PJ_AKT + (c * (unsigned)M + row) * 2u, v); }
        else if (pn < 8) { store4_T(proj, (unsigned)PJ_AVT + ((col0 - 1024) * (unsigned)M + row) * 2u, v); }
        else if (pn < 12) { store4_bf16(proj, (unsigned)PJ_AO + (row * 1024u + (col0 - 2048)) * 2u, v); }
        else if (pn < 16) { const unsigned c = col0 - 3072; if (row < (unsigned)T) rope4(v, rope, row, c & 127); store4_bf16(proj, (unsigned)PJ_BQ + (row * 1024u + c) * 2u, v); }
        else if (pn == 16) { const unsigned c = col0 - 4096; if (row < (unsigned)T) rope4(v, rope, row, c & 127); store4_bf16(proj, (unsigned)PJ_BK + (row * 256u + c) * 2u, v); }
        else if (pn == 17) { store4_T(proj, (unsigned)PJ_BVT + ((col0 - 4352) * (unsigned)M + row) * 2u, v); }
        else { const unsigned c = col0 - 4608; if (c < 32) *AT(f32x4, proj, (unsigned)PJ_G + (row * 32u + c) * 4u) = v + *AT(const f32x4, gate_b, c * 4u); }
    }
    __device__ __forceinline__ void operator()(const f32x4 (&acc)[2][2][4][2], const pg8::Unit& u, int wr, int wc, int fr, int fq) const {
        const int pn = u.pn;
#pragma unroll
        for (int ai = 0; ai < 2; ++ai)
#pragma unroll
            for (int m = 0; m < 4; ++m) { const unsigned row = u.pm * 256 + ai * 128 + wr * 64 + m * 16 + fr;
#pragma unroll
                for (int bj = 0; bj < 2; ++bj) { const unsigned col0 = pn * 256 + bj * 128 + wc * 32 + 8 * fq;
                    f32x4 v0 = acc[ai][bj][m][0], v1 = acc[ai][bj][m][1];
                    if (pn < 2) { store8_bf16(proj, (unsigned)PJ_AQ + (row * 512u + col0) * 2u, v0 * 0.125f, v1 * 0.125f); }
                    else if (pn < 4) { const unsigned c = col0 - 512; store8_bf16(proj, (unsigned)PJ_AK + (row * 512u + c) * 2u, v0, v1); store8_T(proj, (unsigned)PJ_AKT + (c * (unsigned)M + row) * 2u, v0, v1); }
                    else if (pn < 8) { store8_T(proj, (unsigned)PJ_AVT + ((col0 - 1024) * (unsigned)M + row) * 2u, v0, v1); }
                    else if (pn < 12) { store8_bf16(proj, (unsigned)PJ_AO + (row * 1024u + (col0 - 2048)) * 2u, v0, v1); }
                    else if (pn < 16) { const unsigned c = col0 - 3072; if (row < (unsigned)T) rope8(v0, v1, rope, row, c & 127); store8_bf16(proj, (unsigned)PJ_BQ + (row * 1024u + c) * 2u, v0, v1); }
                    else if (pn == 16) { const unsigned c = col0 - 4096; if (row < (unsigned)T) rope8(v0, v1, rope, row, c & 127); store8_bf16(proj, (unsigned)PJ_BK + (row * 256u + c) * 2u, v0, v1); }
                    else if (pn == 17) { store8_T(proj, (unsigned)PJ_BVT + ((col0 - 4352) * (unsigned)M + row) * 2u, v0, v1); }
                    else { const unsigned c = col0 - 4608; if (c < 32) { const unsigned go = (unsigned)PJ_G + (row * 32u + c) * 4u;
                            *AT(f32x4, proj, go) = v0 + *AT(const f32x4, gate_b, c * 4u); *AT(f32x4, proj, go + 16u) = v1 + *AT(const f32x4, gate_b, c * 4u + 16u); } }
                } }
    }
};
struct EpiOdd {
    static constexpr bool PERM = true, AFTER_DRAIN = false;
    unsigned char* proj;
    __device__ __forceinline__ void elem4(unsigned row, unsigned col0, f32x4 v) const {
        const unsigned pn = col0 >> 8;
        if (pn < 8) store4_bf16(proj, (unsigned)PJ_Q + (row * 2048u + col0) * 2u, v);
        else if (pn < 16) store4_bf16(proj, (unsigned)PJ_K + (row * 2048u + (col0 - 2048)) * 2u, v);
        else store4_T(proj, (unsigned)PJ_VT + ((col0 - 4096) * (unsigned)M + row) * 2u, v);
    }
    __device__ __forceinline__ void operator()(const f32x4 (&acc)[2][2][4][2], const pg8::Unit& u, int wr, int wc, int fr, int fq) const {
        const int pn = u.pn;
#pragma unroll
        for (int ai = 0; ai < 2; ++ai)
#pragma unroll
            for (int m = 0; m < 4; ++m) { const unsigned row = u.pm * 256 + ai * 128 + wr * 64 + m * 16 + fr;
#pragma unroll
                for (int bj = 0; bj < 2; ++bj) { const unsigned col0 = pn * 256 + bj * 128 + wc * 32 + 8 * fq;
                    const f32x4 v0 = acc[ai][bj][m][0], v1 = acc[ai][bj][m][1];
                    if (pn < 8) store8_bf16(proj, (unsigned)PJ_Q + (row * 2048u + col0) * 2u, v0, v1);
                    else if (pn < 16) store8_bf16(proj, (unsigned)PJ_K + (row * 2048u + (col0 - 2048)) * 2u, v0, v1);
                    else store8_T(proj, (unsigned)PJ_VT + ((col0 - 4096) * (unsigned)M + row) * 2u, v0, v1);
                } }
    }
};
struct EpiResid {
    static constexpr bool PERM = true, AFTER_DRAIN = false;
    float* X; const float* gl; const float* gc; const float* srcl; const float* srcc;
    unsigned char* XB; float* part; float* partc;
    __device__ __forceinline__ void elem4(unsigned row, unsigned col0, f32x4 v) const {
        f32x4* xp = AT(f32x4, X, (row * (unsigned)D + col0) * 4u);
        const f32x4* sp = AT(const f32x4, srcc, ((row - (unsigned)T) * (unsigned)D + col0) * 4u);
        const f32x4 x = *sp + *AT(const f32x4, gc, col0 * 4u) * v;
        *xp = x; store4_bf16(XB, (row * (unsigned)D + col0) * 2u, x);
        const float s = fq_sum((x.x * x.x + x.y * x.y) + (x.z * x.z + x.w * x.w));
        if (((col0 >> 2) & 3u) == 0u) *AT(float, partc, ((row - (unsigned)T) * 128u + (col0 >> 4)) * 4u) = s;
    }
    __device__ __forceinline__ void operator()(const f32x4 (&acc)[2][2][4][2], const pg8::Unit& u, int wr, int wc, int fr, int fq) const {
        const float* g = (u.pm * 256 < T) ? gl : gc;
        f32x4 gg[2][2];
#pragma unroll
        for (int bj = 0; bj < 2; ++bj) { const unsigned col0 = u.pn * 256 + bj * 128 + wc * 32 + 8 * fq; gg[bj][0] = *AT(const f32x4, g, col0 * 4u); gg[bj][1] = *AT(const f32x4, g, col0 * 4u + 16u); }
#pragma unroll
        for (int ai = 0; ai < 2; ++ai) {
            f32x4 sv[4][2][2];
#pragma unroll
            for (int m = 0; m < 4; ++m) { const unsigned row = u.pm * 256 + ai * 128 + wr * 64 + m * 16 + fr;
#pragma unroll
                for (int bj = 0; bj < 2; ++bj) { const unsigned col0 = u.pn * 256 + bj * 128 + wc * 32 + 8 * fq;
                    const f32x4* sp = (u.pm * 256 < T) ? AT(const f32x4, srcl, (row * (unsigned)D + col0) * 4u) : AT(const f32x4, srcc, ((row - (unsigned)T) * (unsigned)D + col0) * 4u);
                    sv[m][bj][0] = __builtin_nontemporal_load(sp); sv[m][bj][1] = __builtin_nontemporal_load(sp + 1); } }
            __builtin_amdgcn_sched_barrier(0);
#pragma unroll
            for (int m = 0; m < 4; ++m) { const unsigned row = u.pm * 256 + ai * 128 + wr * 64 + m * 16 + fr; float ssq = 0.f;
#pragma unroll
                for (int bj = 0; bj < 2; ++bj) { const unsigned col0 = u.pn * 256 + bj * 128 + wc * 32 + 8 * fq;
                    f32x4* xp = AT(f32x4, X, (row * (unsigned)D + col0) * 4u);
                    const f32x4 x0 = sv[m][bj][0] + gg[bj][0] * acc[ai][bj][m][0], x1 = sv[m][bj][1] + gg[bj][1] * acc[ai][bj][m][1];
                    xp[0] = x0; xp[1] = x1; store8_bf16(XB, (row * (unsigned)D + col0) * 2u, x0, x1);
                    ssq += ((x0.x * x0.x + x0.y * x0.y) + (x0.z * x0.z + x0.w * x0.w)) + ((x1.x * x1.x + x1.y * x1.y) + (x1.z * x1.z + x1.w * x1.w));
                }
                ssq = fq_sum(ssq);
                if (fq == 0) *AT(float, part, (row * 32u + u.pn * 4u + wc) * 4u) = ssq; }
            __builtin_amdgcn_sched_barrier(0);
        }
    }
};
struct EpiPlain {
    static constexpr bool PERM = true, AFTER_DRAIN = false;
    bf16_t* O;
    __device__ __forceinline__ void elem4(unsigned row, unsigned col0, f32x4 v) const { store4_bf16((unsigned char*)O, (row * (unsigned)D + col0) * 2u, v); }
    __device__ __forceinline__ void operator()(const f32x4 (&acc)[2][2][4][2], const pg8::Unit& u, int wr, int wc, int fr, int fq) const {
#pragma unroll
        for (int ai = 0; ai < 2; ++ai)
#pragma unroll
            for (int m = 0; m < 4; ++m) { const unsigned row = u.pm * 256 + ai * 128 + wr * 64 + m * 16 + fr;
#pragma unroll
                for (int bj = 0; bj < 2; ++bj) { const unsigned col0 = u.pn * 256 + bj * 128 + wc * 32 + 8 * fq;
                    store8_bf16((unsigned char*)O, (row * (unsigned)D + col0) * 2u, acc[ai][bj][m][0], acc[ai][bj][m][1]); } }
    }
};
struct EpiQ {
    static constexpr bool PERM = true, AFTER_DRAIN = false;
    bf16_t* O; const float* part; const float* bias;
    __device__ __forceinline__ void operator()(const f32x4 (&acc)[2][2][4][2], const pg8::Unit& u, int wr, int wc, int fr, int fq) const {
        f32x4 bb[2][2], pp[2][4][2];
#pragma unroll
        for (int bj = 0; bj < 2; ++bj) { const unsigned col0 = u.pn * 256 + bj * 128 + wc * 32 + 8 * fq; bb[bj][0] = *AT(const f32x4, bias, col0 * 4u); bb[bj][1] = *AT(const f32x4, bias, col0 * 4u + 16u); }
#pragma unroll
        for (int ai = 0; ai < 2; ++ai)
#pragma unroll
            for (int m = 0; m < 4; ++m) { const unsigned row = u.pm * 256 + ai * 128 + wr * 64 + m * 16 + fr;
                pp[ai][m][0] = *AT(const f32x4, part, (row * 32u + 8u * fq) * 4u); pp[ai][m][1] = *AT(const f32x4, part, (row * 32u + 8u * fq) * 4u + 16u); }
        __builtin_amdgcn_sched_barrier(0);
#pragma unroll
        for (int ai = 0; ai < 2; ++ai)
#pragma unroll
            for (int m = 0; m < 4; ++m) { const unsigned row = u.pm * 256 + ai * 128 + wr * 64 + m * 16 + fr;
                const f32x4 p0 = pp[ai][m][0], p1 = pp[ai][m][1];
                const float r = rsqrtf(fq_sum(((p0.x + p0.y) + (p0.z + p0.w)) + ((p1.x + p1.y) + (p1.z + p1.w))) * (1.f / D) + EPS);
#pragma unroll
                for (int bj = 0; bj < 2; ++bj) { const unsigned col0 = u.pn * 256 + bj * 128 + wc * 32 + 8 * fq;
                    store8_bf16((unsigned char*)O, (row * (unsigned)D + col0) * 2u, acc[ai][bj][m][0] * r + bb[bj][0], acc[ai][bj][m][1] * r + bb[bj][1]); } }
    }
};
struct EpiQC {
    bf16_t* O; const float* partc; const float* bias;
    __device__ __forceinline__ void elem4(unsigned row, unsigned col0, f32x4 v) const {
        const unsigned po = ((row - (unsigned)T) * 128u + 32u * ((col0 >> 2) & 3u)) * 4u; float sq = 0.f;
#pragma unroll
        for (int i = 0; i < 8; ++i) { const f32x4 t = *AT(const f32x4, partc, po + 16u * i); sq += (t.x + t.y) + (t.z + t.w); }
        const float r = rsqrtf(fq_sum(sq) * (1.f / D) + EPS);
        store4_bf16((unsigned char*)O, (row * (unsigned)D + col0) * 2u, v * r + *AT(const f32x4, bias, col0 * 4u)); }
};
struct EpiInProj {
    static constexpr bool PERM = true, AFTER_DRAIN = false;
    EpiEven ev; EpiOdd od; bool even;
    __device__ __forceinline__ void elem4(unsigned row, unsigned col0, f32x4 v) const { if (even) ev.elem4(row, col0, v); else od.elem4(row, col0, v); }
    __device__ __forceinline__ void operator()(const f32x4 (&acc)[2][2][4][2], const pg8::Unit& u, int wr, int wc, int fr, int fq) const {
        if (even) ev(acc, u, wr, wc, fr, fq); else od(acc, u, wr, wc, fr, fq);
    }
};
struct EpiOutQ {
    static constexpr bool PERM = true, AFTER_DRAIN = false;
    EpiResid rs; EpiPlain pl; bool resid;
    __device__ __forceinline__ void operator()(const f32x4 (&acc)[2][2][4][2], const pg8::Unit& u, int wr, int wc, int fr, int fq) const {
        if (resid) rs(acc, u, wr, wc, fr, fq); else pl(acc, u, wr, wc, fr, fq);
    }
};

template <class Epi, int NT  >
__device__ __forceinline__ void ctx_gemm_piece(const bf16_t* __restrict__ A, const bf16_t* __restrict__ Bt, const Epi& E, int rb, int cb, int wave, int lane) {
    const int fr = lane & 15, fq = lane >> 4;
    const bf16_t* ap = A + (size_t)(T + 16 * rb + fr) * D + 8 * fq;
    const bf16_t* bp = Bt + (size_t)(cb * 128 * NT + 16 * NT * wave + fr) * D + 8 * fq;
    f32x4 acc[NT];
#pragma unroll
    for (int n = 0; n < NT; ++n) acc[n] = (f32x4){0.f, 0.f, 0.f, 0.f};
    constexpr int KC = NT == 1 ? 16 : 8;
#pragma unroll 1
    for (int k0 = 0; k0 < D; k0 += 32 * KC) {
        bf16x8 af[KC], bfg[NT][KC];
#pragma unroll
        for (int kk = 0; kk < KC; ++kk) { af[kk] = *(const bf16x8*)(ap + k0 + 32 * kk);
#pragma unroll
            for (int n = 0; n < NT; ++n) bfg[n][kk] = *(const bf16x8*)(bp + (size_t)16 * n * D + k0 + 32 * kk); }
        __builtin_amdgcn_sched_barrier(0);
#pragma unroll
        for (int kk = 0; kk < KC; ++kk)
#pragma unroll
            for (int n = 0; n < NT; ++n) acc[n] = MFMA16(bfg[n][kk], af[kk], acc[n]);
    }
#pragma unroll
    for (int n = 0; n < NT; ++n) E.elem4((unsigned)(T + 16 * rb + fr), (unsigned)(cb * 128 * NT + 16 * NT * wave + 16 * n + 4 * fq), acc[n]);
}
template <class Epi>
__device__ __forceinline__ void ctx_gemm(const bf16_t* __restrict__ A, const bf16_t* __restrict__ Bt, int N, const Epi& E, int wave, int lane, int vcu, int G) {
    asm volatile("" : "+v"(lane));
    const int npc = 16 * (N >> 7);
    for (int pc = vcu; pc < npc; pc += G) ctx_gemm_piece<Epi, 1>(A, Bt, E, pc & 15, pc >> 4, wave, lane);
}

template <class TF>
__device__ __forceinline__ void attn_wave16(const bf16_t* __restrict__ Qh, int qstride, int qrow0,
                                            const bf16_t* __restrict__ Kh, int kstride, const bf16_t* __restrict__ VTh  ,
                                            int ntiles, const TF& tf, bool has_sink, float sink, float scale,
                                            bf16_t* __restrict__ Oh, int ostride, int lane) {
    asm volatile("" : "+v"(lane));
    const int fr = lane & 15, fq = lane >> 4;
    bf16x8 qf[4];
#pragma unroll
    for (int kd = 0; kd < 4; ++kd) qf[kd] = *(const bf16x8*)(Qh + (size_t)(qrow0 + fr) * qstride + 32 * kd + 8 * fq);
    f32x4 o[8];
#pragma unroll
    for (int nd = 0; nd < 8; ++nd) o[nd] = (f32x4){0.f, 0.f, 0.f, 0.f};
    float mrun = has_sink ? sink * LOG2E : -1e30f;
    float lrun = (has_sink && fq == 0) ? 1.f : 0.f;
    const float sc2 = scale * LOG2E;
    for (int ti = 0; ti < ntiles; ++ti) {
        const int tok0 = tf.tok0(ti);
        f32x4 s[2];
#pragma unroll
        for (int sub = 0; sub < 2; ++sub) {
            s[sub] = (f32x4){0.f, 0.f, 0.f, 0.f};
            int tk = tok0 + 16 * sub + fr; tk = tk < 0 ? 0 : (tk > M - 1 ? M - 1 : tk);
#pragma unroll
            for (int kd = 0; kd < 4; ++kd) { const bf16x8 kf = *(const bf16x8*)(Kh + (size_t)tk * kstride + 32 * kd + 8 * fq); s[sub] = MFMA16(kf, qf[kd], s[sub]); }
        }
        float pv[8]; float tmax = -INFINITY;
#pragma unroll
        for (int sub = 0; sub < 2; ++sub)
#pragma unroll
            for (int r = 0; r < 4; ++r) { const int ks = 16 * sub + 4 * fq + r; const float b = tf.bias(ti, ks);
                const float v = s[sub][r] * sc2 + b * LOG2E; pv[4 * sub + r] = v; tmax = fmaxf(tmax, v); }
        tmax = fmaxf(tmax, __shfl_xor(tmax, 16)); tmax = fmaxf(tmax, __shfl_xor(tmax, 32));
        const float mnew = fmaxf(mrun, tmax), alpha = exp2f(mrun - mnew);
        float ps = 0.f;
#pragma unroll
        for (int i = 0; i < 8; ++i) { pv[i] = exp2f(pv[i] - mnew); ps += pv[i]; }
        lrun = lrun * alpha + ps; mrun = mnew;
#pragma unroll
        for (int nd = 0; nd < 8; ++nd) o[nd] = o[nd] * alpha;
        u32x4 pw; pw.x = pk2(pv[0], pv[1]); pw.y = pk2(pv[2], pv[3]); pw.z = pk2(pv[4], pv[5]); pw.w = pk2(pv[6], pv[7]);
        const bf16x8 pf = mk_frag(pw);
        int t0 = tok0 + 4 * fq, t1 = tok0 + 16 + 4 * fq;
        t0 = t0 < 0 ? 0 : (t0 > M - 4 ? M - 4 : t0); t1 = t1 < 0 ? 0 : (t1 > M - 4 ? M - 4 : t1);
#pragma unroll
        for (int nd = 0; nd < 8; ++nd) { const bf16_t* vr = VTh + (size_t)(16 * nd + fr) * M;
            const u32x2 a = *(const u32x2*)(vr + t0), b = *(const u32x2*)(vr + t1);
            u32x4 w; w.x = a.x; w.y = a.y; w.z = b.x; w.w = b.y;
            o[nd] = MFMA16(mk_frag(w), pf, o[nd]); }
    }
    lrun += __shfl_xor(lrun, 16); lrun += __shfl_xor(lrun, 32);
    const float rl = 1.f / lrun;
#pragma unroll
    for (int nd = 0; nd < 8; ++nd) { const f32x4 v = o[nd] * rl; u32x2 w; w.x = pk2(v[0], v[1]); w.y = pk2(v[2], v[3]);
        *(u32x2*)(Oh + (size_t)(qrow0 + fr) * ostride + 16 * nd + 4 * fq) = w; }
}
struct TFCtxOnly {
    __device__ __forceinline__ int tok0(int ti) const { return T + 32 * ti; }
    __device__ __forceinline__ float bias(int, int) const { return 0.f; }
};
struct TFGqa {
    int jb, tq;
    __device__ __forceinline__ int tok0(int ti) const { return ti < 9 ? 16 * jb - 128 + 32 * ti : T + 32 * (ti - 9); }
    __device__ __forceinline__ float bias(int ti, int ks) const {
        if (ti >= 9) return 0.f;
        const int kp = 16 * jb - 128 + 32 * ti + ks, d = kp - tq;
        return (kp >= 0 && kp < T && d <= 128 && d >= -128) ? 0.f : -INFINITY;
    }
};
struct TFNa {
    int r0, kc0, r, c, c0; const float* rpb;
    __device__ __forceinline__ int tok0(int ti) const { return ti < 8 ? 64 * (r0 + ti) + kc0 : T + 32 * (ti - 8); }
    __device__ __forceinline__ float bias(int ti, int ks) const {
        if (ti >= 8) return 0.f;
        const int kc = kc0 + ks;
        if (kc < c0 || kc >= c0 + 16) return -INFINITY;
        return rpb[(r0 + ti - r + 7) * 31 + (kc - c + 15)];
    }
};

#ifndef ATT_NB
#define ATT_NB 4
#endif
constexpr int ATT_KB = 16384, ATT_VROW = 136, ATT_BUF = ATT_KB + 128 * ATT_VROW;
template <class TF, int MODE = 0>
__device__ __forceinline__ void attn_wg(const TF& tf, const bf16_t* __restrict__ Qh, int qstride, int qrow0, int qrow1,
                                        const bf16_t* __restrict__ Kh, int kstride, const bf16_t* __restrict__ VTh,
                                        bool has_sink, float sink, float scale, bf16_t* __restrict__ Oh, int ostride, LAS unsigned char* lds, int tid, int lane, bool rt_false = false) {
    asm volatile("" : "+v"(lane));
    const int fr = lane & 15, fq = lane >> 4;
    bf16x8 qf[2][4];
#pragma unroll
    for (int qt = 0; qt < 2; ++qt)
#pragma unroll
        for (int kd = 0; kd < 4; ++kd) qf[qt][kd] = __builtin_nontemporal_load((const bf16x8*)(Qh + (size_t)((qt ? qrow1 : qrow0) + fr) * qstride + 32 * kd + 8 * fq));
    f32x4 o[2][8]; float mrun[2], lrun[2];
#pragma unroll
    for (int qt = 0; qt < 2; ++qt) { mrun[qt] = has_sink ? sink * LOG2E : -1e30f; lrun[qt] = (has_sink && fq == 0) ? 1.f : 0.f;
#pragma unroll
        for (int nd = 0; nd < 8; ++nd) o[qt][nd] = (f32x4){0.f, 0.f, 0.f, 0.f}; }
    const float sc2 = scale * LOG2E;
    const int kr0 = tid >> 4, kch = tid & 15, vd0 = tid >> 3, vc8 = tid & 7;
    u32x4 kreg[2], vreg[2];
    const int nt = tf.ntiles();
#define ATT_LOAD(ti) do { const int t0_ = tf.tile_t0(ti); _Pragma("unroll") for (int i_ = 0; i_ < 2; ++i_) { \
        int tk_ = t0_ + kr0 + 32 * i_; tk_ = tk_ < 0 ? 0 : (tk_ > M - 1 ? M - 1 : tk_); kreg[i_] = *(const u32x4*)(Kh + (size_t)tk_ * kstride + 8 * kch); \
        int tv_ = t0_ + 8 * vc8; tv_ = tv_ < 0 ? 0 : (tv_ > M - 8 ? M - 8 : tv_); vreg[i_] = *(const u32x4*)(VTh + (size_t)(vd0 + 64 * i_) * M + tv_); } } while (0)
#define ATT_STORE(b) do { LAS unsigned char* bb_ = lds + (b) * ATT_BUF; _Pragma("unroll") for (int i_ = 0; i_ < 2; ++i_) { const int r_ = kr0 + 32 * i_; \
        *(LAS u32x4*)(bb_ + r_ * 256 + ((kch ^ (r_ & 15)) << 4)) = kreg[i_]; \
        LAS u32x2* vp_ = (LAS u32x2*)(bb_ + ATT_KB + (vd0 + 64 * i_) * ATT_VROW + 16 * vc8); u32x2 a_, b_; a_.x = vreg[i_].x; a_.y = vreg[i_].y; b_.x = vreg[i_].z; b_.y = vreg[i_].w; vp_[0] = a_; vp_[1] = b_; } } while (0)
    __syncthreads();
    ATT_LOAD(0); ATT_STORE(0);
    __syncthreads();
    for (int ti = 0; ti < nt; ++ti) {
        if (ti + 1 < nt && MODE != 2) ATT_LOAD(ti + 1);
        if (tf.active(ti) && MODE != 3) {
            const LAS unsigned char* kb = lds + (ti & 1) * ATT_BUF; const LAS unsigned char* vbase = kb + ATT_KB;
            const int ns = tf.nsteps(ti);
            for (int st = 0; st < ns; ++st) {
                int ws[2]; f32x4 s[2][2]; float pv[2][8], bs8[2][8], alpha[2];
#pragma unroll
                for (int qt = 0; qt < 2; ++qt) { ws[qt] = tf.win(ti, qt, st);
#pragma unroll
                    for (int sub = 0; sub < 2; ++sub) { s[qt][sub] = (f32x4){0.f, 0.f, 0.f, 0.f}; const int tl = ws[qt] + 16 * sub + fr;
#pragma unroll
                        for (int kd = 0; kd < 4; ++kd) { const bf16x8 kf = *(const LAS bf16x8*)(kb + tl * 256 + (((4 * kd + fq) ^ (tl & 15)) << 4)); s[qt][sub] = MFMA16(kf, qf[qt][kd], s[qt][sub]); } } }
#pragma unroll
                for (int qt = 0; qt < 2; ++qt) tf.bias8(ti, qt, ws[qt] + 4 * fq, bs8[qt]);
                float tmax[2];
#pragma unroll
                for (int qt = 0; qt < 2; ++qt) { tmax[qt] = -INFINITY;
#pragma unroll
                    for (int sub = 0; sub < 2; ++sub)
#pragma unroll
                        for (int r = 0; r < 4; ++r) { const float v = s[qt][sub][r] * sc2 + bs8[qt][4 * sub + r] * LOG2E; pv[qt][4 * sub + r] = v; tmax[qt] = fmaxf(tmax[qt], v); } }
                { const float t0 = __shfl_xor(tmax[0], 16), t1 = __shfl_xor(tmax[1], 16);
                  __builtin_amdgcn_sched_barrier(0);
                  tmax[0] = fmaxf(tmax[0], t0); tmax[1] = fmaxf(tmax[1], t1); }
                { const float t0 = __shfl_xor(tmax[0], 32), t1 = __shfl_xor(tmax[1], 32);
                  __builtin_amdgcn_sched_barrier(0);
                  tmax[0] = fmaxf(tmax[0], t0); tmax[1] = fmaxf(tmax[1], t1); }
                if (__builtin_amdgcn_ballot_w64(tmax[0] > mrun[0] + 8.f || tmax[1] > mrun[1] + 8.f) != 0ull) {
#pragma unroll
                    for (int qt = 0; qt < 2; ++qt) { const float mnew = fmaxf(mrun[qt], tmax[qt]); alpha[qt] = __builtin_amdgcn_exp2f(mrun[qt] - mnew); lrun[qt] *= alpha[qt]; mrun[qt] = mnew;
#pragma unroll
                        for (int nd = 0; nd < 8; ++nd) o[qt][nd] = o[qt][nd] * alpha[qt]; }
                }
#pragma unroll
                for (int qt = 0; qt < 2; ++qt) {
                    float ps = 0.f;
#pragma unroll
                    for (int i = 0; i < 8; ++i) { pv[qt][i] = __builtin_amdgcn_exp2f(pv[qt][i] - mrun[qt]); ps += pv[qt][i]; }
                    lrun[qt] += ps; }
                bf16x8 pf[2];
#pragma unroll
                for (int qt = 0; qt < 2; ++qt) { u32x4 pw; pw.x = pk2(pv[qt][0], pv[qt][1]); pw.y = pk2(pv[qt][2], pv[qt][3]); pw.z = pk2(pv[qt][4], pv[qt][5]); pw.w = pk2(pv[qt][6], pv[qt][7]); pf[qt] = mk_frag(pw); }
                constexpr int NB_ = ATT_NB;
#pragma unroll
                for (int nh = 0; nh < 8; nh += NB_) {
                    u32x4 vw[NB_][2];
#pragma unroll
                    for (int n4 = 0; n4 < NB_; ++n4)
#pragma unroll
                        for (int qt = 0; qt < 2; ++qt) { const LAS unsigned char* vr = vbase + (16 * (nh + n4) + fr) * ATT_VROW + 2 * (ws[qt] + 4 * fq);
                            const u32x2 a = *(const LAS u32x2*)vr, b2 = *(const LAS u32x2*)(vr + 32);
                            vw[n4][qt].x = a.x; vw[n4][qt].y = a.y; vw[n4][qt].z = b2.x; vw[n4][qt].w = b2.y; }
                    __builtin_amdgcn_sched_barrier(0);
#pragma unroll
                    for (int n4 = 0; n4 < NB_; ++n4)
#pragma unroll
                        for (int qt = 0; qt < 2; ++qt) o[qt][nh + n4] = MFMA16(mk_frag(vw[n4][qt]), pf[qt], o[qt][nh + n4]);
                    __builtin_amdgcn_sched_barrier(0);
                }
            }
        }
        if (ti + 1 < nt) ATT_STORE((ti + 1) & 1);
        __syncthreads();
    }
#undef ATT_LOAD
#undef ATT_STORE
    if (MODE == 0 || rt_false)
#pragma unroll
    for (int qt = 0; qt < 2; ++qt) {
        const float lt = fq_sum(lrun[qt]);
        const float rl = 1.f / lt;
#pragma unroll
        for (int nd = 0; nd < 8; ++nd) { const f32x4 v = o[qt][nd] * rl; u32x2 w; w.x = pk2(v[0], v[1]); w.y = pk2(v[2], v[3]);
            *(u32x2*)(Oh + (size_t)((qt ? qrow1 : qrow0) + fr) * ostride + 16 * nd + 4 * fq) = w; }
    }
}
struct TFCtxW {
    __device__ __forceinline__ int ntiles() const { return 4; }
    __device__ __forceinline__ int tile_t0(int ti) const { return T + 64 * ti; }
    __device__ __forceinline__ bool active(int) const { return true; }
    __device__ __forceinline__ int nsteps(int) const { return 2; }
    __device__ __forceinline__ int win(int, int, int st) const { return 32 * st; }
    __device__ __forceinline__ void bias8(int, int, int, float (&b)[8]) const {
#pragma unroll
        for (int i = 0; i < 8; ++i) b[i] = 0.f; }
};
struct TFGqaW {
    int jb64, q0;
    __device__ __forceinline__ int ntiles() const { return 9; }
    __device__ __forceinline__ int tile_t0(int ti) const { return ti < 5 ? 64 * jb64 - 128 + 64 * ti : T + 64 * (ti - 5); }
    __device__ __forceinline__ bool active(int) const { return true; }
    __device__ __forceinline__ int nsteps(int) const { return 2; }
    __device__ __forceinline__ int win(int, int, int st) const { return 32 * st; }
    __device__ __forceinline__ void bias8(int ti, int qt, int key0, float (&b)[8]) const {
        const bool plain = ti >= 5 || (ti >= 1 && ti <= 3 && 64 * jb64 - 128 + 64 * ti >= 0 && 64 * jb64 - 128 + 64 * ti + 63 < T);
        if (plain) {
#pragma unroll
            for (int i = 0; i < 8; ++i) b[i] = 0.f;
        } else {
#pragma unroll
            for (int i = 0; i < 8; ++i) { const int key = key0 + 16 * (i >> 2) + (i & 3); const int kp = 64 * jb64 - 128 + 64 * ti + key, d = kp - (q0 + 16 * qt);
                b[i] = (kp >= 0 && kp < T && d <= 128 && d >= -128) ? 0.f : -INFINITY; }
        }
    }
};
struct TFNaW {
    int rlo, nl, r, r0, hf, fr; const LAS float* rpb;
    __device__ __forceinline__ int ntiles() const { return nl + 4; }
    __device__ __forceinline__ int tile_t0(int ti) const { return ti < nl ? 64 * (rlo + ti) : T + 64 * (ti - nl); }
    __device__ __forceinline__ bool active(int ti) const { return ti >= nl || (rlo + ti >= r0 && rlo + ti < r0 + 8); }
    __device__ __forceinline__ int nsteps(int ti) const { return ti < nl ? 1 : 2; }
    __device__ __forceinline__ int win(int ti, int qt, int st) const { if (ti >= nl) return 32 * st; const int cq = 2 * hf + qt; return cq == 0 ? 0 : (cq == 1 ? 8 : (cq == 2 ? 24 : 32)); }
    __device__ __forceinline__ void bias8(int ti, int qt, int key0, float (&b)[8]) const {
        if (ti >= nl) {
#pragma unroll
            for (int i = 0; i < 8; ++i) b[i] = 0.f;
        } else {
            const int c = 32 * hf + 16 * qt + fr, c0 = c - 8 < 0 ? 0 : (c - 8 > 48 ? 48 : c - 8);
            const LAS float* row = rpb + (rlo + ti - r + 7) * 31;
#pragma unroll
            for (int i = 0; i < 8; ++i) { const int key = key0 + 16 * (i >> 2) + (i & 3); int off = key - c + 15; off = off < 0 ? 0 : (off > 30 ? 30 : off);
                const float v = row[off]; b[i] = ((unsigned)(key - c0) < 16u) ? v : -INFINITY; }
        }
    }
};

__device__ __forceinline__ void ph_attn_even(const Params& p, int e, bool with_ctx, LAS unsigned char* lds, int tid, int lane, int wave, int vcu, int G) {
    unsigned char* proj = p.ws + WS_PROJ;
    const bf16_t* BQ = (const bf16_t*)(proj + PJ_BQ); const bf16_t* BK = (const bf16_t*)(proj + PJ_BK); const bf16_t* BVT = (const bf16_t*)(proj + PJ_BVT);
    bf16_t* MIX = (bf16_t*)(p.ws + WS_MIX);
    const float scale = 0.08838834764831845f;
#ifdef ATT_PROBE
    for (int U = vcu; U < 256; U += G) {
        const int jb64 = U >> 1, kvh = U & 1, h = kvh * 4 + (wave & 3), hf = wave >> 2;
        TFGqaW tf; tf.jb64 = jb64; tf.q0 = 64 * jb64 + 32 * hf + (lane & 15);
        attn_wg<TFGqaW, ATT_PROBE>(tf, BQ + h * 128, 1024, 64 * jb64 + 32 * hf, 64 * jb64 + 32 * hf + 16, BK + kvh * 128, 256, BVT + (size_t)kvh * 128 * M, true, p.ab_sink[e * 8 + h], scale, MIX + 1024 + h * 128, 2048, lds, tid, lane, p.grid == 12345);
    }
#endif
    for (int U = vcu; U < 256; U += G) {
        const int jb64 = U >> 1, kvh = U & 1, h = kvh * 4 + (wave & 3), hf = wave >> 2;
        TFGqaW tf; tf.jb64 = jb64; tf.q0 = 64 * jb64 + 32 * hf + (lane & 15);
        attn_wg(tf, BQ + h * 128, 1024, 64 * jb64 + 32 * hf, 64 * jb64 + 32 * hf + 16, BK + kvh * 128, 256, BVT + (size_t)kvh * 128 * M, true, p.ab_sink[e * 8 + h], scale, MIX + 1024 + h * 128, 2048, lds, tid, lane);
    }
    if (with_ctx) for (int U = G - 1 - vcu; U < 8; U += G) {
        const int h = U, kvh = h >> 2;
        attn_wg(TFCtxW(), BQ + h * 128, 1024, T + 32 * wave, T + 32 * wave + 16, BK + kvh * 128, 256, BVT + (size_t)kvh * 128 * M, true, p.ab_sink[e * 8 + h], scale, MIX + 1024 + h * 128, 2048, lds, tid, lane);
    }
}
__device__ __forceinline__ void ph_attn_odd(const Params& p, int o, bool with_ctx, LAS unsigned char* lds, int tid, int lane, int wave, int vcu, int G) {
    unsigned char* proj = p.ws + WS_PROJ;
    const bf16_t* Q = (const bf16_t*)(proj + PJ_Q); const bf16_t* K = (const bf16_t*)(proj + PJ_K); const bf16_t* VT = (const bf16_t*)(proj + PJ_VT);
    bf16_t* MIX = (bf16_t*)(p.ws + WS_MIX);
    const float scale = 0.08838834764831845f;
#ifdef NA_PROBE
    for (int U = vcu; U < 512; U += G) {
        const int rg = U >> 4, h = U & 15, r = 4 * rg + (wave >> 1), hf = wave & 1;
        TFNaW tf; tf.r = r; tf.r0 = r - 4 < 0 ? 0 : (r - 4 > 120 ? 120 : r - 4); tf.hf = hf; tf.fr = lane & 15; tf.rpb = (const LAS float*)(lds + 2 * ATT_BUF);
        { const float* rsrc = p.na_rpb + ((size_t)o * 16 + h) * 15 * 31; __syncthreads(); if (tid < 465) ((LAS float*)(lds + 2 * ATT_BUF))[tid] = rsrc[tid]; }
        const int rl_ = 4 * rg - 4 < 0 ? 0 : (4 * rg - 4 > 120 ? 120 : 4 * rg - 4), rh_ = (4 * rg - 1 < 0 ? 0 : (4 * rg - 1 > 120 ? 120 : 4 * rg - 1)) + 7;
        tf.rlo = rl_; tf.nl = rh_ - rl_ + 1;
        attn_wg<TFNaW, 1>(tf, Q + h * 128, 2048, 64 * r + 32 * hf, 64 * r + 32 * hf + 16, K + h * 128, 2048, VT + (size_t)h * 128 * M, false, 0.f, scale, MIX + h * 128, 2048, lds, tid, lane, p.grid == 12345);
    }
#endif
    for (int U = vcu; U < 512; U += G) {
        const int rg = U >> 4, h = U & 15, r = 4 * rg + (wave >> 1), hf = wave & 1;
        TFNaW tf; tf.r = r; tf.r0 = r - 4 < 0 ? 0 : (r - 4 > 120 ? 120 : r - 4); tf.hf = hf; tf.fr = lane & 15; tf.rpb = (const LAS float*)(lds + 2 * ATT_BUF);
        { const float* rsrc = p.na_rpb + ((size_t)o * 16 + h) * 15 * 31; __syncthreads(); if (tid < 465) ((LAS float*)(lds + 2 * ATT_BUF))[tid] = rsrc[tid]; }
        const int rl_ = 4 * rg - 4 < 0 ? 0 : (4 * rg - 4 > 120 ? 120 : 4 * rg - 4), rh_ = (4 * rg - 1 < 0 ? 0 : (4 * rg - 1 > 120 ? 120 : 4 * rg - 1)) + 7;
        tf.rlo = rl_; tf.nl = rh_ - rl_ + 1;
        attn_wg(tf, Q + h * 128, 2048, 64 * r + 32 * hf, 64 * r + 32 * hf + 16, K + h * 128, 2048, VT + (size_t)h * 128 * M, false, 0.f, scale, MIX + h * 128, 2048, lds, tid, lane);
    }
    if (with_ctx) for (int U = G - 1 - vcu; U < 16; U += G) {
        const int h = U;
        attn_wg(TFCtxW(), Q + h * 128, 2048, T + 32 * wave, T + 32 * wave + 16, K + h * 128, 2048, VT + (size_t)h * 128 * M, false, 0.f, scale, MIX + h * 128, 2048, lds, tid, lane);
    }
}

__device__ __forceinline__ void mlstm_A_unit(const Params& p, int cc, int hd, int lane) {
    asm volatile("" : "+v"(lane));
    const int fr = lane & 15, fq = lane >> 4, dir = hd >> 3, head = hd & 7, tok0 = cc * 64;
    unsigned char* proj = p.ws + WS_PROJ;
    const bf16_t* AKT = (const bf16_t*)(proj + PJ_AKT); const bf16_t* AVT = (const bf16_t*)(proj + PJ_AVT); const float* Gt = (const float*)(proj + PJ_G);
    float* U = (float*)(p.ws + WS_U); float* CHS = (float*)(p.ws + WS_CHS);
    const float* grow = Gt + (size_t)(tok0 + lane) * 32;
    u32x4 rawk[2][4]; bf16x8 bv[8][2];
#pragma unroll
    for (int ks = 0; ks < 2; ++ks)
#pragma unroll
        for (int nd = 0; nd < 4; ++nd) rawk[ks][nd] = *(const u32x4*)(AKT + (size_t)(head * 64 + 16 * nd + fr) * M + tok0 + 32 * ks + 8 * fq);
#pragma unroll
    for (int ne = 0; ne < 8; ++ne)
#pragma unroll
        for (int ks = 0; ks < 2; ++ks) bv[ne][ks] = *(const bf16x8*)(AVT + (size_t)(head * 128 + 16 * ne + fr) * M + tok0 + 32 * ks + 8 * fq);
    const float ig = grow[(2 * dir) * 8 + head], lf_raw = grow[(2 * dir + 1) * 8 + head];
    __builtin_amdgcn_sched_barrier(0);
    const float lf = log_sigmoid(lf_raw);
    const float F = scan_add(lf, lane, dir);
    const float FL = __shfl(F, dir ? 0 : 63);
    const float wend = FL - F + ig, wmax = wave_max(wend), wv = expf(wend - wmax);
    if (lane == 0) { CHS[((size_t)hd * NCH + cc) * 2] = FL; CHS[((size_t)hd * NCH + cc) * 2 + 1] = wmax; }
    { float* GF = (float*)(p.ws + WS_GF); const float Bs_ = ig - F, pm_ = scan_max(Bs_, lane, dir); const size_t gi = (size_t)hd * M + tok0 + lane;
      GF[gi] = F; GF[(size_t)16 * M + gi] = Bs_; GF[(size_t)32 * M + gi] = pm_; }
    bf16x8 af[4][2];
#pragma unroll
    for (int ks = 0; ks < 2; ++ks) {
        float w8[8];
#pragma unroll
        for (int j = 0; j < 8; ++j) w8[j] = __shfl(wv, 32 * ks + 8 * fq + j);
#pragma unroll
        for (int nd = 0; nd < 4; ++nd) {
            const u32x4 raw = rawk[ks][nd];
            u32x4 w; w.x = pk2(bf_lo(raw.x) * w8[0], bf_hi(raw.x) * w8[1]); w.y = pk2(bf_lo(raw.y) * w8[2], bf_hi(raw.y) * w8[3]);
            w.z = pk2(bf_lo(raw.z) * w8[4], bf_hi(raw.z) * w8[5]); w.w = pk2(bf_lo(raw.w) * w8[6], bf_hi(raw.w) * w8[7]);
            af[nd][ks] = mk_frag(w);
        }
    }
    const unsigned onew = (fr == 0) ? 0x3F803F80u : 0u;
#pragma unroll
    for (int ne = 0; ne < 9; ++ne) {
        bf16x8 bfr[2];
#pragma unroll
        for (int ks = 0; ks < 2; ++ks) {
            if (ne < 8) bfr[ks] = bv[ne < 8 ? ne : 0][ks];
            else { u32x4 w; w.x = onew; w.y = onew; w.z = onew; w.w = onew; bfr[ks] = mk_frag(w); }
        }
#pragma unroll
        for (int nd = 0; nd < 4; ++nd) {
            f32x4 acc = (f32x4){0.f, 0.f, 0.f, 0.f};
#pragma unroll
            for (int ks = 0; ks < 2; ++ks) acc = MFMA16(af[nd][ks], bfr[ks], acc);
            *(f32x4*)(U + (((size_t)hd * NCH + cc) * 144 + 16 * ne + fr) * 64 + 16 * nd + 4 * fq) = acc;
        }
    }
}
__device__ __forceinline__ void ph_mlstm_B(const Params& p, LAS unsigned char* lds, int tid, int G) {
    const float* U = (const float*)(p.ws + WS_U); const float* CHS = (const float*)(p.ws + WS_CHS);
    bf16_t* SNAP = (bf16_t*)(p.ws + WS_SNAP); float* MPREV = (float*)(p.ws + WS_CHS + 65536);
    LAS float* sDec = (LAS float*)lds; LAS float* sInj = sDec + 132;
    for (int b = blockIdx.x; b < 256; b += G) {
        const int hd = b >> 4, part = b & 15, dir = hd >> 3;
        __syncthreads();
        if (tid < NCH) { const int cc = dir ? (NCH - 1 - tid) : (tid < 4 ? 128 + tid : tid - 4); sDec[tid] = CHS[((size_t)hd * NCH + cc) * 2]; sInj[tid] = CHS[((size_t)hd * NCH + cc) * 2 + 1]; }
        __syncthreads();
        LAS float* sM = sInj + 132;
        if (tid == 0) { float m = 0.f;
            for (int step = 0; step < NCH; ++step) { sM[step] = m; m = fmaxf(sDec[step] + m, sInj[step]); } sM[NCH] = m; }
        __syncthreads();
        if (tid < NCH) { const int step = tid; const int cc = dir ? (NCH - 1 - step) : (step < 4 ? 128 + step : step - 4);
            const float FL = sDec[step], wm = sInj[step], m = sM[step], mn = sM[step + 1];
            if (part == 0) MPREV[hd * NCH + cc] = m;
            sDec[step] = expf(FL + m - mn); sInj[step] = expf(wm - mn); }
        __syncthreads();
        const int i0 = part * 512 + tid; const bool has2 = (part == 0 && tid < 64); const int i1 = 8192 + tid;
        float C0 = 0.f, C1 = 0.f;
#pragma unroll 1
        for (int s12 = 0; s12 < NCH; s12 += 22) {
            float u0[22], u1[22]; size_t base[22];
#pragma unroll
            for (int k = 0; k < 22; ++k) { const int step = s12 + k; const int cc = dir ? (NCH - 1 - step) : (step < 4 ? 128 + step : step - 4);
                base[k] = ((size_t)hd * NCH + cc) * 9216; u0[k] = __builtin_nontemporal_load(U + base[k] + i0); u1[k] = has2 ? __builtin_nontemporal_load(U + base[k] + i1) : 0.f; }
#pragma unroll
            for (int k = 0; k < 22; ++k) {
                SNAP[base[k] + i0] = (bf16_t)(pk2(C0, 0.f) & 0xffff);
                if (has2) SNAP[base[k] + i1] = (bf16_t)(pk2(C1, 0.f) & 0xffff);
                const float decay = sDec[s12 + k], inj = sInj[s12 + k];
                C0 = decay * C0 + inj * u0[k]; C1 = decay * C1 + inj * u1[k]; }
        }
    }
}
__device__ __forceinline__ void mlstm_C_unit(const Params& p, int e_idx, int cc, int head, int tq, int lane) {
    asm volatile("" : "+v"(lane));
    const int fr = lane & 15, fq = lane >> 4, tok0 = cc * 64, tl = 16 * tq + fr;
    unsigned char* proj = p.ws + WS_PROJ;
    const bf16_t* AQ = (const bf16_t*)(proj + PJ_AQ); const bf16_t* AK = (const bf16_t*)(proj + PJ_AK); const bf16_t* AVT = (const bf16_t*)(proj + PJ_AVT);
    const bf16_t* AO = (const bf16_t*)(proj + PJ_AO); const float* Gt = (const float*)(proj + PJ_G);
    const bf16_t* SNAP = (const bf16_t*)(p.ws + WS_SNAP); const float* MPREV = (const float*)(p.ws + WS_CHS + 65536);
    bf16_t* MIX = (bf16_t*)(p.ws + WS_MIX);
    bf16x8 qf[2];
#pragma unroll
    for (int kd = 0; kd < 2; ++kd) qf[kd] = *(const bf16x8*)(AQ + (size_t)(tok0 + tl) * 512 + head * 64 + 32 * kd + 8 * fq);
    f32x4 s[4];
#pragma unroll
    for (int ns = 0; ns < 4; ++ns) { s[ns] = (f32x4){0.f, 0.f, 0.f, 0.f};
#pragma unroll
        for (int kd = 0; kd < 2; ++kd) { const bf16x8 kf = *(const bf16x8*)(AK + (size_t)(tok0 + 16 * ns + fr) * 512 + head * 64 + 32 * kd + 8 * fq); s[ns] = MFMA16(kf, qf[kd], s[ns]); } }
    f32x4 hs[8];
#pragma unroll
    for (int ne = 0; ne < 8; ++ne) hs[ne] = (f32x4){0.f, 0.f, 0.f, 0.f};
    const float* grow = Gt + (size_t)(tok0 + lane) * 32;
#pragma unroll
    for (int dir = 0; dir < 2; ++dir) {
        const int hd = dir * 8 + head;
        const float* GF = (const float*)(p.ws + WS_GF) + (size_t)hd * M + tok0;
        const float F_t = GF[tl], pm_t = GF[(size_t)32 * M + tl];
        const float inter = F_t + MPREV[hd * NCH + cc], mt = fmaxf(inter, F_t + pm_t);
        const float A_t = F_t - mt, a_t = expf(inter - mt), fl_t = expf(-mt);
        bf16x8 pf[2];
#pragma unroll
        for (int ks = 0; ks < 2; ++ks) { unsigned w[4];
#pragma unroll
            for (int hf = 0; hf < 2; ++hf) { const int ns = 2 * ks + hf; float ev[4];
                const f32x4 b4 = *(const f32x4*)(GF + (size_t)16 * M + 16 * ns + 4 * fq);
#pragma unroll
                for (int r = 0; r < 4; ++r) { const int sl = 16 * ns + 4 * fq + r;
                    const bool valid = dir ? (sl >= tl) : (sl <= tl);
                    ev[r] = s[ns][r] * expf(valid ? (A_t + b4[r]) : -INFINITY); }
                w[2 * hf] = pk2(ev[0], ev[1]); w[2 * hf + 1] = pk2(ev[2], ev[3]); }
            u32x4 ww; ww.x = w[0]; ww.y = w[1]; ww.z = w[2]; ww.w = w[3]; pf[ks] = mk_frag(ww); }
        const bf16_t* snap = SNAP + ((size_t)hd * NCH + cc) * 9216;
        float rden = 0.f;
#pragma unroll
        for (int it = 0; it < 9; ++it) {
            const int ne = (it == 0) ? 8 : it - 1;
            f32x4 acc = (f32x4){0.f, 0.f, 0.f, 0.f};
#pragma unroll
            for (int kd = 0; kd < 2; ++kd) {
                u32x4 cw = *(const u32x4*)(snap + (size_t)(16 * ne + fr) * 64 + 32 * kd + 8 * fq);
                if (ne == 8 && fr != 0) { cw.x = 0u; cw.y = 0u; cw.z = 0u; cw.w = 0u; }
                acc = MFMA16(mk_frag(cw), qf[kd], acc);
            }
            acc = acc * a_t;
#pragma unroll
            for (int ks = 0; ks < 2; ++ks) {
                u32x4 vw;
                if (ne < 8) { const bf16_t* vr = AVT + (size_t)(head * 128 + 16 * ne + fr) * M + tok0 + 32 * ks + 4 * fq;
                    const u32x2 a = *(const u32x2*)vr, b = *(const u32x2*)(vr + 16); vw.x = a.x; vw.y = a.y; vw.z = b.x; vw.w = b.y; }
                else { const unsigned onew = (fr == 0) ? 0x3F803F80u : 0u; vw.x = onew; vw.y = onew; vw.z = onew; vw.w = onew; }
                acc = MFMA16(mk_frag(vw), pf[ks], acc);
            }
            if (ne == 8) { const float den = __shfl(acc[0], fr); rden = 1.f / fmaxf(fabsf(den), fl_t); }
            else hs[ne] = hs[ne] + acc * rden;
        }
    }
    float ss = 0.f;
#pragma unroll
    for (int ne = 0; ne < 8; ++ne) ss += (hs[ne][0] * hs[ne][0] + hs[ne][1] * hs[ne][1]) + (hs[ne][2] * hs[ne][2] + hs[ne][3] * hs[ne][3]);
    ss += __shfl_xor(ss, 16); ss += __shfl_xor(ss, 32);
    const float rs = rsqrtf(ss * (1.f / 128.f) + EPS);
    const int tok = tok0 + tl;
#pragma unroll
    for (int ne = 0; ne < 8; ++ne) { const int col = head * 128 + 16 * ne + 4 * fq;
        const f32x4 g4 = *(const f32x4*)(p.ab_mh_g + (size_t)e_idx * 1024 + col);
        const u32x2 ow = *(const u32x2*)(AO + (size_t)tok * 1024 + col);
        const float o0 = bf_lo(ow.x), o1 = bf_hi(ow.x), o2 = bf_lo(ow.y), o3 = bf_hi(ow.y);
        const f32x4 v = hs[ne] * rs * g4;
        u32x2 w; w.x = pk2(v[0] / (1.f + expf(-o0)), v[1] / (1.f + expf(-o1))); w.y = pk2(v[2] / (1.f + expf(-o2)), v[3] / (1.f + expf(-o3)));
        *(u32x2*)(MIX + (size_t)tok * 2048 + col) = w; }
}

constexpr int MC_K = 0, MC_Q = 8192, MC_VT = 16384, MC_S = 34816  , MC_G = 71680  , MC_H = 73728  , MC_END = 106496;
__device__ __forceinline__ void mlstm_C_wg(const Params& p, int e_idx, LAS unsigned char* lds, int tid, int lane, int wave, int vcu, int G) {
    asm volatile("" : "+v"(lane));
    const int fr = lane & 15, fq = lane >> 4, tq = wave & 3, dir = wave >> 2, tl = 16 * tq + fr;
    unsigned char* proj = p.ws + WS_PROJ;
    const bf16_t* AQ = (const bf16_t*)(proj + PJ_AQ); const bf16_t* AK = (const bf16_t*)(proj + PJ_AK); const bf16_t* AVT = (const bf16_t*)(proj + PJ_AVT);
    const bf16_t* AO = (const bf16_t*)(proj + PJ_AO);
    const bf16_t* SNAP = (const bf16_t*)(p.ws + WS_SNAP); const float* MPREV = (const float*)(p.ws + WS_CHS + 65536);
    const float* GFg = (const float*)(p.ws + WS_GF);
    bf16_t* MIX = (bf16_t*)(p.ws + WS_MIX);
    const int row = tid >> 3, ch = tid & 7;
    u32x4 kv, qv, vv[2], sv[2][3]; float gv = 0.f;
#define MC_FETCH(U_) do { const int cc_ = (U_) >> 3, hd_ = (U_) & 7, t0_ = cc_ * 64; \
        kv = __builtin_nontemporal_load((const u32x4*)(AK + (size_t)(t0_ + row) * 512 + hd_ * 64 + ch * 8)); qv = __builtin_nontemporal_load((const u32x4*)(AQ + (size_t)(t0_ + row) * 512 + hd_ * 64 + ch * 8)); \
        _Pragma("unroll") for (int i = 0; i < 2; ++i) vv[i] = __builtin_nontemporal_load((const u32x4*)(AVT + (size_t)(hd_ * 128 + row + 64 * i) * M + t0_ + ch * 8)); \
        _Pragma("unroll") for (int d = 0; d < 2; ++d) _Pragma("unroll") for (int i = 0; i < 3; ++i) { const int q = tid + 512 * i, e = q >> 3; const u32x4 z = {0u, 0u, 0u, 0u}; \
            sv[d][i] = (q < 1152 && e < 129) ? __builtin_nontemporal_load((const u32x4*)(SNAP + ((size_t)(d * 8 + hd_) * NCH + cc_) * 9216 + (size_t)e * 64 + ch * 8)) : z; } \
        if (tid < 384) { const int which = tid >> 6, t = tid & 63, kind = which % 3, dd = which / 3; gv = GFg[((size_t)kind * 16 + dd * 8 + hd_) * M + t0_ + t]; } } while (0)
    int U = vcu;
    if (U < NCH * 8) MC_FETCH(U);
    for (; U < NCH * 8; U += G) {
    const int cc = U >> 3, head = U & 7, tok0 = cc * 64, hd = dir * 8 + head;
    __syncthreads();
    {
        *(LAS u32x4*)(lds + MC_K + row * 128 + ((ch ^ (row & 7)) << 4)) = kv;
        *(LAS u32x4*)(lds + MC_Q + row * 128 + ((ch ^ (row & 7)) << 4)) = qv;
#pragma unroll
        for (int i = 0; i < 2; ++i) { const int e = row + 64 * i; *(LAS u32x4*)(lds + MC_VT + e * 128 + ((ch ^ (e & 7)) << 4)) = vv[i]; }
        if (tid < 128) { const int e = 128 + row; const unsigned o1 = (e == 128) ? 0x3F803F80u : 0u; const u32x4 ov = {o1, o1, o1, o1}; *(LAS u32x4*)(lds + MC_VT + e * 128 + ((ch ^ (e & 7)) << 4)) = ov; }
#pragma unroll
        for (int d = 0; d < 2; ++d)
#pragma unroll
            for (int i = 0; i < 3; ++i) { const int q = tid + 512 * i, e = q >> 3; if (q < 1152) *(LAS u32x4*)(lds + MC_S + d * 18432 + e * 128 + ((ch ^ (e & 7)) << 4)) = sv[d][i]; }
        if (tid < 384) *(LAS float*)(lds + MC_G + tid * 4) = gv;
    }
    __syncthreads();
    if (U + G < NCH * 8) MC_FETCH(U + G);
    bf16x8 qf[2];
#pragma unroll
    for (int kd = 0; kd < 2; ++kd) qf[kd] = *(const LAS bf16x8*)(lds + MC_Q + tl * 128 + (((4 * kd + fq) ^ (tl & 7)) << 4));
    f32x4 s[4];
#pragma unroll
    for (int ns = 0; ns < 4; ++ns) { s[ns] = (f32x4){0.f, 0.f, 0.f, 0.f}; const int sr = 16 * ns + fr;
#pragma unroll
        for (int kd = 0; kd < 2; ++kd) { const bf16x8 kf = *(const LAS bf16x8*)(lds + MC_K + sr * 128 + (((4 * kd + fq) ^ (sr & 7)) << 4)); s[ns] = MFMA16(kf, qf[kd], s[ns]); } }
    const LAS float* G = (const LAS float*)(lds + MC_G + dir * 768);
    const float F_t = G[tl], pm_t = G[128 + tl];
    const float inter = F_t + MPREV[hd * NCH + cc], mt = fmaxf(inter, F_t + pm_t);
    const float A_t = F_t - mt, a_t = expf(inter - mt), fl_t = expf(-mt);
    bf16x8 pf[2];
#pragma unroll
    for (int ks = 0; ks < 2; ++ks) { unsigned w[4];
#pragma unroll
        for (int hf = 0; hf < 2; ++hf) { const int ns = 2 * ks + hf; float ev[4];
            const f32x4 b4 = *(const LAS f32x4*)(G + 64 + 16 * ns + 4 * fq);
#pragma unroll
            for (int r = 0; r < 4; ++r) { const int sl = 16 * ns + 4 * fq + r; const bool valid = dir ? (sl >= tl) : (sl <= tl);
                ev[r] = s[ns][r] * expf(valid ? (A_t + b4[r]) : -INFINITY); }
            w[2 * hf] = pk2(ev[0], ev[1]); w[2 * hf + 1] = pk2(ev[2], ev[3]); }
        u32x4 ww; ww.x = w[0]; ww.y = w[1]; ww.z = w[2]; ww.w = w[3]; pf[ks] = mk_frag(ww); }
    const LAS unsigned char* snap = lds + MC_S + dir * 18432;
    f32x4 hs[8]; float rden = 0.f;
#pragma unroll
    for (int g3 = 0; g3 < 3; ++g3) {
        bf16x8 cfr[3][2]; u32x4 vwr[3][2];
#pragma unroll
        for (int i3 = 0; i3 < 3; ++i3) { const int it = 3 * g3 + i3; const int ne = (it == 0) ? 8 : it - 1; const int er = 16 * ne + fr;
#pragma unroll
            for (int kd = 0; kd < 2; ++kd) cfr[i3][kd] = *(const LAS bf16x8*)(snap + er * 128 + (((4 * kd + fq) ^ (er & 7)) << 4));
#pragma unroll
            for (int ks = 0; ks < 2; ++ks) {
                const LAS unsigned char* vr = lds + MC_VT + er * 128 + 8 * (fq & 1);
                const u32x2 a = *(const LAS u32x2*)(vr + (((4 * ks + (fq >> 1)) ^ (er & 7)) << 4)), b = *(const LAS u32x2*)(vr + (((4 * ks + 2 + (fq >> 1)) ^ (er & 7)) << 4));
                vwr[i3][ks].x = a.x; vwr[i3][ks].y = a.y; vwr[i3][ks].z = b.x; vwr[i3][ks].w = b.y; } }
        __builtin_amdgcn_sched_barrier(0);
#pragma unroll
        for (int i3 = 0; i3 < 3; ++i3) { const int it = 3 * g3 + i3; const int ne = (it == 0) ? 8 : it - 1;
            f32x4 acc = (f32x4){0.f, 0.f, 0.f, 0.f};
#pragma unroll
            for (int kd = 0; kd < 2; ++kd) acc = MFMA16(cfr[i3][kd], qf[kd], acc);
            acc = acc * a_t;
#pragma unroll
            for (int ks = 0; ks < 2; ++ks) acc = MFMA16(mk_frag(vwr[i3][ks]), pf[ks], acc);
            if (ne == 8) { const float den = __shfl(acc[0], fr); rden = 1.f / fmaxf(fabsf(den), fl_t); }
            else hs[ne] = acc * rden; }
        __builtin_amdgcn_sched_barrier(0);
    }
    if (dir == 1) {
#pragma unroll
        for (int ne = 0; ne < 8; ++ne) *(LAS f32x4*)(lds + MC_H + tq * 8192 + ne * 1024 + lane * 16) = hs[ne];
    }
    __syncthreads();
    if (dir == 0) {
        float ss = 0.f;
#pragma unroll
        for (int ne = 0; ne < 8; ++ne) { hs[ne] = hs[ne] + *(const LAS f32x4*)(lds + MC_H + tq * 8192 + ne * 1024 + lane * 16);
            ss += (hs[ne][0] * hs[ne][0] + hs[ne][1] * hs[ne][1]) + (hs[ne][2] * hs[ne][2] + hs[ne][3] * hs[ne][3]); }
        ss = fq_sum(ss);
        const float rs = rsqrtf(ss * (1.f / 128.f) + EPS);
        const int tok = tok0 + tl;
        f32x4 g4a[8]; u32x2 owa[8];
#pragma unroll
        for (int ne = 0; ne < 8; ++ne) { const int col = head * 128 + 16 * ne + 4 * fq; g4a[ne] = *(const f32x4*)(p.ab_mh_g + (size_t)e_idx * 1024 + col); owa[ne] = *(const u32x2*)(AO + (size_t)tok * 1024 + col); }
        __builtin_amdgcn_sched_barrier(0);
#pragma unroll
        for (int ne = 0; ne < 8; ++ne) { const int col = head * 128 + 16 * ne + 4 * fq;
            const f32x4 g4 = g4a[ne];
            const u32x2 ow = owa[ne];
            const float o0 = bf_lo(ow.x), o1 = bf_hi(ow.x), o2 = bf_lo(ow.y), o3 = bf_hi(ow.y);
            const f32x4 v = hs[ne] * rs * g4;
            u32x2 w; w.x = pk2(v[0] / (1.f + expf(-o0)), v[1] / (1.f + expf(-o1))); w.y = pk2(v[2] / (1.f + expf(-o2)), v[3] / (1.f + expf(-o3)));
            *(u32x2*)(MIX + (size_t)tok * 2048 + col) = w; }
    }
    }
#undef MC_FETCH
}

#define CE_DESC(a, b) do { const float _x = fmaxf(a, b), _y = fminf(a, b); a = _x; b = _y; } while (0)
__device__ __forceinline__ void sort16_desc(float (&v)[16]) {
#pragma unroll
    for (int k = 2; k <= 16; k <<= 1)
#pragma unroll
        for (int j = k >> 1; j > 0; j >>= 1)
#pragma unroll
            for (int i = 0; i < 16; ++i) { const int l = i ^ j; if (l > i) { if ((i & k) == 0) CE_DESC(v[i], v[l]); else CE_DESC(v[l], v[i]); } }
}
__device__ __forceinline__ void merge16_desc(float (&a)[16], const float (&b)[16]) {
#pragma unroll
    for (int i = 0; i < 16; ++i) a[i] = fmaxf(a[i], b[15 - i]);
#pragma unroll
    for (int j = 8; j > 0; j >>= 1)
#pragma unroll
        for (int i = 0; i < 16; ++i) { const int l = i ^ j; if (l > i) CE_DESC(a[i], a[l]); }
}
__device__ __forceinline__ void ce_desc_p(float& va, int& pa, float& vb, int& pb) {
    float nva, nvb; int npa, npb;
    asm volatile("v_cmp_gt_f32 vcc, %5, %4\n\tv_cndmask_b32 %0, %4, %5, vcc\n\tv_cndmask_b32 %1, %5, %4, vcc\n\tv_cndmask_b32 %2, %6, %7, vcc\n\tv_cndmask_b32 %3, %7, %6, vcc"
                 : "=&v"(nva), "=&v"(nvb), "=&v"(npa), "=&v"(npb) : "v"(va), "v"(vb), "v"(pa), "v"(pb) : "vcc");
    va = nva; vb = nvb; pa = npa; pb = npb;
}
#define CE_DESC_P(va, pa, vb, pb) ce_desc_p(va, pa, vb, pb)
__device__ __forceinline__ void sort16p_desc(float (&v)[16], int (&q)[16]) {
#pragma unroll
    for (int k = 2; k <= 16; k <<= 1)
#pragma unroll
        for (int j = k >> 1; j > 0; j >>= 1)
#pragma unroll
            for (int i = 0; i < 16; ++i) { const int l = i ^ j; if (l > i) { if ((i & k) == 0) CE_DESC_P(v[i], q[i], v[l], q[l]); else CE_DESC_P(v[l], q[l], v[i], q[i]); } }
}
__device__ __forceinline__ void merge16p_desc(float (&a)[16], int (&qa)[16], const float (&b)[16], const int (&qb)[16]) {
#pragma unroll
    for (int i = 0; i < 16; ++i) { float tb = b[15 - i]; int tq = qb[15 - i]; ce_desc_p(a[i], qa[i], tb, tq); }
#pragma unroll
    for (int j = 8; j > 0; j >>= 1)
#pragma unroll
        for (int i = 0; i < 16; ++i) { const int l = i ^ j; if (l > i) CE_DESC_P(a[i], qa[i], a[l], qa[l]); }
}
#define CAND_G0(X) X(0,0) X(0,1) X(0,2) X(0,3) X(0,4) X(0,5) X(0,6) X(0,7) X(0,8) X(0,9) X(0,10) X(0,11) X(0,12) X(0,13) X(0,14) X(0,15)
#define CAND_G1(X) X(1,0) X(1,1) X(1,2) X(1,3) X(1,4) X(1,5) X(1,6) X(1,7) X(2,0) X(2,1) X(2,2) X(2,3) X(2,4) X(3,0) X(3,1) X(3,2)
#define CAND_G2(X) X(3,3) X(4,0) X(4,1) X(4,2) X(5,0) X(5,1) X(6,0) X(6,1) X(7,0) X(7,1) X(8,0) X(9,0) X(10,0) X(11,0) X(12,0) X(13,0)
#define CAND_G3(X) X(14,0) X(15,0)

__device__ __forceinline__ void peer_topk_unit(const Params& p, int l, int mt, int hh, int lane) {
    asm volatile("" : "+v"(lane));
    const int fr = lane & 15, fq = lane >> 4, row = mt * 16 + fr;
    const bf16_t* QP = (const bf16_t*)(p.ws + WS_QP); const bf16_t* KEYS = (const bf16_t*)(p.ws + WS_KEYS);
    float s1[16], s2[16]; int i1[16], i2[16];
#pragma unroll
    for (int p2 = 0; p2 < 2; ++p2) {
        bf16x8 qf[4];
#pragma unroll
        for (int kd = 0; kd < 4; ++kd) qf[kd] = __builtin_nontemporal_load((const bf16x8*)(QP + (size_t)row * 2048 + hh * 256 + p2 * 128 + 32 * kd + 8 * fq));
        float a[16], b[16];
#pragma unroll
        for (int nh = 0; nh < 2; ++nh) {
            bf16x8 kf[4][4];
#pragma unroll
            for (int nb = 0; nb < 4; ++nb)
#pragma unroll
                for (int kd = 0; kd < 4; ++kd) kf[nb][kd] = *(const bf16x8*)(KEYS + ((((size_t)l * 8 + hh) * 2 + p2) * 128 + 16 * (4 * nh + nb) + fr) * 128 + 32 * kd + 8 * fq);
            __builtin_amdgcn_sched_barrier(0);
#pragma unroll
            for (int nb = 0; nb < 4; ++nb) { const int nk = 4 * nh + nb;
                f32x4 acc = (f32x4){0.f, 0.f, 0.f, 0.f};
#pragma unroll
                for (int kd = 0; kd < 4; ++kd) acc = MFMA16(kf[nb][kd], qf[kd], acc);
#pragma unroll
                for (int r = 0; r < 4; ++r) { const unsigned idx = 16 * nk + 4 * fq + r; const float v = __uint_as_float((__float_as_uint(acc[r]) & ~0x7Fu) | idx);
                    if (nk < 4) a[4 * nk + r] = v; else b[4 * (nk - 4) + r] = v; } }
            __builtin_amdgcn_sched_barrier(0);
        }
        sort16_desc(a); sort16_desc(b); merge16_desc(a, b);
#pragma unroll
        for (int i = 0; i < 16; ++i) b[i] = __shfl_xor(a[i], 16);
        __builtin_amdgcn_sched_barrier(0);
        merge16_desc(a, b);
#pragma unroll
        for (int i = 0; i < 16; ++i) b[i] = __shfl_xor(a[i], 32);
        __builtin_amdgcn_sched_barrier(0);
        merge16_desc(a, b);
#pragma unroll
        for (int i = 0; i < 16; ++i) { const unsigned bits = __float_as_uint(a[i]); const float v = __uint_as_float(bits & ~0x7Fu); const int id = (int)(bits & 0x7Fu);
            if (p2 == 0) { s1[i] = v; i1[i] = id; } else { s2[i] = v; i2[i] = id; } }
    }
    float tv[16], gv[16]; int tp[16], gp[16];
    { float v0[16], v1[16], v2[16]; int q0[16], q1[16], q2[16]; float v3a, v3b; int q3a, q3b;
      { int ci = 0;
#define CX(A, B) v0[ci] = s1[A] + s2[B]; q0[ci] = i1[A] * 128 + i2[B]; ++ci;
        CAND_G0(CX) }
#undef CX
      { int ci = 0;
#define CX(A, B) v1[ci] = s1[A] + s2[B]; q1[ci] = i1[A] * 128 + i2[B]; ++ci;
        CAND_G1(CX) }
#undef CX
      { int ci = 0;
#define CX(A, B) v2[ci] = s1[A] + s2[B]; q2[ci] = i1[A] * 128 + i2[B]; ++ci;
        CAND_G2(CX) }
#undef CX
      v3a = s1[14] + s2[0]; q3a = i1[14] * 128 + i2[0]; v3b = s1[15] + s2[0]; q3b = i1[15] * 128 + i2[0];
#pragma unroll
      for (int i = 0; i < 16; ++i) { const float w3 = i == 0 ? v3a : (i == 1 ? v3b : -1e30f); const int r3 = i == 0 ? q3a : (i == 1 ? q3b : 0);
          tv[i] = fq == 0 ? v0[i] : (fq == 1 ? v1[i] : (fq == 2 ? v2[i] : w3)); tp[i] = fq == 0 ? q0[i] : (fq == 1 ? q1[i] : (fq == 2 ? q2[i] : r3)); } }
    sort16p_desc(tv, tp);
#pragma unroll
    for (int i = 0; i < 16; ++i) { gv[i] = __shfl_xor(tv[i], 16); gp[i] = __shfl_xor(tp[i], 16); }
    __builtin_amdgcn_sched_barrier(0);
    merge16p_desc(tv, tp, gv, gp);
#pragma unroll
    for (int i = 0; i < 16; ++i) { gv[i] = __shfl_xor(tv[i], 32); gp[i] = __shfl_xor(tp[i], 32); }
    __builtin_amdgcn_sched_barrier(0);
    merge16p_desc(tv, tp, gv, gp);
    float sum = 0.f; const float tmx = tv[0];
#pragma unroll
    for (int i = 0; i < 16; ++i) { tv[i] = expf(tv[i] - tmx); sum += tv[i]; }
    const float rsum = 1.f / sum;
    if (fq == 0) {
        int* IDX = (int*)(p.ws + WS_IDX) + (size_t)row * 128 + hh * 16; float* GT = (float*)(p.ws + WS_GATE) + (size_t)row * 128 + hh * 16;
#pragma unroll
        for (int i = 0; i < 16; i += 4) {
            *(int4*)(IDX + i) = make_int4(tp[i], tp[i + 1], tp[i + 2], tp[i + 3]);
            *(f32x4*)(GT + i) = (f32x4){tv[i] * rsum, tv[i + 1] * rsum, tv[i + 2] * rsum, tv[i + 3] * rsum};
        }
    }
}

typedef int i32x4 __attribute__((ext_vector_type(4)));
__device__ __forceinline__ float gelu_erf(float x) { return 0.5f * x * (1.f + erff(x * 0.70710678118654752f)); }
typedef float f32x2 __attribute__((ext_vector_type(2)));
__device__ __forceinline__ void acc_row16(f32x2 (&y)[8], const i32x4 w, float cf) {
    const f32x2 cf2 = {cf, cf};
#pragma unroll
    for (int d = 0; d < 4; ++d) { const unsigned u = (unsigned)w[d];
        const f32x2 a = {(float)(u & 0xffu), (float)((u >> 8) & 0xffu)}, b = {(float)((u >> 16) & 0xffu), (float)(u >> 24)};
        y[2 * d] = __builtin_elementwise_fma(cf2, a, y[2 * d]); y[2 * d + 1] = __builtin_elementwise_fma(cf2, b, y[2 * d + 1]); }
}
template <int N> __device__ __forceinline__ void reduce_scatter_g(float (&y)[N]) {
#pragma unroll
    for (int i = 0; i < N; ++i) y[i] += __builtin_bit_cast(float, __builtin_amdgcn_mov_dpp(__builtin_bit_cast(int, y[i]), 0x128  , 0xf, 0xf, false));
#pragma unroll
    for (int i = 0; i < N / 2; ++i) { const auto r = __builtin_amdgcn_permlane16_swap(__float_as_uint(y[i]), __float_as_uint(y[N / 2 + i]), false, false); y[i] = __uint_as_float(r[0]) + __uint_as_float(r[1]); }
#pragma unroll
    for (int i = 0; i < N / 4; ++i) { const auto r = __builtin_amdgcn_permlane32_swap(__float_as_uint(y[i]), __float_as_uint(y[N / 4 + i]), false, false); y[i] = __uint_as_float(r[0]) + __uint_as_float(r[1]); }
}
__device__ __forceinline__ void dot_rows4(int (&yi)[16], const i32x4 a, const i32x4 b, const i32x4 c, const i32x4 d, int cq) {
#pragma unroll
    for (int k = 0; k < 4; ++k) {
        const unsigned ablo = __builtin_amdgcn_perm((unsigned)b[k], (unsigned)a[k], 0x05010400u), abhi = __builtin_amdgcn_perm((unsigned)b[k], (unsigned)a[k], 0x07030602u);
        const unsigned cdlo = __builtin_amdgcn_perm((unsigned)d[k], (unsigned)c[k], 0x05010400u), cdhi = __builtin_amdgcn_perm((unsigned)d[k], (unsigned)c[k], 0x07030602u);
        yi[4 * k + 0] = __builtin_amdgcn_sdot4((int)__builtin_amdgcn_perm(cdlo, ablo, 0x05040100u), cq, yi[4 * k + 0], false);
        yi[4 * k + 1] = __builtin_amdgcn_sdot4((int)__builtin_amdgcn_perm(cdlo, ablo, 0x07060302u), cq, yi[4 * k + 1], false);
        yi[4 * k + 2] = __builtin_amdgcn_sdot4((int)__builtin_amdgcn_perm(cdhi, abhi, 0x05040100u), cq, yi[4 * k + 2], false);
        yi[4 * k + 3] = __builtin_amdgcn_sdot4((int)__builtin_amdgcn_perm(cdhi, abhi, 0x07060302u), cq, yi[4 * k + 3], false);
    }
}
__device__ __forceinline__ void ph_peer_gather(const Params& p, int l, LAS unsigned char* lds, int lane, int wave, int vcu, int tid, bool dry  ) {
    asm volatile("" : "+v"(lane));
    const int g = lane >> 3, c = lane & 7, m0 = vcu * 33;
    LAS int* idxL = (LAS int*)lds;
    LAS float* gatL = (LAS float*)(lds + 16896);
    LAS float* coefL = (LAS float*)(lds + 33792);
    const int* IDX = (const int*)(p.ws + WS_IDX) + (size_t)m0 * 128; const float* GT = (const float*)(p.ws + WS_GATE) + (size_t)m0 * 128;
    __syncthreads();
    { int iv[9]; float gv[9];
#pragma unroll
      for (int k = 0; k < 9; ++k) { const int i = tid + 512 * k; const bool ok = i < 33 * 128; iv[k] = ok ? IDX[i] : 0; gv[k] = ok ? GT[i] : 0.f; }
#pragma unroll
      for (int k = 0; k < 9; ++k) { const int i = tid + 512 * k; if (i < 33 * 128) { idxL[i] = iv[k]; gatL[i] = gv[k]; } } }
    __syncthreads();
    const unsigned char* H8 = p.ws + WS_H8; const float* SH = (const float*)(p.ws + WS_SH); const float* HSQ = (const float*)(p.ws + WS_SH + 512 * 1024);
    const float* SU = (const float*)(p.ws + WS_SU) + l * 16384; const float* SV = (const float*)(p.ws + WS_SV) + l * 16384;
    const unsigned char* U8 = p.ws + WS_U8 + (size_t)l * (32 * MiB); const unsigned char* V8 = p.ws + WS_V8 + (size_t)l * (32 * MiB);
    const __amdgpu_buffer_rsrc_t ru = __builtin_amdgcn_make_buffer_rsrc((void*)U8, 0, 16 << 20, 0x00020000), rv = __builtin_amdgcn_make_buffer_rsrc((void*)V8, 0, 32 << 20, 0x00020000);
    float* DELTA = (float*)(p.ws + WS_DELTA);
    const float* gmod = (const float*)(p.ws + WS_MOD) + ((size_t)l * 2 + (m0 >= T ? 1 : 0)) * D6 + 5 * D;
    unsigned off[33][2];
#pragma unroll
    for (int ui = 0; ui < 33; ++ui)
#pragma unroll
        for (int i = 0; i < 2; ++i) { const int mi = ui < 32 ? 4 * wave + (ui >> 3) : 32, hd = ui < 32 ? (ui & 7) : wave;
            off[ui][i] = (unsigned)idxL[mi * 128 + hd * 16 + 8 * i + g] * 128u + 16u * c; }
    int acc[33][2];
#pragma unroll
    for (int ui = 0; ui < 33; ++ui) { acc[ui][0] = 0; acc[ui][1] = 0; }
#pragma unroll 1
    for (int j = 0; j < 8; ++j) {
        const int so = j << 21;
        i32x4 w[2][4][2], hq[2];
#define U_LOAD(B, U0) do { _Pragma("unroll") for (int uu_ = 0; uu_ < 4; ++uu_) _Pragma("unroll") for (int i_ = 0; i_ < 2; ++i_) if ((U0) + uu_ < 33) \
            w[B][uu_][i_] = __builtin_bit_cast(i32x4, __builtin_amdgcn_raw_buffer_load_b128(ru, off[(U0) + uu_][i_], so, 0)); } while (0)
#define H_LOAD(U0) do { const int mi_ = (U0) < 32 ? 4 * wave + ((U0) >> 3) : 32; const unsigned char* hb_ = H8 + (size_t)(m0 + mi_) * D + j * 256 + 32 * c; hq[0] = *(const i32x4*)hb_; hq[1] = *(const i32x4*)(hb_ + 16); } while (0)
        H_LOAD(0); U_LOAD(0, 0);
#pragma unroll
        for (int u0 = 0; u0 < 36; u0 += 4) {
            const int B = (u0 >> 2) & 1;
            if (u0 + 4 < 36) { if (B) U_LOAD(0, u0 + 4); else U_LOAD(1, u0 + 4); }
#pragma unroll
            for (int uu = 0; uu < 4; ++uu)
#pragma unroll
                for (int i = 0; i < 2; ++i) if (u0 + uu < 33) { const int ui = u0 + uu;
                    int a = acc[ui][i];
#pragma unroll
                    for (int k = 0; k < 4; ++k) { const unsigned ww = (unsigned)w[B][uu][i][k]; const i32x4 hh = hq[k >> 1];
                        a = __builtin_amdgcn_sdot4((int)(ww & 0x0F0F0F0Fu), hh[2 * (k & 1)], a, false); a = __builtin_amdgcn_sdot4((int)((ww >> 4) & 0x0F0F0F0Fu), hh[2 * (k & 1) + 1], a, false); }
                    acc[ui][i] = a; }
            if (B && u0 + 4 < 36) H_LOAD(u0 + 4);
            __builtin_amdgcn_sched_barrier(0);
        }
#undef H_LOAD
#undef U_LOAD
    }
#pragma unroll
    for (int ui = 0; ui < 33; ++ui)
#pragma unroll
        for (int i = 0; i < 2; ++i) { const int mi = ui < 32 ? 4 * wave + (ui >> 3) : 32, hd = ui < 32 ? (ui & 7) : wave, k = hd * 16 + 8 * i + g;
            int t = acc[ui][i]; t += __shfl_xor(t, 1); t += __shfl_xor(t, 2); t += __shfl_xor(t, 4);
            if (c == 0) coefL[mi * 128 + k] = (float)t; }
    __syncthreads();
    {
        float su[9], sv[9], hs[9], sh[9];
#pragma unroll
        for (int k = 0; k < 9; ++k) { const int it = tid + 512 * k; const bool ok = it < 33 * 128; const int mi = ok ? (it >> 7) : 0, e = ok ? idxL[it] : 0;
            su[k] = SU[e]; sv[k] = SV[e]; hs[k] = HSQ[m0 + mi]; sh[k] = SH[m0 + mi]; }
        __builtin_amdgcn_sched_barrier(0);
#pragma unroll
        for (int k = 0; k < 9; ++k) { const int it = tid + 512 * k;
            if (it < 33 * 128) { const float pd = (coefL[it] - 8.f * hs[k]) * su[k] * sh[k];
                coefL[it] = gatL[it] * gelu_erf(pd) * sv[k]; } }
    }
    __syncthreads();
    LAS int* cfqL = (LAS int*)(lds + 50688);
    LAS int* cfq32L = (LAS int*)(lds + 54912);
    LAS float* sTL = (LAS float*)(lds + 55040);
#pragma unroll 1
    for (int tk = 0; tk < 5; ++tk) {
        if (tk == 4 && wave != 0) break;
        const int mi = tk < 4 ? 4 * wave + tk : 32;
        const float am = wave_max(fmaxf(fabsf(coefL[mi * 128 + lane]), fabsf(coefL[mi * 128 + 64 + lane])));
        const float inv = am > 0.f ? 127.f / am : 0.f;
        if (lane == 0) sTL[mi] = am > 0.f ? am * (1.f / 127.f) : 0.f;
        if (lane < 32) { const int hq = lane >> 4, i = (lane >> 3) & 1, g_ = lane & 7; unsigned pk = 0;
#pragma unroll
            for (int uu = 0; uu < 4; ++uu) { const int q = (int)rintf(coefL[mi * 128 + (4 * hq + uu) * 16 + 8 * i + g_] * inv); pk |= ((unsigned)q & 0xffu) << (8 * uu); }
            cfqL[mi * 32 + lane] = (int)pk;
            if (tk == 4) { const int qd = lane >> 3; unsigned p2 = 0;
#pragma unroll
                for (int r = 0; r < 4; ++r) { const int q = (int)rintf(coefL[32 * 128 + 32 * qd + 8 * r + g_] * inv); p2 |= ((unsigned)q & 0xffu) << (8 * r); }
                cfq32L[lane] = (int)p2; } }
    }
    __syncthreads();
    i32x4 w[2][4][2]; int cfq[2][2];
#define V_LOAD(B, HB, SO) do { const int ts_ = (HB) >> 1, hq_ = (HB) & 1, mi_ = 4 * wave + ts_; _Pragma("unroll") for (int uu_ = 0; uu_ < 4; ++uu_) _Pragma("unroll") for (int i_ = 0; i_ < 2; ++i_) \
            w[B][uu_][i_] = __builtin_bit_cast(i32x4, __builtin_amdgcn_raw_buffer_load_b128(rv, off[ts_ * 8 + 4 * hq_ + uu_][i_], (SO), 0)); \
        cfq[B][0] = cfqL[mi_ * 32 + (hq_ * 2 + 0) * 8 + g]; cfq[B][1] = cfqL[mi_ * 32 + (hq_ * 2 + 1) * 8 + g]; } while (0)
    V_LOAD(0, 0, 0);
#pragma unroll 1
    for (int j = 0; j < 16; ++j) {
        const int so = j << 21;
        int yi[16];
#pragma unroll
        for (int hb = 0; hb < 8; ++hb) {
            const int B = hb & 1, ts = hb >> 1, mi = 4 * wave + ts;
            if (hb + 1 < 8) { if (B) V_LOAD(0, hb + 1, so); else V_LOAD(1, hb + 1, so); }
            else if (j + 1 < 16) V_LOAD(0, 0, (j + 1) << 21);
            if (!B) {
#pragma unroll
                for (int q = 0; q < 16; ++q) yi[q] = 0; }
#pragma unroll
            for (int i = 0; i < 2; ++i) dot_rows4(yi, w[B][0][i], w[B][1][i], w[B][2][i], w[B][3][i], cfq[B][i]);
            if (B) {
                float y[16];
#pragma unroll
                for (int q = 0; q < 16; ++q) y[q] = (float)yi[q];
                reduce_scatter_g<16>(y);
                const float st = sTL[mi];
                float* dp = DELTA + (size_t)(m0 + mi) * D + j * 128 + 16 * c + ((lane & 16) ? 8 : 0) + ((lane & 32) ? 4 : 0) + ((lane & 8) ? 2 : 0);
                { const bool b3 = (lane & 8) != 0; *(float2*)dp = make_float2((b3 ? y[2] : y[0]) * st, (b3 ? y[3] : y[1]) * st); }
            }
            __builtin_amdgcn_sched_barrier(0);
        }
#undef V_LOAD
    }
    {
        const float st = sTL[32];
        const int m = m0 + 32;
#pragma unroll 1
        for (int jj = 0; jj < 2; ++jj) { const int j = 2 * wave + jj; const int so = j << 21;
            int yi[16];
#pragma unroll
            for (int q = 0; q < 16; ++q) yi[q] = 0;
#pragma unroll
            for (int k0 = 0; k0 < 16; k0 += 8) {
                i32x4 w8[8];
#pragma unroll
                for (int kk = 0; kk < 8; ++kk) w8[kk] = __builtin_bit_cast(i32x4, __builtin_amdgcn_raw_buffer_load_b128(rv, (unsigned)idxL[32 * 128 + 8 * (k0 + kk) + g] * 128u + 16u * c, so, 0));
                const int c0 = cfq32L[(k0 / 4) * 8 + g], c1 = cfq32L[(k0 / 4 + 1) * 8 + g];
                dot_rows4(yi, w8[0], w8[1], w8[2], w8[3], c0); dot_rows4(yi, w8[4], w8[5], w8[6], w8[7], c1);
                __builtin_amdgcn_sched_barrier(0);
            }
            float y[16];
#pragma unroll
            for (int q = 0; q < 16; ++q) y[q] = (float)yi[q];
            reduce_scatter_g<16>(y);
            float* dp = DELTA + (size_t)m * D + j * 128 + 16 * c + ((lane & 16) ? 8 : 0) + ((lane & 32) ? 4 : 0) + ((lane & 8) ? 2 : 0);
            { const bool b3 = (lane & 8) != 0; *(float2*)dp = make_float2((b3 ? y[2] : y[0]) * st, (b3 ? y[3] : y[1]) * st); }
        }
    }
    (void)gmod;
    {
        asm volatile("s_waitcnt vmcnt(0)" ::: "memory");
        __syncthreads();
#pragma unroll 1
        for (int mi = wave; mi < 33; mi += NWAVES) peer_tail_row(p, l, m0 + mi, lane);
    }
    (void)dry;
}

__device__ __forceinline__ Params load_params(const CAS Params* k) {
    Params r;
#define LP(f) r.f = k->f;
    LP(x) LP(c) LP(ctx) LP(c_ctx) LP(ada_w) LP(ada_b) LP(norm1_g) LP(norm2_g) LP(ab_w_in) LP(ab_gate_b) LP(ab_mh_g) LP(ab_sink) LP(ab_w_out)
    LP(na_w_in) LP(na_rpb) LP(na_w_out) LP(peer_wq) LP(peer_keys) LP(peer_u) LP(peer_v) LP(final_g) LP(out) LP(ws) LP(ph_lo) LP(ph_hi) LP(grid)
#undef LP
    return r;
}
__device__ __forceinline__ int lane_id_opaque() { int x; asm volatile("v_mbcnt_lo_u32_b32 %0, -1, 0\n\tv_mbcnt_hi_u32_b32 %0, -1, %0" : "=v"(x)); return x; }
constexpr int PH_PER_LAYER = 10, PH_FINAL = 1 + DEPTH * PH_PER_LAYER, N_PHASES = PH_FINAL + 1;
template <unsigned PH_MASK> __global__ void __launch_bounds__(NWAVES * 64, 2) fwd_kernel(Params p) {
    extern __shared__ __attribute__((aligned(16))) unsigned char lds_raw[];
    LAS unsigned char* lds = (LAS unsigned char*)lds_raw;
    const int wave = __builtin_amdgcn_readfirstlane((int)threadIdx.x >> 6);
#define LANE_ID() lane_id_opaque()
#define KQ() const CAS Params* kq_ = (const CAS Params*)__builtin_amdgcn_kernarg_segment_ptr(); asm volatile("" : "+s"(kq_))
    volatile LAS unsigned* MISC = (volatile LAS unsigned*)(lds + LDS_MISC);
    if (wave == 0) MISC[LANE_ID()] = 0u;
    __syncthreads();
    { KQ(); (void)xcd_barrier_post((unsigned*)(kq_->ws + WS_CTL) + 4096, MISC + 8, wave * 64 + LANE_ID()); }
#ifdef STAMP_PROBE
#define STAMP_PRE(k) const unsigned long long st0_ = wall_clock64()
#define STAMP_POST(k) do { if (wave * 64 + LANE_ID() == 0) { KQ(); unsigned* sp_ = (unsigned*)(kq_->ws + WS_END); const unsigned long long st1_ = wall_clock64(); \
        sp_[(k) * 256 + blockIdx.x] = (unsigned)(st1_ - st0_); sp_[(64 + (k)) * 256 + blockIdx.x] = (unsigned)st0_; sp_[(128 + (k)) * 256 + blockIdx.x] = (unsigned)st1_; } } while (0)
#else
#define STAMP_PRE(k) do {} while (0)
#define STAMP_POST(k) do {} while (0)
#endif
#define PM(k) (((PH_MASK) >> (k)) & 1u)
#ifndef REP_MASK
#define REP_MASK 0u
#endif
#define REPEAT(k) for (int rep_ = 0; rep_ <= (int)(((REP_MASK) >> (k)) & 1u); ++rep_)
#define IN(k) ({ KQ(); const int k_ = (k); (kq_->ph_lo <= k_ && k_ < kq_->ph_hi); })
#define SEAM(k) do { KQ(); const int k_ = (k); if (kq_->ph_lo <= k_ && k_ + 1 < kq_->ph_hi) { XcdBarrier b_; b_.bar = (unsigned*)(kq_->ws + WS_CTL) + 4096; b_.x = xb_xcc_id(); b_.st = MISC + 8; \
        STAMP_PRE(k_); xcd_barrier(b_, wave * 64 + LANE_ID()); STAMP_POST(k_); } } while (0)
#define LAUNDER() KQ(); const Params pl = load_params(kq_); unsigned char* ws = pl.ws; int ll = LANE_ID(); asm volatile("" : "+v"(ll)); const int tid = wave * 64 + ll; \
    const int G = pl.grid, bx = blockIdx.x, vcu = (G % 8 == 0) ? (bx % 8) * (G / 8) + bx / 8 : bx, gw = vcu * NWAVES + wave, NGW = G * NWAVES; (void)ws; (void)ll; (void)tid; (void)vcu; (void)gw; (void)NGW
    if (PM(0) && IN(0)) REPEAT(0) { LAUNDER(); ph_prologue(pl, lds, tid, ll, wave, vcu, G); __syncthreads(); }
    SEAM(0);
    for (int l = 0; l < DEPTH; ++l) {
        const int pb = 1 + l * PH_PER_LAYER; const bool even = (l & 1) == 0; const int ei = l >> 1; const bool with_ctx = l < DEPTH - 1;
        if (PM(1) && IN(pb + 0) && l == 0) REPEAT(1) { LAUNDER(); ph_norm(pl, l, 0, ll, gw, NGW); ph_fold_wq(pl, lds, ll, wave, gw, NGW); }
        if (l == 0) SEAM(pb + 0);
        if (PM(2) && IN(pb + 1)) REPEAT(2) {
            LAUNDER();
            if (l == 0) ph_fold_bias(pl, ll, gw, NGW);
            const int N = even ? NAB : NNA;
            pg8::Gemm g{(const bf16_t*)(ws + WS_H), even ? (const bf16_t*)(ws + WS_WAB_IN) + (size_t)ei * NAB * D : (const bf16_t*)(ws + WS_WNA_IN) + (size_t)ei * NNA * D, M, N, D};
            pg8::StaticOrder S; S.init(M, N, G, bx);
            EpiInProj E{EpiEven{ws + WS_PROJ, pl.ab_gate_b + ei * 32, (const float2*)(ws + WS_ROPE)}, EpiOdd{ws + WS_PROJ}, even};
            pg8::gemm_phase<EpiInProj, pg8::StaticOrder, false>(lds, g, S, E, nullptr, tid);
            peer_convert_deferred(pl, l, bx, G, wave, ll);
        }
        SEAM(pb + 1);
        if (PM(3) && IN(pb + 2)) REPEAT(3) {
            LAUNDER();
            if (even) { ph_attn_even(pl, ei, with_ctx, lds, tid, ll, wave, vcu, G);
                for (int q = gw; q < NCH * 16; q += NGW) mlstm_A_unit(pl, q >> 4, q & 15, ll); }
            else ph_attn_odd(pl, ei, with_ctx, lds, tid, ll, wave, vcu, G);
        }
        SEAM(pb + 2);
        if (PM(4) && IN(pb + 3)) REPEAT(4) { LAUNDER(); if (even) ph_mlstm_B(pl, lds, tid, G); }
        if (even) SEAM(pb + 3);
        if (PM(5) && IN(pb + 4)) REPEAT(5) { LAUNDER(); if (even) mlstm_C_wg(pl, ei, lds, tid, ll, wave, vcu, G); }
        if (even) SEAM(pb + 4);
        if (PM(6) && IN(pb + 5)) {
            LAUNDER();
            const float* MODl = (const float*)(ws + WS_MOD) + (size_t)l * 2 * D6;
            pg8::Gemm g{(const bf16_t*)(ws + WS_MIX), even ? (const bf16_t*)(ws + WS_WAB_OUT) + (size_t)ei * D * D : (const bf16_t*)(ws + WS_WNA_OUT) + (size_t)ei * D * D, T, D, D};
            pg8::StaticOrder S; S.init(T, D, G, bx);
            EpiResid E{(float*)(ws + WS_X), MODl + 2 * D, MODl + D6 + 2 * D, l == 0 ? pl.x : (const float*)(ws + WS_X), l == 0 ? pl.ctx : (const float*)(ws + WS_X) + (size_t)T * D,
                       ws + WS_XB, (float*)(ws + WS_PART), (float*)(ws + WS_PARTC)};
            pg8::gemm_phase<EpiResid, pg8::StaticOrder, false>(lds, g, S, E, nullptr, tid);
            if (with_ctx) ctx_gemm(g.A, g.Bt, D, E, wave, ll, vcu, G);
        }
        SEAM(pb + 5);
        if (PM(8) && IN(pb + 7)) REPEAT(8) {
            LAUNDER();
            pg8::Gemm g{(const bf16_t*)(ws + WS_XB), (const bf16_t*)(ws + WS_WQ) + (size_t)l * D * D, T, D, D};
            pg8::StaticOrder S; S.init(T, D, G, bx);
            EpiQ E{(bf16_t*)(ws + WS_QP), (const float*)(ws + WS_PART), (const float*)(ws + WS_BQ) + (size_t)(l * 2) * D};
            pg8::gemm_phase<EpiQ, pg8::StaticOrder, false>(lds, g, S, E, nullptr, tid);
            const int cpc = G - 1 - vcu;
            if (with_ctx && cpc < 128) { int l2 = ll; asm volatile("" : "+v"(l2)); EpiQC Ec{(bf16_t*)(ws + WS_QP), (const float*)(ws + WS_PARTC), (const float*)(ws + WS_BQ) + (size_t)(l * 2 + 1) * D};
                ctx_gemm_piece<EpiQC, 2>(g.A, (const bf16_t*)(ws + WS_WQC) + (size_t)l * D * D, Ec, cpc & 15, cpc >> 4, wave, l2); }
            asm volatile("s_waitcnt vmcnt(0)" ::: "memory");
            __syncthreads();
            { pg8::Unit u; const bool has = S.next(0, u);
#pragma unroll 1
              for (int j = 0; j < 3; ++j) {
                  const bool ok = j < 2 ? has : (with_ctx && cpc < 128 && wave == 0);
                  const int mt = j < 2 ? u.pm * 16 + 8 * j + wave : 512 + (cpc & 15), hh = j < 2 ? u.pn : (cpc >> 4);
                  if (ok) peer_topk_unit(pl, l, mt, hh, ll); } }
            { int l3 = ll; asm volatile("" : "+v"(l3));
              if (!with_ctx) h8_rows<33>(pl, l, vcu * 33, l3, wave); else if (vcu < 128) h8_rows<66>(pl, l, vcu * 66, l3, wave); }
        }
        SEAM(pb + 7);
        if (PM(10) && IN(pb + 9)) REPEAT(10) { LAUNDER(); ph_peer_gather(pl, l, lds, ll, wave, vcu, tid, rep_ < (int)(((REP_MASK) >> 10) & 1u)); }
        if (l + 1 < DEPTH) SEAM(pb + 9);
    }
#ifdef STAMP_PROBE
    {
        { KQ(); XcdBarrier b_; b_.bar = (unsigned*)(kq_->ws + WS_CTL) + 4096; b_.x = xb_xcc_id(); b_.st = MISC + 8; xcd_barrier(b_, wave * 64 + LANE_ID()); }
        LAUNDER();
        const unsigned* ST = (const unsigned*)(ws + WS_END);
        float smean = 0.f, smax = 0.f;
        for (int w = ll; w < 256; w += 64) { const float d = (float)(ST[(64 + STAMP_SEL) * 256 + w] - ST[(128 + STAMP_PREV) * 256 + w]) * 0.01f; smean += d; smax = fmaxf(smax, d); }
        smean = wave_sum(smean) * (1.f / 256.f); smax = wave_max(smax);
        const float c1 = smax * 0.05f, c2 = 0.f; (void)smean;
        for (size_t i = (size_t)bx * 512 + tid; i < (size_t)T * D; i += (size_t)G * 512) pl.out[i] = c1 + c2;
    }
#endif
#undef IN
#undef SEAM
#undef LAUNDER
#undef LANE_ID
#undef KQ
#undef PM
}

#ifndef ONE_MASK
#define ONE_MASK 0xFFFu
#endif
#ifndef MK_ONE_LAUNCH
#define MK_ONE_LAUNCH 1
#endif
typedef void (*kern_t)(Params);
#if !MK_ONE_LAUNCH
static kern_t kern_for_bit(int b) {
    switch (b) {
        case 0: return fwd_kernel<1u << 0>; case 1: return fwd_kernel<1u << 1>; case 2: return fwd_kernel<1u << 2>; case 3: return fwd_kernel<1u << 3>;
        case 4: return fwd_kernel<1u << 4>; case 5: return fwd_kernel<1u << 5>; case 6: return fwd_kernel<1u << 6>; case 7: return fwd_kernel<1u << 7>;
        case 8: return fwd_kernel<1u << 8>; case 9: return fwd_kernel<1u << 9>; case 10: return fwd_kernel<1u << 10>; default: return fwd_kernel<1u << 11>;
    }
}
#endif
extern "C" void kernel_launch(void* const* d_in, const int* in_sizes, int n_in, void* d_out, int out_size, void* d_ws, size_t ws_size, hipStream_t stream) {
    static int grid = 0;
    if (grid == 0) {
        int dev = 0, cus = 0;
        if (n_in != 21 || ws_size < WS_END) { fprintf(stderr, "kernel_launch: unexpected inputs (n_in %d, ws %zu)\n", n_in, ws_size); grid = -1; return; }
        if (hipGetDevice(&dev) != hipSuccess || hipDeviceGetAttribute(&cus, hipDeviceAttributeMultiprocessorCount, dev) != hipSuccess) { grid = -1; return; }
#if MK_ONE_LAUNCH
        if (hipFuncSetAttribute((const void*)fwd_kernel<ONE_MASK>, hipFuncAttributeMaxDynamicSharedMemorySize, LDS_BYTES) != hipSuccess) { fprintf(stderr, "kernel_launch: hipFuncSetAttribute failed\n"); grid = -1; return; }
#else
        for (int b = 0; b < 12; ++b) if (hipFuncSetAttribute((const void*)kern_for_bit(b), hipFuncAttributeMaxDynamicSharedMemorySize, LDS_BYTES) != hipSuccess) { fprintf(stderr, "kernel_launch: hipFuncSetAttribute failed\n"); grid = -1; return; }
#endif
        (void)hipGetLastError();
        grid = cus;
    }
    if (grid < 0) return;
    (void)hipMemsetAsync((char*)d_ws + WS_CTL, 0, CTL_ZERO_BYTES, stream);
#ifdef STAMP_PROBE
    (void)hipMemsetAsync((char*)d_ws + WS_END, 0, 192 * 256 * 4, stream);
#endif
    Params p{};
    const float** pin = (const float**)&p;
    for (int i = 0; i < 21; ++i) pin[i] = (const float*)d_in[i];
    p.out = (float*)d_out; p.ws = (unsigned char*)d_ws; p.grid = grid; p.pad = 0;
#if MK_ONE_LAUNCH
    p.ph_lo = 0; p.ph_hi = N_PHASES;
    hipLaunchKernelGGL(fwd_kernel<ONE_MASK>, dim3(grid), dim3(NWAVES * 64), LDS_BYTES, stream, p);
#else
    for (int ph = 0; ph < N_PHASES; ++ph) {
        int bit = 0;
        if (ph == PH_FINAL) bit = 11;
        else if (ph >= 1) { const int l = (ph - 1) / PH_PER_LAYER, k = (ph - 1) % PH_PER_LAYER; if ((l & 1) && (k == 3 || k == 4)) continue; bit = 1 + k; }
        p.ph_lo = ph; p.ph_hi = ph + 1;
        hipLaunchKernelGGL(kern_for_bit(bit), dim3(grid), dim3(NWAVES * 64), LDS_BYTES, stream, p);
    }
#endif
}
```
